# Optimizing an MI355X kernel written in HIP

```python
import jax, jax.numpy as jnp
from jax import lax
import numpy as np

D_MODEL = 1024
BATCH = 8
SEQ = 4096
DEPTH = 4

PLE_DIM = 256
CHUNK = 128
A_WIDTH = D_MODEL
A_GROUPS = 8
A_GROUP_DIM = A_WIDTH // A_GROUPS
B_HEAD_DIM = 64
B_HEADS = D_MODEL // B_HEAD_DIM
B_WIDTH = B_HEADS * B_HEAD_DIM
Q_BLOCK = 128
IN_SIZES = (A_WIDTH, A_WIDTH, A_WIDTH, B_WIDTH, B_WIDTH, B_WIDTH, B_WIDTH, D_MODEL, D_MODEL)
IN_WIDTH = 3 * A_WIDTH + 4 * B_WIDTH + 2 * D_MODEL
ALPHA = (2 * DEPTH) ** 0.25
BETA = (8 * DEPTH) ** -0.25
LN_EPS = 1e-5

kernel_name = "gated_gmlp_stickbreaking_deepnorm_trunk"


def _layer_norm(x, g, b):
    xf = x.astype(jnp.float32)
    mu = jnp.mean(xf, axis=-1, keepdims=True)
    var = jnp.mean(jnp.square(xf - mu), axis=-1, keepdims=True)
    return ((xf - mu) * lax.rsqrt(var + LN_EPS) * g.astype(jnp.float32) + b.astype(jnp.float32)).astype(x.dtype)


def _chunked_spatial_gating(u, v, vn_g, vn_b, w_s, b_s):
    bsz, seq, _ = v.shape
    vn = _layer_norm(v, vn_g, vn_b).reshape(bsz, seq // CHUNK, CHUNK, A_GROUPS, A_GROUP_DIM)
    causal = jnp.tril(jnp.ones((CHUNK, CHUNK), dtype=bool))
    ws = jnp.where(causal, w_s, jnp.zeros((), w_s.dtype))
    mixed = jnp.einsum('gts,bcsgd->bctgd', ws, vn) + b_s.T[None, None, :, :, None]
    return u * mixed.reshape(bsz, seq, A_WIDTH)


def _stick_breaking_attention(q, k, v):
    bsz, seq, _ = q.shape

    def heads(t):
        return t.reshape(bsz, seq, B_HEADS, B_HEAD_DIM).transpose(0, 2, 1, 3).astype(jnp.float32)

    qh, kh, vh = heads(q), heads(k), heads(v)
    scale = B_HEAD_DIM ** -0.5
    outs = []
    for start in range(0, seq, Q_BLOCK):
        end = start + Q_BLOCK
        z = jnp.einsum('bhtd,bhsd->bhts', qh[:, :, start:end], kh[:, :, :end]) * scale
        t_pos = start + jnp.arange(Q_BLOCK)[:, None]
        s_pos = jnp.arange(end)[None, :]
        strict = s_pos < t_pos
        log_keep = jnp.where(strict, jax.nn.log_sigmoid(-z), 0.0)
        between = lax.cumsum(log_keep, axis=3, reverse=True) - log_keep
        weights = jnp.where(strict, jnp.exp(jax.nn.log_sigmoid(z) + between), 0.0)
        outs.append(jnp.einsum('bhts,bhsd->bhtd', weights, vh[:, :, :end]))
    o = jnp.concatenate(outs, axis=2)
    return o.transpose(0, 2, 1, 3).reshape(bsz, seq, B_WIDTH).astype(v.dtype)


def _layer(x, p_i, w_in, vn_g, vn_b, w_s, b_s, w_pa, w_pb, w_out, w_pe, w_pg, ln_g, ln_b):
    proj = jnp.einsum('bsd,dn->bsn', x, w_in)
    split_points = [int(s) for s in np.cumsum(IN_SIZES)[:-1]]
    u, v, gate_a, q, k, v_b, gate_b, merge_a, merge_b = jnp.split(proj, split_points, axis=-1)
    y_a = _chunked_spatial_gating(u, v, vn_g, vn_b, w_s, b_s) * jax.nn.silu(gate_a)
    y_b = _stick_breaking_attention(q, k, v_b) * jax.nn.silu(gate_b)
    merged = (jax.nn.sigmoid(merge_a) * jnp.einsum('bsc,cd->bsd', y_a, w_pa)
              + jax.nn.sigmoid(merge_b) * jnp.einsum('bsc,cd->bsd', y_b, w_pb))
    y = jnp.einsum('bsd,de->bse', merged, w_out)
    h = ALPHA * x + y
    h = h + jnp.einsum('bsp,pd->bsd', p_i, w_pe) * jax.nn.sigmoid(jnp.einsum('bsd,de->bse', h, w_pg))
    return _layer_norm(h, ln_g, ln_b)


def setup_inputs(seed: int = 0) -> dict:
    key = jax.random.key(seed)
    ks = jax.random.split(key, 15)
    f32 = jnp.float32
    d_sc = D_MODEL ** -0.5
    return {
        "x": jax.random.normal(ks[0], (BATCH, SEQ, D_MODEL), f32),
        "p": jax.random.normal(ks[1], (DEPTH, BATCH, SEQ, PLE_DIM), f32),
        "w_in": jax.random.normal(ks[2], (DEPTH, D_MODEL, IN_WIDTH), f32) * d_sc,
        "vn_g": 1.0 + 0.02 * jax.random.normal(ks[3], (DEPTH, A_WIDTH), f32),
        "vn_b": 0.02 * jax.random.normal(ks[4], (DEPTH, A_WIDTH), f32),
        "w_s": jax.random.normal(ks[5], (DEPTH, A_GROUPS, CHUNK, CHUNK), f32) * CHUNK ** -0.5,
        "b_s": 1.0 + 0.02 * jax.random.normal(ks[6], (DEPTH, A_GROUPS, CHUNK), f32),
        "w_pa": jax.random.normal(ks[7], (DEPTH, A_WIDTH, D_MODEL), f32) * A_WIDTH ** -0.5,
        "w_pb": jax.random.normal(ks[8], (DEPTH, B_WIDTH, D_MODEL), f32) * B_WIDTH ** -0.5,
        "w_out": jax.random.normal(ks[9], (DEPTH, D_MODEL, D_MODEL), f32) * d_sc * BETA,
        "w_pe": jax.random.normal(ks[10], (DEPTH, PLE_DIM, D_MODEL), f32) * PLE_DIM ** -0.5,
        "w_pg": jax.random.normal(ks[11], (DEPTH, D_MODEL, D_MODEL), f32) * d_sc,
        "ln_g": 1.0 + 0.02 * jax.random.normal(ks[12], (DEPTH, D_MODEL), f32),
        "ln_b": 0.02 * jax.random.normal(ks[13], (DEPTH, D_MODEL), f32),
    }


def reference(x, p, w_in, vn_g, vn_b, w_s, b_s, w_pa, w_pb, w_out, w_pe, w_pg, ln_g, ln_b):
    for i in range(DEPTH):
        x = _layer(x, p[i], w_in[i], vn_g[i], vn_b[i], w_s[i], b_s[i], w_pa[i], w_pb[i],
                   w_out[i], w_pe[i], w_pg[i], ln_g[i], ln_b[i])
    return x
```

```cpp
#include <hip/hip_runtime.h>
#include <hip/hip_cooperative_groups.h>
#include <cstdio>
#include <cstdint>
namespace cg = cooperative_groups;
namespace pg8 {
#define PG8_LAS __attribute__((address_space(3)))
typedef unsigned short bf16_t;
typedef short bf16x8 __attribute__((ext_vector_type(8)));
typedef _Float16 f16x8 __attribute__((ext_vector_type(8)));
typedef float f32x4 __attribute__((ext_vector_type(4)));
typedef unsigned u32x4 __attribute__((ext_vector_type(4)));
constexpr int BM = 256, BK = 64, HALF = 128, HTB = HALF * BK * 2  , STAGE_BYTES = 8 * HTB, NXCD = 8, WGM = 8;

__host__ __device__ __forceinline__ int lds_byte(int r, int c) { const int st = (r >> 4) * 2 + (c >> 5), rr = r & 15, cc = c & 31, ob = rr * 64 + cc * 2; return st * 1024 + (ob ^ (((ob >> 9) & 1) << 5)); }
__host__ __device__ __forceinline__ void stage_rc(int b, int& R, int& C) { const int st = b / 1024, sb = b % 1024, swz = sb ^ (((sb >> 9) & 1) << 5); R = (st >> 1) * 16 + swz / 64; C = (st & 1) * 32 + (swz % 64) / 2; }
__host__ __device__ __forceinline__ int perm32(int rho) { const int n = rho >> 4, i = rho & 15; return 8 * (i >> 2) + 4 * n + (i & 3); }

struct Unit { int pm, pn; };
struct Gemm { const bf16_t* A; const bf16_t* Bt; int M, N, K, lda; };

struct StaticOrder {
    int nM, nN, nwg, G, c;
    __host__ __device__ void init(int M, int N, int G_, int c_) { nM = M / BM; nN = N / BM; nwg = nM * nN; G = G_; c = c_; }
    __host__ __device__ bool next(int i, Unit& u) const {
        const long L = (long)i * G + c; if (L >= nwg) return false;
        int wgid = (int)L; { const int q = nwg / NXCD, r = nwg % NXCD, xcd = wgid % NXCD, off = wgid / NXCD; wgid = (xcd < r ? xcd * (q + 1) : r * (q + 1) + (xcd - r) * q) + off; }
        const int nig = WGM * nN, gid = wgid / nig, fm = gid * WGM, gsz = (nM - fm) < WGM ? (nM - fm) : WGM;
        u.pm = fm + ((wgid % nig) % gsz); u.pn = (wgid % nig) / gsz; return true;
    }
    __device__ __forceinline__ void a_ready(const Unit&) const {}
    __device__ __forceinline__ void done(const Unit&) const {}
};
struct GateOrder {
    StaticOrder inner;
    __host__ __device__ void init(int M, int G_, int c_) { inner.init(M, 1024, G_, c_); }
    __host__ __device__ bool next(int i, Unit& u) const { Unit v; if (!inner.next(i >> 1, v)) return false; u.pm = v.pm; u.pn = 2 * v.pn + (i & 1); return true; }
    __device__ __forceinline__ void a_ready(const Unit&) const {}
    __device__ __forceinline__ void done(const Unit&) const {}
};


typedef float f32x2_t __attribute__((ext_vector_type(2))); typedef __bf16 bf16x2_t __attribute__((ext_vector_type(2)));
__device__ __forceinline__ unsigned cvt_pk_bf16(float lo, float hi) { f32x2_t v = {lo, hi}; bf16x2_t b = __builtin_convertvector(v, bf16x2_t); return __builtin_bit_cast(unsigned, b); }
__device__ __forceinline__ float sigm(float x) { return __builtin_amdgcn_rcpf(1.f + __builtin_amdgcn_exp2f(-1.4426950408889634f * x)); }
__device__ __forceinline__ u32x4 pack8(const f32x4 a, const f32x4 b) { u32x4 w; w.x = cvt_pk_bf16(a[0], a[1]); w.y = cvt_pk_bf16(a[2], a[3]); w.z = cvt_pk_bf16(b[0], b[1]); w.w = cvt_pk_bf16(b[2], b[3]); return w; }
__device__ __forceinline__ void unpack8(const u32x4 w, f32x4& a, f32x4& b) {
    a[0] = __uint_as_float(w.x << 16); a[1] = __uint_as_float(w.x & 0xffff0000u); a[2] = __uint_as_float(w.y << 16); a[3] = __uint_as_float(w.y & 0xffff0000u);
    b[0] = __uint_as_float(w.z << 16); b[1] = __uint_as_float(w.z & 0xffff0000u); b[2] = __uint_as_float(w.w << 16); b[3] = __uint_as_float(w.w & 0xffff0000u); }
typedef _Float16 f16x2_t __attribute__((ext_vector_type(2)));
__device__ __forceinline__ unsigned cvt_pk_f16(float lo, float hi) { f32x2_t v = {lo, hi}; f16x2_t h = __builtin_convertvector(v, f16x2_t); return __builtin_bit_cast(unsigned, h); }
__device__ __forceinline__ u32x4 pack8h(const f32x4 a, const f32x4 b) { u32x4 w; w.x = cvt_pk_f16(a[0], a[1]); w.y = cvt_pk_f16(a[2], a[3]); w.z = cvt_pk_f16(b[0], b[1]); w.w = cvt_pk_f16(b[2], b[3]); return w; }
__device__ __forceinline__ void unpack8h(const u32x4 w, f32x4& a, f32x4& b) {
    const unsigned x0 = w.x, x1 = w.y, x2 = w.z, x3 = w.w;
    const f32x2_t p0 = __builtin_convertvector(__builtin_bit_cast(f16x2_t, x0), f32x2_t), p1 = __builtin_convertvector(__builtin_bit_cast(f16x2_t, x1), f32x2_t);
    const f32x2_t p2 = __builtin_convertvector(__builtin_bit_cast(f16x2_t, x2), f32x2_t), p3 = __builtin_convertvector(__builtin_bit_cast(f16x2_t, x3), f32x2_t);
    a[0] = p0[0]; a[1] = p0[1]; a[2] = p1[0]; a[3] = p1[1]; b[0] = p2[0]; b[1] = p2[1]; b[2] = p3[0]; b[3] = p3[1]; }
#define PG8_FENCE asm volatile("" ::: "memory")

struct Epi1 {
    static constexpr bool PERM = true, AFTER_DRAIN = false, HAS_MID = false;
    bf16_t *UGQ, *V, *K, *VB, *GB; float qscale; int dry;
    __device__ __forceinline__ void operator()(const f32x4 (&acc)[2][2][4][2], const Unit& u, int wr, int wc, int fr, int fq) const {
        asm volatile("" : "+v"(fr), "+v"(fq));
        const int row0 = u.pm * BM + wr * 64 + fr, cw = wc * 32 + 8 * fq;
        if (dry) { if (acc[0][0][0][0][0] == 1.2345e-30f) UGQ[row0] = 1; return; }
        if (u.pn < 8) {
            bf16_t* base = UGQ + u.pn * 128 + cw;
#pragma unroll
            for (int ai = 0; ai < 2; ++ai)
#pragma unroll
                for (int m = 0; m < 4; ++m) {
                    f32x4 u0 = acc[ai][0][m][0], u1 = acc[ai][0][m][1]; const f32x4 g0 = acc[ai][1][m][0], g1 = acc[ai][1][m][1];
#pragma unroll
                    for (int e = 0; e < 4; ++e) { u0[e] *= g0[e] * sigm(g0[e]); u1[e] *= g1[e] * sigm(g1[e]); }
                    __builtin_nontemporal_store(pack8(u0, u1), (u32x4*)(base + (size_t)(row0 + ai * HALF + m * 16) * 2048));
                }
        } else {
            const int seg = (u.pn - 8) >> 2, ct = (u.pn - 8) & 3;
            bf16_t* base; int ldc = 1024; float sc = 1.f;
            if (seg == 0) base = V; else if (seg == 1) { base = UGQ + 1024; ldc = 2048; sc = qscale; } else if (seg == 2) base = K; else if (seg == 3) base = VB; else base = GB;
            base += ct * 256 + cw;
#pragma unroll
            for (int ai = 0; ai < 2; ++ai)
#pragma unroll
                for (int m = 0; m < 4; ++m) { bf16_t* rowp = base + (size_t)(row0 + ai * HALF + m * 16) * ldc;
#pragma unroll
                    for (int bj = 0; bj < 2; ++bj) __builtin_nontemporal_store(pack8(acc[ai][bj][m][0] * sc, acc[ai][bj][m][1] * sc), (u32x4*)(rowp + bj * HALF)); }
        }
    }
};
template <int SIG> struct EpiStore {
    static constexpr bool PERM = true, AFTER_DRAIN = false, HAS_MID = false;
    bf16_t *D0, *D1;
    __device__ __forceinline__ void operator()(const f32x4 (&acc)[2][2][4][2], const Unit& u, int wr, int wc, int fr, int fq) const {
        asm volatile("" : "+v"(fr), "+v"(fq));
        const int row0 = u.pm * BM + wr * 64 + fr, cw = wc * 32 + 8 * fq;
        bf16_t* base = (u.pn < 4 ? D0 : D1) + (u.pn & 3) * 256 + cw;
#pragma unroll
        for (int ai = 0; ai < 2; ++ai)
#pragma unroll
            for (int m = 0; m < 4; ++m) { bf16_t* rowp = base + (size_t)(row0 + ai * HALF + m * 16) * 1024;
#pragma unroll
                for (int bj = 0; bj < 2; ++bj) { f32x4 v0 = acc[ai][bj][m][0], v1 = acc[ai][bj][m][1];
                    if (SIG) {
#pragma unroll
                        for (int e = 0; e < 4; ++e) { v0[e] = sigm(v0[e]); v1[e] = sigm(v1[e]); } }
                    __builtin_nontemporal_store(pack8(v0, v1), (u32x4*)(rowp + bj * HALF)); } }
    }
};
struct EpiGate {
    static constexpr bool PERM = true, AFTER_DRAIN = false, HAS_MID = false;
    bf16_t *RHO, *SMB;
    __device__ __forceinline__ void operator()(const f32x4 (&acc)[2][2][4][2], const Unit& u, int wr, int wc, int fr, int fq) const {
        asm volatile("" : "+v"(fr), "+v"(fq));
        const int row0 = u.pm * BM + wr * 64 + fr, c0 = u.pn * 128 + wc * 32 + 8 * fq;
#pragma unroll
        for (int ai = 0; ai < 2; ++ai)
#pragma unroll
            for (int m = 0; m < 4; ++m) { const size_t off = (size_t)(row0 + ai * HALF + m * 16) * 1024 + c0;
                f32x4 r0, r1, s0, s1;
#pragma unroll
                for (int e = 0; e < 4; ++e) {
                    const float ea0 = __builtin_amdgcn_exp2f(fminf(-1.4426950408889634f * acc[ai][0][m][0][e], 80.f)), eb0 = __builtin_amdgcn_exp2f(fminf(-1.4426950408889634f * acc[ai][1][m][0][e], 80.f));
                    const float ea1 = __builtin_amdgcn_exp2f(fminf(-1.4426950408889634f * acc[ai][0][m][1][e], 80.f)), eb1 = __builtin_amdgcn_exp2f(fminf(-1.4426950408889634f * acc[ai][1][m][1][e], 80.f));
                    r0[e] = (1.f + eb0) * __builtin_amdgcn_rcpf(1.f + ea0); r1[e] = (1.f + eb1) * __builtin_amdgcn_rcpf(1.f + ea1);
                    s0[e] = __builtin_amdgcn_rcpf(1.f + eb0); s1[e] = __builtin_amdgcn_rcpf(1.f + eb1); }
                *(u32x4*)(RHO + off) = pack8(r0, r1); *(u32x4*)(SMB + off) = pack8(s0, s1); }
    }
};
struct Epi2 {
    static constexpr bool PERM = true, AFTER_DRAIN = false, HAS_MID = true;
    const bf16_t *SMA, *SMB; bf16_t* OUT;
    __device__ __forceinline__ void mid(f32x4 (&acc)[2][2][4][2], const Unit& u, int wr, int wc, int fr, int fq) const {
        asm volatile("" : "+v"(fr), "+v"(fq));
        const int row0 = u.pm * BM + wr * 64 + fr, c0 = u.pn * BM + wc * 32 + 8 * fq;
#pragma unroll
        for (int ai = 0; ai < 2; ++ai) {
            u32x4 wa[4][2];
#pragma unroll
            for (int m = 0; m < 4; ++m) { const size_t off = (size_t)(row0 + ai * HALF + m * 16) * 1024 + c0;
#pragma unroll
                for (int bj = 0; bj < 2; ++bj) wa[m][bj] = *(const u32x4*)(SMA + off + bj * HALF); }
            PG8_FENCE;
#pragma unroll
            for (int m = 0; m < 4; ++m)
#pragma unroll
                for (int bj = 0; bj < 2; ++bj) { f32x4 a0, a1; unpack8(wa[m][bj], a0, a1); acc[ai][bj][m][0] *= a0; acc[ai][bj][m][1] *= a1; }
            PG8_FENCE; }
    }
    __device__ __forceinline__ void operator()(const f32x4 (&acc)[2][2][4][2], const Unit& u, int wr, int wc, int fr, int fq) const {
        asm volatile("" : "+v"(fr), "+v"(fq));
        const int row0 = u.pm * BM + wr * 64 + fr, c0 = u.pn * BM + wc * 32 + 8 * fq;
        u32x4 wb[2][4][2];
#pragma unroll
        for (int ai = 0; ai < 2; ++ai)
#pragma unroll
            for (int m = 0; m < 4; ++m) { const size_t off = (size_t)(row0 + ai * HALF + m * 16) * 1024 + c0;
#pragma unroll
                for (int bj = 0; bj < 2; ++bj) wb[ai][m][bj] = *(const u32x4*)(SMB + off + bj * HALF); }
        PG8_FENCE;
#pragma unroll
        for (int ai = 0; ai < 2; ++ai)
#pragma unroll
            for (int m = 0; m < 4; ++m) { const size_t off = (size_t)(row0 + ai * HALF + m * 16) * 1024 + c0;
#pragma unroll
                for (int bj = 0; bj < 2; ++bj) { f32x4 b0, b1; unpack8(wb[ai][m][bj], b0, b1);
                    *(u32x4*)(OUT + off + bj * HALF) = pack8(acc[ai][bj][m][0] * b0, acc[ai][bj][m][1] * b1); } }
    }
};
struct Epi3 {
    static constexpr bool PERM = true, AFTER_DRAIN = false, HAS_MID = false;
    const bf16_t* XH; bf16_t* XO; float alpha;
    __device__ __forceinline__ void operator()(const f32x4 (&acc)[2][2][4][2], const Unit& u, int wr, int wc, int fr, int fq) const {
        asm volatile("" : "+v"(fr), "+v"(fq));
        const int row0 = u.pm * BM + wr * 64 + fr, c0 = u.pn * BM + wc * 32 + 8 * fq;
#pragma unroll
        for (int ai = 0; ai < 2; ++ai) {
            u32x4 wx[4][2];
#pragma unroll
            for (int m = 0; m < 4; ++m) { const size_t off = (size_t)(row0 + ai * HALF + m * 16) * 1024 + c0;
#pragma unroll
                for (int bj = 0; bj < 2; ++bj) wx[m][bj] = *(const u32x4*)(XH + off + bj * HALF); }
            PG8_FENCE;
#pragma unroll
            for (int m = 0; m < 4; ++m) { const size_t off = (size_t)(row0 + ai * HALF + m * 16) * 1024 + c0;
#pragma unroll
                for (int bj = 0; bj < 2; ++bj) { f32x4 r0, r1; unpack8h(wx[m][bj], r0, r1);
                    const f32x4 h0 = r0 * alpha + acc[ai][bj][m][0], h1 = r1 * alpha + acc[ai][bj][m][1];
                    *(u32x4*)(XO + off + bj * HALF) = pack8h(h0, h1); } }
            PG8_FENCE; }
    }
};
struct Epi4 {
    static constexpr bool PERM = true, AFTER_DRAIN = false, HAS_MID = false;
    const bf16_t* H0; bf16_t* XO; const bf16_t* E;
    __device__ __forceinline__ void operator()(const f32x4 (&acc)[2][2][4][2], const Unit& u, int wr, int wc, int fr, int fq) const {
        asm volatile("" : "+v"(fr), "+v"(fq));
        const int row0 = u.pm * BM + wr * 64 + fr, c0 = u.pn * BM + wc * 32 + 8 * fq;
#pragma unroll
        for (int ai = 0; ai < 2; ++ai) {
            u32x4 wx[4][2], we[4][2];
#pragma unroll
            for (int m = 0; m < 4; ++m) { const size_t off = (size_t)(row0 + ai * HALF + m * 16) * 1024 + c0;
#pragma unroll
                for (int bj = 0; bj < 2; ++bj) { wx[m][bj] = *(const u32x4*)(H0 + off + bj * HALF); we[m][bj] = *(const u32x4*)(E + off + bj * HALF); } }
            PG8_FENCE;
#pragma unroll
            for (int m = 0; m < 4; ++m) { const size_t off = (size_t)(row0 + ai * HALF + m * 16) * 1024 + c0;
#pragma unroll
                for (int bj = 0; bj < 2; ++bj) { f32x4 h0, h1, e0, e1; unpack8h(wx[m][bj], h0, h1); unpack8(we[m][bj], e0, e1);
#pragma unroll
                    for (int e = 0; e < 4; ++e) { h0[e] += e0[e] * sigm(acc[ai][bj][m][0][e]); h1[e] += e1[e] * sigm(acc[ai][bj][m][1][e]); }
                    *(u32x4*)(XO + off + bj * HALF) = pack8h(h0, h1); } }
            PG8_FENCE; }
    }
};
template <class Epi, class Sched, bool ALIGN_EPI = false, bool SP2 = false, bool F16 = false>
__device__ __forceinline__ void gemm_phase(PG8_LAS unsigned char* lds, const Gemm g, const Sched& S, const Epi& E) {
    int tid_ = threadIdx.x; asm volatile("" : "+v"(tid_));
    const int tid = tid_, wid = __builtin_amdgcn_readfirstlane(tid >> 6), lane = tid & 63, wr = wid >> 2, wc = wid & 3, fr = lane & 15, fq = lane >> 4;
    const int K = g.K, nt = K / BK;
    unsigned voffA[2], voffB[2];
#pragma unroll
    for (int i = 0; i < 2; ++i) { int R, C; stage_rc(tid * 16 + i * 8192, R, C); const int Rb = Epi::PERM ? ((R & ~31) + perm32(R & 31)) : R;
        voffA[i] = (unsigned)(R * g.lda + C) * 2u; voffB[i] = (unsigned)(Rb * K + C) * 2u; }
    const size_t kstep = (size_t)(BK * 2);
    const size_t hstepA = (size_t)HALF * g.lda * 2, hstepB = (size_t)HALF * K * 2;
    const size_t tstepA = 2 * hstepA, tstepB = 2 * hstepB;
    const unsigned ldsw = (unsigned)wid * 1024u;
    const int aoff = lds_byte(wr * 64 + fr, fq * 8), boff = lds_byte(wc * 32 + fr, fq * 8);
#define PG8_SA(b, h) (((b) * 2 + (h)) * HTB)
#define PG8_SB(b, h) ((4 + (b) * 2 + (h)) * HTB)
#define PG8_STAGE(bufoff, gbase, voff) do { _Pragma("unroll") for (int _i = 0; _i < 2; ++_i) \
        __builtin_amdgcn_global_load_lds((const unsigned*)((const char*)(gbase) + (voff)[_i]), (PG8_LAS unsigned*)(lds + (bufoff) + ldsw + _i * 8192), 16, 0, 0); } while (0)
#define PG8_LDA(dst, b, h) do { _Pragma("unroll") for (int m = 0; m < 4; ++m) _Pragma("unroll") for (int k = 0; k < 2; ++k) dst[m][k] = *(const PG8_LAS bf16x8*)(lds + PG8_SA(b, h) + aoff + m * 2048 + k * 1024); } while (0)
#define PG8_LDB(dst, b, h) do { _Pragma("unroll") for (int n = 0; n < 2; ++n) _Pragma("unroll") for (int k = 0; k < 2; ++k) dst[n][k] = *(const PG8_LAS bf16x8*)(lds + PG8_SB(b, h) + boff + n * 2048 + k * 1024); } while (0)
#define PG8_MMA(ai, bj, At, Bt) do { __builtin_amdgcn_s_setprio(1); _Pragma("unroll") for (int m = 0; m < 4; ++m) _Pragma("unroll") for (int n = 0; n < 2; ++n) _Pragma("unroll") for (int k = 0; k < 2; ++k) \
        { if constexpr (F16) acc[ai][bj][m][n] = __builtin_amdgcn_mfma_f32_16x16x32_f16(__builtin_bit_cast(f16x8, Bt[n][k]), __builtin_bit_cast(f16x8, At[m][k]), acc[ai][bj][m][n], 0, 0, 0); \
          else acc[ai][bj][m][n] = __builtin_amdgcn_mfma_f32_16x16x32_bf16(Bt[n][k], At[m][k], acc[ai][bj][m][n], 0, 0, 0); } __builtin_amdgcn_s_setprio(0); } while (0)
#define PG8_WAIT_V(n) asm volatile("s_waitcnt vmcnt(" #n ")" ::: "memory")
#define PG8_WAIT_L(n) asm volatile("s_waitcnt lgkmcnt(" #n ")" ::: "memory")
#define PG8_BAR __builtin_amdgcn_s_barrier()
#define PG8_SCHED __builtin_amdgcn_sched_barrier(0)
    Unit cur, nxt; int ui = 0;
    if (!S.next(0, cur)) return;
    f32x4 acc[2][2][4][2];
#pragma unroll
    for (int a = 0; a < 2; ++a)
#pragma unroll
        for (int b = 0; b < 2; ++b)
#pragma unroll
            for (int m = 0; m < 4; ++m)
#pragma unroll
                for (int n = 0; n < 2; ++n) acc[a][b][m][n] = (f32x4){0.f, 0.f, 0.f, 0.f};
    bf16x8 At[4][2], B0[2][2], B1[2][2];
    const char* cA = (const char*)g.A + (size_t)cur.pm * tstepA; const char* cB = (const char*)g.Bt + (size_t)cur.pn * tstepB;
    S.a_ready(cur);
    if constexpr (SP2) {
        PG8_STAGE(PG8_SB(0, 0), cB, voffB); PG8_STAGE(PG8_SB(0, 1), cB + hstepB, voffB); PG8_STAGE(PG8_SA(0, 0), cA, voffA); PG8_STAGE(PG8_SA(0, 1), cA + hstepA, voffA);
        if (wr == 1) PG8_BAR;
        PG8_WAIT_V(2); PG8_BAR;
        PG8_STAGE(PG8_SB(1, 0), cB + kstep, voffB); PG8_STAGE(PG8_SA(1, 0), cA + kstep, voffA); PG8_STAGE(PG8_SB(1, 1), cB + hstepB + kstep, voffB);
        PG8_WAIT_V(6); PG8_BAR;
    } else {
        PG8_STAGE(PG8_SB(0, 0), cB, voffB); PG8_STAGE(PG8_SA(0, 0), cA, voffA); PG8_STAGE(PG8_SB(0, 1), cB + hstepB, voffB); PG8_STAGE(PG8_SA(0, 1), cA + hstepA, voffA);
        if (wr == 1) PG8_BAR;
        PG8_WAIT_V(4); PG8_BAR;
        PG8_STAGE(PG8_SB(1, 0), cB + kstep, voffB); PG8_STAGE(PG8_SA(1, 0), cA + kstep, voffA); PG8_STAGE(PG8_SB(1, 1), cB + hstepB + kstep, voffB);
        PG8_WAIT_V(6); PG8_BAR;
    }
    for (;;) {
        const bool has_next = S.next(ui + 1, nxt);
        const char* nA = has_next ? (const char*)g.A + (size_t)nxt.pm * tstepA : cA; const char* nB = has_next ? (const char*)g.Bt + (size_t)nxt.pn * tstepB : cB;
        for (int t = 0; t < nt; t += 2) { if constexpr (Epi::HAS_MID) { if (t == (nt >> 1)) E.mid(acc, cur, wr, wc, fr, fq); }
            const bool last = (t == nt - 2);
            const char* a1 = cA + (size_t)(t + 1) * kstep;
            const char* a2 = last ? nA : cA + (size_t)(t + 2) * kstep; const char* b2 = last ? nB : cB + (size_t)(t + 2) * kstep;
            const char* a3 = a2 + kstep; const char* b3 = b2 + kstep;
            if (last && has_next) S.a_ready(nxt);
            if constexpr (SP2) {
            PG8_LDB(B0, 0, 0); PG8_LDB(B1, 0, 1); PG8_SCHED; PG8_LDA(At, 0, 0); PG8_STAGE(PG8_SA(1, 1), a1 + hstepA, voffA);
            PG8_WAIT_V(8); PG8_WAIT_L(0); PG8_BAR; PG8_MMA(0, 0, At, B0); PG8_MMA(0, 1, At, B1); PG8_BAR; PG8_SCHED;
            PG8_LDA(At, 0, 1); PG8_STAGE(PG8_SB(0, 0), b2, voffB); PG8_STAGE(PG8_SB(0, 1), b2 + hstepB, voffB); PG8_STAGE(PG8_SA(0, 0), a2, voffA);
            PG8_WAIT_V(8); PG8_WAIT_L(0); PG8_BAR; PG8_MMA(1, 0, At, B0); PG8_MMA(1, 1, At, B1); PG8_BAR; PG8_SCHED;
            PG8_LDB(B0, 1, 0); PG8_LDB(B1, 1, 1); PG8_SCHED; PG8_LDA(At, 1, 0); PG8_STAGE(PG8_SA(0, 1), a2 + hstepA, voffA);
            PG8_WAIT_V(8); PG8_WAIT_L(0); PG8_BAR; PG8_MMA(0, 0, At, B0); PG8_MMA(0, 1, At, B1); PG8_BAR; PG8_SCHED;
            PG8_LDA(At, 1, 1); PG8_STAGE(PG8_SB(1, 0), b3, voffB); PG8_STAGE(PG8_SB(1, 1), b3 + hstepB, voffB); PG8_STAGE(PG8_SA(1, 0), a3, voffA);
            PG8_WAIT_V(8); PG8_WAIT_L(0); PG8_BAR; PG8_MMA(1, 0, At, B0); PG8_MMA(1, 1, At, B1); PG8_BAR; PG8_SCHED;
            } else {
            PG8_LDB(B0, 0, 0); PG8_SCHED; PG8_LDA(At, 0, 0); PG8_STAGE(PG8_SA(1, 1), a1 + hstepA, voffA);
            PG8_WAIT_L(8); PG8_BAR; PG8_WAIT_L(0); PG8_MMA(0, 0, At, B0); PG8_BAR; PG8_SCHED;
            PG8_LDB(B1, 0, 1); PG8_STAGE(PG8_SB(0, 0), b2, voffB);
            PG8_BAR; PG8_WAIT_L(0); PG8_MMA(0, 1, At, B1); PG8_BAR;
            PG8_LDA(At, 0, 1); PG8_STAGE(PG8_SA(0, 0), a2, voffA);
            PG8_BAR; PG8_WAIT_L(0); PG8_MMA(1, 0, At, B0); PG8_BAR; PG8_SCHED;
            PG8_STAGE(PG8_SB(0, 1), b2 + hstepB, voffB);
            PG8_WAIT_V(6); PG8_BAR; PG8_MMA(1, 1, At, B1); PG8_BAR;
            PG8_LDB(B0, 1, 0); PG8_SCHED; PG8_LDA(At, 1, 0); PG8_STAGE(PG8_SA(0, 1), a2 + hstepA, voffA);
            PG8_WAIT_L(8); PG8_BAR; PG8_WAIT_L(0); PG8_MMA(0, 0, At, B0); PG8_BAR; PG8_SCHED;
            PG8_LDB(B1, 1, 1); PG8_STAGE(PG8_SB(1, 0), b3, voffB);
            PG8_BAR; PG8_WAIT_L(0); PG8_MMA(0, 1, At, B1); PG8_BAR;
            PG8_LDA(At, 1, 1); PG8_STAGE(PG8_SA(1, 0), a3, voffA);
            PG8_BAR; PG8_WAIT_L(0); PG8_MMA(1, 0, At, B0); PG8_BAR; PG8_SCHED;
            PG8_STAGE(PG8_SB(1, 1), b3 + hstepB, voffB);
            PG8_WAIT_V(6); PG8_BAR; PG8_MMA(1, 1, At, B1); PG8_BAR;
            }
        }
        if constexpr (ALIGN_EPI) { if (wr == 0) PG8_BAR; }
        if constexpr (!Epi::AFTER_DRAIN) { E(acc, cur, wr, wc, fr, fq); S.done(cur); }
        if (!has_next) break;
#pragma unroll
        for (int a = 0; a < 2; ++a)
#pragma unroll
            for (int b = 0; b < 2; ++b)
#pragma unroll
                for (int m = 0; m < 4; ++m)
#pragma unroll
                    for (int n = 0; n < 2; ++n) acc[a][b][m][n] = (f32x4){0.f, 0.f, 0.f, 0.f};
        cur = nxt; cA = nA; cB = nB; ++ui;
        if constexpr (ALIGN_EPI) { if (wr == 1) PG8_BAR; }
    }
    PG8_WAIT_V(0);
    if constexpr (!ALIGN_EPI) { if (wr == 0) PG8_BAR; }
    PG8_BAR;
    if constexpr (Epi::AFTER_DRAIN) { E.fused(acc, cur, wr, wc, fr, fq, lds, wid, lane); S.done(cur); }
#undef PG8_SA
#undef PG8_SB
#undef PG8_STAGE
#undef PG8_LDA
#undef PG8_LDB
#undef PG8_MMA
#undef PG8_WAIT_V
#undef PG8_WAIT_L
#undef PG8_BAR
#undef PG8_SCHED
}
}
#define LAS __attribute__((address_space(3)))
typedef unsigned short bf16;
typedef unsigned u32x4 __attribute__((ext_vector_type(4)));
typedef unsigned u32x2 __attribute__((ext_vector_type(2)));
typedef float f32x4 __attribute__((ext_vector_type(4)));
typedef float f32x16 __attribute__((ext_vector_type(16)));
typedef short bf16x8 __attribute__((ext_vector_type(8)));
constexpr int DM = 1024, NBATCH = 8, SEQ = 4096, T = NBATCH * SEQ, DEPTH = 4, PLE = 256, NIN = 9216, NHEAD = 16, HD = 64;
constexpr float LN_EPS = 1e-5f;
constexpr float ALPHA = 1.681792830507429f;
constexpr float QSCALE = 0.125f * 1.4426950408889634f;
constexpr size_t MiB = 1u << 20;
constexpr size_t WS_WIN = 0, WS_W2 = 18 * MiB, WS_WO = 22 * MiB, WS_WG = 24 * MiB, WS_WE = 26 * MiB, WS_WS = 27 * MiB, WS_PB = 28 * MiB, WS_XH1 = 44 * MiB,
                 WS_UGQ = 108 * MiB, WS_V = 236 * MiB, WS_K = 300 * MiB, WS_VB = 364 * MiB, WS_GB = 428 * MiB, WS_CTL = 492 * MiB, WS_XH = 493 * MiB, WS_END = 557 * MiB;
constexpr int LDS_BYTES = 147456, RING_BYTES = 131072;

__device__ __forceinline__ float wave_sum(float v) {
#pragma unroll
    for (int o = 1; o < 64; o <<= 1) v += __shfl_xor(v, o);
    return v;
}
__device__ __forceinline__ unsigned pk2(float lo, float hi) { return pg8::cvt_pk_bf16(lo, hi); }
__device__ __forceinline__ float bf_lo(unsigned w) { return __uint_as_float(w << 16); }
__device__ __forceinline__ float bf_hi(unsigned w) { return __uint_as_float(w & 0xffff0000u); }

template <bool F16 = false> __device__ __forceinline__ void tr_item(const float* W, int N, bf16* WT, int ldk, int koff, int k0, int n0, int drow0, LAS float* scr, int lane) {
#pragma unroll 8
    for (int i = 0; i < 32; ++i) { const int kk = 2 * i + (lane >> 5); scr[kk * 33 + (lane & 31)] = W[(size_t)(k0 + kk) * N + n0 + (lane & 31)]; }
    asm volatile("s_waitcnt lgkmcnt(0)" ::: "memory");
    const int c = lane & 7;
#pragma unroll
    for (int j = 0; j < 4; ++j) { const int n = (lane >> 3) + 8 * j; const LAS float* s = scr + (8 * c) * 33 + n;
        u32x4 o;
        if constexpr (F16) { o.x = pg8::cvt_pk_f16(s[0 * 33], s[1 * 33]); o.y = pg8::cvt_pk_f16(s[2 * 33], s[3 * 33]); o.z = pg8::cvt_pk_f16(s[4 * 33], s[5 * 33]); o.w = pg8::cvt_pk_f16(s[6 * 33], s[7 * 33]); }
        else { o.x = pk2(s[0 * 33], s[1 * 33]); o.y = pk2(s[2 * 33], s[3 * 33]); o.z = pk2(s[4 * 33], s[5 * 33]); o.w = pk2(s[6 * 33], s[7 * 33]); }
        *(u32x4*)(WT + (size_t)(drow0 + n) * ldk + koff + k0 + 8 * c) = o; }
    asm volatile("s_waitcnt lgkmcnt(0)" ::: "memory");
}
__device__ __forceinline__ int win_dest_row(int c) {
    if (c < 1024) return 256 * (c >> 7) + (c & 127);
    if (c < 2048) return 2048 + (c - 1024);
    if (c < 3072) { const int cc = c - 2048; return 256 * (cc >> 7) + 128 + (cc & 127); }
    if (c < 7168) return c;
    if (c < 8192) { const int cc = c - 7168; return 7168 + 256 * (cc >> 7) + (cc & 127); }
    { const int cc = c - 8192; return 7168 + 256 * (cc >> 7) + 128 + (cc & 127); }
}
struct Args { const float* in[14]; float* out; unsigned char* ws; };

__device__ __forceinline__ void convert_layer(const Args& a, int l, LAS unsigned char* lds, int gw, int NGW, int lane, int wave) {
    LAS float* scr = (LAS float*)(lds + wave * 8704);
    unsigned char* ws = (l & 1) ? (unsigned char*)a.out : a.ws;
    const float* w_in = a.in[2] + (size_t)l * DM * NIN;
    const float* w_pa = a.in[7] + (size_t)l * DM * DM; const float* w_pb = a.in[8] + (size_t)l * DM * DM; const float* w_out = a.in[9] + (size_t)l * DM * DM;
    const float* w_pe = a.in[10] + (size_t)l * PLE * DM; const float* w_pg = a.in[11] + (size_t)l * DM * DM;
    constexpr int I_IN = 16 * (NIN / 32), I_SQ = 16 * 32, I_PE = 4 * 32, NITEMS = I_IN + 4 * I_SQ + I_PE;
    for (int it = gw; it < NITEMS; it += NGW) {
        int r = it;
        if (r < I_IN) { const int kb = r / (NIN / 32), nb = r % (NIN / 32); tr_item<true>(w_in, NIN, (bf16*)(ws + WS_WIN), 1024, 0, 64 * kb, 32 * nb, win_dest_row(32 * nb), scr, lane); continue; } r -= I_IN;
        if (r < I_SQ) { tr_item(w_pa, DM, (bf16*)(ws + WS_W2), 2048, 0, 64 * (r >> 5), 32 * (r & 31), 32 * (r & 31), scr, lane); continue; } r -= I_SQ;
        if (r < I_SQ) { tr_item(w_pb, DM, (bf16*)(ws + WS_W2), 2048, 1024, 64 * (r >> 5), 32 * (r & 31), 32 * (r & 31), scr, lane); continue; } r -= I_SQ;
        if (r < I_SQ) { tr_item(w_out, DM, (bf16*)(ws + WS_WO), 1024, 0, 64 * (r >> 5), 32 * (r & 31), 32 * (r & 31), scr, lane); continue; } r -= I_SQ;
        if (r < I_SQ) { tr_item<true>(w_pg, DM, (bf16*)(ws + WS_WG), 1024, 0, 64 * (r >> 5), 32 * (r & 31), 32 * (r & 31), scr, lane); continue; } r -= I_SQ;
        tr_item(w_pe, DM, (bf16*)(ws + WS_WE), 256, 0, 64 * (r >> 5), 32 * (r & 31), 32 * (r & 31), scr, lane);
    }
    const int gt = gw * 64 + lane, NGT = NGW * 64;
    { const float* w_s = a.in[5] + (size_t)l * 8 * 128 * 128; bf16* WsB = (bf16*)(ws + WS_WS);
      for (int p = gt; p < 8 * 128 * 16; p += NGT) { const int s0 = (p & 15) * 8, t = (p >> 4) & 127;
          const f32x4 x0 = *(const f32x4*)(w_s + (size_t)p * 8), x1 = *(const f32x4*)(w_s + (size_t)p * 8 + 4);
          float v[8] = {x0[0], x0[1], x0[2], x0[3], x1[0], x1[1], x1[2], x1[3]};
#pragma unroll
          for (int j = 0; j < 8; ++j) v[j] = (s0 + j <= t) ? v[j] : 0.f;
          u32x4 o; o.x = pk2(v[0], v[1]); o.y = pk2(v[2], v[3]); o.z = pk2(v[4], v[5]); o.w = pk2(v[6], v[7]);
          *(u32x4*)(WsB + (size_t)p * 8) = o; } }
    { const float* p = a.in[1] + (size_t)l * T * PLE; bf16* PB = (bf16*)(ws + WS_PB);
      for (int q = gt; q < T * PLE / 8; q += NGT) { const f32x4 x0 = *(const f32x4*)(p + (size_t)q * 8), x1 = *(const f32x4*)(p + (size_t)q * 8 + 4);
          u32x4 o; o.x = pk2(x0[0], x0[1]); o.y = pk2(x0[2], x0[3]); o.z = pk2(x1[0], x1[1]); o.w = pk2(x1[2], x1[3]);
          *(u32x4*)(PB + (size_t)q * 8) = o; } }
}

constexpr int AT_K = 0, AT_V = 16384, AT_STG = 16384 + 2 * 9216, AT_STG_W = 8704;
struct AttnJob { int b, h, qb; };
struct AttnPre { bf16x8 qr[4]; u32x4 kreg, vreg; };
__device__ __forceinline__ void attn_prefetch(AttnPre& P, const AttnJob& J, const bf16* UGQ, const bf16* Kb, const bf16* Vb) {
    int tid_ = threadIdx.x; asm volatile("" : "+v"(tid_));
    const int lane = tid_ & 63, wid = __builtin_amdgcn_readfirstlane(tid_ >> 6), r32 = lane & 31, hi = lane >> 5;
    const size_t rowbase = (size_t)J.b * SEQ; const int qw = J.qb * 256 + wid * 32, NT = 4 * (J.qb + 1);
    const bf16* qp = UGQ + (rowbase + qw + r32) * 2048 + 1024 + J.h * HD + hi * 8;
#pragma unroll
    for (int d0 = 0; d0 < 4; ++d0) P.qr[d0] = *(const bf16x8*)(qp + d0 * 16);
    const size_t kvo = (rowbase + lane) * 1024 + J.h * HD + wid * 8 + (size_t)(NT - 1) * 64 * 1024;
    P.kreg = *(const u32x4*)(Kb + kvo); P.vreg = *(const u32x4*)(Vb + kvo);
}
__device__ __forceinline__ void attn_unit(AttnPre& P, const AttnJob J, bool has_next, const AttnJob Jn, bf16* UGQ, const bf16* Kb, const bf16* Vb, const bf16* GBb, LAS unsigned char* lds, int dry = 0) {
    const int b = J.b, h = J.h, qb = J.qb;
    int tid_ = threadIdx.x; asm volatile("" : "+v"(tid_));
    const int tid = tid_, lane = tid & 63, wid = __builtin_amdgcn_readfirstlane(tid >> 6), r32 = lane & 31, hi = lane >> 5;
    const size_t rowbase = (size_t)b * SEQ;
    const int q0 = qb * 256, qw = q0 + wid * 32;
    bf16x8 qr[4];
#pragma unroll
    for (int d0 = 0; d0 < 4; ++d0) qr[d0] = P.qr[d0];
    f32x16 o0, o1;
#pragma unroll
    for (int r = 0; r < 16; ++r) { o0[r] = 0.f; o1[r] = 0.f; }
    float C = 1.f; int alive = 1;
    volatile LAS unsigned* aflag = (volatile LAS unsigned*)(lds + RING_BYTES);
    const int NT = 4 * (qb + 1);
    const int lkey = lane, lch = wid;
    const int kk = lkey & 31, slot = (lkey & 32) | (8 * ((kk >> 2) & 3) + 4 * (kk >> 4) + (kk & 3));
    const bf16* kg = Kb + (rowbase + lkey) * 1024 + h * HD + lch * 8;
    const bf16* vg = Vb + (rowbase + lkey) * 1024 + h * HD + lch * 8;
    u32x4 kreg = P.kreg, vreg = P.vreg;
#define AT_WRITE(buf) do { *(LAS u32x4*)(lds + AT_K + (buf) * 8192 + lch * 1024 + slot * 16) = kreg; \
        LAS unsigned short* vt_ = (LAS unsigned short*)(lds + AT_V + (buf) * 9216) + (lch * 8) * 72 + lkey; \
        vt_[0 * 72] = (unsigned short)(vreg.x & 0xffffu); vt_[1 * 72] = (unsigned short)(vreg.x >> 16); vt_[2 * 72] = (unsigned short)(vreg.y & 0xffffu); vt_[3 * 72] = (unsigned short)(vreg.y >> 16); \
        vt_[4 * 72] = (unsigned short)(vreg.z & 0xffffu); vt_[5 * 72] = (unsigned short)(vreg.z >> 16); vt_[6 * 72] = (unsigned short)(vreg.w & 0xffffu); vt_[7 * 72] = (unsigned short)(vreg.w >> 16); } while (0)
    AT_WRITE(0);
    __syncthreads();
    const int qrel = qw + r32;
    for (int it = 0; it < NT; ++it) {
        const int kt = NT - 1 - it, cur = it & 1;
        if (it + 1 < NT) { kreg = *(const u32x4*)(kg + (size_t)(kt - 1) * 64 * 1024); vreg = *(const u32x4*)(vg + (size_t)(kt - 1) * 64 * 1024); }
        const int k0 = kt * 64;
        if (k0 < qw + 32 && alive) {
            const LAS unsigned char* kb = lds + AT_K + cur * 8192 + hi * 1024 + r32 * 16;
            f32x16 p0, p1;
#pragma unroll
            for (int r = 0; r < 16; ++r) { p0[r] = 0.f; p1[r] = 0.f; }
#pragma unroll
            for (int d0 = 0; d0 < 4; ++d0) {
                const bf16x8 a0 = *(const LAS bf16x8*)(kb + d0 * 2048), a1 = *(const LAS bf16x8*)(kb + d0 * 2048 + 512);
                p0 = __builtin_amdgcn_mfma_f32_32x32x16_bf16(a0, qr[d0], p0, 0, 0, 0);
                p1 = __builtin_amdgcn_mfma_f32_32x32x16_bf16(a1, qr[d0], p1, 0, 0, 0);
            }
#pragma unroll
            for (int r = 0; r < 16; ++r) { p0[r] = __builtin_amdgcn_rcpf(1.f + __builtin_amdgcn_exp2f(p0[r])); p1[r] = __builtin_amdgcn_rcpf(1.f + __builtin_amdgcn_exp2f(p1[r])); }
            if (k0 + 63 >= qw) {
                const int kb0 = k0 + 16 * hi;
#pragma unroll
                for (int r = 0; r < 16; ++r) { if (kb0 + r >= qrel) p0[r] = 1.f; if (kb0 + 32 + r >= qrel) p1[r] = 1.f; }
            }
#pragma unroll
            for (int r = 14; r >= 0; --r) { p0[r] *= p0[r + 1]; p1[r] *= p1[r + 1]; }
            const float L0 = p0[0], L1 = p1[0];
            const float pL0 = __shfl_xor(L0, 32), pL1 = __shfl_xor(L1, 32);
            const float tot1 = L1 * pL1;
            const float pre1 = hi ? C : C * pL1;
            const float pre0 = C * tot1 * (hi ? 1.f : pL0);
            C = C * tot1 * (L0 * pL0);
#pragma unroll
            for (int r = 0; r < 15; ++r) { p0[r] = pre0 * (p0[r + 1] - p0[r]); p1[r] = pre1 * (p1[r + 1] - p1[r]); }
            p0[15] = pre0 * (1.f - p0[15]); p1[15] = pre1 * (1.f - p1[15]);
            u32x4 w00, w01, w10, w11;
            w00.x = pk2(p0[0], p0[1]); w00.y = pk2(p0[2], p0[3]); w00.z = pk2(p0[4], p0[5]); w00.w = pk2(p0[6], p0[7]);
            w01.x = pk2(p0[8], p0[9]); w01.y = pk2(p0[10], p0[11]); w01.z = pk2(p0[12], p0[13]); w01.w = pk2(p0[14], p0[15]);
            w10.x = pk2(p1[0], p1[1]); w10.y = pk2(p1[2], p1[3]); w10.z = pk2(p1[4], p1[5]); w10.w = pk2(p1[6], p1[7]);
            w11.x = pk2(p1[8], p1[9]); w11.y = pk2(p1[10], p1[11]); w11.z = pk2(p1[12], p1[13]); w11.w = pk2(p1[14], p1[15]);
            const LAS unsigned char* vb = lds + AT_V + cur * 9216 + r32 * 144 + hi * 32;
#define AT_PV(W, off) do { const bf16x8 pf_ = __builtin_bit_cast(bf16x8, W); \
                const bf16x8 v0_ = *(const LAS bf16x8*)(vb + (off)), v1_ = *(const LAS bf16x8*)(vb + 4608 + (off)); \
                o0 = __builtin_amdgcn_mfma_f32_32x32x16_bf16(v0_, pf_, o0, 0, 0, 0); o1 = __builtin_amdgcn_mfma_f32_32x32x16_bf16(v1_, pf_, o1, 0, 0, 0); } while (0)
            AT_PV(w00, 0); AT_PV(w01, 16); AT_PV(w10, 64); AT_PV(w11, 80);
#undef AT_PV
            alive = __any(C != 0.f);
        }
        if (it + 1 < NT) AT_WRITE(cur ^ 1);
        if (lane == 0) aflag[(it & 1) * 8 + wid] = (unsigned)alive;
        __syncthreads();
        const unsigned fl = (lane < 8) ? aflag[(it & 1) * 8 + lane] : 0u;
        if (!__any(fl != 0u)) break;
    }
#undef AT_WRITE
    if (has_next) attn_prefetch(P, Jn, UGQ, Kb, Vb);
    LAS float* stg = (LAS float*)(lds + AT_STG + wid * AT_STG_W);
#pragma unroll
    for (int g4 = 0; g4 < 4; ++g4) {
        *(LAS f32x4*)(stg + r32 * 68 + 8 * g4 + 4 * hi) = (f32x4){o0[4 * g4], o0[4 * g4 + 1], o0[4 * g4 + 2], o0[4 * g4 + 3]};
        *(LAS f32x4*)(stg + r32 * 68 + 32 + 8 * g4 + 4 * hi) = (f32x4){o1[4 * g4], o1[4 * g4 + 1], o1[4 * g4 + 2], o1[4 * g4 + 3]};
    }
    asm volatile("s_waitcnt lgkmcnt(0)" ::: "memory");
#pragma unroll
    for (int i = 0; i < 4; ++i) {
        const int row = i * 8 + (lane >> 3), ch = lane & 7;
        f32x4 a0 = *(const LAS f32x4*)(stg + row * 68 + ch * 8), a1 = *(const LAS f32x4*)(stg + row * 68 + ch * 8 + 4);
        const size_t tok = rowbase + qw + row;
        const u32x4 gw_ = *(const u32x4*)(GBb + tok * 1024 + h * HD + ch * 8);
        f32x4 g0, g1; pg8::unpack8(gw_, g0, g1);
#pragma unroll
        for (int e = 0; e < 4; ++e) { a0[e] *= g0[e] * pg8::sigm(g0[e]); a1[e] *= g1[e] * pg8::sigm(g1[e]); }
        if (!dry) *(u32x4*)(UGQ + tok * 2048 + 1024 + h * HD + ch * 8) = pg8::pack8(a0, a1);
    }
    asm volatile("s_waitcnt lgkmcnt(0)" ::: "memory");
}

constexpr int BA_STAT = 0, BA_GB = 1024, BA_VNT = 1024 + 8192, BA_OT = BA_VNT + 128 * 272;
__device__ __forceinline__ void brancha_unit(int chunk, bf16* UGQ, const bf16* Vb, const bf16* WsB, const float* vn_g, const float* vn_b, const float* b_s, LAS unsigned char* lds, int dry = 0) {
    int tid_ = threadIdx.x; asm volatile("" : "+v"(tid_));
    const int tid = tid_, lane = tid & 63, wid = __builtin_amdgcn_readfirstlane(tid >> 6), r32 = lane & 31, hi = lane >> 5;
    const size_t t0 = (size_t)chunk * 128;
    LAS float* stat = (LAS float*)(lds + BA_STAT);
    LAS float* gbl = (LAS float*)(lds + BA_GB);
    u32x4 vpc[4];
#pragma unroll
    for (int i = 0; i < 4; ++i) { const int p = tid + 512 * i, s = p >> 4, dc = p & 15; vpc[i] = *(const u32x4*)(Vb + (t0 + s) * 1024 + dc * 8); }
    gbl[tid] = vn_g[tid]; gbl[tid + 512] = vn_g[tid + 512]; gbl[1024 + tid] = vn_b[tid]; gbl[1536 + tid] = vn_b[tid + 512];
#pragma unroll
    for (int hb = 0; hb < 2; ++hb) {
        u32x4 x0[8], x1[8];
#pragma unroll
        for (int i = 0; i < 8; ++i) { const bf16* vr = Vb + (t0 + wid * 16 + hb * 8 + i) * 1024; x0[i] = *(const u32x4*)(vr + lane * 8); x1[i] = *(const u32x4*)(vr + 512 + lane * 8); }
#pragma unroll
        for (int i = 0; i < 8; ++i) {
            f32x4 a, bq, c, d; pg8::unpack8(x0[i], a, bq); pg8::unpack8(x1[i], c, d);
            float s = (a[0] + a[1]) + (a[2] + a[3]) + (bq[0] + bq[1]) + (bq[2] + bq[3]) + (c[0] + c[1]) + (c[2] + c[3]) + (d[0] + d[1]) + (d[2] + d[3]);
            const float mean = wave_sum(s) * (1.f / 1024.f);
            a = a - mean; bq = bq - mean; c = c - mean; d = d - mean;
            float q = (a[0] * a[0] + a[1] * a[1]) + (a[2] * a[2] + a[3] * a[3]) + (bq[0] * bq[0] + bq[1] * bq[1]) + (bq[2] * bq[2] + bq[3] * bq[3])
                    + (c[0] * c[0] + c[1] * c[1]) + (c[2] * c[2] + c[3] * c[3]) + (d[0] * d[0] + d[1] * d[1]) + (d[2] * d[2] + d[3] * d[3]);
            const float rstd = 1.0f / sqrtf(wave_sum(q) * (1.f / 1024.f) + LN_EPS);
            if (lane == 0) { const int row = wid * 16 + hb * 8 + i; stat[row * 2] = mean; stat[row * 2 + 1] = rstd; }
        }
    }
    __syncthreads();
    const int dblk = wid & 3, tbp = wid >> 2;
    u32x4 ugp[4]; bf16x8 wf[2][8];
#define BA_LOAD_UG(g_) do { _Pragma("unroll") for (int i = 0; i < 4; ++i) { const int p = tid + 512 * i, t = p >> 4, dc = p & 15; ugp[i] = *(const u32x4*)(UGQ + (t0 + t) * 2048 + (g_) * 128 + dc * 8); } } while (0)
#define BA_LOAD_WS(g_) do { _Pragma("unroll") for (int j = 0; j < 2; ++j) { const int tb = 2 * tbp + j; const bf16* wrow = WsB + ((size_t)(g_) * 128 + 32 * tb + r32) * 128 + hi * 8; \
        _Pragma("unroll") for (int ks = 0; ks < 8; ++ks) if (ks < 2 * (tb + 1)) wf[j][ks] = *(const bf16x8*)(wrow + ks * 16); } } while (0)
    BA_LOAD_WS(0); BA_LOAD_UG(0);
    for (int g = 0; g < 8; ++g) {
#pragma unroll
        for (int i = 0; i < 4; ++i) {
            const int p = tid + 512 * i, s = p >> 4, dc = p & 15;
            f32x4 v0, v1; pg8::unpack8(vpc[i], v0, v1);
            const f32x4 ga = *(const LAS f32x4*)(gbl + g * 128 + dc * 8), gb2 = *(const LAS f32x4*)(gbl + g * 128 + dc * 8 + 4);
            const f32x4 ba = *(const LAS f32x4*)(gbl + 1024 + g * 128 + dc * 8), bb2 = *(const LAS f32x4*)(gbl + 1024 + g * 128 + dc * 8 + 4);
            const float mean = stat[s * 2], rstd = stat[s * 2 + 1];
            v0 = (v0 - mean) * rstd * ga + ba; v1 = (v1 - mean) * rstd * gb2 + bb2;
            const u32x4 w = pg8::pack8(v0, v1);
            LAS unsigned short* dst = (LAS unsigned short*)(lds + BA_VNT) + dc * 136 + s;
            dst[0 * 16 * 136] = (unsigned short)(w.x & 0xffffu); dst[1 * 16 * 136] = (unsigned short)(w.x >> 16); dst[2 * 16 * 136] = (unsigned short)(w.y & 0xffffu); dst[3 * 16 * 136] = (unsigned short)(w.y >> 16);
            dst[4 * 16 * 136] = (unsigned short)(w.z & 0xffffu); dst[5 * 16 * 136] = (unsigned short)(w.z >> 16); dst[6 * 16 * 136] = (unsigned short)(w.w & 0xffffu); dst[7 * 16 * 136] = (unsigned short)(w.w >> 16);
        }
        if (g + 1 < 8) {
#pragma unroll
            for (int i = 0; i < 4; ++i) { const int p = tid + 512 * i, s = p >> 4, dc = p & 15; vpc[i] = *(const u32x4*)(Vb + (t0 + s) * 1024 + (g + 1) * 128 + dc * 8); }
        }
        __syncthreads();
        const int d = 32 * dblk + r32;
        const LAS unsigned char* ab = lds + BA_VNT + ((d & 7) * 16 + (d >> 3)) * 272 + hi * 16;
        f32x16 acc[2];
#pragma unroll
        for (int j = 0; j < 2; ++j) {
            const int tb = 2 * tbp + j;
#pragma unroll
            for (int r = 0; r < 16; ++r) acc[j][r] = 0.f;
#pragma unroll
            for (int ks = 0; ks < 8; ++ks) if (ks < 2 * (tb + 1)) {
                const bf16x8 af = *(const LAS bf16x8*)(ab + ks * 32);
                acc[j] = __builtin_amdgcn_mfma_f32_32x32x16_bf16(af, wf[j][ks], acc[j], 0, 0, 0);
            }
        }
        if (g + 1 < 8) BA_LOAD_WS(g + 1);
#pragma unroll
        for (int j = 0; j < 2; ++j) {
            const int tb = 2 * tbp + j, t = 32 * tb + r32;
            const float bias = b_s[g * 128 + t];
            LAS float* ot = (LAS float*)(lds + BA_OT) + t * 132 + 32 * dblk + 4 * hi;
#pragma unroll
            for (int g4 = 0; g4 < 4; ++g4) *(LAS f32x4*)(ot + 8 * g4) = (f32x4){acc[j][4 * g4] + bias, acc[j][4 * g4 + 1] + bias, acc[j][4 * g4 + 2] + bias, acc[j][4 * g4 + 3] + bias};
        }
        __syncthreads();
#pragma unroll
        for (int i = 0; i < 4; ++i) {
            const int p = tid + 512 * i, t = p >> 4, dc = p & 15;
            const LAS float* ot = (const LAS float*)(lds + BA_OT) + t * 132 + dc * 8;
            const f32x4 m0 = *(const LAS f32x4*)ot, m1 = *(const LAS f32x4*)(ot + 4);
            bf16* up = UGQ + (t0 + t) * 2048 + g * 128 + dc * 8;
            f32x4 u0, u1; pg8::unpack8(ugp[i], u0, u1);
            if (!dry) *(u32x4*)up = pg8::pack8(u0 * m0, u1 * m1);
        }
        if (g + 1 < 8) BA_LOAD_UG(g + 1);
    }
#undef BA_LOAD_UG
#undef BA_LOAD_WS
    __syncthreads();
}

__device__ __forceinline__ void ln_rows(bf16* XH, float* OUT, const float* g, const float* bta, bool last, int gw, int NGW, int lane) {
    f32x4 gv[4], bv[4];
#pragma unroll
    for (int j = 0; j < 2; ++j) { gv[2 * j] = *(const f32x4*)(g + 512 * j + lane * 8); gv[2 * j + 1] = *(const f32x4*)(g + 512 * j + lane * 8 + 4);
                                  bv[2 * j] = *(const f32x4*)(bta + 512 * j + lane * 8); bv[2 * j + 1] = *(const f32x4*)(bta + 512 * j + lane * 8 + 4); }
    for (int m = gw; m < T; m += NGW) {
        bf16* xr = XH + (size_t)m * DM + lane * 8;
        f32x4 v[4]; float s = 0.f;
        pg8::unpack8h(*(const u32x4*)xr, v[0], v[1]); pg8::unpack8h(*(const u32x4*)(xr + 512), v[2], v[3]);
#pragma unroll
        for (int j = 0; j < 4; ++j) s += (v[j][0] + v[j][1]) + (v[j][2] + v[j][3]);
        const float mean = wave_sum(s) * (1.f / DM); float s2 = 0.f;
#pragma unroll
        for (int j = 0; j < 4; ++j) { v[j] = v[j] - mean; s2 += (v[j][0] * v[j][0] + v[j][1] * v[j][1]) + (v[j][2] * v[j][2] + v[j][3] * v[j][3]); }
        const float rstd = 1.0f / sqrtf(wave_sum(s2) * (1.f / DM) + LN_EPS);
#pragma unroll
        for (int j = 0; j < 4; ++j) v[j] = v[j] * rstd * gv[j] + bv[j];
        if (last) { float* o = OUT + (size_t)m * DM + lane * 8;
            *(f32x4*)o = v[0]; *(f32x4*)(o + 4) = v[1]; *(f32x4*)(o + 512) = v[2]; *(f32x4*)(o + 516) = v[3]; }
        else { *(u32x4*)xr = pg8::pack8h(v[0], v[1]); *(u32x4*)(xr + 512) = pg8::pack8h(v[2], v[3]); }
    }
}

#define XB_TMO      128
#define XB_XCNT(j)  (256  + 64 * (j))
#define XB_XSUB(j)  (1280 + 64 * (j))
#define XB_XGEN(j)  (2304 + 64 * (j))
#define XB_TOP      3328
#define XB_TOPGEN   3392
#define XCD_BAR_WORDS 3456
#define XB_SPIN_CAP (1u << 18)

__device__ __forceinline__ unsigned xb_ld(unsigned* p)              { return __hip_atomic_load(p, __ATOMIC_RELAXED, __HIP_MEMORY_SCOPE_AGENT); }
__device__ __forceinline__ unsigned xb_add(unsigned* p, unsigned v) { return __hip_atomic_fetch_add(p, v, __ATOMIC_RELAXED, __HIP_MEMORY_SCOPE_AGENT); }
__device__ __forceinline__ unsigned xb_xcc_id() { return (unsigned)__builtin_amdgcn_s_getreg((3 << 11) | 20) & 0xFu; }
#define XB_SPIN(cond, bar) do { unsigned _sp = 0; while (cond) { __builtin_amdgcn_s_sleep(1); \
    if ((++_sp & 255u) == 0u) { if (xb_ld(&(bar)[XB_TMO])) break; if (_sp > XB_SPIN_CAP) { atomicAdd(&(bar)[XB_TMO], 1u); break; } } } } while (0)

struct XcdBarrier {
    unsigned* bar; unsigned x;
    volatile LAS unsigned* st;
};

__device__ __forceinline__ XcdBarrier xcd_barrier_post(unsigned* bar, volatile LAS unsigned* st) {
    XcdBarrier b; b.bar = bar; b.x = xb_xcc_id(); b.st = st;
    if (threadIdx.x == 0) (void)xb_add(&bar[XB_XCNT(b.x)], 1u);
    return b;
}
__device__ __forceinline__ void xcd_barrier_complete(unsigned* bar, unsigned x, unsigned& nloc, unsigned& nx) {
    const unsigned G = gridDim.x * gridDim.y * gridDim.z;
    unsigned sum, cnt, mine, sp = 0u;
    for (;;) {
        sum = 0u; cnt = 0u; mine = 0u;
#pragma unroll
        for (unsigned j = 0; j < 16; ++j) { const unsigned c = xb_ld(&bar[XB_XCNT(j)]); sum += c; cnt += (c > 0u) ? 1u : 0u; mine = (j == x) ? c : mine; }
        if (sum == G) break;
        __builtin_amdgcn_s_sleep(1);
        if ((++sp & 255u) == 0u) { if (xb_ld(&bar[XB_TMO])) break; if (sp > XB_SPIN_CAP) { atomicAdd(&bar[XB_TMO], 1u); break; } }
    }
    nloc = mine > 0u ? mine : 1u; nx = cnt > 0u ? cnt : 1u;
}

__device__ __forceinline__ void xcd_barrier(const XcdBarrier& b) {
    asm volatile("s_waitcnt vmcnt(0)" ::: "memory");
    __syncthreads();
    if (threadIdx.x == 0) {
        unsigned* bar = b.bar;
        __builtin_amdgcn_s_waitcnt(0);
        unsigned nloc = b.st[0], nx = b.st[1];
        if (nloc == 0u) { xcd_barrier_complete(bar, b.x, nloc, nx); b.st[0] = nloc; b.st[1] = nx; }
        const unsigned old = xb_add(&bar[XB_XSUB(b.x)], 1u);
        const unsigned gen = old / nloc;
        if (old + 1u == (gen + 1u) * nloc) {
            __builtin_amdgcn_fence(__ATOMIC_RELEASE, "agent");
            asm volatile("s_waitcnt vmcnt(0)" ::: "memory");
            const unsigned og = xb_add(&bar[XB_TOP], 1u);
            const unsigned tg = og / nx;
            if (og + 1u == (tg + 1u) * nx) xb_add(&bar[XB_TOPGEN], 1u);
            else XB_SPIN(xb_ld(&bar[XB_TOPGEN]) == tg, bar);
            __builtin_amdgcn_fence(__ATOMIC_ACQUIRE, "agent");
            xb_add(&bar[XB_XGEN(b.x)], 1u);
            asm volatile("s_waitcnt vmcnt(0)" ::: "memory");
        } else {
            XB_SPIN(xb_ld(&bar[XB_XGEN(b.x)]) == gen, bar);
            __builtin_amdgcn_fence(__ATOMIC_ACQUIRE, "agent");
            asm volatile("s_waitcnt vmcnt(0)" ::: "memory");
        }
    }
    __syncthreads();
}

__global__ void __launch_bounds__(512, 2) fwd_kernel(Args a) {
    extern __shared__ __attribute__((aligned(16))) unsigned char lds_raw[];
    cg::grid_group grid = cg::this_grid();
    LAS unsigned char* lds = (LAS unsigned char*)lds_raw;
    const int G = gridDim.x, bx = blockIdx.x;
    const int vcu = (G % 8 == 0) ? (bx % 8) * (G / 8) + bx / 8 : bx;
    const int NGW = G * 8;
#define LAUNDER_TID int tid_l = threadIdx.x; asm volatile("" : "+v"(tid_l)); const int lane = tid_l & 63, wave = __builtin_amdgcn_readfirstlane(tid_l >> 6), gw = vcu * 8 + wave;
#define WSW(name, off) size_t name##_o = (off); asm volatile("" : "+s"(name##_o)); bf16* const name = (bf16*)(((l & 1) ? (unsigned char*)a.out : a.ws) + name##_o);
#define WSP(name, off) size_t name##_o = (off); asm volatile("" : "+s"(name##_o)); bf16* const name = (bf16*)(a.ws + name##_o);
    volatile LAS unsigned* MISC = (volatile LAS unsigned*)(lds + RING_BYTES + 256);
    if (threadIdx.x < 16) MISC[threadIdx.x] = 0u;
    unsigned* barw = (unsigned*)(a.ws + WS_CTL);
    if (bx == 0) for (int i = threadIdx.x; i < XCD_BAR_WORDS; i += 512) barw[i] = 0u;
    __syncthreads();
    { LAUNDER_TID
    convert_layer(a, 0, lds, gw, NGW, lane, wave);
    const float* x = a.in[0]; const int gt = gw * 64 + lane, NGT = NGW * 64; WSP(XH, WS_XH)
      for (int q = gt; q < T * DM / 8; q += NGT) { const f32x4 x0 = *(const f32x4*)(x + (size_t)q * 8), x1 = *(const f32x4*)(x + (size_t)q * 8 + 4);
          *(u32x4*)(XH + (size_t)q * 8) = pg8::pack8h(x0, x1); } }
    grid.sync();
    const XcdBarrier xbar = xcd_barrier_post(barw, MISC + 8);
#define GRID_SYNC() xcd_barrier(xbar)
#pragma unroll 1
    for (int l = 0; l < DEPTH; ++l) {
#ifndef SKIP_P1
        { WSP(XH, WS_XH) WSW(WinT, WS_WIN) WSP(UGQ, WS_UGQ) WSP(Vb, WS_V) WSP(Kb, WS_K) WSP(VBb, WS_VB) WSP(GBb, WS_GB)
          pg8::Gemm g{XH, WinT, T, 7168, DM, DM}; pg8::StaticOrder S; S.init(T, 7168, G, bx);
          pg8::Epi1 E{UGQ, Vb, Kb, VBb, GBb, QSCALE, 0};
          pg8::gemm_phase<pg8::Epi1, pg8::StaticOrder, true, true, true>(lds, g, S, E);
#ifdef PROBE_DUP_P1
          { int dry = 1; asm volatile("" : "+s"(dry)); pg8::Epi1 E2{UGQ, Vb, Kb, VBb, GBb, QSCALE, dry};
          pg8::gemm_phase<pg8::Epi1, pg8::StaticOrder, true, true, true>(lds, g, S, E2); }
#endif
        }
#endif
        GRID_SYNC();
        { WSP(UGQ, WS_UGQ) WSP(Vb, WS_V) WSW(WsB, WS_WS) WSP(Kb, WS_K) WSP(VBb, WS_VB) WSP(GBb, WS_GB)
#pragma unroll 1
        for (int st = 0; st < 2; ++st) {
            if (((st ^ vcu) & 1) == 0) {
#ifndef SKIP_BA
                for (int c = vcu; c < T / 128; c += G)
                    brancha_unit(c, UGQ, Vb, WsB, a.in[3] + l * DM, a.in[4] + l * DM, a.in[6] + l * 8 * 128, lds);
#endif
            } else {
#ifndef SKIP_AT
#define AT_JOB(J, idx) do { const int pu_ = vcu_l + ((idx) >> 1) * G_l, bh_ = pu_ >> 3, s_ = pu_ & 7; (J).b = bh_ >> 4; (J).h = bh_ & 15; (J).qb = ((idx) & 1) ? s_ : 15 - s_; } while (0)
                int vcu_l = vcu, G_l = G; asm volatile("" : "+s"(vcu_l), "+s"(G_l));
                const int njobs = 2 * ((128 * 8 - vcu_l + G_l - 1) / G_l);
                AttnPre pre; AttnJob J, Jn; Jn.b = 0; Jn.h = 0; Jn.qb = 0;
                AT_JOB(J, 0); attn_prefetch(pre, J, UGQ, Kb, VBb);
#pragma unroll 1
                for (int idx = 0; idx < njobs; ++idx) {
                    AT_JOB(J, idx); const bool hn = idx + 1 < njobs; if (hn) AT_JOB(Jn, idx + 1);
                    attn_unit(pre, J, hn, Jn, UGQ, Kb, VBb, GBb, lds);
                }
#undef AT_JOB
#endif
            }
        }
        if (l + 1 < DEPTH) { __syncthreads(); LAUNDER_TID convert_layer(a, l + 1, lds, gw, NGW, lane, wave); }
        }
        GRID_SYNC();
#ifndef SKIP_P25
        { WSP(XH, WS_XH) WSW(WinT, WS_WIN) WSP(SMA, WS_K) WSP(SMB, WS_VB)
          pg8::Gemm g{XH, WinT + (size_t)7168 * DM, T, 2048, DM, DM}; pg8::GateOrder S; S.init(T, G, bx);
          pg8::EpiGate E{SMA, SMB};
          pg8::gemm_phase<pg8::EpiGate, pg8::GateOrder, true, true, true>(lds, g, S, E); }
        { WSW(PB, WS_PB) WSW(WeT, WS_WE) WSP(EB, WS_GB)
          int kp = PLE; asm volatile("" : "+s"(kp));
          pg8::Gemm g{PB, WeT, T, DM, kp, kp}; pg8::StaticOrder S; S.init(T, DM, G, bx);
          pg8::EpiStore<0> E{EB, EB};
          pg8::gemm_phase<pg8::EpiStore<0>, pg8::StaticOrder, true, true>(lds, g, S, E); }
#endif
#ifndef SKIP_P3
        { WSP(UGQ, WS_UGQ) WSW(W2T, WS_W2) WSP(SMA, WS_K) WSP(SMB, WS_VB) WSP(MERGED, WS_V)
          pg8::Gemm g{UGQ, W2T, T, DM, 2048, 2048}; pg8::StaticOrder S; S.init(T, DM, G, bx);
          pg8::Epi2 E{SMA, SMB, MERGED};
          pg8::gemm_phase<pg8::Epi2, pg8::StaticOrder, true, true>(lds, g, S, E);
#ifdef PROBE_DUP_P3
          pg8::gemm_phase<pg8::Epi2, pg8::StaticOrder, true, true>(lds, g, S, E);
#endif
        }
#endif
        GRID_SYNC();
#ifndef SKIP_P4
        { WSP(MERGED, WS_V) WSW(WoT, WS_WO) WSP(XH1, WS_XH1) WSP(XH, WS_XH)
          pg8::Gemm g{MERGED, WoT, T, DM, DM, DM}; pg8::StaticOrder S; S.init(T, DM, G, bx);
          pg8::Epi3 E{XH, XH1, ALPHA};
          pg8::gemm_phase<pg8::Epi3, pg8::StaticOrder, true, true>(lds, g, S, E); }
#endif
        GRID_SYNC();
#ifndef SKIP_P5
        { WSP(XH1, WS_XH1) WSW(WgT, WS_WG) WSP(EB, WS_GB) WSP(XH, WS_XH)
          pg8::Gemm g{XH1, WgT, T, DM, DM, DM}; pg8::StaticOrder S; S.init(T, DM, G, bx);
          pg8::Epi4 E{XH1, XH, EB};
          pg8::gemm_phase<pg8::Epi4, pg8::StaticOrder, true, true, true>(lds, g, S, E); }
#endif
        GRID_SYNC();
#ifdef PROBE_SYNC
        for (int z = 0; z < 10; ++z) GRID_SYNC();
#endif
        LAUNDER_TID WSP(XH, WS_XH)
        ln_rows(XH, a.out, a.in[12] + l * DM, a.in[13] + l * DM, l + 1 == DEPTH, gw, NGW, lane);
        if (l + 1 < DEPTH) GRID_SYNC();
    }
}

extern "C" void kernel_launch(void* const* d_in, const int* in_sizes, int n_in, void* d_out, int out_size, void* d_ws, size_t ws_size, hipStream_t stream) {
    static int grid = 0;
    if (grid == 0) {
        if (n_in != 14 || out_size != T * DM || ws_size < WS_END) { fprintf(stderr, "kernel_launch: unexpected shapes (n_in %d out %d ws %zu)\n", n_in, out_size, ws_size); grid = -1; return; }
        int dev = 0, cus = 0, per_cu = 0;
        hipGetDevice(&dev); hipDeviceGetAttribute(&cus, hipDeviceAttributeMultiprocessorCount, dev);
        hipFuncSetAttribute((const void*)fwd_kernel, hipFuncAttributeMaxDynamicSharedMemorySize, LDS_BYTES);
        hipOccupancyMaxActiveBlocksPerMultiprocessor(&per_cu, (const void*)fwd_kernel, 512, LDS_BYTES);
        if (per_cu < 1) per_cu = 1;
        grid = cus;
        (void)hipGetLastError();
    }
    if (grid < 0) return;
    Args a{};
    for (int i = 0; i < 14; ++i) a.in[i] = (const float*)d_in[i];
    a.out = (float*)d_out; a.ws = (unsigned char*)d_ws;
    void* args[] = {&a};
    hipError_t e = hipLaunchCooperativeKernel((const void*)fwd_kernel, dim3(grid), dim3(512), args, LDS_BYTES, stream);
    if (e != hipSuccess) fprintf(stderr, "cooperative launch failed: %s (grid %d)\n", hipGetErrorString(e), grid);
}
```

```cpp
#include <hip/hip_runtime.h>
#include <hip/hip_cooperative_groups.h>
#include <cstdio>
#include <cstdint>
namespace cg = cooperative_groups;
namespace pg8 {
#define PG8_LAS __attribute__((address_space(3)))
typedef unsigned short bf16_t;
typedef short bf16x8 __attribute__((ext_vector_type(8)));
typedef _Float16 f16x8 __attribute__((ext_vector_type(8)));
typedef int i32x4 __attribute__((ext_vector_type(4)));
typedef float f32x4 __attribute__((ext_vector_type(4)));
typedef unsigned u32x4 __attribute__((ext_vector_type(4)));
constexpr int BM = 256, BK = 64, HALF = 128, HTB = HALF * BK * 2  , STAGE_BYTES = 8 * HTB, NXCD = 8, WGM = 8;

__host__ __device__ __forceinline__ int lds_byte(int r, int c) { const int st = (r >> 4) * 2 + (c >> 5), rr = r & 15, cc = c & 31, ob = rr * 64 + cc * 2; return st * 1024 + (ob ^ (((ob >> 9) & 1) << 5)); }
__host__ __device__ __forceinline__ void stage_rc(int b, int& R, int& C) { const int st = b / 1024, sb = b % 1024, swz = sb ^ (((sb >> 9) & 1) << 5); R = (st >> 1) * 16 + swz / 64; C = (st & 1) * 32 + (swz % 64) / 2; }
__host__ __device__ __forceinline__ int perm32(int rho) { const int n = rho >> 4, i = rho & 15; return 8 * (i >> 2) + 4 * n + (i & 3); }

struct Unit { int pm, pn; };
struct Gemm { const bf16_t* A; const bf16_t* Bt; int M, N, K, lda; };

struct StaticOrder {
    int nM, nN, nwg, G, c;
    __host__ __device__ void init(int M, int N, int G_, int c_) { nM = M / BM; nN = N / BM; nwg = nM * nN; G = G_; c = c_; }
    __host__ __device__ bool next(int i, Unit& u) const {
        const long L = (long)i * G + c; if (L >= nwg) return false;
        int wgid = (int)L; { const int q = nwg / NXCD, r = nwg % NXCD, xcd = wgid % NXCD, off = wgid / NXCD; wgid = (xcd < r ? xcd * (q + 1) : r * (q + 1) + (xcd - r) * q) + off; }
        const int nig = WGM * nN, gid = wgid / nig, fm = gid * WGM, gsz = (nM - fm) < WGM ? (nM - fm) : WGM;
        u.pm = fm + ((wgid % nig) % gsz); u.pn = (wgid % nig) / gsz; return true;
    }
    __device__ __forceinline__ void a_ready(const Unit&) const {}
    __device__ __forceinline__ void done(const Unit&) const {}
};
struct GateOrder {
    StaticOrder inner;
    __host__ __device__ void init(int M, int G_, int c_) { inner.init(M, 1024, G_, c_); }
    __host__ __device__ bool next(int i, Unit& u) const { Unit v; if (!inner.next(i >> 1, v)) return false; u.pm = v.pm; u.pn = 2 * v.pn + (i & 1); return true; }
    __device__ __forceinline__ void a_ready(const Unit&) const {}
    __device__ __forceinline__ void done(const Unit&) const {}
};


typedef float f32x2_t __attribute__((ext_vector_type(2))); typedef __bf16 bf16x2_t __attribute__((ext_vector_type(2)));
__device__ __forceinline__ unsigned cvt_pk_bf16(float lo, float hi) { f32x2_t v = {lo, hi}; bf16x2_t b = __builtin_convertvector(v, bf16x2_t); return __builtin_bit_cast(unsigned, b); }
__device__ __forceinline__ float sigm(float x) { return __builtin_amdgcn_rcpf(1.f + __builtin_amdgcn_exp2f(-1.4426950408889634f * x)); }
__device__ __forceinline__ u32x4 pack8(const f32x4 a, const f32x4 b) { u32x4 w; w.x = cvt_pk_bf16(a[0], a[1]); w.y = cvt_pk_bf16(a[2], a[3]); w.z = cvt_pk_bf16(b[0], b[1]); w.w = cvt_pk_bf16(b[2], b[3]); return w; }
__device__ __forceinline__ void unpack8(const u32x4 w, f32x4& a, f32x4& b) {
    a[0] = __uint_as_float(w.x << 16); a[1] = __uint_as_float(w.x & 0xffff0000u); a[2] = __uint_as_float(w.y << 16); a[3] = __uint_as_float(w.y & 0xffff0000u);
    b[0] = __uint_as_float(w.z << 16); b[1] = __uint_as_float(w.z & 0xffff0000u); b[2] = __uint_as_float(w.w << 16); b[3] = __uint_as_float(w.w & 0xffff0000u); }
typedef _Float16 f16x2_t __attribute__((ext_vector_type(2)));
__device__ __forceinline__ unsigned cvt_pk_f16(float lo, float hi) { f32x2_t v = {lo, hi}; f16x2_t h = __builtin_convertvector(v, f16x2_t); return __builtin_bit_cast(unsigned, h); }
__device__ __forceinline__ u32x4 pack8h(const f32x4 a, const f32x4 b) { u32x4 w; w.x = cvt_pk_f16(a[0], a[1]); w.y = cvt_pk_f16(a[2], a[3]); w.z = cvt_pk_f16(b[0], b[1]); w.w = cvt_pk_f16(b[2], b[3]); return w; }
__device__ __forceinline__ void unpack8h(const u32x4 w, f32x4& a, f32x4& b) {
    const unsigned x0 = w.x, x1 = w.y, x2 = w.z, x3 = w.w;
    const f32x2_t p0 = __builtin_convertvector(__builtin_bit_cast(f16x2_t, x0), f32x2_t), p1 = __builtin_convertvector(__builtin_bit_cast(f16x2_t, x1), f32x2_t);
    const f32x2_t p2 = __builtin_convertvector(__builtin_bit_cast(f16x2_t, x2), f32x2_t), p3 = __builtin_convertvector(__builtin_bit_cast(f16x2_t, x3), f32x2_t);
    a[0] = p0[0]; a[1] = p0[1]; a[2] = p1[0]; a[3] = p1[1]; b[0] = p2[0]; b[1] = p2[1]; b[2] = p3[0]; b[3] = p3[1]; }
#define PG8_FENCE asm volatile("" ::: "memory")

struct Epi1 {
    static constexpr bool PERM = true, AFTER_DRAIN = false, HAS_MID = false;
    bf16_t *UGQ, *V, *K, *VB, *GB; float qscale; int dry;
    __device__ __forceinline__ void operator()(const f32x4 (&acc)[2][2][4][2], const Unit& u, int wr, int wc, int fr, int fq) const {
        asm volatile("" : "+v"(fr), "+v"(fq));
        const int row0 = u.pm * BM + wr * 64 + fr, cw = wc * 32 + 8 * fq;
        if (dry) { if (acc[0][0][0][0][0] == 1.2345e-30f) UGQ[row0] = 1; return; }
        if (u.pn < 8) {
            bf16_t* base = UGQ + u.pn * 128 + cw;
#pragma unroll
            for (int ai = 0; ai < 2; ++ai)
#pragma unroll
                for (int m = 0; m < 4; ++m) {
                    f32x4 u0 = acc[ai][0][m][0], u1 = acc[ai][0][m][1]; const f32x4 g0 = acc[ai][1][m][0], g1 = acc[ai][1][m][1];
#pragma unroll
                    for (int e = 0; e < 4; ++e) { u0[e] *= g0[e] * sigm(g0[e]); u1[e] *= g1[e] * sigm(g1[e]); }
                    __builtin_nontemporal_store(pack8(u0, u1), (u32x4*)(base + (size_t)(row0 + ai * HALF + m * 16) * 2048));
                }
        } else {
            const int seg = (u.pn - 8) >> 2, ct = (u.pn - 8) & 3;
            bf16_t* base; int ldc = 1024; float sc = 1.f;
            if (seg == 0) base = V; else if (seg == 1) { base = UGQ + 1024; ldc = 2048; sc = qscale; } else if (seg == 2) base = K; else if (seg == 3) base = VB; else base = GB;
            base += ct * 256 + cw;
#pragma unroll
            for (int ai = 0; ai < 2; ++ai)
#pragma unroll
                for (int m = 0; m < 4; ++m) { bf16_t* rowp = base + (size_t)(row0 + ai * HALF + m * 16) * ldc;
#pragma unroll
                    for (int bj = 0; bj < 2; ++bj) __builtin_nontemporal_store(pack8(acc[ai][bj][m][0] * sc, acc[ai][bj][m][1] * sc), (u32x4*)(rowp + bj * HALF)); }
        }
    }
};
template <int SIG> struct EpiStore {
    static constexpr bool PERM = true, AFTER_DRAIN = false, HAS_MID = false;
    bf16_t *D0, *D1;
    __device__ __forceinline__ void operator()(const f32x4 (&acc)[2][2][4][2], const Unit& u, int wr, int wc, int fr, int fq) const {
        asm volatile("" : "+v"(fr), "+v"(fq));
        const int row0 = u.pm * BM + wr * 64 + fr, cw = wc * 32 + 8 * fq;
        bf16_t* base = (u.pn < 4 ? D0 : D1) + (u.pn & 3) * 256 + cw;
#pragma unroll
        for (int ai = 0; ai < 2; ++ai)
#pragma unroll
            for (int m = 0; m < 4; ++m) { bf16_t* rowp = base + (size_t)(row0 + ai * HALF + m * 16) * 1024;
#pragma unroll
                for (int bj = 0; bj < 2; ++bj) { f32x4 v0 = acc[ai][bj][m][0], v1 = acc[ai][bj][m][1];
                    if (SIG) {
#pragma unroll
                        for (int e = 0; e < 4; ++e) { v0[e] = sigm(v0[e]); v1[e] = sigm(v1[e]); } }
                    __builtin_nontemporal_store(pack8(v0, v1), (u32x4*)(rowp + bj * HALF)); } }
    }
};
struct EpiGate {
    static constexpr bool PERM = true, AFTER_DRAIN = false, HAS_MID = false;
    bf16_t *RHO, *SMB;
    __device__ __forceinline__ void operator()(const f32x4 (&acc)[2][2][4][2], const Unit& u, int wr, int wc, int fr, int fq) const {
        asm volatile("" : "+v"(fr), "+v"(fq));
        const int row0 = u.pm * BM + wr * 64 + fr, c0 = u.pn * 128 + wc * 32 + 8 * fq;
#pragma unroll
        for (int ai = 0; ai < 2; ++ai)
#pragma unroll
            for (int m = 0; m < 4; ++m) { const size_t off = (size_t)(row0 + ai * HALF + m * 16) * 1024 + c0;
                f32x4 r0, r1, s0, s1;
#pragma unroll
                for (int e = 0; e < 4; ++e) {
                    const float ea0 = __builtin_amdgcn_exp2f(fminf(-1.4426950408889634f * acc[ai][0][m][0][e], 80.f)), eb0 = __builtin_amdgcn_exp2f(fminf(-1.4426950408889634f * acc[ai][1][m][0][e], 80.f));
                    const float ea1 = __builtin_amdgcn_exp2f(fminf(-1.4426950408889634f * acc[ai][0][m][1][e], 80.f)), eb1 = __builtin_amdgcn_exp2f(fminf(-1.4426950408889634f * acc[ai][1][m][1][e], 80.f));
                    r0[e] = (1.f + eb0) * __builtin_amdgcn_rcpf(1.f + ea0); r1[e] = (1.f + eb1) * __builtin_amdgcn_rcpf(1.f + ea1);
                    s0[e] = __builtin_amdgcn_rcpf(1.f + eb0); s1[e] = __builtin_amdgcn_rcpf(1.f + eb1); }
                *(u32x4*)(RHO + off) = pack8(r0, r1); *(u32x4*)(SMB + off) = pack8(s0, s1); }
    }
};
struct EpiGateQ {
    static constexpr bool PERM = true, AFTER_DRAIN = false, HAS_MID = false;
    bf16_t *RHO, *SMB; const float* XS; const float* CS;
    __device__ __forceinline__ void operator()(const f32x4 (&acc)[2][2][4][2], const Unit& u, int wr, int wc, int fr, int fq) const {
        asm volatile("" : "+v"(fr), "+v"(fq));
        const int row0 = u.pm * BM + wr * 64 + fr, c0 = u.pn * 128 + wc * 32 + 8 * fq;
        float rsc[2][4]; f32x4 cs[2][2];
#pragma unroll
        for (int ai = 0; ai < 2; ++ai)
#pragma unroll
            for (int m = 0; m < 4; ++m) rsc[ai][m] = XS[row0 + ai * HALF + m * 16] * (1.f / (127.f * 127.f));
#pragma unroll
        for (int bj = 0; bj < 2; ++bj) { const int ci = u.pn * BM + bj * HALF + wc * 32 + 8 * fq; cs[bj][0] = *(const f32x4*)(CS + ci); cs[bj][1] = *(const f32x4*)(CS + ci + 4); }
#pragma unroll
        for (int ai = 0; ai < 2; ++ai)
#pragma unroll
            for (int m = 0; m < 4; ++m) { const size_t off = (size_t)(row0 + ai * HALF + m * 16) * 1024 + c0;
                f32x4 r0, r1, s0, s1;
#pragma unroll
                for (int e = 0; e < 4; ++e) {
                    const i32x4 qa0 = __builtin_bit_cast(i32x4, acc[ai][0][m][0]), qa1 = __builtin_bit_cast(i32x4, acc[ai][0][m][1]), qb0 = __builtin_bit_cast(i32x4, acc[ai][1][m][0]), qb1 = __builtin_bit_cast(i32x4, acc[ai][1][m][1]);
                    const float ma0 = (float)qa0[e] * (rsc[ai][m] * cs[0][0][e]), ma1 = (float)qa1[e] * (rsc[ai][m] * cs[0][1][e]);
                    const float mb0 = (float)qb0[e] * (rsc[ai][m] * cs[1][0][e]), mb1 = (float)qb1[e] * (rsc[ai][m] * cs[1][1][e]);
                    const float ea0 = __builtin_amdgcn_exp2f(fminf(-1.4426950408889634f * ma0, 80.f)), eb0 = __builtin_amdgcn_exp2f(fminf(-1.4426950408889634f * mb0, 80.f));
                    const float ea1 = __builtin_amdgcn_exp2f(fminf(-1.4426950408889634f * ma1, 80.f)), eb1 = __builtin_amdgcn_exp2f(fminf(-1.4426950408889634f * mb1, 80.f));
                    r0[e] = (1.f + eb0) * __builtin_amdgcn_rcpf(1.f + ea0); r1[e] = (1.f + eb1) * __builtin_amdgcn_rcpf(1.f + ea1);
                    s0[e] = __builtin_amdgcn_rcpf(1.f + eb0); s1[e] = __builtin_amdgcn_rcpf(1.f + eb1); }
                *(u32x4*)(RHO + off) = pack8(r0, r1); *(u32x4*)(SMB + off) = pack8(s0, s1); }
    }
};
struct Epi2 {
    static constexpr bool PERM = true, AFTER_DRAIN = false, HAS_MID = true;
    const bf16_t *SMA, *SMB; bf16_t* OUT;
    __device__ __forceinline__ void mid(f32x4 (&acc)[2][2][4][2], const Unit& u, int wr, int wc, int fr, int fq) const {
        asm volatile("" : "+v"(fr), "+v"(fq));
        const int row0 = u.pm * BM + wr * 64 + fr, c0 = u.pn * BM + wc * 32 + 8 * fq;
#pragma unroll
        for (int ai = 0; ai < 2; ++ai) {
            u32x4 wa[4][2];
#pragma unroll
            for (int m = 0; m < 4; ++m) { const size_t off = (size_t)(row0 + ai * HALF + m * 16) * 1024 + c0;
#pragma unroll
                for (int bj = 0; bj < 2; ++bj) wa[m][bj] = *(const u32x4*)(SMA + off + bj * HALF); }
            PG8_FENCE;
#pragma unroll
            for (int m = 0; m < 4; ++m)
#pragma unroll
                for (int bj = 0; bj < 2; ++bj) { f32x4 a0, a1; unpack8(wa[m][bj], a0, a1); acc[ai][bj][m][0] *= a0; acc[ai][bj][m][1] *= a1; }
            PG8_FENCE; }
    }
    __device__ __forceinline__ void operator()(const f32x4 (&acc)[2][2][4][2], const Unit& u, int wr, int wc, int fr, int fq) const {
        asm volatile("" : "+v"(fr), "+v"(fq));
        const int row0 = u.pm * BM + wr * 64 + fr, c0 = u.pn * BM + wc * 32 + 8 * fq;
        u32x4 wb[2][4][2];
#pragma unroll
        for (int ai = 0; ai < 2; ++ai)
#pragma unroll
            for (int m = 0; m < 4; ++m) { const size_t off = (size_t)(row0 + ai * HALF + m * 16) * 1024 + c0;
#pragma unroll
                for (int bj = 0; bj < 2; ++bj) wb[ai][m][bj] = *(const u32x4*)(SMB + off + bj * HALF); }
        PG8_FENCE;
#pragma unroll
        for (int ai = 0; ai < 2; ++ai)
#pragma unroll
            for (int m = 0; m < 4; ++m) { const size_t off = (size_t)(row0 + ai * HALF + m * 16) * 1024 + c0;
#pragma unroll
                for (int bj = 0; bj < 2; ++bj) { f32x4 b0, b1; unpack8(wb[ai][m][bj], b0, b1);
                    *(u32x4*)(OUT + off + bj * HALF) = pack8(acc[ai][bj][m][0] * b0, acc[ai][bj][m][1] * b1); } }
    }
};
struct Epi3 {
    static constexpr bool PERM = true, AFTER_DRAIN = false, HAS_MID = false;
    const bf16_t* XH; bf16_t* XO; float alpha;
    __device__ __forceinline__ void operator()(const f32x4 (&acc)[2][2][4][2], const Unit& u, int wr, int wc, int fr, int fq) const {
        asm volatile("" : "+v"(fr), "+v"(fq));
        const int row0 = u.pm * BM + wr * 64 + fr, c0 = u.pn * BM + wc * 32 + 8 * fq;
#pragma unroll
        for (int ai = 0; ai < 2; ++ai) {
            u32x4 wx[4][2];
#pragma unroll
            for (int m = 0; m < 4; ++m) { const size_t off = (size_t)(row0 + ai * HALF + m * 16) * 1024 + c0;
#pragma unroll
                for (int bj = 0; bj < 2; ++bj) wx[m][bj] = *(const u32x4*)(XH + off + bj * HALF); }
            PG8_FENCE;
#pragma unroll
            for (int m = 0; m < 4; ++m) { const size_t off = (size_t)(row0 + ai * HALF + m * 16) * 1024 + c0;
#pragma unroll
                for (int bj = 0; bj < 2; ++bj) { f32x4 r0, r1; unpack8h(wx[m][bj], r0, r1);
                    const f32x4 h0 = r0 * alpha + acc[ai][bj][m][0], h1 = r1 * alpha + acc[ai][bj][m][1];
                    *(u32x4*)(XO + off + bj * HALF) = pack8h(h0, h1); } }
            PG8_FENCE; }
    }
};
struct Epi4 {
    static constexpr bool PERM = true, AFTER_DRAIN = false, HAS_MID = false;
    const bf16_t* H0; bf16_t* XO; const bf16_t* E;
    __device__ __forceinline__ void operator()(const f32x4 (&acc)[2][2][4][2], const Unit& u, int wr, int wc, int fr, int fq) const {
        asm volatile("" : "+v"(fr), "+v"(fq));
        const int row0 = u.pm * BM + wr * 64 + fr, c0 = u.pn * BM + wc * 32 + 8 * fq;
#pragma unroll
        for (int ai = 0; ai < 2; ++ai) {
            u32x4 wx[4][2], we[4][2];
#pragma unroll
            for (int m = 0; m < 4; ++m) { const size_t off = (size_t)(row0 + ai * HALF + m * 16) * 1024 + c0;
#pragma unroll
                for (int bj = 0; bj < 2; ++bj) { wx[m][bj] = *(const u32x4*)(H0 + off + bj * HALF); we[m][bj] = *(const u32x4*)(E + off + bj * HALF); } }
            PG8_FENCE;
#pragma unroll
            for (int m = 0; m < 4; ++m) { const size_t off = (size_t)(row0 + ai * HALF + m * 16) * 1024 + c0;
#pragma unroll
                for (int bj = 0; bj < 2; ++bj) { f32x4 h0, h1, e0, e1; unpack8h(wx[m][bj], h0, h1); unpack8(we[m][bj], e0, e1);
#pragma unroll
                    for (int e = 0; e < 4; ++e) { h0[e] += e0[e] * sigm(acc[ai][bj][m][0][e]); h1[e] += e1[e] * sigm(acc[ai][bj][m][1][e]); }
                    *(u32x4*)(XO + off + bj * HALF) = pack8h(h0, h1); } }
            PG8_FENCE; }
    }
};
template <class Epi, class Sched, bool ALIGN_EPI = false, bool SP2 = false, int MODE = 0>
__device__ __forceinline__ void gemm_phase(PG8_LAS unsigned char* lds, const Gemm g, const Sched& S, const Epi& E) {
    int tid_ = threadIdx.x; asm volatile("" : "+v"(tid_));
    const int tid = tid_, wid = __builtin_amdgcn_readfirstlane(tid >> 6), lane = tid & 63, wr = wid >> 2, wc = wid & 3, fr = lane & 15, fq = lane >> 4;
    const int K = g.K, nt = K / BK;
    unsigned voffA[2], voffB[2];
#pragma unroll
    for (int i = 0; i < 2; ++i) { int R, C; stage_rc(tid * 16 + i * 8192, R, C); const int Rb = Epi::PERM ? ((R & ~31) + perm32(R & 31)) : R;
        voffA[i] = (unsigned)(R * g.lda + C) * 2u; voffB[i] = (unsigned)(Rb * K + C) * 2u; }
    const size_t kstep = (size_t)(BK * 2);
    const size_t hstepA = (size_t)HALF * g.lda * 2, hstepB = (size_t)HALF * K * 2;
    const size_t tstepA = 2 * hstepA, tstepB = 2 * hstepB;
    const unsigned ldsw = (unsigned)wid * 1024u;
    const int aoff = lds_byte(wr * 64 + fr, fq * 8), boff = lds_byte(wc * 32 + fr, fq * 8);
#define PG8_SA(b, h) (((b) * 2 + (h)) * HTB)
#define PG8_SB(b, h) ((4 + (b) * 2 + (h)) * HTB)
#define PG8_STAGE(bufoff, gbase, voff) do { _Pragma("unroll") for (int _i = 0; _i < 2; ++_i) \
        __builtin_amdgcn_global_load_lds((const unsigned*)((const char*)(gbase) + (voff)[_i]), (PG8_LAS unsigned*)(lds + (bufoff) + ldsw + _i * 8192), 16, 0, 0); } while (0)
#define PG8_LDA(dst, b, h) do { _Pragma("unroll") for (int m = 0; m < 4; ++m) _Pragma("unroll") for (int k = 0; k < 2; ++k) dst[m][k] = *(const PG8_LAS bf16x8*)(lds + PG8_SA(b, h) + aoff + m * 2048 + k * 1024); } while (0)
#define PG8_LDB(dst, b, h) do { _Pragma("unroll") for (int n = 0; n < 2; ++n) _Pragma("unroll") for (int k = 0; k < 2; ++k) dst[n][k] = *(const PG8_LAS bf16x8*)(lds + PG8_SB(b, h) + boff + n * 2048 + k * 1024); } while (0)
#define PG8_MMA(ai, bj, At, Bt) do { __builtin_amdgcn_s_setprio(1); _Pragma("unroll") for (int m = 0; m < 4; ++m) _Pragma("unroll") for (int n = 0; n < 2; ++n) _Pragma("unroll") for (int k = 0; k < 2; ++k) \
        { if constexpr (MODE == 2) acc[ai][bj][m][n] = __builtin_bit_cast(f32x4, __builtin_amdgcn_mfma_i32_16x16x64_i8(__builtin_bit_cast(i32x4, Bt[n][k]), __builtin_bit_cast(i32x4, At[m][k]), __builtin_bit_cast(i32x4, acc[ai][bj][m][n]), 0, 0, 0)); \
          else if constexpr (MODE == 1) acc[ai][bj][m][n] = __builtin_amdgcn_mfma_f32_16x16x32_f16(__builtin_bit_cast(f16x8, Bt[n][k]), __builtin_bit_cast(f16x8, At[m][k]), acc[ai][bj][m][n], 0, 0, 0); \
          else acc[ai][bj][m][n] = __builtin_amdgcn_mfma_f32_16x16x32_bf16(Bt[n][k], At[m][k], acc[ai][bj][m][n], 0, 0, 0); } __builtin_amdgcn_s_setprio(0); } while (0)
#define PG8_WAIT_V(n) asm volatile("s_waitcnt vmcnt(" #n ")" ::: "memory")
#define PG8_WAIT_L(n) asm volatile("s_waitcnt lgkmcnt(" #n ")" ::: "memory")
#define PG8_BAR __builtin_amdgcn_s_barrier()
#define PG8_SCHED __builtin_amdgcn_sched_barrier(0)
    Unit cur, nxt; int ui = 0;
    if (!S.next(0, cur)) return;
    f32x4 acc[2][2][4][2];
#pragma unroll
    for (int a = 0; a < 2; ++a)
#pragma unroll
        for (int b = 0; b < 2; ++b)
#pragma unroll
            for (int m = 0; m < 4; ++m)
#pragma unroll
                for (int n = 0; n < 2; ++n) acc[a][b][m][n] = (f32x4){0.f, 0.f, 0.f, 0.f};
    bf16x8 At[4][2], B0[2][2], B1[2][2];
    const char* cA = (const char*)g.A + (size_t)cur.pm * tstepA; const char* cB = (const char*)g.Bt + (size_t)cur.pn * tstepB;
    S.a_ready(cur);
    if constexpr (SP2) {
        PG8_STAGE(PG8_SB(0, 0), cB, voffB); PG8_STAGE(PG8_SB(0, 1), cB + hstepB, voffB); PG8_STAGE(PG8_SA(0, 0), cA, voffA); PG8_STAGE(PG8_SA(0, 1), cA + hstepA, voffA);
        if (wr == 1) PG8_BAR;
        PG8_WAIT_V(2); PG8_BAR;
        PG8_STAGE(PG8_SB(1, 0), cB + kstep, voffB); PG8_STAGE(PG8_SA(1, 0), cA + kstep, voffA); PG8_STAGE(PG8_SB(1, 1), cB + hstepB + kstep, voffB);
        PG8_WAIT_V(6); PG8_BAR;
    } else {
        PG8_STAGE(PG8_SB(0, 0), cB, voffB); PG8_STAGE(PG8_SA(0, 0), cA, voffA); PG8_STAGE(PG8_SB(0, 1), cB + hstepB, voffB); PG8_STAGE(PG8_SA(0, 1), cA + hstepA, voffA);
        if (wr == 1) PG8_BAR;
        PG8_WAIT_V(4); PG8_BAR;
        PG8_STAGE(PG8_SB(1, 0), cB + kstep, voffB); PG8_STAGE(PG8_SA(1, 0), cA + kstep, voffA); PG8_STAGE(PG8_SB(1, 1), cB + hstepB + kstep, voffB);
        PG8_WAIT_V(6); PG8_BAR;
    }
    for (;;) {
        const bool has_next = S.next(ui + 1, nxt);
        const char* nA = has_next ? (const char*)g.A + (size_t)nxt.pm * tstepA : cA; const char* nB = has_next ? (const char*)g.Bt + (size_t)nxt.pn * tstepB : cB;
        for (int t = 0; t < nt; t += 2) { if constexpr (Epi::HAS_MID) { if (t == (nt >> 1)) E.mid(acc, cur, wr, wc, fr, fq); }
            const bool last = (t == nt - 2);
            const char* a1 = cA + (size_t)(t + 1) * kstep;
            const char* a2 = last ? nA : cA + (size_t)(t + 2) * kstep; const char* b2 = last ? nB : cB + (size_t)(t + 2) * kstep;
            const char* a3 = a2 + kstep; const char* b3 = b2 + kstep;
            if (last && has_next) S.a_ready(nxt);
            if constexpr (SP2) {
            PG8_LDB(B0, 0, 0); PG8_LDB(B1, 0, 1); PG8_SCHED; PG8_LDA(At, 0, 0); PG8_STAGE(PG8_SA(1, 1), a1 + hstepA, voffA);
            PG8_WAIT_V(8); PG8_WAIT_L(0); PG8_BAR; PG8_MMA(0, 0, At, B0); PG8_MMA(0, 1, At, B1); PG8_BAR; PG8_SCHED;
            PG8_LDA(At, 0, 1); PG8_STAGE(PG8_SB(0, 0), b2, voffB); PG8_STAGE(PG8_SB(0, 1), b2 + hstepB, voffB); PG8_STAGE(PG8_SA(0, 0), a2, voffA);
            PG8_WAIT_V(8); PG8_WAIT_L(0); PG8_BAR; PG8_MMA(1, 0, At, B0); PG8_MMA(1, 1, At, B1); PG8_BAR; PG8_SCHED;
            PG8_LDB(B0, 1, 0); PG8_LDB(B1, 1, 1); PG8_SCHED; PG8_LDA(At, 1, 0); PG8_STAGE(PG8_SA(0, 1), a2 + hstepA, voffA);
            PG8_WAIT_V(8); PG8_WAIT_L(0); PG8_BAR; PG8_MMA(0, 0, At, B0); PG8_MMA(0, 1, At, B1); PG8_BAR; PG8_SCHED;
            PG8_LDA(At, 1, 1); PG8_STAGE(PG8_SB(1, 0), b3, voffB); PG8_STAGE(PG8_SB(1, 1), b3 + hstepB, voffB); PG8_STAGE(PG8_SA(1, 0), a3, voffA);
            PG8_WAIT_V(8); PG8_WAIT_L(0); PG8_BAR; PG8_MMA(1, 0, At, B0); PG8_MMA(1, 1, At, B1); PG8_BAR; PG8_SCHED;
            } else {
            PG8_LDB(B0, 0, 0); PG8_SCHED; PG8_LDA(At, 0, 0); PG8_STAGE(PG8_SA(1, 1), a1 + hstepA, voffA);
            PG8_WAIT_L(8); PG8_BAR; PG8_WAIT_L(0); PG8_MMA(0, 0, At, B0); PG8_BAR; PG8_SCHED;
            PG8_LDB(B1, 0, 1); PG8_STAGE(PG8_SB(0, 0), b2, voffB);
            PG8_BAR; PG8_WAIT_L(0); PG8_MMA(0, 1, At, B1); PG8_BAR;
            PG8_LDA(At, 0, 1); PG8_STAGE(PG8_SA(0, 0), a2, voffA);
            PG8_BAR; PG8_WAIT_L(0); PG8_MMA(1, 0, At, B0); PG8_BAR; PG8_SCHED;
            PG8_STAGE(PG8_SB(0, 1), b2 + hstepB, voffB);
            PG8_WAIT_V(6); PG8_BAR; PG8_MMA(1, 1, At, B1); PG8_BAR;
            PG8_LDB(B0, 1, 0); PG8_SCHED; PG8_LDA(At, 1, 0); PG8_STAGE(PG8_SA(0, 1), a2 + hstepA, voffA);
            PG8_WAIT_L(8); PG8_BAR; PG8_WAIT_L(0); PG8_MMA(0, 0, At, B0); PG8_BAR; PG8_SCHED;
            PG8_LDB(B1, 1, 1); PG8_STAGE(PG8_SB(1, 0), b3, voffB);
            PG8_BAR; PG8_WAIT_L(0); PG8_MMA(0, 1, At, B1); PG8_BAR;
            PG8_LDA(At, 1, 1); PG8_STAGE(PG8_SA(1, 0), a3, voffA);
            PG8_BAR; PG8_WAIT_L(0); PG8_MMA(1, 0, At, B0); PG8_BAR; PG8_SCHED;
            PG8_STAGE(PG8_SB(1, 1), b3 + hstepB, voffB);
            PG8_WAIT_V(6); PG8_BAR; PG8_MMA(1, 1, At, B1); PG8_BAR;
            }
        }
        if constexpr (ALIGN_EPI) { if (wr == 0) PG8_BAR; }
        if constexpr (!Epi::AFTER_DRAIN) { E(acc, cur, wr, wc, fr, fq); S.done(cur); }
        if (!has_next) break;
#pragma unroll
        for (int a = 0; a < 2; ++a)
#pragma unroll
            for (int b = 0; b < 2; ++b)
#pragma unroll
                for (int m = 0; m < 4; ++m)
#pragma unroll
                    for (int n = 0; n < 2; ++n) acc[a][b][m][n] = (f32x4){0.f, 0.f, 0.f, 0.f};
        cur = nxt; cA = nA; cB = nB; ++ui;
        if constexpr (ALIGN_EPI) { if (wr == 1) PG8_BAR; }
    }
    PG8_WAIT_V(0);
    if constexpr (!ALIGN_EPI) { if (wr == 0) PG8_BAR; }
    PG8_BAR;
    if constexpr (Epi::AFTER_DRAIN) { E.fused(acc, cur, wr, wc, fr, fq, lds, wid, lane); S.done(cur); }
#undef PG8_SA
#undef PG8_SB
#undef PG8_STAGE
#undef PG8_LDA
#undef PG8_LDB
#undef PG8_MMA
#undef PG8_WAIT_V
#undef PG8_WAIT_L
#undef PG8_BAR
#undef PG8_SCHED
}
}
#define LAS __attribute__((address_space(3)))
typedef unsigned short bf16;
typedef unsigned u32x4 __attribute__((ext_vector_type(4)));
typedef unsigned u32x2 __attribute__((ext_vector_type(2)));
typedef float f32x4 __attribute__((ext_vector_type(4)));
typedef float f32x16 __attribute__((ext_vector_type(16)));
typedef short bf16x8 __attribute__((ext_vector_type(8)));
constexpr int DM = 1024, NBATCH = 8, SEQ = 4096, T = NBATCH * SEQ, DEPTH = 4, PLE = 256, NIN = 9216, NHEAD = 16, HD = 64;
constexpr float LN_EPS = 1e-5f;
constexpr float ALPHA = 1.681792830507429f;
constexpr float QSCALE = 0.125f * 1.4426950408889634f;
constexpr size_t MiB = 1u << 20;
constexpr size_t WS_WIN = 0, WS_W2 = 18 * MiB, WS_WO = 22 * MiB, WS_WG = 24 * MiB, WS_WE = 26 * MiB, WS_WS = 27 * MiB, WS_PB = 28 * MiB, WS_XH1 = 44 * MiB,
                 WS_UGQ = 108 * MiB, WS_V = 236 * MiB, WS_K = 300 * MiB, WS_VB = 364 * MiB, WS_GB = 428 * MiB, WS_CTL = 492 * MiB, WS_XH = 493 * MiB, WS_XS = 557 * MiB  , WS_CMAX = WS_XS + 256 * 1024  , WS_END = 558 * MiB;
constexpr size_t OUT_XQ = 64 * MiB;
constexpr int LDS_BYTES = 147456, RING_BYTES = 131072;

__device__ __forceinline__ float wave_sum(float v) {
#pragma unroll
    for (int o = 1; o < 64; o <<= 1) v += __shfl_xor(v, o);
    return v;
}
__device__ __forceinline__ unsigned pk2(float lo, float hi) { return pg8::cvt_pk_bf16(lo, hi); }
__device__ __forceinline__ float bf_lo(unsigned w) { return __uint_as_float(w << 16); }
__device__ __forceinline__ float bf_hi(unsigned w) { return __uint_as_float(w & 0xffff0000u); }

template <bool F16 = false> __device__ __forceinline__ void tr_item(const float* W, int N, bf16* WT, int ldk, int koff, int k0, int n0, int drow0, LAS float* scr, int lane) {
#pragma unroll 8
    for (int i = 0; i < 32; ++i) { const int kk = 2 * i + (lane >> 5); scr[kk * 33 + (lane & 31)] = W[(size_t)(k0 + kk) * N + n0 + (lane & 31)]; }
    asm volatile("s_waitcnt lgkmcnt(0)" ::: "memory");
    const int c = lane & 7;
#pragma unroll
    for (int j = 0; j < 4; ++j) { const int n = (lane >> 3) + 8 * j; const LAS float* s = scr + (8 * c) * 33 + n;
        u32x4 o;
        if constexpr (F16) { o.x = pg8::cvt_pk_f16(s[0 * 33], s[1 * 33]); o.y = pg8::cvt_pk_f16(s[2 * 33], s[3 * 33]); o.z = pg8::cvt_pk_f16(s[4 * 33], s[5 * 33]); o.w = pg8::cvt_pk_f16(s[6 * 33], s[7 * 33]); }
        else { o.x = pk2(s[0 * 33], s[1 * 33]); o.y = pk2(s[2 * 33], s[3 * 33]); o.z = pk2(s[4 * 33], s[5 * 33]); o.w = pk2(s[6 * 33], s[7 * 33]); }
        *(u32x4*)(WT + (size_t)(drow0 + n) * ldk + koff + k0 + 8 * c) = o; }
    asm volatile("s_waitcnt lgkmcnt(0)" ::: "memory");
}
__device__ __forceinline__ float wave_max(float v) {
#pragma unroll
    for (int o = 1; o < 64; o <<= 1) v = fmaxf(v, __shfl_xor(v, o));
    return v;
}
__device__ __forceinline__ unsigned q4(float a, float b, float c, float d, float inv) {
    const int ia = (int)__builtin_rintf(a * inv), ib = (int)__builtin_rintf(b * inv), ic = (int)__builtin_rintf(c * inv), id = (int)__builtin_rintf(d * inv);
    return (unsigned)(ia & 0xff) | ((unsigned)(ib & 0xff) << 8) | ((unsigned)(ic & 0xff) << 16) | ((unsigned)(id & 0xff) << 24);
}
__device__ __forceinline__ int win_dest_row(int c);
__device__ __forceinline__ void tr_item_q(const float* W, const float* cmax, unsigned char* WQ, int k0, int n0, int drow0, LAS float* scr, int lane) {
#pragma unroll 8
    for (int i = 0; i < 32; ++i) { const int kk = 2 * i + (lane >> 5); scr[kk * 33 + (lane & 31)] = W[(size_t)(k0 + kk) * NIN + n0 + (lane & 31)]; }
    asm volatile("s_waitcnt lgkmcnt(0)" ::: "memory");
    const int c16 = lane & 3;
#pragma unroll
    for (int j = 0; j < 2; ++j) { const int n = (lane >> 2) + 16 * j; const LAS float* sp = scr + (16 * c16) * 33 + n;
        const float cm = cmax[drow0 + n - 7168], inv = cm > 0.f ? 127.f / cm : 0.f;
        u32x4 o; o.x = q4(sp[0 * 33], sp[1 * 33], sp[2 * 33], sp[3 * 33], inv); o.y = q4(sp[4 * 33], sp[5 * 33], sp[6 * 33], sp[7 * 33], inv);
        o.z = q4(sp[8 * 33], sp[9 * 33], sp[10 * 33], sp[11 * 33], inv); o.w = q4(sp[12 * 33], sp[13 * 33], sp[14 * 33], sp[15 * 33], inv);
        *(u32x4*)(WQ + (size_t)(drow0 + n - 7168) * 1024 + k0 + 16 * c16) = o; }
    asm volatile("s_waitcnt lgkmcnt(0)" ::: "memory");
}
__device__ __forceinline__ int win_dest_row(int c) {
    if (c < 1024) return 256 * (c >> 7) + (c & 127);
    if (c < 2048) return 2048 + (c - 1024);
    if (c < 3072) { const int cc = c - 2048; return 256 * (cc >> 7) + 128 + (cc & 127); }
    if (c < 7168) return c;
    if (c < 8192) { const int cc = c - 7168; return 7168 + 256 * (cc >> 7) + (cc & 127); }
    { const int cc = c - 8192; return 7168 + 256 * (cc >> 7) + 128 + (cc & 127); }
}
struct Args { const float* in[14]; float* out; unsigned char* ws; };

__device__ __forceinline__ void convert_layer(const Args& a, int l, LAS unsigned char* lds, int gw, int NGW, int lane, int wave, bool gates = true) {
    LAS float* scr = (LAS float*)(lds + wave * 8704);
    unsigned char* ws = (l & 1) ? (unsigned char*)a.out : a.ws;
    const float* w_in = a.in[2] + (size_t)l * DM * NIN;
    const float* w_pa = a.in[7] + (size_t)l * DM * DM; const float* w_pb = a.in[8] + (size_t)l * DM * DM; const float* w_out = a.in[9] + (size_t)l * DM * DM;
    const float* w_pe = a.in[10] + (size_t)l * PLE * DM; const float* w_pg = a.in[11] + (size_t)l * DM * DM;
    constexpr int I_IN = 16 * (NIN / 32), I_SQ = 16 * 32, I_PE = 4 * 32, NITEMS = I_IN + 4 * I_SQ + I_PE;
    for (int it = gw; it < NITEMS; it += NGW) {
        int r = it;
        if (r < I_IN) { const int kb = r / (NIN / 32), nb = r % (NIN / 32);
            if (32 * nb >= 7168) { if (gates) tr_item_q(w_in, (const float*)(a.ws + WS_CMAX) + l * 2048, ws + WS_WIN + (size_t)7168 * 2048, 64 * kb, 32 * nb, win_dest_row(32 * nb), scr, lane); }
            else tr_item<true>(w_in, NIN, (bf16*)(ws + WS_WIN), 1024, 0, 64 * kb, 32 * nb, win_dest_row(32 * nb), scr, lane);
            continue; } r -= I_IN;
        if (r < I_SQ) { tr_item(w_pa, DM, (bf16*)(ws + WS_W2), 2048, 0, 64 * (r >> 5), 32 * (r & 31), 32 * (r & 31), scr, lane); continue; } r -= I_SQ;
        if (r < I_SQ) { tr_item(w_pb, DM, (bf16*)(ws + WS_W2), 2048, 1024, 64 * (r >> 5), 32 * (r & 31), 32 * (r & 31), scr, lane); continue; } r -= I_SQ;
        if (r < I_SQ) { tr_item(w_out, DM, (bf16*)(ws + WS_WO), 1024, 0, 64 * (r >> 5), 32 * (r & 31), 32 * (r & 31), scr, lane); continue; } r -= I_SQ;
        if (r < I_SQ) { tr_item<true>(w_pg, DM, (bf16*)(ws + WS_WG), 1024, 0, 64 * (r >> 5), 32 * (r & 31), 32 * (r & 31), scr, lane); continue; } r -= I_SQ;
        tr_item(w_pe, DM, (bf16*)(ws + WS_WE), 256, 0, 64 * (r >> 5), 32 * (r & 31), 32 * (r & 31), scr, lane);
    }
    const int gt = gw * 64 + lane, NGT = NGW * 64;
    { const float* w_s = a.in[5] + (size_t)l * 8 * 128 * 128; bf16* WsB = (bf16*)(ws + WS_WS);
      for (int p = gt; p < 8 * 128 * 16; p += NGT) { const int s0 = (p & 15) * 8, t = (p >> 4) & 127;
          const f32x4 x0 = *(const f32x4*)(w_s + (size_t)p * 8), x1 = *(const f32x4*)(w_s + (size_t)p * 8 + 4);
          float v[8] = {x0[0], x0[1], x0[2], x0[3], x1[0], x1[1], x1[2], x1[3]};
#pragma unroll
          for (int j = 0; j < 8; ++j) v[j] = (s0 + j <= t) ? v[j] : 0.f;
          u32x4 o; o.x = pk2(v[0], v[1]); o.y = pk2(v[2], v[3]); o.z = pk2(v[4], v[5]); o.w = pk2(v[6], v[7]);
          *(u32x4*)(WsB + (size_t)p * 8) = o; } }
    { const float* p = a.in[1] + (size_t)l * T * PLE; bf16* PB = (bf16*)(ws + WS_PB);
      for (int q = gt; q < T * PLE / 8; q += NGT) { const f32x4 x0 = *(const f32x4*)(p + (size_t)q * 8), x1 = *(const f32x4*)(p + (size_t)q * 8 + 4);
          u32x4 o; o.x = pk2(x0[0], x0[1]); o.y = pk2(x0[2], x0[3]); o.z = pk2(x1[0], x1[1]); o.w = pk2(x1[2], x1[3]);
          *(u32x4*)(PB + (size_t)q * 8) = o; } }
}

constexpr int AT_K = 0, AT_V = 16384, AT_STG = 16384 + 2 * 9216, AT_STG_W = 8704;
__device__ __forceinline__ void attn_unit(int b, int h, int qb, bf16* UGQ, const bf16* Kb, const bf16* Vb, const bf16* GBb, LAS unsigned char* lds, int dry = 0) {
    int tid_ = threadIdx.x; asm volatile("" : "+v"(tid_));
    const int tid = tid_, lane = tid & 63, wid = __builtin_amdgcn_readfirstlane(tid >> 6), r32 = lane & 31, hi = lane >> 5;
    const size_t rowbase = (size_t)b * SEQ;
    const int q0 = qb * 256, qw = q0 + wid * 32;
    bf16x8 qr[4];
    { const bf16* qp = UGQ + (rowbase + qw + r32) * 2048 + 1024 + h * HD + hi * 8;
#pragma unroll
      for (int d0 = 0; d0 < 4; ++d0) qr[d0] = *(const bf16x8*)(qp + d0 * 16); }
    f32x16 o0, o1;
#pragma unroll
    for (int r = 0; r < 16; ++r) { o0[r] = 0.f; o1[r] = 0.f; }
    float C = 1.f; int alive = 1;
    volatile LAS unsigned* aflag = (volatile LAS unsigned*)(lds + RING_BYTES);
    const int NT = 4 * (qb + 1);
    const int lkey = lane, lch = wid;
    const int kk = lkey & 31, slot = (lkey & 32) | (8 * ((kk >> 2) & 3) + 4 * (kk >> 4) + (kk & 3));
    const bf16* kg = Kb + (rowbase + lkey) * 1024 + h * HD + lch * 8;
    const bf16* vg = Vb + (rowbase + lkey) * 1024 + h * HD + lch * 8;
    u32x4 kreg, vreg;
    kreg = *(const u32x4*)(kg + (size_t)(NT - 1) * 64 * 1024); vreg = *(const u32x4*)(vg + (size_t)(NT - 1) * 64 * 1024);
#define AT_WRITE(buf) do { *(LAS u32x4*)(lds + AT_K + (buf) * 8192 + lch * 1024 + slot * 16) = kreg; \
        LAS unsigned short* vt_ = (LAS unsigned short*)(lds + AT_V + (buf) * 9216) + (lch * 8) * 72 + lkey; \
        vt_[0 * 72] = (unsigned short)(vreg.x & 0xffffu); vt_[1 * 72] = (unsigned short)(vreg.x >> 16); vt_[2 * 72] = (unsigned short)(vreg.y & 0xffffu); vt_[3 * 72] = (unsigned short)(vreg.y >> 16); \
        vt_[4 * 72] = (unsigned short)(vreg.z & 0xffffu); vt_[5 * 72] = (unsigned short)(vreg.z >> 16); vt_[6 * 72] = (unsigned short)(vreg.w & 0xffffu); vt_[7 * 72] = (unsigned short)(vreg.w >> 16); } while (0)
    AT_WRITE(0);
    __syncthreads();
    const int qrel = qw + r32;
    for (int it = 0; it < NT; ++it) {
        const int kt = NT - 1 - it, cur = it & 1;
        if (it + 1 < NT) { kreg = *(const u32x4*)(kg + (size_t)(kt - 1) * 64 * 1024); vreg = *(const u32x4*)(vg + (size_t)(kt - 1) * 64 * 1024); }
        const int k0 = kt * 64;
        if (k0 < qw + 32 && alive) {
            const LAS unsigned char* kb = lds + AT_K + cur * 8192 + hi * 1024 + r32 * 16;
            f32x16 p0, p1;
#pragma unroll
            for (int r = 0; r < 16; ++r) { p0[r] = 0.f; p1[r] = 0.f; }
#pragma unroll
            for (int d0 = 0; d0 < 4; ++d0) {
                const bf16x8 a0 = *(const LAS bf16x8*)(kb + d0 * 2048), a1 = *(const LAS bf16x8*)(kb + d0 * 2048 + 512);
                p0 = __builtin_amdgcn_mfma_f32_32x32x16_bf16(a0, qr[d0], p0, 0, 0, 0);
                p1 = __builtin_amdgcn_mfma_f32_32x32x16_bf16(a1, qr[d0], p1, 0, 0, 0);
            }
#pragma unroll
            for (int r = 0; r < 16; ++r) { p0[r] = __builtin_amdgcn_rcpf(1.f + __builtin_amdgcn_exp2f(p0[r])); p1[r] = __builtin_amdgcn_rcpf(1.f + __builtin_amdgcn_exp2f(p1[r])); }
            if (k0 + 63 >= qw) {
                const int kb0 = k0 + 16 * hi;
#pragma unroll
                for (int r = 0; r < 16; ++r) { if (kb0 + r >= qrel) p0[r] = 1.f; if (kb0 + 32 + r >= qrel) p1[r] = 1.f; }
            }
#pragma unroll
            for (int r = 14; r >= 0; --r) { p0[r] *= p0[r + 1]; p1[r] *= p1[r + 1]; }
            const float L0 = p0[0], L1 = p1[0];
            const float pL0 = __shfl_xor(L0, 32), pL1 = __shfl_xor(L1, 32);
            const float tot1 = L1 * pL1;
            const float pre1 = hi ? C : C * pL1;
            const float pre0 = C * tot1 * (hi ? 1.f : pL0);
            C = C * tot1 * (L0 * pL0);
#pragma unroll
            for (int r = 0; r < 15; ++r) { p0[r] = pre0 * (p0[r + 1] - p0[r]); p1[r] = pre1 * (p1[r + 1] - p1[r]); }
            p0[15] = pre0 * (1.f - p0[15]); p1[15] = pre1 * (1.f - p1[15]);
            u32x4 w00, w01, w10, w11;
            w00.x = pk2(p0[0], p0[1]); w00.y = pk2(p0[2], p0[3]); w00.z = pk2(p0[4], p0[5]); w00.w = pk2(p0[6], p0[7]);
            w01.x = pk2(p0[8], p0[9]); w01.y = pk2(p0[10], p0[11]); w01.z = pk2(p0[12], p0[13]); w01.w = pk2(p0[14], p0[15]);
            w10.x = pk2(p1[0], p1[1]); w10.y = pk2(p1[2], p1[3]); w10.z = pk2(p1[4], p1[5]); w10.w = pk2(p1[6], p1[7]);
            w11.x = pk2(p1[8], p1[9]); w11.y = pk2(p1[10], p1[11]); w11.z = pk2(p1[12], p1[13]); w11.w = pk2(p1[14], p1[15]);
            const LAS unsigned char* vb = lds + AT_V + cur * 9216 + r32 * 144 + hi * 32;
#define AT_PV(W, off) do { const bf16x8 pf_ = __builtin_bit_cast(bf16x8, W); \
                const bf16x8 v0_ = *(const LAS bf16x8*)(vb + (off)), v1_ = *(const LAS bf16x8*)(vb + 4608 + (off)); \
                o0 = __builtin_amdgcn_mfma_f32_32x32x16_bf16(v0_, pf_, o0, 0, 0, 0); o1 = __builtin_amdgcn_mfma_f32_32x32x16_bf16(v1_, pf_, o1, 0, 0, 0); } while (0)
            AT_PV(w00, 0); AT_PV(w01, 16); AT_PV(w10, 64); AT_PV(w11, 80);
#undef AT_PV
            alive = __any(C != 0.f);
        }
        if (it + 1 < NT) AT_WRITE(cur ^ 1);
        if (lane == 0) aflag[(it & 1) * 8 + wid] = (unsigned)alive;
        __syncthreads();
        const unsigned fl = (lane < 8) ? aflag[(it & 1) * 8 + lane] : 0u;
        if (!__any(fl != 0u)) break;
    }
#undef AT_WRITE
    LAS float* stg = (LAS float*)(lds + AT_STG + wid * AT_STG_W);
#pragma unroll
    for (int g4 = 0; g4 < 4; ++g4) {
        *(LAS f32x4*)(stg + r32 * 68 + 8 * g4 + 4 * hi) = (f32x4){o0[4 * g4], o0[4 * g4 + 1], o0[4 * g4 + 2], o0[4 * g4 + 3]};
        *(LAS f32x4*)(stg + r32 * 68 + 32 + 8 * g4 + 4 * hi) = (f32x4){o1[4 * g4], o1[4 * g4 + 1], o1[4 * g4 + 2], o1[4 * g4 + 3]};
    }
    asm volatile("s_waitcnt lgkmcnt(0)" ::: "memory");
#pragma unroll
    for (int i = 0; i < 4; ++i) {
        const int row = i * 8 + (lane >> 3), ch = lane & 7;
        f32x4 a0 = *(const LAS f32x4*)(stg + row * 68 + ch * 8), a1 = *(const LAS f32x4*)(stg + row * 68 + ch * 8 + 4);
        const size_t tok = rowbase + qw + row;
        const u32x4 gw_ = *(const u32x4*)(GBb + tok * 1024 + h * HD + ch * 8);
        f32x4 g0, g1; pg8::unpack8(gw_, g0, g1);
#pragma unroll
        for (int e = 0; e < 4; ++e) { a0[e] *= g0[e] * pg8::sigm(g0[e]); a1[e] *= g1[e] * pg8::sigm(g1[e]); }
        if (!dry) *(u32x4*)(UGQ + tok * 2048 + 1024 + h * HD + ch * 8) = pg8::pack8(a0, a1);
    }
    asm volatile("s_waitcnt lgkmcnt(0)" ::: "memory");
}

constexpr int BA_STAT = 0, BA_GB = 1024, BA_VNT = 1024 + 8192, BA_OT = BA_VNT + 128 * 272;
__device__ __forceinline__ void brancha_unit(int chunk, bf16* UGQ, const bf16* Vb, const bf16* WsB, const float* vn_g, const float* vn_b, const float* b_s, LAS unsigned char* lds, int dry = 0) {
    int tid_ = threadIdx.x; asm volatile("" : "+v"(tid_));
    const int tid = tid_, lane = tid & 63, wid = __builtin_amdgcn_readfirstlane(tid >> 6), r32 = lane & 31, hi = lane >> 5;
    const size_t t0 = (size_t)chunk * 128;
    LAS float* stat = (LAS float*)(lds + BA_STAT);
    LAS float* gbl = (LAS float*)(lds + BA_GB);
    u32x4 vpc[4];
#pragma unroll
    for (int i = 0; i < 4; ++i) { const int p = tid + 512 * i, s = p >> 4, dc = p & 15; vpc[i] = *(const u32x4*)(Vb + (t0 + s) * 1024 + dc * 8); }
    gbl[tid] = vn_g[tid]; gbl[tid + 512] = vn_g[tid + 512]; gbl[1024 + tid] = vn_b[tid]; gbl[1536 + tid] = vn_b[tid + 512];
#pragma unroll
    for (int hb = 0; hb < 2; ++hb) {
        u32x4 x0[8], x1[8];
#pragma unroll
        for (int i = 0; i < 8; ++i) { const bf16* vr = Vb + (t0 + wid * 16 + hb * 8 + i) * 1024; x0[i] = *(const u32x4*)(vr + lane * 8); x1[i] = *(const u32x4*)(vr + 512 + lane * 8); }
#pragma unroll
        for (int i = 0; i < 8; ++i) {
            f32x4 a, bq, c, d; pg8::unpack8(x0[i], a, bq); pg8::unpack8(x1[i], c, d);
            float s = (a[0] + a[1]) + (a[2] + a[3]) + (bq[0] + bq[1]) + (bq[2] + bq[3]) + (c[0] + c[1]) + (c[2] + c[3]) + (d[0] + d[1]) + (d[2] + d[3]);
            const float mean = wave_sum(s) * (1.f / 1024.f);
            a = a - mean; bq = bq - mean; c = c - mean; d = d - mean;
            float q = (a[0] * a[0] + a[1] * a[1]) + (a[2] * a[2] + a[3] * a[3]) + (bq[0] * bq[0] + bq[1] * bq[1]) + (bq[2] * bq[2] + bq[3] * bq[3])
                    + (c[0] * c[0] + c[1] * c[1]) + (c[2] * c[2] + c[3] * c[3]) + (d[0] * d[0] + d[1] * d[1]) + (d[2] * d[2] + d[3] * d[3]);
            const float rstd = 1.0f / sqrtf(wave_sum(q) * (1.f / 1024.f) + LN_EPS);
            if (lane == 0) { const int row = wid * 16 + hb * 8 + i; stat[row * 2] = mean; stat[row * 2 + 1] = rstd; }
        }
    }
    __syncthreads();
    const int dblk = wid & 3, tbp = wid >> 2;
    u32x4 ugp[4]; bf16x8 wf[2][8];
#define BA_LOAD_UG(g_) do { _Pragma("unroll") for (int i = 0; i < 4; ++i) { const int p = tid + 512 * i, t = p >> 4, dc = p & 15; ugp[i] = *(const u32x4*)(UGQ + (t0 + t) * 2048 + (g_) * 128 + dc * 8); } } while (0)
#define BA_LOAD_WS(g_) do { _Pragma("unroll") for (int j = 0; j < 2; ++j) { const int tb = 2 * tbp + j; const bf16* wrow = WsB + ((size_t)(g_) * 128 + 32 * tb + r32) * 128 + hi * 8; \
        _Pragma("unroll") for (int ks = 0; ks < 8; ++ks) if (ks < 2 * (tb + 1)) wf[j][ks] = *(const bf16x8*)(wrow + ks * 16); } } while (0)
    BA_LOAD_WS(0); BA_LOAD_UG(0);
    for (int g = 0; g < 8; ++g) {
#pragma unroll
        for (int i = 0; i < 4; ++i) {
            const int p = tid + 512 * i, s = p >> 4, dc = p & 15;
            f32x4 v0, v1; pg8::unpack8(vpc[i], v0, v1);
            const f32x4 ga = *(const LAS f32x4*)(gbl + g * 128 + dc * 8), gb2 = *(const LAS f32x4*)(gbl + g * 128 + dc * 8 + 4);
            const f32x4 ba = *(const LAS f32x4*)(gbl + 1024 + g * 128 + dc * 8), bb2 = *(const LAS f32x4*)(gbl + 1024 + g * 128 + dc * 8 + 4);
            const float mean = stat[s * 2], rstd = stat[s * 2 + 1];
            v0 = (v0 - mean) * rstd * ga + ba; v1 = (v1 - mean) * rstd * gb2 + bb2;
            const u32x4 w = pg8::pack8(v0, v1);
            LAS unsigned short* dst = (LAS unsigned short*)(lds + BA_VNT) + dc * 136 + s;
            dst[0 * 16 * 136] = (unsigned short)(w.x & 0xffffu); dst[1 * 16 * 136] = (unsigned short)(w.x >> 16); dst[2 * 16 * 136] = (unsigned short)(w.y & 0xffffu); dst[3 * 16 * 136] = (unsigned short)(w.y >> 16);
            dst[4 * 16 * 136] = (unsigned short)(w.z & 0xffffu); dst[5 * 16 * 136] = (unsigned short)(w.z >> 16); dst[6 * 16 * 136] = (unsigned short)(w.w & 0xffffu); dst[7 * 16 * 136] = (unsigned short)(w.w >> 16);
        }
        if (g + 1 < 8) {
#pragma unroll
            for (int i = 0; i < 4; ++i) { const int p = tid + 512 * i, s = p >> 4, dc = p & 15; vpc[i] = *(const u32x4*)(Vb + (t0 + s) * 1024 + (g + 1) * 128 + dc * 8); }
        }
        __syncthreads();
        const int d = 32 * dblk + r32;
        const LAS unsigned char* ab = lds + BA_VNT + ((d & 7) * 16 + (d >> 3)) * 272 + hi * 16;
        f32x16 acc[2];
#pragma unroll
        for (int j = 0; j < 2; ++j) {
            const int tb = 2 * tbp + j;
#pragma unroll
            for (int r = 0; r < 16; ++r) acc[j][r] = 0.f;
#pragma unroll
            for (int ks = 0; ks < 8; ++ks) if (ks < 2 * (tb + 1)) {
                const bf16x8 af = *(const LAS bf16x8*)(ab + ks * 32);
                acc[j] = __builtin_amdgcn_mfma_f32_32x32x16_bf16(af, wf[j][ks], acc[j], 0, 0, 0);
            }
        }
        if (g + 1 < 8) BA_LOAD_WS(g + 1);
#pragma unroll
        for (int j = 0; j < 2; ++j) {
            const int tb = 2 * tbp + j, t = 32 * tb + r32;
            const float bias = b_s[g * 128 + t];
            LAS float* ot = (LAS float*)(lds + BA_OT) + t * 132 + 32 * dblk + 4 * hi;
#pragma unroll
            for (int g4 = 0; g4 < 4; ++g4) *(LAS f32x4*)(ot + 8 * g4) = (f32x4){acc[j][4 * g4] + bias, acc[j][4 * g4 + 1] + bias, acc[j][4 * g4 + 2] + bias, acc[j][4 * g4 + 3] + bias};
        }
        __syncthreads();
#pragma unroll
        for (int i = 0; i < 4; ++i) {
            const int p = tid + 512 * i, t = p >> 4, dc = p & 15;
            const LAS float* ot = (const LAS float*)(lds + BA_OT) + t * 132 + dc * 8;
            const f32x4 m0 = *(const LAS f32x4*)ot, m1 = *(const LAS f32x4*)(ot + 4);
            bf16* up = UGQ + (t0 + t) * 2048 + g * 128 + dc * 8;
            f32x4 u0, u1; pg8::unpack8(ugp[i], u0, u1);
            if (!dry) *(u32x4*)up = pg8::pack8(u0 * m0, u1 * m1);
        }
        if (g + 1 < 8) BA_LOAD_UG(g + 1);
    }
#undef BA_LOAD_UG
#undef BA_LOAD_WS
    __syncthreads();
}

__device__ __forceinline__ void ln_rows(bf16* XH, unsigned char* XQ, float* XS, float* OUT, const float* g, const float* bta, bool last, int gw, int NGW, int lane) {
    f32x4 gv[4], bv[4];
#pragma unroll
    for (int j = 0; j < 2; ++j) { gv[2 * j] = *(const f32x4*)(g + 512 * j + lane * 8); gv[2 * j + 1] = *(const f32x4*)(g + 512 * j + lane * 8 + 4);
                                  bv[2 * j] = *(const f32x4*)(bta + 512 * j + lane * 8); bv[2 * j + 1] = *(const f32x4*)(bta + 512 * j + lane * 8 + 4); }
    for (int m = gw; m < T; m += NGW) {
        bf16* xr = XH + (size_t)m * DM + lane * 8;
        f32x4 v[4]; float s = 0.f;
        pg8::unpack8h(*(const u32x4*)xr, v[0], v[1]); pg8::unpack8h(*(const u32x4*)(xr + 512), v[2], v[3]);
#pragma unroll
        for (int j = 0; j < 4; ++j) s += (v[j][0] + v[j][1]) + (v[j][2] + v[j][3]);
        const float mean = wave_sum(s) * (1.f / DM); float s2 = 0.f;
#pragma unroll
        for (int j = 0; j < 4; ++j) { v[j] = v[j] - mean; s2 += (v[j][0] * v[j][0] + v[j][1] * v[j][1]) + (v[j][2] * v[j][2] + v[j][3] * v[j][3]); }
        const float rstd = 1.0f / sqrtf(wave_sum(s2) * (1.f / DM) + LN_EPS);
#pragma unroll
        for (int j = 0; j < 4; ++j) v[j] = v[j] * rstd * gv[j] + bv[j];
        if (last) { float* o = OUT + (size_t)m * DM + lane * 8;
            *(f32x4*)o = v[0]; *(f32x4*)(o + 4) = v[1]; *(f32x4*)(o + 512) = v[2]; *(f32x4*)(o + 516) = v[3]; }
        else { *(u32x4*)xr = pg8::pack8h(v[0], v[1]); *(u32x4*)(xr + 512) = pg8::pack8h(v[2], v[3]);
            float am = 0.f;
#pragma unroll
            for (int j = 0; j < 4; ++j) am = fmaxf(am, fmaxf(fmaxf(fabsf(v[j][0]), fabsf(v[j][1])), fmaxf(fabsf(v[j][2]), fabsf(v[j][3]))));
            am = wave_max(am); const float inv = am > 0.f ? 127.f / am : 0.f;
            unsigned char* xq = XQ + (size_t)m * DM + lane * 8;
            u32x2 w0, w1; w0.x = q4(v[0][0], v[0][1], v[0][2], v[0][3], inv); w0.y = q4(v[1][0], v[1][1], v[1][2], v[1][3], inv);
            w1.x = q4(v[2][0], v[2][1], v[2][2], v[2][3], inv); w1.y = q4(v[3][0], v[3][1], v[3][2], v[3][3], inv);
            *(u32x2*)xq = w0; *(u32x2*)(xq + 512) = w1; if (lane == 0) XS[m] = am; }
    }
}

#define XB_TMO      128
#define XB_XCNT(j)  (256  + 64 * (j))
#define XB_XSUB(j)  (1280 + 64 * (j))
#define XB_XGEN(j)  (2304 + 64 * (j))
#define XB_TOP      3328
#define XB_TOPGEN   3392
#define XCD_BAR_WORDS 3456
#define XB_SPIN_CAP (1u << 18)

__device__ __forceinline__ unsigned xb_ld(unsigned* p)              { return __hip_atomic_load(p, __ATOMIC_RELAXED, __HIP_MEMORY_SCOPE_AGENT); }
__device__ __forceinline__ unsigned xb_add(unsigned* p, unsigned v) { return __hip_atomic_fetch_add(p, v, __ATOMIC_RELAXED, __HIP_MEMORY_SCOPE_AGENT); }
__device__ __forceinline__ unsigned xb_xcc_id() { return (unsigned)__builtin_amdgcn_s_getreg((3 << 11) | 20) & 0xFu; }
#define XB_SPIN(cond, bar) do { unsigned _sp = 0; while (cond) { __builtin_amdgcn_s_sleep(1); \
    if ((++_sp & 255u) == 0u) { if (xb_ld(&(bar)[XB_TMO])) break; if (_sp > XB_SPIN_CAP) { atomicAdd(&(bar)[XB_TMO], 1u); break; } } } } while (0)

struct XcdBarrier {
    unsigned* bar; unsigned x;
    volatile LAS unsigned* st;
};

__device__ __forceinline__ XcdBarrier xcd_barrier_post(unsigned* bar, volatile LAS unsigned* st) {
    XcdBarrier b; b.bar = bar; b.x = xb_xcc_id(); b.st = st;
    if (threadIdx.x == 0) (void)xb_add(&bar[XB_XCNT(b.x)], 1u);
    return b;
}
__device__ __forceinline__ void xcd_barrier_complete(unsigned* bar, unsigned x, unsigned& nloc, unsigned& nx) {
    const unsigned G = gridDim.x * gridDim.y * gridDim.z;
    unsigned sum, cnt, mine, sp = 0u;
    for (;;) {
        sum = 0u; cnt = 0u; mine = 0u;
#pragma unroll
        for (unsigned j = 0; j < 16; ++j) { const unsigned c = xb_ld(&bar[XB_XCNT(j)]); sum += c; cnt += (c > 0u) ? 1u : 0u; mine = (j == x) ? c : mine; }
        if (sum == G) break;
        __builtin_amdgcn_s_sleep(1);
        if ((++sp & 255u) == 0u) { if (xb_ld(&bar[XB_TMO])) break; if (sp > XB_SPIN_CAP) { atomicAdd(&bar[XB_TMO], 1u); break; } }
    }
    nloc = mine > 0u ? mine : 1u; nx = cnt > 0u ? cnt : 1u;
}

__device__ __forceinline__ void xcd_barrier(const XcdBarrier& b) {
    asm volatile("s_waitcnt vmcnt(0)" ::: "memory");
    __syncthreads();
    if (threadIdx.x == 0) {
        unsigned* bar = b.bar;
        __builtin_amdgcn_s_waitcnt(0);
        unsigned nloc = b.st[0], nx = b.st[1];
        if (nloc == 0u) { xcd_barrier_complete(bar, b.x, nloc, nx); b.st[0] = nloc; b.st[1] = nx; }
        const unsigned old = xb_add(&bar[XB_XSUB(b.x)], 1u);
        const unsigned gen = old / nloc;
        if (old + 1u == (gen + 1u) * nloc) {
            __builtin_amdgcn_fence(__ATOMIC_RELEASE, "agent");
            asm volatile("s_waitcnt vmcnt(0)" ::: "memory");
            const unsigned og = xb_add(&bar[XB_TOP], 1u);
            const unsigned tg = og / nx;
            if (og + 1u == (tg + 1u) * nx) xb_add(&bar[XB_TOPGEN], 1u);
            else XB_SPIN(xb_ld(&bar[XB_TOPGEN]) == tg, bar);
            __builtin_amdgcn_fence(__ATOMIC_ACQUIRE, "agent");
            xb_add(&bar[XB_XGEN(b.x)], 1u);
            asm volatile("s_waitcnt vmcnt(0)" ::: "memory");
        } else {
            XB_SPIN(xb_ld(&bar[XB_XGEN(b.x)]) == gen, bar);
            __builtin_amdgcn_fence(__ATOMIC_ACQUIRE, "agent");
            asm volatile("s_waitcnt vmcnt(0)" ::: "memory");
        }
    }
    __syncthreads();
}

__global__ void __launch_bounds__(512, 2) fwd_kernel(Args a) {
    extern __shared__ __attribute__((aligned(16))) unsigned char lds_raw[];
    cg::grid_group grid = cg::this_grid();
    LAS unsigned char* lds = (LAS unsigned char*)lds_raw;
    const int G = gridDim.x, bx = blockIdx.x;
    const int vcu = (G % 8 == 0) ? (bx % 8) * (G / 8) + bx / 8 : bx;
    const int NGW = G * 8;
#define LAUNDER_TID int tid_l = threadIdx.x; asm volatile("" : "+v"(tid_l)); const int lane = tid_l & 63, wave = __builtin_amdgcn_readfirstlane(tid_l >> 6), gw = vcu * 8 + wave;
#define WSW(name, off) size_t name##_o = (off); asm volatile("" : "+s"(name##_o)); bf16* const name = (bf16*)(((l & 1) ? (unsigned char*)a.out : a.ws) + name##_o);
#define WSP(name, off) size_t name##_o = (off); asm volatile("" : "+s"(name##_o)); bf16* const name = (bf16*)(a.ws + name##_o);
    volatile LAS unsigned* MISC = (volatile LAS unsigned*)(lds + RING_BYTES + 256);
    if (threadIdx.x < 16) MISC[threadIdx.x] = 0u;
    unsigned* barw = (unsigned*)(a.ws + WS_CTL);
    if (bx == 0) for (int i = threadIdx.x; i < XCD_BAR_WORDS; i += 512) barw[i] = 0u;
    __syncthreads();
    { LAUNDER_TID
    for (int tk = gw; tk < 4 * 32 * 16; tk += NGW) { const int l4 = tk >> 9, cg = (tk >> 4) & 31, kc = tk & 15, c = 7168 + 64 * cg + lane;
        const float* wp = a.in[2] + (size_t)l4 * DM * NIN + (size_t)(64 * kc) * NIN + c; float mx = 0.f;
#pragma unroll 16
        for (int kk = 0; kk < 64; ++kk) mx = fmaxf(mx, fabsf(wp[(size_t)kk * NIN]));
        atomicMax((unsigned*)(a.ws + WS_CMAX) + l4 * 2048 + (win_dest_row(c) - 7168), __float_as_uint(mx)); }
    convert_layer(a, 0, lds, gw, NGW, lane, wave, false);
    { const float* x = a.in[0]; WSP(XH, WS_XH) unsigned char* XQ = (unsigned char*)a.out + OUT_XQ; float* XS = (float*)(a.ws + WS_XS);
      for (int m = gw; m < T; m += NGW) { const float* xr = x + (size_t)m * DM + lane * 8;
          const f32x4 v0 = *(const f32x4*)xr, v1 = *(const f32x4*)(xr + 4), v2 = *(const f32x4*)(xr + 512), v3 = *(const f32x4*)(xr + 516);
          bf16* xo = XH + (size_t)m * DM + lane * 8; *(u32x4*)xo = pg8::pack8h(v0, v1); *(u32x4*)(xo + 512) = pg8::pack8h(v2, v3);
          float am = fmaxf(fmaxf(fmaxf(fabsf(v0[0]), fabsf(v0[1])), fmaxf(fabsf(v0[2]), fabsf(v0[3]))), fmaxf(fmaxf(fabsf(v1[0]), fabsf(v1[1])), fmaxf(fabsf(v1[2]), fabsf(v1[3]))));
          am = fmaxf(am, fmaxf(fmaxf(fmaxf(fabsf(v2[0]), fabsf(v2[1])), fmaxf(fabsf(v2[2]), fabsf(v2[3]))), fmaxf(fmaxf(fabsf(v3[0]), fabsf(v3[1])), fmaxf(fabsf(v3[2]), fabsf(v3[3])))));
          am = wave_max(am); const float inv = am > 0.f ? 127.f / am : 0.f;
          unsigned char* xq = XQ + (size_t)m * DM + lane * 8;
          u32x2 w0, w1; w0.x = q4(v0[0], v0[1], v0[2], v0[3], inv); w0.y = q4(v1[0], v1[1], v1[2], v1[3], inv); w1.x = q4(v2[0], v2[1], v2[2], v2[3], inv); w1.y = q4(v3[0], v3[1], v3[2], v3[3], inv);
          *(u32x2*)xq = w0; *(u32x2*)(xq + 512) = w1; if (lane == 0) XS[m] = am; } } }
    grid.sync();
    const XcdBarrier xbar = xcd_barrier_post(barw, MISC + 8);
#define GRID_SYNC() xcd_barrier(xbar)
#pragma unroll 1
    for (int l = 0; l < DEPTH; ++l) {
#ifndef SKIP_P1
        if (l == 0) { LAUNDER_TID
            LAS float* scr = (LAS float*)(lds + wave * 8704);
            for (int it = gw; it < 16 * 64; it += NGW) { const int kb = it >> 6, nb = 224 + (it & 63);
                tr_item_q(a.in[2], (const float*)(a.ws + WS_CMAX), a.ws + WS_WIN + (size_t)7168 * 2048, 64 * kb, 32 * nb, win_dest_row(32 * nb), scr, lane); }
            __syncthreads(); }
        { WSP(XH, WS_XH) WSW(WinT, WS_WIN) WSP(UGQ, WS_UGQ) WSP(Vb, WS_V) WSP(Kb, WS_K) WSP(VBb, WS_VB) WSP(GBb, WS_GB)
          pg8::Gemm g{XH, WinT, T, 7168, DM, DM}; pg8::StaticOrder S; S.init(T, 7168, G, bx);
          pg8::Epi1 E{UGQ, Vb, Kb, VBb, GBb, QSCALE, 0};
          pg8::gemm_phase<pg8::Epi1, pg8::StaticOrder, true, true, true>(lds, g, S, E);
#ifdef PROBE_DUP_P1
          { int dry = 1; asm volatile("" : "+s"(dry)); pg8::Epi1 E2{UGQ, Vb, Kb, VBb, GBb, QSCALE, dry};
          pg8::gemm_phase<pg8::Epi1, pg8::StaticOrder, true, true, true>(lds, g, S, E2); }
#endif
        }
#endif
        GRID_SYNC();
        { WSP(UGQ, WS_UGQ) WSP(Vb, WS_V) WSW(WsB, WS_WS) WSP(Kb, WS_K) WSP(VBb, WS_VB) WSP(GBb, WS_GB)
#pragma unroll 1
        for (int st = 0; st < 2; ++st) {
            if (((st ^ vcu) & 1) == 0) {
#ifndef SKIP_BA
                for (int c = vcu; c < T / 128; c += G)
                    brancha_unit(c, UGQ, Vb, WsB, a.in[3] + l * DM, a.in[4] + l * DM, a.in[6] + l * 8 * 128, lds);
#endif
            } else {
#ifndef SKIP_AT
#pragma unroll 1
                for (int pu2 = 2 * vcu; pu2 < 128 * 16; pu2 += 2 * G) {
#pragma unroll 1
                    for (int j2 = 0; j2 < 2; ++j2) {
                        const int pu = pu2 >> 1, bh = pu >> 3, s = pu & 7;
                        attn_unit(bh >> 4, bh & 15, j2 ? s : 15 - s, UGQ, Kb, VBb, GBb, lds);
                    }
                }
#endif
            }
        }
        if (l + 1 < DEPTH) { __syncthreads(); LAUNDER_TID convert_layer(a, l + 1, lds, gw, NGW, lane, wave); }
        }
        GRID_SYNC();
#ifndef SKIP_P25
        { WSW(WinT, WS_WIN) WSP(SMA, WS_K) WSP(SMB, WS_VB)
          const bf16* XQ = (const bf16*)((const unsigned char*)a.out + OUT_XQ);
          pg8::Gemm g{XQ, WinT + (size_t)7168 * DM, T, 2048, 512, 512}; pg8::GateOrder S; S.init(T, G, bx);
          pg8::EpiGateQ E{SMA, SMB, (const float*)(a.ws + WS_XS), (const float*)(a.ws + WS_CMAX) + l * 2048};
          pg8::gemm_phase<pg8::EpiGateQ, pg8::GateOrder, true, true, 2>(lds, g, S, E); }
        { WSW(PB, WS_PB) WSW(WeT, WS_WE) WSP(EB, WS_GB)
          int kp = PLE; asm volatile("" : "+s"(kp));
          pg8::Gemm g{PB, WeT, T, DM, kp, kp}; pg8::StaticOrder S; S.init(T, DM, G, bx);
          pg8::EpiStore<0> E{EB, EB};
          pg8::gemm_phase<pg8::EpiStore<0>, pg8::StaticOrder, true, true>(lds, g, S, E); }
#endif
#ifndef SKIP_P3
        { WSP(UGQ, WS_UGQ) WSW(W2T, WS_W2) WSP(SMA, WS_K) WSP(SMB, WS_VB) WSP(MERGED, WS_V)
          pg8::Gemm g{UGQ, W2T, T, DM, 2048, 2048}; pg8::StaticOrder S; S.init(T, DM, G, bx);
          pg8::Epi2 E{SMA, SMB, MERGED};
          pg8::gemm_phase<pg8::Epi2, pg8::StaticOrder, true, true>(lds, g, S, E);
#ifdef PROBE_DUP_P3
          pg8::gemm_phase<pg8::Epi2, pg8::StaticOrder, true, true>(lds, g, S, E);
#endif
        }
#endif
        GRID_SYNC();
#ifndef SKIP_P4
        { WSP(MERGED, WS_V) WSW(WoT, WS_WO) WSP(XH1, WS_XH1) WSP(XH, WS_XH)
          pg8::Gemm g{MERGED, WoT, T, DM, DM, DM}; pg8::StaticOrder S; S.init(T, DM, G, bx);
          pg8::Epi3 E{XH, XH1, ALPHA};
          pg8::gemm_phase<pg8::Epi3, pg8::StaticOrder, true, true>(lds, g, S, E); }
#endif
        GRID_SYNC();
#ifndef SKIP_P5
        { WSP(XH1, WS_XH1) WSW(WgT, WS_WG) WSP(EB, WS_GB) WSP(XH, WS_XH)
          pg8::Gemm g{XH1, WgT, T, DM, DM, DM}; pg8::StaticOrder S; S.init(T, DM, G, bx);
          pg8::Epi4 E{XH1, XH, EB};
          pg8::gemm_phase<pg8::Epi4, pg8::StaticOrder, true, true, true>(lds, g, S, E); }
#endif
        GRID_SYNC();
#ifdef PROBE_SYNC
        for (int z = 0; z < 10; ++z) GRID_SYNC();
#endif
        LAUNDER_TID WSP(XH, WS_XH)
        ln_rows(XH, (unsigned char*)a.out + OUT_XQ, (float*)(a.ws + WS_XS), a.out, a.in[12] + l * DM, a.in[13] + l * DM, l + 1 == DEPTH, gw, NGW, lane);
        if (l + 1 < DEPTH) GRID_SYNC();
    }
}

extern "C" void kernel_launch(void* const* d_in, const int* in_sizes, int n_in, void* d_out, int out_size, void* d_ws, size_t ws_size, hipStream_t stream) {
    static int grid = 0;
    if (grid == 0) {
        if (n_in != 14 || out_size != T * DM || ws_size < WS_END) { fprintf(stderr, "kernel_launch: unexpected shapes (n_in %d out %d ws %zu)\n", n_in, out_size, ws_size); grid = -1; return; }
        int dev = 0, cus = 0, per_cu = 0;
        hipGetDevice(&dev); hipDeviceGetAttribute(&cus, hipDeviceAttributeMultiprocessorCount, dev);
        hipFuncSetAttribute((const void*)fwd_kernel, hipFuncAttributeMaxDynamicSharedMemorySize, LDS_BYTES);
        hipOccupancyMaxActiveBlocksPerMultiprocessor(&per_cu, (const void*)fwd_kernel, 512, LDS_BYTES);
        if (per_cu < 1) per_cu = 1;
        grid = cus;
        (void)hipGetLastError();
    }
    if (grid < 0) return;
    Args a{};
    for (int i = 0; i < 14; ++i) a.in[i] = (const float*)d_in[i];
    a.out = (float*)d_out; a.ws = (unsigned char*)d_ws;
    hipMemsetAsync((char*)d_ws + WS_CMAX, 0, 4 * 2048 * sizeof(float), stream);
    void* args[] = {&a};
    hipError_t e = hipLaunchCooperativeKernel((const void*)fwd_kernel, dim3(grid), dim3(512), args, LDS_BYTES, stream);
    if (e != hipSuccess) fprintf(stderr, "cooperative launch failed: %s (grid %d)\n", hipGetErrorString(e), grid);
}
```

```cpp
#include <hip/hip_runtime.h>
#include <hip/hip_cooperative_groups.h>
#include <cstdio>
#include <cstdint>
namespace cg = cooperative_groups;
namespace pg8 {
#define PG8_LAS __attribute__((address_space(3)))
typedef unsigned short bf16_t;
typedef short bf16x8 __attribute__((ext_vector_type(8)));
typedef _Float16 f16x8 __attribute__((ext_vector_type(8)));
typedef int i32x4 __attribute__((ext_vector_type(4)));
typedef float f32x4 __attribute__((ext_vector_type(4)));
typedef unsigned u32x4 __attribute__((ext_vector_type(4)));
constexpr int BM = 256, BK = 64, HALF = 128, HTB = HALF * BK * 2  , STAGE_BYTES = 8 * HTB, NXCD = 8, WGM = 8;

__host__ __device__ __forceinline__ int lds_byte(int r, int c) { const int st = (r >> 4) * 2 + (c >> 5), rr = r & 15, cc = c & 31, ob = rr * 64 + cc * 2; return st * 1024 + (ob ^ (((ob >> 9) & 1) << 5)); }
__host__ __device__ __forceinline__ void stage_rc(int b, int& R, int& C) { const int st = b / 1024, sb = b % 1024, swz = sb ^ (((sb >> 9) & 1) << 5); R = (st >> 1) * 16 + swz / 64; C = (st & 1) * 32 + (swz % 64) / 2; }
__host__ __device__ __forceinline__ int perm32(int rho) { const int n = rho >> 4, i = rho & 15; return 8 * (i >> 2) + 4 * n + (i & 3); }

struct Unit { int pm, pn; };
struct Gemm { const bf16_t* A; const bf16_t* Bt; int M, N, K, lda; };

struct StaticOrder {
    int nM, nN, nwg, G, c;
    __host__ __device__ void init(int M, int N, int G_, int c_) { nM = M / BM; nN = N / BM; nwg = nM * nN; G = G_; c = c_; }
    __host__ __device__ bool next(int i, Unit& u) const {
        const long L = (long)i * G + c; if (L >= nwg) return false;
        int wgid = (int)L; { const int q = nwg / NXCD, r = nwg % NXCD, xcd = wgid % NXCD, off = wgid / NXCD; wgid = (xcd < r ? xcd * (q + 1) : r * (q + 1) + (xcd - r) * q) + off; }
        const int nig = WGM * nN, gid = wgid / nig, fm = gid * WGM, gsz = (nM - fm) < WGM ? (nM - fm) : WGM;
        u.pm = fm + ((wgid % nig) % gsz); u.pn = (wgid % nig) / gsz; return true;
    }
    __device__ __forceinline__ void a_ready(const Unit&) const {}
    __device__ __forceinline__ void done(const Unit&) const {}
};
struct GateOrder {
    StaticOrder inner;
    __host__ __device__ void init(int M, int G_, int c_) { inner.init(M, 1024, G_, c_); }
    __host__ __device__ bool next(int i, Unit& u) const { Unit v; if (!inner.next(i >> 1, v)) return false; u.pm = v.pm; u.pn = 2 * v.pn + (i & 1); return true; }
    __device__ __forceinline__ void a_ready(const Unit&) const {}
    __device__ __forceinline__ void done(const Unit&) const {}
};


typedef float f32x2_t __attribute__((ext_vector_type(2))); typedef __bf16 bf16x2_t __attribute__((ext_vector_type(2)));
__device__ __forceinline__ unsigned cvt_pk_bf16(float lo, float hi) { f32x2_t v = {lo, hi}; bf16x2_t b = __builtin_convertvector(v, bf16x2_t); return __builtin_bit_cast(unsigned, b); }
__device__ __forceinline__ float sigm(float x) { return __builtin_amdgcn_rcpf(1.f + __builtin_amdgcn_exp2f(-1.4426950408889634f * x)); }
__device__ __forceinline__ u32x4 pack8(const f32x4 a, const f32x4 b) { u32x4 w; w.x = cvt_pk_bf16(a[0], a[1]); w.y = cvt_pk_bf16(a[2], a[3]); w.z = cvt_pk_bf16(b[0], b[1]); w.w = cvt_pk_bf16(b[2], b[3]); return w; }
__device__ __forceinline__ void unpack8(const u32x4 w, f32x4& a, f32x4& b) {
    a[0] = __uint_as_float(w.x << 16); a[1] = __uint_as_float(w.x & 0xffff0000u); a[2] = __uint_as_float(w.y << 16); a[3] = __uint_as_float(w.y & 0xffff0000u);
    b[0] = __uint_as_float(w.z << 16); b[1] = __uint_as_float(w.z & 0xffff0000u); b[2] = __uint_as_float(w.w << 16); b[3] = __uint_as_float(w.w & 0xffff0000u); }
typedef _Float16 f16x2_t __attribute__((ext_vector_type(2)));
__device__ __forceinline__ unsigned cvt_pk_f16(float lo, float hi) { f32x2_t v = {lo, hi}; f16x2_t h = __builtin_convertvector(v, f16x2_t); return __builtin_bit_cast(unsigned, h); }
__device__ __forceinline__ u32x4 pack8h(const f32x4 a, const f32x4 b) { u32x4 w; w.x = cvt_pk_f16(a[0], a[1]); w.y = cvt_pk_f16(a[2], a[3]); w.z = cvt_pk_f16(b[0], b[1]); w.w = cvt_pk_f16(b[2], b[3]); return w; }
__device__ __forceinline__ void unpack8h(const u32x4 w, f32x4& a, f32x4& b) {
    const unsigned x0 = w.x, x1 = w.y, x2 = w.z, x3 = w.w;
    const f32x2_t p0 = __builtin_convertvector(__builtin_bit_cast(f16x2_t, x0), f32x2_t), p1 = __builtin_convertvector(__builtin_bit_cast(f16x2_t, x1), f32x2_t);
    const f32x2_t p2 = __builtin_convertvector(__builtin_bit_cast(f16x2_t, x2), f32x2_t), p3 = __builtin_convertvector(__builtin_bit_cast(f16x2_t, x3), f32x2_t);
    a[0] = p0[0]; a[1] = p0[1]; a[2] = p1[0]; a[3] = p1[1]; b[0] = p2[0]; b[1] = p2[1]; b[2] = p3[0]; b[3] = p3[1]; }
#define PG8_FENCE asm volatile("" ::: "memory")

constexpr int P1_NQ = 12, P1_F0 = 8, P1_NF = 16;
__host__ __device__ constexpr int p1_qtile(int j) { return j < 8 ? j : 24 + (j - 8); }
__host__ __device__ constexpr int p1_qslot(int tile) { return tile < 8 ? tile : (tile >= 24 && tile < 28 ? 8 + (tile - 24) : -1); }
template <bool Q> struct Epi1 {
    static constexpr bool PERM = true, AFTER_DRAIN = false, HAS_MID = false;
    bf16_t *UGQ, *V, *K, *VB, *GB; float qscale; const float* XS; const float* CS;
    __device__ __forceinline__ static f32x4 val(const f32x4 a, float rs, const f32x4 cs) {
        if constexpr (Q) { const i32x4 q = __builtin_bit_cast(i32x4, a); return (f32x4){(float)q[0], (float)q[1], (float)q[2], (float)q[3]} * (cs * rs); } else return a; }
    __device__ __forceinline__ void operator()(const f32x4 (&acc)[2][2][4][2], const Unit& u, int wr, int wc, int fr, int fq) const {
        asm volatile("" : "+v"(fr), "+v"(fq));
        const int row0 = u.pm * BM + wr * 64 + fr, cw = wc * 32 + 8 * fq;
        const int pn = Q ? p1_qtile(u.pn) : u.pn + P1_F0;
        float rsc[2][4]; f32x4 cs[2][2];
#pragma unroll
        for (int ai = 0; ai < 2; ++ai)
#pragma unroll
            for (int m = 0; m < 4; ++m) rsc[ai][m] = Q ? XS[row0 + ai * HALF + m * 16] * (1.f / (127.f * 127.f)) : 1.f;
#pragma unroll
        for (int bj = 0; bj < 2; ++bj)
#pragma unroll
            for (int n = 0; n < 2; ++n) cs[bj][n] = Q ? *(const f32x4*)(CS + u.pn * BM + bj * HALF + cw + 4 * n) : (f32x4){1.f, 1.f, 1.f, 1.f};
        if (pn < 8) {
            bf16_t* base = UGQ + pn * 128 + cw;
#pragma unroll
            for (int ai = 0; ai < 2; ++ai)
#pragma unroll
                for (int m = 0; m < 4; ++m) {
                    f32x4 u0 = val(acc[ai][0][m][0], rsc[ai][m], cs[0][0]), u1 = val(acc[ai][0][m][1], rsc[ai][m], cs[0][1]);
                    const f32x4 g0 = val(acc[ai][1][m][0], rsc[ai][m], cs[1][0]), g1 = val(acc[ai][1][m][1], rsc[ai][m], cs[1][1]);
#pragma unroll
                    for (int e = 0; e < 4; ++e) { u0[e] *= g0[e] * sigm(g0[e]); u1[e] *= g1[e] * sigm(g1[e]); }
                    __builtin_nontemporal_store(pack8(u0, u1), (u32x4*)(base + (size_t)(row0 + ai * HALF + m * 16) * 2048));
                }
        } else {
            const int seg = (pn - 8) >> 2, ct = (pn - 8) & 3;
            bf16_t* base; int ldc = 1024; float sc = 1.f;
            if (seg == 0) base = V; else if (seg == 1) { base = UGQ + 1024; ldc = 2048; sc = qscale; } else if (seg == 2) base = K; else if (seg == 3) base = VB; else base = GB;
            base += ct * 256 + cw;
#pragma unroll
            for (int ai = 0; ai < 2; ++ai)
#pragma unroll
                for (int m = 0; m < 4; ++m) { bf16_t* rowp = base + (size_t)(row0 + ai * HALF + m * 16) * ldc;
#pragma unroll
                    for (int bj = 0; bj < 2; ++bj) __builtin_nontemporal_store(pack8(val(acc[ai][bj][m][0], rsc[ai][m], cs[bj][0]) * sc, val(acc[ai][bj][m][1], rsc[ai][m], cs[bj][1]) * sc), (u32x4*)(rowp + bj * HALF)); }
        }
    }
};
template <int SIG> struct EpiStore {
    static constexpr bool PERM = true, AFTER_DRAIN = false, HAS_MID = false;
    bf16_t *D0, *D1;
    __device__ __forceinline__ void operator()(const f32x4 (&acc)[2][2][4][2], const Unit& u, int wr, int wc, int fr, int fq) const {
        asm volatile("" : "+v"(fr), "+v"(fq));
        const int row0 = u.pm * BM + wr * 64 + fr, cw = wc * 32 + 8 * fq;
        bf16_t* base = (u.pn < 4 ? D0 : D1) + (u.pn & 3) * 256 + cw;
#pragma unroll
        for (int ai = 0; ai < 2; ++ai)
#pragma unroll
            for (int m = 0; m < 4; ++m) { bf16_t* rowp = base + (size_t)(row0 + ai * HALF + m * 16) * 1024;
#pragma unroll
                for (int bj = 0; bj < 2; ++bj) { f32x4 v0 = acc[ai][bj][m][0], v1 = acc[ai][bj][m][1];
                    if (SIG) {
#pragma unroll
                        for (int e = 0; e < 4; ++e) { v0[e] = sigm(v0[e]); v1[e] = sigm(v1[e]); } }
                    __builtin_nontemporal_store(pack8(v0, v1), (u32x4*)(rowp + bj * HALF)); } }
    }
};
struct EpiGate {
    static constexpr bool PERM = true, AFTER_DRAIN = false, HAS_MID = false;
    bf16_t *RHO, *SMB;
    __device__ __forceinline__ void operator()(const f32x4 (&acc)[2][2][4][2], const Unit& u, int wr, int wc, int fr, int fq) const {
        asm volatile("" : "+v"(fr), "+v"(fq));
        const int row0 = u.pm * BM + wr * 64 + fr, c0 = u.pn * 128 + wc * 32 + 8 * fq;
#pragma unroll
        for (int ai = 0; ai < 2; ++ai)
#pragma unroll
            for (int m = 0; m < 4; ++m) { const size_t off = (size_t)(row0 + ai * HALF + m * 16) * 1024 + c0;
                f32x4 r0, r1, s0, s1;
#pragma unroll
                for (int e = 0; e < 4; ++e) {
                    const float ea0 = __builtin_amdgcn_exp2f(fminf(-1.4426950408889634f * acc[ai][0][m][0][e], 80.f)), eb0 = __builtin_amdgcn_exp2f(fminf(-1.4426950408889634f * acc[ai][1][m][0][e], 80.f));
                    const float ea1 = __builtin_amdgcn_exp2f(fminf(-1.4426950408889634f * acc[ai][0][m][1][e], 80.f)), eb1 = __builtin_amdgcn_exp2f(fminf(-1.4426950408889634f * acc[ai][1][m][1][e], 80.f));
                    r0[e] = (1.f + eb0) * __builtin_amdgcn_rcpf(1.f + ea0); r1[e] = (1.f + eb1) * __builtin_amdgcn_rcpf(1.f + ea1);
                    s0[e] = __builtin_amdgcn_rcpf(1.f + eb0); s1[e] = __builtin_amdgcn_rcpf(1.f + eb1); }
                *(u32x4*)(RHO + off) = pack8(r0, r1); *(u32x4*)(SMB + off) = pack8(s0, s1); }
    }
};
struct EpiGateQ {
    static constexpr bool PERM = true, AFTER_DRAIN = false, HAS_MID = false;
    bf16_t *RHO, *SMB; const float* XS; const float* CS;
    __device__ __forceinline__ void operator()(const f32x4 (&acc)[2][2][4][2], const Unit& u, int wr, int wc, int fr, int fq) const {
        asm volatile("" : "+v"(fr), "+v"(fq));
        const int row0 = u.pm * BM + wr * 64 + fr, c0 = u.pn * 128 + wc * 32 + 8 * fq;
        float rsc[2][4]; f32x4 cs[2][2];
#pragma unroll
        for (int ai = 0; ai < 2; ++ai)
#pragma unroll
            for (int m = 0; m < 4; ++m) rsc[ai][m] = XS[row0 + ai * HALF + m * 16] * (1.f / (127.f * 127.f));
#pragma unroll
        for (int bj = 0; bj < 2; ++bj) { const int ci = u.pn * BM + bj * HALF + wc * 32 + 8 * fq; cs[bj][0] = *(const f32x4*)(CS + ci); cs[bj][1] = *(const f32x4*)(CS + ci + 4); }
#pragma unroll
        for (int ai = 0; ai < 2; ++ai)
#pragma unroll
            for (int m = 0; m < 4; ++m) { const size_t off = (size_t)(row0 + ai * HALF + m * 16) * 1024 + c0;
                f32x4 r0, r1, s0, s1;
#pragma unroll
                for (int e = 0; e < 4; ++e) {
                    const i32x4 qa0 = __builtin_bit_cast(i32x4, acc[ai][0][m][0]), qa1 = __builtin_bit_cast(i32x4, acc[ai][0][m][1]), qb0 = __builtin_bit_cast(i32x4, acc[ai][1][m][0]), qb1 = __builtin_bit_cast(i32x4, acc[ai][1][m][1]);
                    const float ma0 = (float)qa0[e] * (rsc[ai][m] * cs[0][0][e]), ma1 = (float)qa1[e] * (rsc[ai][m] * cs[0][1][e]);
                    const float mb0 = (float)qb0[e] * (rsc[ai][m] * cs[1][0][e]), mb1 = (float)qb1[e] * (rsc[ai][m] * cs[1][1][e]);
                    const float ea0 = __builtin_amdgcn_exp2f(fminf(-1.4426950408889634f * ma0, 80.f)), eb0 = __builtin_amdgcn_exp2f(fminf(-1.4426950408889634f * mb0, 80.f));
                    const float ea1 = __builtin_amdgcn_exp2f(fminf(-1.4426950408889634f * ma1, 80.f)), eb1 = __builtin_amdgcn_exp2f(fminf(-1.4426950408889634f * mb1, 80.f));
                    r0[e] = (1.f + eb0) * __builtin_amdgcn_rcpf(1.f + ea0); r1[e] = (1.f + eb1) * __builtin_amdgcn_rcpf(1.f + ea1);
                    s0[e] = __builtin_amdgcn_rcpf(1.f + eb0); s1[e] = __builtin_amdgcn_rcpf(1.f + eb1); }
                *(u32x4*)(RHO + off) = pack8(r0, r1); *(u32x4*)(SMB + off) = pack8(s0, s1); }
    }
};
struct Epi2 {
    static constexpr bool PERM = true, AFTER_DRAIN = false, HAS_MID = true;
    const bf16_t *SMA, *SMB; bf16_t* OUT;
    __device__ __forceinline__ void mid(f32x4 (&acc)[2][2][4][2], const Unit& u, int wr, int wc, int fr, int fq) const {
        asm volatile("" : "+v"(fr), "+v"(fq));
        const int row0 = u.pm * BM + wr * 64 + fr, c0 = u.pn * BM + wc * 32 + 8 * fq;
#pragma unroll
        for (int ai = 0; ai < 2; ++ai) {
            u32x4 wa[4][2];
#pragma unroll
            for (int m = 0; m < 4; ++m) { const size_t off = (size_t)(row0 + ai * HALF + m * 16) * 1024 + c0;
#pragma unroll
                for (int bj = 0; bj < 2; ++bj) wa[m][bj] = *(const u32x4*)(SMA + off + bj * HALF); }
            PG8_FENCE;
#pragma unroll
            for (int m = 0; m < 4; ++m)
#pragma unroll
                for (int bj = 0; bj < 2; ++bj) { f32x4 a0, a1; unpack8(wa[m][bj], a0, a1); acc[ai][bj][m][0] *= a0; acc[ai][bj][m][1] *= a1; }
            PG8_FENCE; }
    }
    __device__ __forceinline__ void operator()(const f32x4 (&acc)[2][2][4][2], const Unit& u, int wr, int wc, int fr, int fq) const {
        asm volatile("" : "+v"(fr), "+v"(fq));
        const int row0 = u.pm * BM + wr * 64 + fr, c0 = u.pn * BM + wc * 32 + 8 * fq;
        u32x4 wb[2][4][2];
#pragma unroll
        for (int ai = 0; ai < 2; ++ai)
#pragma unroll
            for (int m = 0; m < 4; ++m) { const size_t off = (size_t)(row0 + ai * HALF + m * 16) * 1024 + c0;
#pragma unroll
                for (int bj = 0; bj < 2; ++bj) wb[ai][m][bj] = *(const u32x4*)(SMB + off + bj * HALF); }
        PG8_FENCE;
#pragma unroll
        for (int ai = 0; ai < 2; ++ai)
#pragma unroll
            for (int m = 0; m < 4; ++m) { const size_t off = (size_t)(row0 + ai * HALF + m * 16) * 1024 + c0;
#pragma unroll
                for (int bj = 0; bj < 2; ++bj) { f32x4 b0, b1; unpack8(wb[ai][m][bj], b0, b1);
                    *(u32x4*)(OUT + off + bj * HALF) = pack8(acc[ai][bj][m][0] * b0, acc[ai][bj][m][1] * b1); } }
    }
};
struct Epi3 {
    static constexpr bool PERM = true, AFTER_DRAIN = false, HAS_MID = false;
    const bf16_t* XH; bf16_t* XO; float alpha;
    __device__ __forceinline__ void operator()(const f32x4 (&acc)[2][2][4][2], const Unit& u, int wr, int wc, int fr, int fq) const {
        asm volatile("" : "+v"(fr), "+v"(fq));
        const int row0 = u.pm * BM + wr * 64 + fr, c0 = u.pn * BM + wc * 32 + 8 * fq;
#pragma unroll
        for (int ai = 0; ai < 2; ++ai) {
            u32x4 wx[4][2];
#pragma unroll
            for (int m = 0; m < 4; ++m) { const size_t off = (size_t)(row0 + ai * HALF + m * 16) * 1024 + c0;
#pragma unroll
                for (int bj = 0; bj < 2; ++bj) wx[m][bj] = *(const u32x4*)(XH + off + bj * HALF); }
            PG8_FENCE;
#pragma unroll
            for (int m = 0; m < 4; ++m) { const size_t off = (size_t)(row0 + ai * HALF + m * 16) * 1024 + c0;
#pragma unroll
                for (int bj = 0; bj < 2; ++bj) { f32x4 r0, r1; unpack8h(wx[m][bj], r0, r1);
                    const f32x4 h0 = r0 * alpha + acc[ai][bj][m][0], h1 = r1 * alpha + acc[ai][bj][m][1];
                    *(u32x4*)(XO + off + bj * HALF) = pack8h(h0, h1); } }
            PG8_FENCE; }
    }
};
struct Epi4 {
    static constexpr bool PERM = true, AFTER_DRAIN = false, HAS_MID = false;
    const bf16_t* H0; bf16_t* XO; const bf16_t* E;
    __device__ __forceinline__ void operator()(const f32x4 (&acc)[2][2][4][2], const Unit& u, int wr, int wc, int fr, int fq) const {
        asm volatile("" : "+v"(fr), "+v"(fq));
        const int row0 = u.pm * BM + wr * 64 + fr, c0 = u.pn * BM + wc * 32 + 8 * fq;
#pragma unroll
        for (int ai = 0; ai < 2; ++ai) {
            u32x4 wx[4][2], we[4][2];
#pragma unroll
            for (int m = 0; m < 4; ++m) { const size_t off = (size_t)(row0 + ai * HALF + m * 16) * 1024 + c0;
#pragma unroll
                for (int bj = 0; bj < 2; ++bj) { wx[m][bj] = *(const u32x4*)(H0 + off + bj * HALF); we[m][bj] = *(const u32x4*)(E + off + bj * HALF); } }
            PG8_FENCE;
#pragma unroll
            for (int m = 0; m < 4; ++m) { const size_t off = (size_t)(row0 + ai * HALF + m * 16) * 1024 + c0;
#pragma unroll
                for (int bj = 0; bj < 2; ++bj) { f32x4 h0, h1, e0, e1; unpack8h(wx[m][bj], h0, h1); unpack8(we[m][bj], e0, e1);
#pragma unroll
                    for (int e = 0; e < 4; ++e) { h0[e] += e0[e] * sigm(acc[ai][bj][m][0][e]); h1[e] += e1[e] * sigm(acc[ai][bj][m][1][e]); }
                    *(u32x4*)(XO + off + bj * HALF) = pack8h(h0, h1); } }
            PG8_FENCE; }
    }
};
template <class Epi, class Sched, bool ALIGN_EPI = false, bool SP2 = false, int MODE = 0>
__device__ __forceinline__ void gemm_phase(PG8_LAS unsigned char* lds, const Gemm g, const Sched& S, const Epi& E) {
    int tid_ = threadIdx.x; asm volatile("" : "+v"(tid_));
    const int tid = tid_, wid = __builtin_amdgcn_readfirstlane(tid >> 6), lane = tid & 63, wr = wid >> 2, wc = wid & 3, fr = lane & 15, fq = lane >> 4;
    const int K = g.K, nt = K / BK;
    unsigned voffA[2], voffB[2];
#pragma unroll
    for (int i = 0; i < 2; ++i) { int R, C; stage_rc(tid * 16 + i * 8192, R, C); const int Rb = Epi::PERM ? ((R & ~31) + perm32(R & 31)) : R;
        voffA[i] = (unsigned)(R * g.lda + C) * 2u; voffB[i] = (unsigned)(Rb * K + C) * 2u; }
    const size_t kstep = (size_t)(BK * 2);
    const size_t hstepA = (size_t)HALF * g.lda * 2, hstepB = (size_t)HALF * K * 2;
    const size_t tstepA = 2 * hstepA, tstepB = 2 * hstepB;
    const unsigned ldsw = (unsigned)wid * 1024u;
    const int aoff = lds_byte(wr * 64 + fr, fq * 8), boff = lds_byte(wc * 32 + fr, fq * 8);
#define PG8_SA(b, h) (((b) * 2 + (h)) * HTB)
#define PG8_SB(b, h) ((4 + (b) * 2 + (h)) * HTB)
#define PG8_STAGE(bufoff, gbase, voff) do { _Pragma("unroll") for (int _i = 0; _i < 2; ++_i) \
        __builtin_amdgcn_global_load_lds((const unsigned*)((const char*)(gbase) + (voff)[_i]), (PG8_LAS unsigned*)(lds + (bufoff) + ldsw + _i * 8192), 16, 0, 0); } while (0)
#define PG8_LDA(dst, b, h) do { _Pragma("unroll") for (int m = 0; m < 4; ++m) _Pragma("unroll") for (int k = 0; k < 2; ++k) dst[m][k] = *(const PG8_LAS bf16x8*)(lds + PG8_SA(b, h) + aoff + m * 2048 + k * 1024); } while (0)
#define PG8_LDB(dst, b, h) do { _Pragma("unroll") for (int n = 0; n < 2; ++n) _Pragma("unroll") for (int k = 0; k < 2; ++k) dst[n][k] = *(const PG8_LAS bf16x8*)(lds + PG8_SB(b, h) + boff + n * 2048 + k * 1024); } while (0)
#define PG8_MMA(ai, bj, At, Bt) do { __builtin_amdgcn_s_setprio(1); _Pragma("unroll") for (int m = 0; m < 4; ++m) _Pragma("unroll") for (int n = 0; n < 2; ++n) _Pragma("unroll") for (int k = 0; k < 2; ++k) \
        { if constexpr (MODE == 2) acc[ai][bj][m][n] = __builtin_bit_cast(f32x4, __builtin_amdgcn_mfma_i32_16x16x64_i8(__builtin_bit_cast(i32x4, Bt[n][k]), __builtin_bit_cast(i32x4, At[m][k]), __builtin_bit_cast(i32x4, acc[ai][bj][m][n]), 0, 0, 0)); \
          else if constexpr (MODE == 1) acc[ai][bj][m][n] = __builtin_amdgcn_mfma_f32_16x16x32_f16(__builtin_bit_cast(f16x8, Bt[n][k]), __builtin_bit_cast(f16x8, At[m][k]), acc[ai][bj][m][n], 0, 0, 0); \
          else acc[ai][bj][m][n] = __builtin_amdgcn_mfma_f32_16x16x32_bf16(Bt[n][k], At[m][k], acc[ai][bj][m][n], 0, 0, 0); } __builtin_amdgcn_s_setprio(0); } while (0)
#define PG8_WAIT_V(n) asm volatile("s_waitcnt vmcnt(" #n ")" ::: "memory")
#define PG8_WAIT_L(n) asm volatile("s_waitcnt lgkmcnt(" #n ")" ::: "memory")
#define PG8_BAR __builtin_amdgcn_s_barrier()
#define PG8_SCHED __builtin_amdgcn_sched_barrier(0)
    Unit cur, nxt; int ui = 0;
    if (!S.next(0, cur)) return;
    f32x4 acc[2][2][4][2];
#pragma unroll
    for (int a = 0; a < 2; ++a)
#pragma unroll
        for (int b = 0; b < 2; ++b)
#pragma unroll
            for (int m = 0; m < 4; ++m)
#pragma unroll
                for (int n = 0; n < 2; ++n) acc[a][b][m][n] = (f32x4){0.f, 0.f, 0.f, 0.f};
    bf16x8 At[4][2], B0[2][2], B1[2][2];
    const char* cA = (const char*)g.A + (size_t)cur.pm * tstepA; const char* cB = (const char*)g.Bt + (size_t)cur.pn * tstepB;
    S.a_ready(cur);
    if constexpr (SP2) {
        PG8_STAGE(PG8_SB(0, 0), cB, voffB); PG8_STAGE(PG8_SB(0, 1), cB + hstepB, voffB); PG8_STAGE(PG8_SA(0, 0), cA, voffA); PG8_STAGE(PG8_SA(0, 1), cA + hstepA, voffA);
        if (wr == 1) PG8_BAR;
        PG8_WAIT_V(2); PG8_BAR;
        PG8_STAGE(PG8_SB(1, 0), cB + kstep, voffB); PG8_STAGE(PG8_SA(1, 0), cA + kstep, voffA); PG8_STAGE(PG8_SB(1, 1), cB + hstepB + kstep, voffB);
        PG8_WAIT_V(6); PG8_BAR;
    } else {
        PG8_STAGE(PG8_SB(0, 0), cB, voffB); PG8_STAGE(PG8_SA(0, 0), cA, voffA); PG8_STAGE(PG8_SB(0, 1), cB + hstepB, voffB); PG8_STAGE(PG8_SA(0, 1), cA + hstepA, voffA);
        if (wr == 1) PG8_BAR;
        PG8_WAIT_V(4); PG8_BAR;
        PG8_STAGE(PG8_SB(1, 0), cB + kstep, voffB); PG8_STAGE(PG8_SA(1, 0), cA + kstep, voffA); PG8_STAGE(PG8_SB(1, 1), cB + hstepB + kstep, voffB);
        PG8_WAIT_V(6); PG8_BAR;
    }
    for (;;) {
        const bool has_next = S.next(ui + 1, nxt);
        const char* nA = has_next ? (const char*)g.A + (size_t)nxt.pm * tstepA : cA; const char* nB = has_next ? (const char*)g.Bt + (size_t)nxt.pn * tstepB : cB;
        for (int t = 0; t < nt; t += 2) { if constexpr (Epi::HAS_MID) { if (t == (nt >> 1)) E.mid(acc, cur, wr, wc, fr, fq); }
            const bool last = (t == nt - 2);
            const char* a1 = cA + (size_t)(t + 1) * kstep;
            const char* a2 = last ? nA : cA + (size_t)(t + 2) * kstep; const char* b2 = last ? nB : cB + (size_t)(t + 2) * kstep;
            const char* a3 = a2 + kstep; const char* b3 = b2 + kstep;
            if (last && has_next) S.a_ready(nxt);
            if constexpr (SP2) {
            PG8_LDB(B0, 0, 0); PG8_LDB(B1, 0, 1); PG8_SCHED; PG8_LDA(At, 0, 0); PG8_STAGE(PG8_SA(1, 1), a1 + hstepA, voffA);
            PG8_WAIT_V(8); PG8_WAIT_L(0); PG8_BAR; PG8_MMA(0, 0, At, B0); PG8_MMA(0, 1, At, B1); PG8_BAR; PG8_SCHED;
            PG8_LDA(At, 0, 1); PG8_STAGE(PG8_SB(0, 0), b2, voffB); PG8_STAGE(PG8_SB(0, 1), b2 + hstepB, voffB); PG8_STAGE(PG8_SA(0, 0), a2, voffA);
            PG8_WAIT_V(8); PG8_WAIT_L(0); PG8_BAR; PG8_MMA(1, 0, At, B0); PG8_MMA(1, 1, At, B1); PG8_BAR; PG8_SCHED;
            PG8_LDB(B0, 1, 0); PG8_LDB(B1, 1, 1); PG8_SCHED; PG8_LDA(At, 1, 0); PG8_STAGE(PG8_SA(0, 1), a2 + hstepA, voffA);
            PG8_WAIT_V(8); PG8_WAIT_L(0); PG8_BAR; PG8_MMA(0, 0, At, B0); PG8_MMA(0, 1, At, B1); PG8_BAR; PG8_SCHED;
            PG8_LDA(At, 1, 1); PG8_STAGE(PG8_SB(1, 0), b3, voffB); PG8_STAGE(PG8_SB(1, 1), b3 + hstepB, voffB); PG8_STAGE(PG8_SA(1, 0), a3, voffA);
            PG8_WAIT_V(8); PG8_WAIT_L(0); PG8_BAR; PG8_MMA(1, 0, At, B0); PG8_MMA(1, 1, At, B1); PG8_BAR; PG8_SCHED;
            } else {
            PG8_LDB(B0, 0, 0); PG8_SCHED; PG8_LDA(At, 0, 0); PG8_STAGE(PG8_SA(1, 1), a1 + hstepA, voffA);
            PG8_WAIT_L(8); PG8_BAR; PG8_WAIT_L(0); PG8_MMA(0, 0, At, B0); PG8_BAR; PG8_SCHED;
            PG8_LDB(B1, 0, 1); PG8_STAGE(PG8_SB(0, 0), b2, voffB);
            PG8_BAR; PG8_WAIT_L(0); PG8_MMA(0, 1, At, B1); PG8_BAR;
            PG8_LDA(At, 0, 1); PG8_STAGE(PG8_SA(0, 0), a2, voffA);
            PG8_BAR; PG8_WAIT_L(0); PG8_MMA(1, 0, At, B0); PG8_BAR; PG8_SCHED;
            PG8_STAGE(PG8_SB(0, 1), b2 + hstepB, voffB);
            PG8_WAIT_V(6); PG8_BAR; PG8_MMA(1, 1, At, B1); PG8_BAR;
            PG8_LDB(B0, 1, 0); PG8_SCHED; PG8_LDA(At, 1, 0); PG8_STAGE(PG8_SA(0, 1), a2 + hstepA, voffA);
            PG8_WAIT_L(8); PG8_BAR; PG8_WAIT_L(0); PG8_MMA(0, 0, At, B0); PG8_BAR; PG8_SCHED;
            PG8_LDB(B1, 1, 1); PG8_STAGE(PG8_SB(1, 0), b3, voffB);
            PG8_BAR; PG8_WAIT_L(0); PG8_MMA(0, 1, At, B1); PG8_BAR;
            PG8_LDA(At, 1, 1); PG8_STAGE(PG8_SA(1, 0), a3, voffA);
            PG8_BAR; PG8_WAIT_L(0); PG8_MMA(1, 0, At, B0); PG8_BAR; PG8_SCHED;
            PG8_STAGE(PG8_SB(1, 1), b3 + hstepB, voffB);
            PG8_WAIT_V(6); PG8_BAR; PG8_MMA(1, 1, At, B1); PG8_BAR;
            }
        }
        if constexpr (ALIGN_EPI) { if (wr == 0) PG8_BAR; }
        if constexpr (!Epi::AFTER_DRAIN) { E(acc, cur, wr, wc, fr, fq); S.done(cur); }
        if (!has_next) break;
#pragma unroll
        for (int a = 0; a < 2; ++a)
#pragma unroll
            for (int b = 0; b < 2; ++b)
#pragma unroll
                for (int m = 0; m < 4; ++m)
#pragma unroll
                    for (int n = 0; n < 2; ++n) acc[a][b][m][n] = (f32x4){0.f, 0.f, 0.f, 0.f};
        cur = nxt; cA = nA; cB = nB; ++ui;
        if constexpr (ALIGN_EPI) { if (wr == 1) PG8_BAR; }
    }
    PG8_WAIT_V(0);
    if constexpr (!ALIGN_EPI) { if (wr == 0) PG8_BAR; }
    PG8_BAR;
    if constexpr (Epi::AFTER_DRAIN) { E.fused(acc, cur, wr, wc, fr, fq, lds, wid, lane); S.done(cur); }
#undef PG8_SA
#undef PG8_SB
#undef PG8_STAGE
#undef PG8_LDA
#undef PG8_LDB
#undef PG8_MMA
#undef PG8_WAIT_V
#undef PG8_WAIT_L
#undef PG8_BAR
#undef PG8_SCHED
}
}
#define LAS __attribute__((address_space(3)))
typedef unsigned short bf16;
typedef unsigned u32x4 __attribute__((ext_vector_type(4)));
typedef unsigned u32x2 __attribute__((ext_vector_type(2)));
typedef float f32x4 __attribute__((ext_vector_type(4)));
typedef float f32x16 __attribute__((ext_vector_type(16)));
typedef short bf16x8 __attribute__((ext_vector_type(8)));
constexpr int DM = 1024, NBATCH = 8, SEQ = 4096, T = NBATCH * SEQ, DEPTH = 4, PLE = 256, NIN = 9216, NHEAD = 16, HD = 64;
constexpr float LN_EPS = 1e-5f;
constexpr float ALPHA = 1.681792830507429f;
constexpr float QSCALE = 0.125f * 1.4426950408889634f;
constexpr size_t MiB = 1u << 20;
constexpr size_t WS_WIN = 0, WS_W2 = 18 * MiB, WS_WO = 22 * MiB, WS_WG = 24 * MiB, WS_WE = 26 * MiB, WS_WS = 27 * MiB, WS_PB = 28 * MiB, WS_XH1 = 44 * MiB,
                 WS_UGQ = 108 * MiB, WS_V = 236 * MiB, WS_K = 300 * MiB, WS_VB = 364 * MiB, WS_GB = 428 * MiB, WS_CTL = 492 * MiB, WS_XH = 493 * MiB, WS_XS = 557 * MiB  , WS_CMAX = WS_XS + 256 * 1024  , WS_CMAX1 = WS_CMAX + 32 * 1024  , WS_END = 558 * MiB;
constexpr size_t OUT_XQ = 64 * MiB;
constexpr int LDS_BYTES = 147456, RING_BYTES = 131072;

__device__ __forceinline__ float wave_sum(float v) {
#pragma unroll
    for (int o = 1; o < 64; o <<= 1) v += __shfl_xor(v, o);
    return v;
}
__device__ __forceinline__ unsigned pk2(float lo, float hi) { return pg8::cvt_pk_bf16(lo, hi); }
__device__ __forceinline__ float bf_lo(unsigned w) { return __uint_as_float(w << 16); }
__device__ __forceinline__ float bf_hi(unsigned w) { return __uint_as_float(w & 0xffff0000u); }

template <bool F16 = false> __device__ __forceinline__ void tr_item(const float* W, int N, bf16* WT, int ldk, int koff, int k0, int n0, int drow0, LAS float* scr, int lane) {
#pragma unroll 8
    for (int i = 0; i < 32; ++i) { const int kk = 2 * i + (lane >> 5); scr[kk * 33 + (lane & 31)] = W[(size_t)(k0 + kk) * N + n0 + (lane & 31)]; }
    asm volatile("s_waitcnt lgkmcnt(0)" ::: "memory");
    const int c = lane & 7;
#pragma unroll
    for (int j = 0; j < 4; ++j) { const int n = (lane >> 3) + 8 * j; const LAS float* s = scr + (8 * c) * 33 + n;
        u32x4 o;
        if constexpr (F16) { o.x = pg8::cvt_pk_f16(s[0 * 33], s[1 * 33]); o.y = pg8::cvt_pk_f16(s[2 * 33], s[3 * 33]); o.z = pg8::cvt_pk_f16(s[4 * 33], s[5 * 33]); o.w = pg8::cvt_pk_f16(s[6 * 33], s[7 * 33]); }
        else { o.x = pk2(s[0 * 33], s[1 * 33]); o.y = pk2(s[2 * 33], s[3 * 33]); o.z = pk2(s[4 * 33], s[5 * 33]); o.w = pk2(s[6 * 33], s[7 * 33]); }
        *(u32x4*)(WT + (size_t)(drow0 + n) * ldk + koff + k0 + 8 * c) = o; }
    asm volatile("s_waitcnt lgkmcnt(0)" ::: "memory");
}
__device__ __forceinline__ float wave_max(float v) {
#pragma unroll
    for (int o = 1; o < 64; o <<= 1) v = fmaxf(v, __shfl_xor(v, o));
    return v;
}
__device__ __forceinline__ unsigned q4(float a, float b, float c, float d, float inv) {
    const int ia = (int)__builtin_rintf(a * inv), ib = (int)__builtin_rintf(b * inv), ic = (int)__builtin_rintf(c * inv), id = (int)__builtin_rintf(d * inv);
    return (unsigned)(ia & 0xff) | ((unsigned)(ib & 0xff) << 8) | ((unsigned)(ic & 0xff) << 16) | ((unsigned)(id & 0xff) << 24);
}
__device__ __forceinline__ int win_dest_row(int c);
__device__ __forceinline__ void tr_item_q(const float* W, const float* cmax, unsigned char* WQ, int k0, int n0, int qrow0, LAS float* scr, int lane) {
#pragma unroll 8
    for (int i = 0; i < 32; ++i) { const int kk = 2 * i + (lane >> 5); scr[kk * 33 + (lane & 31)] = W[(size_t)(k0 + kk) * NIN + n0 + (lane & 31)]; }
    asm volatile("s_waitcnt lgkmcnt(0)" ::: "memory");
    const int c16 = lane & 3;
#pragma unroll
    for (int j = 0; j < 2; ++j) { const int n = (lane >> 2) + 16 * j; const LAS float* sp = scr + (16 * c16) * 33 + n;
        const float cm = cmax[qrow0 + n], inv = cm > 0.f ? 127.f / cm : 0.f;
        u32x4 o; o.x = q4(sp[0 * 33], sp[1 * 33], sp[2 * 33], sp[3 * 33], inv); o.y = q4(sp[4 * 33], sp[5 * 33], sp[6 * 33], sp[7 * 33], inv);
        o.z = q4(sp[8 * 33], sp[9 * 33], sp[10 * 33], sp[11 * 33], inv); o.w = q4(sp[12 * 33], sp[13 * 33], sp[14 * 33], sp[15 * 33], inv);
        *(u32x4*)(WQ + (size_t)(qrow0 + n) * 1024 + k0 + 16 * c16) = o; }
    asm volatile("s_waitcnt lgkmcnt(0)" ::: "memory");
}
__device__ __forceinline__ int win_dest_row(int c) {
    if (c < 1024) return 256 * (c >> 7) + (c & 127);
    if (c < 2048) return 2048 + (c - 1024);
    if (c < 3072) { const int cc = c - 2048; return 256 * (cc >> 7) + 128 + (cc & 127); }
    if (c < 7168) return c;
    if (c < 8192) { const int cc = c - 7168; return 7168 + 256 * (cc >> 7) + (cc & 127); }
    { const int cc = c - 8192; return 7168 + 256 * (cc >> 7) + 128 + (cc & 127); }
}
struct Args { const float* in[14]; float* out; unsigned char* ws; };
__device__ __forceinline__ void win_item(const Args& a, int l, unsigned char* wb, int kb, int nb, int what, LAS float* scr, int lane) {
    const float* w_in = a.in[2] + (size_t)l * DM * NIN; const int drow0 = win_dest_row(32 * nb);
    if (drow0 >= 7168) { if (what >= 1) tr_item_q(w_in, (const float*)(a.ws + WS_CMAX) + l * 2048, wb + WS_WIN + (size_t)7168 * 2048, 64 * kb, 32 * nb, drow0 - 7168, scr, lane); return; }
    const int slot = pg8::p1_qslot(drow0 >> 8);
    if (slot >= 0) { if (what >= 1) tr_item_q(w_in, (const float*)(a.ws + WS_CMAX1) + l * (pg8::P1_NQ * 256), wb + WS_WIN, 64 * kb, 32 * nb, slot * 256 + (drow0 & 255), scr, lane); return; }
    if (what != 1) tr_item<true>(w_in, NIN, (bf16*)(wb + WS_WIN), 1024, 0, 64 * kb, 32 * nb, drow0, scr, lane);
}

__device__ __forceinline__ void convert_layer(const Args& a, int l, LAS unsigned char* lds, int gw, int NGW, int lane, int wave, bool gates = true) {
    LAS float* scr = (LAS float*)(lds + wave * 8704);
    unsigned char* ws = (l & 1) ? (unsigned char*)a.out : a.ws;
    const float* w_in = a.in[2] + (size_t)l * DM * NIN;
    const float* w_pa = a.in[7] + (size_t)l * DM * DM; const float* w_pb = a.in[8] + (size_t)l * DM * DM; const float* w_out = a.in[9] + (size_t)l * DM * DM;
    const float* w_pe = a.in[10] + (size_t)l * PLE * DM; const float* w_pg = a.in[11] + (size_t)l * DM * DM;
    constexpr int I_IN = 16 * (NIN / 32), I_SQ = 16 * 32, I_PE = 4 * 32, NITEMS = I_IN + 4 * I_SQ + I_PE;
    for (int it = gw; it < NITEMS; it += NGW) {
        int r = it;
        if (r < I_IN) { win_item(a, l, ws, r / (NIN / 32), r % (NIN / 32), gates ? 2 : 0, scr, lane); continue; } r -= I_IN;
        if (r < I_SQ) { tr_item(w_pa, DM, (bf16*)(ws + WS_W2), 2048, 0, 64 * (r >> 5), 32 * (r & 31), 32 * (r & 31), scr, lane); continue; } r -= I_SQ;
        if (r < I_SQ) { tr_item(w_pb, DM, (bf16*)(ws + WS_W2), 2048, 1024, 64 * (r >> 5), 32 * (r & 31), 32 * (r & 31), scr, lane); continue; } r -= I_SQ;
        if (r < I_SQ) { tr_item(w_out, DM, (bf16*)(ws + WS_WO), 1024, 0, 64 * (r >> 5), 32 * (r & 31), 32 * (r & 31), scr, lane); continue; } r -= I_SQ;
        if (r < I_SQ) { tr_item<true>(w_pg, DM, (bf16*)(ws + WS_WG), 1024, 0, 64 * (r >> 5), 32 * (r & 31), 32 * (r & 31), scr, lane); continue; } r -= I_SQ;
        tr_item(w_pe, DM, (bf16*)(ws + WS_WE), 256, 0, 64 * (r >> 5), 32 * (r & 31), 32 * (r & 31), scr, lane);
    }
    const int gt = gw * 64 + lane, NGT = NGW * 64;
    { const float* w_s = a.in[5] + (size_t)l * 8 * 128 * 128; bf16* WsB = (bf16*)(ws + WS_WS);
      for (int p = gt; p < 8 * 128 * 16; p += NGT) { const int s0 = (p & 15) * 8, t = (p >> 4) & 127;
          const f32x4 x0 = *(const f32x4*)(w_s + (size_t)p * 8), x1 = *(const f32x4*)(w_s + (size_t)p * 8 + 4);
          float v[8] = {x0[0], x0[1], x0[2], x0[3], x1[0], x1[1], x1[2], x1[3]};
#pragma unroll
          for (int j = 0; j < 8; ++j) v[j] = (s0 + j <= t) ? v[j] : 0.f;
          u32x4 o; o.x = pk2(v[0], v[1]); o.y = pk2(v[2], v[3]); o.z = pk2(v[4], v[5]); o.w = pk2(v[6], v[7]);
          *(u32x4*)(WsB + (size_t)p * 8) = o; } }
    { const float* p = a.in[1] + (size_t)l * T * PLE; bf16* PB = (bf16*)(ws + WS_PB);
      for (int q = gt; q < T * PLE / 8; q += NGT) { const f32x4 x0 = *(const f32x4*)(p + (size_t)q * 8), x1 = *(const f32x4*)(p + (size_t)q * 8 + 4);
          u32x4 o; o.x = pk2(x0[0], x0[1]); o.y = pk2(x0[2], x0[3]); o.z = pk2(x1[0], x1[1]); o.w = pk2(x1[2], x1[3]);
          *(u32x4*)(PB + (size_t)q * 8) = o; } }
}

constexpr int AT_K = 0, AT_V = 16384, AT_STG = 16384 + 2 * 9216, AT_STG_W = 8704;
__device__ __forceinline__ void attn_unit(int b, int h, int qb, bf16* UGQ, const bf16* Kb, const bf16* Vb, const bf16* GBb, LAS unsigned char* lds, int dry = 0) {
    int tid_ = threadIdx.x; asm volatile("" : "+v"(tid_));
    const int tid = tid_, lane = tid & 63, wid = __builtin_amdgcn_readfirstlane(tid >> 6), r32 = lane & 31, hi = lane >> 5;
    const size_t rowbase = (size_t)b * SEQ;
    const int q0 = qb * 256, qw = q0 + wid * 32;
    bf16x8 qr[4];
    { const bf16* qp = UGQ + (rowbase + qw + r32) * 2048 + 1024 + h * HD + hi * 8;
#pragma unroll
      for (int d0 = 0; d0 < 4; ++d0) qr[d0] = *(const bf16x8*)(qp + d0 * 16); }
    f32x16 o0, o1;
#pragma unroll
    for (int r = 0; r < 16; ++r) { o0[r] = 0.f; o1[r] = 0.f; }
    float C = 1.f; int alive = 1;
    volatile LAS unsigned* aflag = (volatile LAS unsigned*)(lds + RING_BYTES);
    const int NT = 4 * (qb + 1);
    const int lkey = lane, lch = wid;
    const int kk = lkey & 31, slot = (lkey & 32) | (8 * ((kk >> 2) & 3) + 4 * (kk >> 4) + (kk & 3));
    const bf16* kg = Kb + (rowbase + lkey) * 1024 + h * HD + lch * 8;
    const bf16* vg = Vb + (rowbase + lkey) * 1024 + h * HD + lch * 8;
    u32x4 kreg, vreg;
    kreg = *(const u32x4*)(kg + (size_t)(NT - 1) * 64 * 1024); vreg = *(const u32x4*)(vg + (size_t)(NT - 1) * 64 * 1024);
#define AT_WRITE(buf) do { *(LAS u32x4*)(lds + AT_K + (buf) * 8192 + lch * 1024 + slot * 16) = kreg; \
        LAS unsigned short* vt_ = (LAS unsigned short*)(lds + AT_V + (buf) * 9216) + (lch * 8) * 72 + lkey; \
        vt_[0 * 72] = (unsigned short)(vreg.x & 0xffffu); vt_[1 * 72] = (unsigned short)(vreg.x >> 16); vt_[2 * 72] = (unsigned short)(vreg.y & 0xffffu); vt_[3 * 72] = (unsigned short)(vreg.y >> 16); \
        vt_[4 * 72] = (unsigned short)(vreg.z & 0xffffu); vt_[5 * 72] = (unsigned short)(vreg.z >> 16); vt_[6 * 72] = (unsigned short)(vreg.w & 0xffffu); vt_[7 * 72] = (unsigned short)(vreg.w >> 16); } while (0)
    AT_WRITE(0);
    __syncthreads();
    const int qrel = qw + r32;
    for (int it = 0; it < NT; ++it) {
        const int kt = NT - 1 - it, cur = it & 1;
        if (it + 1 < NT) { kreg = *(const u32x4*)(kg + (size_t)(kt - 1) * 64 * 1024); vreg = *(const u32x4*)(vg + (size_t)(kt - 1) * 64 * 1024); }
        const int k0 = kt * 64;
        if (k0 < qw + 32 && alive) {
            const LAS unsigned char* kb = lds + AT_K + cur * 8192 + hi * 1024 + r32 * 16;
            f32x16 p0, p1;
#pragma unroll
            for (int r = 0; r < 16; ++r) { p0[r] = 0.f; p1[r] = 0.f; }
#pragma unroll
            for (int d0 = 0; d0 < 4; ++d0) {
                const bf16x8 a0 = *(const LAS bf16x8*)(kb + d0 * 2048), a1 = *(const LAS bf16x8*)(kb + d0 * 2048 + 512);
                p0 = __builtin_amdgcn_mfma_f32_32x32x16_bf16(a0, qr[d0], p0, 0, 0, 0);
                p1 = __builtin_amdgcn_mfma_f32_32x32x16_bf16(a1, qr[d0], p1, 0, 0, 0);
            }
#pragma unroll
            for (int r = 0; r < 16; ++r) { p0[r] = __builtin_amdgcn_rcpf(1.f + __builtin_amdgcn_exp2f(p0[r])); p1[r] = __builtin_amdgcn_rcpf(1.f + __builtin_amdgcn_exp2f(p1[r])); }
            if (k0 + 63 >= qw) {
                const int kb0 = k0 + 16 * hi;
#pragma unroll
                for (int r = 0; r < 16; ++r) { if (kb0 + r >= qrel) p0[r] = 1.f; if (kb0 + 32 + r >= qrel) p1[r] = 1.f; }
            }
#pragma unroll
            for (int r = 14; r >= 0; --r) { p0[r] *= p0[r + 1]; p1[r] *= p1[r + 1]; }
            const float L0 = p0[0], L1 = p1[0];
            const float pL0 = __shfl_xor(L0, 32), pL1 = __shfl_xor(L1, 32);
            const float tot1 = L1 * pL1;
            const float pre1 = hi ? C : C * pL1;
            const float pre0 = C * tot1 * (hi ? 1.f : pL0);
            C = C * tot1 * (L0 * pL0);
#pragma unroll
            for (int r = 0; r < 15; ++r) { p0[r] = pre0 * (p0[r + 1] - p0[r]); p1[r] = pre1 * (p1[r + 1] - p1[r]); }
            p0[15] = pre0 * (1.f - p0[15]); p1[15] = pre1 * (1.f - p1[15]);
            u32x4 w00, w01, w10, w11;
            w00.x = pk2(p0[0], p0[1]); w00.y = pk2(p0[2], p0[3]); w00.z = pk2(p0[4], p0[5]); w00.w = pk2(p0[6], p0[7]);
            w01.x = pk2(p0[8], p0[9]); w01.y = pk2(p0[10], p0[11]); w01.z = pk2(p0[12], p0[13]); w01.w = pk2(p0[14], p0[15]);
            w10.x = pk2(p1[0], p1[1]); w10.y = pk2(p1[2], p1[3]); w10.z = pk2(p1[4], p1[5]); w10.w = pk2(p1[6], p1[7]);
            w11.x = pk2(p1[8], p1[9]); w11.y = pk2(p1[10], p1[11]); w11.z = pk2(p1[12], p1[13]); w11.w = pk2(p1[14], p1[15]);
            const LAS unsigned char* vb = lds + AT_V + cur * 9216 + r32 * 144 + hi * 32;
#define AT_PV(W, off) do { const bf16x8 pf_ = __builtin_bit_cast(bf16x8, W); \
                const bf16x8 v0_ = *(const LAS bf16x8*)(vb + (off)), v1_ = *(const LAS bf16x8*)(vb + 4608 + (off)); \
                o0 = __builtin_amdgcn_mfma_f32_32x32x16_bf16(v0_, pf_, o0, 0, 0, 0); o1 = __builtin_amdgcn_mfma_f32_32x32x16_bf16(v1_, pf_, o1, 0, 0, 0); } while (0)
            AT_PV(w00, 0); AT_PV(w01, 16); AT_PV(w10, 64); AT_PV(w11, 80);
#undef AT_PV
            alive = __any(C != 0.f);
        }
        if (it + 1 < NT) AT_WRITE(cur ^ 1);
        if (lane == 0) aflag[(it & 1) * 8 + wid] = (unsigned)alive;
        __syncthreads();
        const unsigned fl = (lane < 8) ? aflag[(it & 1) * 8 + lane] : 0u;
        if (!__any(fl != 0u)) break;
    }
#undef AT_WRITE
    LAS float* stg = (LAS float*)(lds + AT_STG + wid * AT_STG_W);
#pragma unroll
    for (int g4 = 0; g4 < 4; ++g4) {
        *(LAS f32x4*)(stg + r32 * 68 + 8 * g4 + 4 * hi) = (f32x4){o0[4 * g4], o0[4 * g4 + 1], o0[4 * g4 + 2], o0[4 * g4 + 3]};
        *(LAS f32x4*)(stg + r32 * 68 + 32 + 8 * g4 + 4 * hi) = (f32x4){o1[4 * g4], o1[4 * g4 + 1], o1[4 * g4 + 2], o1[4 * g4 + 3]};
    }
    asm volatile("s_waitcnt lgkmcnt(0)" ::: "memory");
#pragma unroll
    for (int i = 0; i < 4; ++i) {
        const int row = i * 8 + (lane >> 3), ch = lane & 7;
        f32x4 a0 = *(const LAS f32x4*)(stg + row * 68 + ch * 8), a1 = *(const LAS f32x4*)(stg + row * 68 + ch * 8 + 4);
        const size_t tok = rowbase + qw + row;
        const u32x4 gw_ = *(const u32x4*)(GBb + tok * 1024 + h * HD + ch * 8);
        f32x4 g0, g1; pg8::unpack8(gw_, g0, g1);
#pragma unroll
        for (int e = 0; e < 4; ++e) { a0[e] *= g0[e] * pg8::sigm(g0[e]); a1[e] *= g1[e] * pg8::sigm(g1[e]); }
        if (!dry) *(u32x4*)(UGQ + tok * 2048 + 1024 + h * HD + ch * 8) = pg8::pack8(a0, a1);
    }
    asm volatile("s_waitcnt lgkmcnt(0)" ::: "memory");
}

constexpr int BA_STAT = 0, BA_GB = 1024, BA_VNT = 1024 + 8192, BA_OT = BA_VNT + 128 * 272;
__device__ __forceinline__ void brancha_unit(int chunk, bf16* UGQ, const bf16* Vb, const bf16* WsB, const float* vn_g, const float* vn_b, const float* b_s, LAS unsigned char* lds, int dry = 0) {
    int tid_ = threadIdx.x; asm volatile("" : "+v"(tid_));
    const int tid = tid_, lane = tid & 63, wid = __builtin_amdgcn_readfirstlane(tid >> 6), r32 = lane & 31, hi = lane >> 5;
    const size_t t0 = (size_t)chunk * 128;
    LAS float* stat = (LAS float*)(lds + BA_STAT);
    LAS float* gbl = (LAS float*)(lds + BA_GB);
    u32x4 vpc[4];
#pragma unroll
    for (int i = 0; i < 4; ++i) { const int p = tid + 512 * i, s = p >> 4, dc = p & 15; vpc[i] = *(const u32x4*)(Vb + (t0 + s) * 1024 + dc * 8); }
    gbl[tid] = vn_g[tid]; gbl[tid + 512] = vn_g[tid + 512]; gbl[1024 + tid] = vn_b[tid]; gbl[1536 + tid] = vn_b[tid + 512];
#pragma unroll
    for (int hb = 0; hb < 2; ++hb) {
        u32x4 x0[8], x1[8];
#pragma unroll
        for (int i = 0; i < 8; ++i) { const bf16* vr = Vb + (t0 + wid * 16 + hb * 8 + i) * 1024; x0[i] = *(const u32x4*)(vr + lane * 8); x1[i] = *(const u32x4*)(vr + 512 + lane * 8); }
#pragma unroll
        for (int i = 0; i < 8; ++i) {
            f32x4 a, bq, c, d; pg8::unpack8(x0[i], a, bq); pg8::unpack8(x1[i], c, d);
            float s = (a[0] + a[1]) + (a[2] + a[3]) + (bq[0] + bq[1]) + (bq[2] + bq[3]) + (c[0] + c[1]) + (c[2] + c[3]) + (d[0] + d[1]) + (d[2] + d[3]);
            const float mean = wave_sum(s) * (1.f / 1024.f);
            a = a - mean; bq = bq - mean; c = c - mean; d = d - mean;
            float q = (a[0] * a[0] + a[1] * a[1]) + (a[2] * a[2] + a[3] * a[3]) + (bq[0] * bq[0] + bq[1] * bq[1]) + (bq[2] * bq[2] + bq[3] * bq[3])
                    + (c[0] * c[0] + c[1] * c[1]) + (c[2] * c[2] + c[3] * c[3]) + (d[0] * d[0] + d[1] * d[1]) + (d[2] * d[2] + d[3] * d[3]);
            const float rstd = 1.0f / sqrtf(wave_sum(q) * (1.f / 1024.f) + LN_EPS);
            if (lane == 0) { const int row = wid * 16 + hb * 8 + i; stat[row * 2] = mean; stat[row * 2 + 1] = rstd; }
        }
    }
    __syncthreads();
    const int dblk = wid & 3, tbp = wid >> 2;
    u32x4 ugp[4]; bf16x8 wf[2][8];
#define BA_LOAD_UG(g_) do { _Pragma("unroll") for (int i = 0; i < 4; ++i) { const int p = tid + 512 * i, t = p >> 4, dc = p & 15; ugp[i] = *(const u32x4*)(UGQ + (t0 + t) * 2048 + (g_) * 128 + dc * 8); } } while (0)
#define BA_LOAD_WS(g_) do { _Pragma("unroll") for (int j = 0; j < 2; ++j) { const int tb = 2 * tbp + j; const bf16* wrow = WsB + ((size_t)(g_) * 128 + 32 * tb + r32) * 128 + hi * 8; \
        _Pragma("unroll") for (int ks = 0; ks < 8; ++ks) if (ks < 2 * (tb + 1)) wf[j][ks] = *(const bf16x8*)(wrow + ks * 16); } } while (0)
    BA_LOAD_WS(0); BA_LOAD_UG(0);
    for (int g = 0; g < 8; ++g) {
#pragma unroll
        for (int i = 0; i < 4; ++i) {
            const int p = tid + 512 * i, s = p >> 4, dc = p & 15;
            f32x4 v0, v1; pg8::unpack8(vpc[i], v0, v1);
            const f32x4 ga = *(const LAS f32x4*)(gbl + g * 128 + dc * 8), gb2 = *(const LAS f32x4*)(gbl + g * 128 + dc * 8 + 4);
            const f32x4 ba = *(const LAS f32x4*)(gbl + 1024 + g * 128 + dc * 8), bb2 = *(const LAS f32x4*)(gbl + 1024 + g * 128 + dc * 8 + 4);
            const float mean = stat[s * 2], rstd = stat[s * 2 + 1];
            v0 = (v0 - mean) * rstd * ga + ba; v1 = (v1 - mean) * rstd * gb2 + bb2;
            const u32x4 w = pg8::pack8(v0, v1);
            LAS unsigned short* dst = (LAS unsigned short*)(lds + BA_VNT) + dc * 136 + s;
            dst[0 * 16 * 136] = (unsigned short)(w.x & 0xffffu); dst[1 * 16 * 136] = (unsigned short)(w.x >> 16); dst[2 * 16 * 136] = (unsigned short)(w.y & 0xffffu); dst[3 * 16 * 136] = (unsigned short)(w.y >> 16);
            dst[4 * 16 * 136] = (unsigned short)(w.z & 0xffffu); dst[5 * 16 * 136] = (unsigned short)(w.z >> 16); dst[6 * 16 * 136] = (unsigned short)(w.w & 0xffffu); dst[7 * 16 * 136] = (unsigned short)(w.w >> 16);
        }
        if (g + 1 < 8) {
#pragma unroll
            for (int i = 0; i < 4; ++i) { const int p = tid + 512 * i, s = p >> 4, dc = p & 15; vpc[i] = *(const u32x4*)(Vb + (t0 + s) * 1024 + (g + 1) * 128 + dc * 8); }
        }
        __syncthreads();
        const int d = 32 * dblk + r32;
        const LAS unsigned char* ab = lds + BA_VNT + ((d & 7) * 16 + (d >> 3)) * 272 + hi * 16;
        f32x16 acc[2];
#pragma unroll
        for (int j = 0; j < 2; ++j) {
            const int tb = 2 * tbp + j;
#pragma unroll
            for (int r = 0; r < 16; ++r) acc[j][r] = 0.f;
#pragma unroll
            for (int ks = 0; ks < 8; ++ks) if (ks < 2 * (tb + 1)) {
                const bf16x8 af = *(const LAS bf16x8*)(ab + ks * 32);
                acc[j] = __builtin_amdgcn_mfma_f32_32x32x16_bf16(af, wf[j][ks], acc[j], 0, 0, 0);
            }
        }
        if (g + 1 < 8) BA_LOAD_WS(g + 1);
#pragma unroll
        for (int j = 0; j < 2; ++j) {
            const int tb = 2 * tbp + j, t = 32 * tb + r32;
            const float bias = b_s[g * 128 + t];
            LAS float* ot = (LAS float*)(lds + BA_OT) + t * 132 + 32 * dblk + 4 * hi;
#pragma unroll
            for (int g4 = 0; g4 < 4; ++g4) *(LAS f32x4*)(ot + 8 * g4) = (f32x4){acc[j][4 * g4] + bias, acc[j][4 * g4 + 1] + bias, acc[j][4 * g4 + 2] + bias, acc[j][4 * g4 + 3] + bias};
        }
        __syncthreads();
#pragma unroll
        for (int i = 0; i < 4; ++i) {
            const int p = tid + 512 * i, t = p >> 4, dc = p & 15;
            const LAS float* ot = (const LAS float*)(lds + BA_OT) + t * 132 + dc * 8;
            const f32x4 m0 = *(const LAS f32x4*)ot, m1 = *(const LAS f32x4*)(ot + 4);
            bf16* up = UGQ + (t0 + t) * 2048 + g * 128 + dc * 8;
            f32x4 u0, u1; pg8::unpack8(ugp[i], u0, u1);
            if (!dry) *(u32x4*)up = pg8::pack8(u0 * m0, u1 * m1);
        }
        if (g + 1 < 8) BA_LOAD_UG(g + 1);
    }
#undef BA_LOAD_UG
#undef BA_LOAD_WS
    __syncthreads();
}

__device__ __forceinline__ void ln_rows(bf16* XH, unsigned char* XQ, float* XS, float* OUT, const float* g, const float* bta, bool last, int gw, int NGW, int lane) {
    f32x4 gv[4], bv[4];
#pragma unroll
    for (int j = 0; j < 2; ++j) { gv[2 * j] = *(const f32x4*)(g + 512 * j + lane * 8); gv[2 * j + 1] = *(const f32x4*)(g + 512 * j + lane * 8 + 4);
                                  bv[2 * j] = *(const f32x4*)(bta + 512 * j + lane * 8); bv[2 * j + 1] = *(const f32x4*)(bta + 512 * j + lane * 8 + 4); }
    for (int m = gw; m < T; m += NGW) {
        bf16* xr = XH + (size_t)m * DM + lane * 8;
        f32x4 v[4]; float s = 0.f;
        pg8::unpack8h(*(const u32x4*)xr, v[0], v[1]); pg8::unpack8h(*(const u32x4*)(xr + 512), v[2], v[3]);
#pragma unroll
        for (int j = 0; j < 4; ++j) s += (v[j][0] + v[j][1]) + (v[j][2] + v[j][3]);
        const float mean = wave_sum(s) * (1.f / DM); float s2 = 0.f;
#pragma unroll
        for (int j = 0; j < 4; ++j) { v[j] = v[j] - mean; s2 += (v[j][0] * v[j][0] + v[j][1] * v[j][1]) + (v[j][2] * v[j][2] + v[j][3] * v[j][3]); }
        const float rstd = 1.0f / sqrtf(wave_sum(s2) * (1.f / DM) + LN_EPS);
#pragma unroll
        for (int j = 0; j < 4; ++j) v[j] = v[j] * rstd * gv[j] + bv[j];
        if (last) { float* o = OUT + (size_t)m * DM + lane * 8;
            *(f32x4*)o = v[0]; *(f32x4*)(o + 4) = v[1]; *(f32x4*)(o + 512) = v[2]; *(f32x4*)(o + 516) = v[3]; }
        else { *(u32x4*)xr = pg8::pack8h(v[0], v[1]); *(u32x4*)(xr + 512) = pg8::pack8h(v[2], v[3]);
            float am = 0.f;
#pragma unroll
            for (int j = 0; j < 4; ++j) am = fmaxf(am, fmaxf(fmaxf(fabsf(v[j][0]), fabsf(v[j][1])), fmaxf(fabsf(v[j][2]), fabsf(v[j][3]))));
            am = wave_max(am); const float inv = am > 0.f ? 127.f / am : 0.f;
            unsigned char* xq = XQ + (size_t)m * DM + lane * 8;
            u32x2 w0, w1; w0.x = q4(v[0][0], v[0][1], v[0][2], v[0][3], inv); w0.y = q4(v[1][0], v[1][1], v[1][2], v[1][3], inv);
            w1.x = q4(v[2][0], v[2][1], v[2][2], v[2][3], inv); w1.y = q4(v[3][0], v[3][1], v[3][2], v[3][3], inv);
            *(u32x2*)xq = w0; *(u32x2*)(xq + 512) = w1; if (lane == 0) XS[m] = am; }
    }
}

#define XB_TMO      128
#define XB_XCNT(j)  (256  + 64 * (j))
#define XB_XSUB(j)  (1280 + 64 * (j))
#define XB_XGEN(j)  (2304 + 64 * (j))
#define XB_TOP      3328
#define XB_TOPGEN   3392
#define XCD_BAR_WORDS 3456
#define XB_SPIN_CAP (1u << 18)

__device__ __forceinline__ unsigned xb_ld(unsigned* p)              { return __hip_atomic_load(p, __ATOMIC_RELAXED, __HIP_MEMORY_SCOPE_AGENT); }
__device__ __forceinline__ unsigned xb_add(unsigned* p, unsigned v) { return __hip_atomic_fetch_add(p, v, __ATOMIC_RELAXED, __HIP_MEMORY_SCOPE_AGENT); }
__device__ __forceinline__ unsigned xb_xcc_id() { return (unsigned)__builtin_amdgcn_s_getreg((3 << 11) | 20) & 0xFu; }
#define XB_SPIN(cond, bar) do { unsigned _sp = 0; while (cond) { __builtin_amdgcn_s_sleep(1); \
    if ((++_sp & 255u) == 0u) { if (xb_ld(&(bar)[XB_TMO])) break; if (_sp > XB_SPIN_CAP) { atomicAdd(&(bar)[XB_TMO], 1u); break; } } } } while (0)

struct XcdBarrier {
    unsigned* bar; unsigned x;
    volatile LAS unsigned* st;
};

__device__ __forceinline__ XcdBarrier xcd_barrier_post(unsigned* bar, volatile LAS unsigned* st) {
    XcdBarrier b; b.bar = bar; b.x = xb_xcc_id(); b.st = st;
    if (threadIdx.x == 0) (void)xb_add(&bar[XB_XCNT(b.x)], 1u);
    return b;
}
__device__ __forceinline__ void xcd_barrier_complete(unsigned* bar, unsigned x, unsigned& nloc, unsigned& nx) {
    const unsigned G = gridDim.x * gridDim.y * gridDim.z;
    unsigned sum, cnt, mine, sp = 0u;
    for (;;) {
        sum = 0u; cnt = 0u; mine = 0u;
#pragma unroll
        for (unsigned j = 0; j < 16; ++j) { const unsigned c = xb_ld(&bar[XB_XCNT(j)]); sum += c; cnt += (c > 0u) ? 1u : 0u; mine = (j == x) ? c : mine; }
        if (sum == G) break;
        __builtin_amdgcn_s_sleep(1);
        if ((++sp & 255u) == 0u) { if (xb_ld(&bar[XB_TMO])) break; if (sp > XB_SPIN_CAP) { atomicAdd(&bar[XB_TMO], 1u); break; } }
    }
    nloc = mine > 0u ? mine : 1u; nx = cnt > 0u ? cnt : 1u;
}

__device__ __forceinline__ void xcd_barrier(const XcdBarrier& b) {
    asm volatile("s_waitcnt vmcnt(0)" ::: "memory");
    __syncthreads();
    if (threadIdx.x == 0) {
        unsigned* bar = b.bar;
        __builtin_amdgcn_s_waitcnt(0);
        unsigned nloc = b.st[0], nx = b.st[1];
        if (nloc == 0u) { xcd_barrier_complete(bar, b.x, nloc, nx); b.st[0] = nloc; b.st[1] = nx; }
        const unsigned old = xb_add(&bar[XB_XSUB(b.x)], 1u);
        const unsigned gen = old / nloc;
        if (old + 1u == (gen + 1u) * nloc) {
            __builtin_amdgcn_fence(__ATOMIC_RELEASE, "agent");
            asm volatile("s_waitcnt vmcnt(0)" ::: "memory");
            const unsigned og = xb_add(&bar[XB_TOP], 1u);
            const unsigned tg = og / nx;
            if (og + 1u == (tg + 1u) * nx) xb_add(&bar[XB_TOPGEN], 1u);
            else XB_SPIN(xb_ld(&bar[XB_TOPGEN]) == tg, bar);
            __builtin_amdgcn_fence(__ATOMIC_ACQUIRE, "agent");
            xb_add(&bar[XB_XGEN(b.x)], 1u);
            asm volatile("s_waitcnt vmcnt(0)" ::: "memory");
        } else {
            XB_SPIN(xb_ld(&bar[XB_XGEN(b.x)]) == gen, bar);
            __builtin_amdgcn_fence(__ATOMIC_ACQUIRE, "agent");
            asm volatile("s_waitcnt vmcnt(0)" ::: "memory");
        }
    }
    __syncthreads();
}

__global__ void __launch_bounds__(512, 2) fwd_kernel(Args a) {
    extern __shared__ __attribute__((aligned(16))) unsigned char lds_raw[];
    cg::grid_group grid = cg::this_grid();
    LAS unsigned char* lds = (LAS unsigned char*)lds_raw;
    const int G = gridDim.x, bx = blockIdx.x;
    const int vcu = (G % 8 == 0) ? (bx % 8) * (G / 8) + bx / 8 : bx;
    const int NGW = G * 8;
#define LAUNDER_TID int tid_l = threadIdx.x; asm volatile("" : "+v"(tid_l)); const int lane = tid_l & 63, wave = __builtin_amdgcn_readfirstlane(tid_l >> 6), gw = vcu * 8 + wave;
#define WSW(name, off) size_t name##_o = (off); asm volatile("" : "+s"(name##_o)); bf16* const name = (bf16*)(((l & 1) ? (unsigned char*)a.out : a.ws) + name##_o);
#define WSP(name, off) size_t name##_o = (off); asm volatile("" : "+s"(name##_o)); bf16* const name = (bf16*)(a.ws + name##_o);
    volatile LAS unsigned* MISC = (volatile LAS unsigned*)(lds + RING_BYTES + 256);
    if (threadIdx.x < 16) MISC[threadIdx.x] = 0u;
    unsigned* barw = (unsigned*)(a.ws + WS_CTL);
    if (bx == 0) for (int i = threadIdx.x; i < XCD_BAR_WORDS; i += 512) barw[i] = 0u;
    __syncthreads();
    { LAUNDER_TID
    for (int tk = gw; tk < 4 * 144 * 16; tk += NGW) { const int l4 = tk / (144 * 16), cg = (tk >> 4) % 144, kc = tk & 15, c = 64 * cg + lane;
        const int drow = win_dest_row(c), slot = drow >= 7168 ? -2 : pg8::p1_qslot(__builtin_amdgcn_readfirstlane(drow) >> 8);
        if (slot == -1) continue;
        const float* wp = a.in[2] + (size_t)l4 * DM * NIN + (size_t)(64 * kc) * NIN + c; float mx = 0.f;
#pragma unroll 16
        for (int kk = 0; kk < 64; ++kk) mx = fmaxf(mx, fabsf(wp[(size_t)kk * NIN]));
        unsigned* dst = slot == -2 ? (unsigned*)(a.ws + WS_CMAX) + l4 * 2048 + (drow - 7168) : (unsigned*)(a.ws + WS_CMAX1) + l4 * (pg8::P1_NQ * 256) + slot * 256 + (drow & 255);
        atomicMax(dst, __float_as_uint(mx)); }
    convert_layer(a, 0, lds, gw, NGW, lane, wave, false);
    { const float* x = a.in[0]; WSP(XH, WS_XH) unsigned char* XQ = (unsigned char*)a.out + OUT_XQ; float* XS = (float*)(a.ws + WS_XS);
      for (int m = gw; m < T; m += NGW) { const float* xr = x + (size_t)m * DM + lane * 8;
          const f32x4 v0 = *(const f32x4*)xr, v1 = *(const f32x4*)(xr + 4), v2 = *(const f32x4*)(xr + 512), v3 = *(const f32x4*)(xr + 516);
          bf16* xo = XH + (size_t)m * DM + lane * 8; *(u32x4*)xo = pg8::pack8h(v0, v1); *(u32x4*)(xo + 512) = pg8::pack8h(v2, v3);
          float am = fmaxf(fmaxf(fmaxf(fabsf(v0[0]), fabsf(v0[1])), fmaxf(fabsf(v0[2]), fabsf(v0[3]))), fmaxf(fmaxf(fabsf(v1[0]), fabsf(v1[1])), fmaxf(fabsf(v1[2]), fabsf(v1[3]))));
          am = fmaxf(am, fmaxf(fmaxf(fmaxf(fabsf(v2[0]), fabsf(v2[1])), fmaxf(fabsf(v2[2]), fabsf(v2[3]))), fmaxf(fmaxf(fabsf(v3[0]), fabsf(v3[1])), fmaxf(fabsf(v3[2]), fabsf(v3[3])))));
          am = wave_max(am); const float inv = am > 0.f ? 127.f / am : 0.f;
          unsigned char* xq = XQ + (size_t)m * DM + lane * 8;
          u32x2 w0, w1; w0.x = q4(v0[0], v0[1], v0[2], v0[3], inv); w0.y = q4(v1[0], v1[1], v1[2], v1[3], inv); w1.x = q4(v2[0], v2[1], v2[2], v2[3], inv); w1.y = q4(v3[0], v3[1], v3[2], v3[3], inv);
          *(u32x2*)xq = w0; *(u32x2*)(xq + 512) = w1; if (lane == 0) XS[m] = am; } } }
    grid.sync();
    const XcdBarrier xbar = xcd_barrier_post(barw, MISC + 8);
#define GRID_SYNC() xcd_barrier(xbar)
#pragma unroll 1
    for (int l = 0; l < DEPTH; ++l) {
#ifndef SKIP_P1
        if (l == 0) { LAUNDER_TID
            LAS float* scr = (LAS float*)(lds + wave * 8704);
            for (int it = gw; it < 16 * (NIN / 32); it += NGW) win_item(a, 0, a.ws, it / (NIN / 32), it % (NIN / 32), 1, scr, lane);
            GRID_SYNC(); }
        { WSP(XH, WS_XH) WSW(WinT, WS_WIN) WSP(UGQ, WS_UGQ) WSP(Vb, WS_V) WSP(Kb, WS_K) WSP(VBb, WS_VB) WSP(GBb, WS_GB)
          { pg8::Gemm g{XH, WinT + (size_t)(pg8::P1_F0 * 256) * DM, T, pg8::P1_NF * 256, DM, DM}; pg8::StaticOrder S; S.init(T, pg8::P1_NF * 256, G, bx);
            pg8::Epi1<false> E{UGQ, Vb, Kb, VBb, GBb, QSCALE, nullptr, nullptr};
            pg8::gemm_phase<pg8::Epi1<false>, pg8::StaticOrder, true, true, 1>(lds, g, S, E); }
          { const bf16* XQ = (const bf16*)((const unsigned char*)a.out + OUT_XQ);
            pg8::Gemm g{XQ, WinT, T, pg8::P1_NQ * 256, 512, 512}; pg8::StaticOrder S; S.init(T, pg8::P1_NQ * 256, G, bx);
            pg8::Epi1<true> E{UGQ, Vb, Kb, VBb, GBb, QSCALE, (const float*)(a.ws + WS_XS), (const float*)(a.ws + WS_CMAX1) + l * (pg8::P1_NQ * 256)};
            pg8::gemm_phase<pg8::Epi1<true>, pg8::StaticOrder, true, true, 2>(lds, g, S, E); }
        }
#endif
        GRID_SYNC();
        { WSP(UGQ, WS_UGQ) WSP(Vb, WS_V) WSW(WsB, WS_WS) WSP(Kb, WS_K) WSP(VBb, WS_VB) WSP(GBb, WS_GB)
#pragma unroll 1
        for (int st = 0; st < 2; ++st) {
            if (((st ^ vcu) & 1) == 0) {
#ifndef SKIP_BA
                for (int c = vcu; c < T / 128; c += G)
                    brancha_unit(c, UGQ, Vb, WsB, a.in[3] + l * DM, a.in[4] + l * DM, a.in[6] + l * 8 * 128, lds);
#endif
            } else {
#ifndef SKIP_AT
#pragma unroll 1
                for (int pu2 = 2 * vcu; pu2 < 128 * 16; pu2 += 2 * G) {
#pragma unroll 1
                    for (int j2 = 0; j2 < 2; ++j2) {
                        const int pu = pu2 >> 1, bh = pu >> 3, s = pu & 7;
                        attn_unit(bh >> 4, bh & 15, j2 ? s : 15 - s, UGQ, Kb, VBb, GBb, lds);
                    }
                }
#endif
            }
        }
        if (l + 1 < DEPTH) { __syncthreads(); LAUNDER_TID convert_layer(a, l + 1, lds, gw, NGW, lane, wave); }
        }
        GRID_SYNC();
#ifndef SKIP_P25
        { WSW(WinT, WS_WIN) WSP(SMA, WS_K) WSP(SMB, WS_VB)
          const bf16* XQ = (const bf16*)((const unsigned char*)a.out + OUT_XQ);
          pg8::Gemm g{XQ, WinT + (size_t)7168 * DM, T, 2048, 512, 512}; pg8::GateOrder S; S.init(T, G, bx);
          pg8::EpiGateQ E{SMA, SMB, (const float*)(a.ws + WS_XS), (const float*)(a.ws + WS_CMAX) + l * 2048};
          pg8::gemm_phase<pg8::EpiGateQ, pg8::GateOrder, true, true, 2>(lds, g, S, E); }
        { WSW(PB, WS_PB) WSW(WeT, WS_WE) WSP(EB, WS_GB)
          int kp = PLE; asm volatile("" : "+s"(kp));
          pg8::Gemm g{PB, WeT, T, DM, kp, kp}; pg8::StaticOrder S; S.init(T, DM, G, bx);
          pg8::EpiStore<0> E{EB, EB};
          pg8::gemm_phase<pg8::EpiStore<0>, pg8::StaticOrder, true, true>(lds, g, S, E); }
#endif
#ifndef SKIP_P3
        { WSP(UGQ, WS_UGQ) WSW(W2T, WS_W2) WSP(SMA, WS_K) WSP(SMB, WS_VB) WSP(MERGED, WS_V)
          pg8::Gemm g{UGQ, W2T, T, DM, 2048, 2048}; pg8::StaticOrder S; S.init(T, DM, G, bx);
          pg8::Epi2 E{SMA, SMB, MERGED};
          pg8::gemm_phase<pg8::Epi2, pg8::StaticOrder, true, true>(lds, g, S, E);
#ifdef PROBE_DUP_P3
          pg8::gemm_phase<pg8::Epi2, pg8::StaticOrder, true, true>(lds, g, S, E);
#endif
        }
#endif
        GRID_SYNC();
#ifndef SKIP_P4
        { WSP(MERGED, WS_V) WSW(WoT, WS_WO) WSP(XH1, WS_XH1) WSP(XH, WS_XH)
          pg8::Gemm g{MERGED, WoT, T, DM, DM, DM}; pg8::StaticOrder S; S.init(T, DM, G, bx);
          pg8::Epi3 E{XH, XH1, ALPHA};
          pg8::gemm_phase<pg8::Epi3, pg8::StaticOrder, true, true>(lds, g, S, E); }
#endif
        GRID_SYNC();
#ifndef SKIP_P5
        { WSP(XH1, WS_XH1) WSW(WgT, WS_WG) WSP(EB, WS_GB) WSP(XH, WS_XH)
          pg8::Gemm g{XH1, WgT, T, DM, DM, DM}; pg8::StaticOrder S; S.init(T, DM, G, bx);
          pg8::Epi4 E{XH1, XH, EB};
          pg8::gemm_phase<pg8::Epi4, pg8::StaticOrder, true, true, true>(lds, g, S, E); }
#endif
        GRID_SYNC();
#ifdef PROBE_SYNC
        for (int z = 0; z < 10; ++z) GRID_SYNC();
#endif
        LAUNDER_TID WSP(XH, WS_XH)
        ln_rows(XH, (unsigned char*)a.out + OUT_XQ, (float*)(a.ws + WS_XS), a.out, a.in[12] + l * DM, a.in[13] + l * DM, l + 1 == DEPTH, gw, NGW, lane);
        if (l + 1 < DEPTH) GRID_SYNC();
    }
}

extern "C" void kernel_launch(void* const* d_in, const int* in_sizes, int n_in, void* d_out, int out_size, void* d_ws, size_t ws_size, hipStream_t stream) {
    static int grid = 0;
    if (grid == 0) {
        if (n_in != 14 || out_size != T * DM || ws_size < WS_END) { fprintf(stderr, "kernel_launch: unexpected shapes (n_in %d out %d ws %zu)\n", n_in, out_size, ws_size); grid = -1; return; }
        int dev = 0, cus = 0, per_cu = 0;
        hipGetDevice(&dev); hipDeviceGetAttribute(&cus, hipDeviceAttributeMultiprocessorCount, dev);
        hipFuncSetAttribute((const void*)fwd_kernel, hipFuncAttributeMaxDynamicSharedMemorySize, LDS_BYTES);
        hipOccupancyMaxActiveBlocksPerMultiprocessor(&per_cu, (const void*)fwd_kernel, 512, LDS_BYTES);
        if (per_cu < 1) per_cu = 1;
        grid = cus;
        (void)hipGetLastError();
    }
    if (grid < 0) return;
    Args a{};
    for (int i = 0; i < 14; ++i) a.in[i] = (const float*)d_in[i];
    a.out = (float*)d_out; a.ws = (unsigned char*)d_ws;
    hipMemsetAsync((char*)d_ws + WS_CMAX, 0, 4 * (2048 + 3072) * sizeof(float), stream);
    void* args[] = {&a};
    hipError_t e = hipLaunchCooperativeKernel((const void*)fwd_kernel, dim3(grid), dim3(512), args, LDS_BYTES, stream);
    if (e != hipSuccess) fprintf(stderr, "cooperative launch failed: %s (grid %d)\n", hipGetErrorString(e), grid);
}
```

```cpp
#include <hip/hip_runtime.h>
#include <hip/hip_cooperative_groups.h>
#include <cstdio>
#include <cstdint>
namespace cg = cooperative_groups;
namespace pg8 {
#define PG8_LAS __attribute__((address_space(3)))
typedef unsigned short bf16_t;
typedef short bf16x8 __attribute__((ext_vector_type(8)));
typedef _Float16 f16x8 __attribute__((ext_vector_type(8)));
typedef int i32x4 __attribute__((ext_vector_type(4)));
typedef float f32x4 __attribute__((ext_vector_type(4)));
typedef unsigned u32x4 __attribute__((ext_vector_type(4)));
constexpr int BM = 256, BK = 64, HALF = 128, HTB = HALF * BK * 2  , STAGE_BYTES = 8 * HTB, NXCD = 8, WGM = 8;

__host__ __device__ __forceinline__ int lds_byte(int r, int c) { const int st = (r >> 4) * 2 + (c >> 5), rr = r & 15, cc = c & 31, ob = rr * 64 + cc * 2; return st * 1024 + (ob ^ (((ob >> 9) & 1) << 5)); }
__host__ __device__ __forceinline__ void stage_rc(int b, int& R, int& C) { const int st = b / 1024, sb = b % 1024, swz = sb ^ (((sb >> 9) & 1) << 5); R = (st >> 1) * 16 + swz / 64; C = (st & 1) * 32 + (swz % 64) / 2; }
__host__ __device__ __forceinline__ int perm32(int rho) { const int n = rho >> 4, i = rho & 15; return 8 * (i >> 2) + 4 * n + (i & 3); }

struct Unit { int pm, pn; };
struct Gemm { const bf16_t* A; const bf16_t* Bt; int M, N, K, lda; };

struct StaticOrder {
    int nM, nN, nwg, G, c;
    __host__ __device__ void init(int M, int N, int G_, int c_) { nM = M / BM; nN = N / BM; nwg = nM * nN; G = G_; c = c_; }
    __host__ __device__ bool next(int i, Unit& u) const {
        const long L = (long)i * G + c; if (L >= nwg) return false;
        int wgid = (int)L; { const int q = nwg / NXCD, r = nwg % NXCD, xcd = wgid % NXCD, off = wgid / NXCD; wgid = (xcd < r ? xcd * (q + 1) : r * (q + 1) + (xcd - r) * q) + off; }
        const int nig = WGM * nN, gid = wgid / nig, fm = gid * WGM, gsz = (nM - fm) < WGM ? (nM - fm) : WGM;
        u.pm = fm + ((wgid % nig) % gsz); u.pn = (wgid % nig) / gsz; return true;
    }
    __device__ __forceinline__ void a_ready(const Unit&) const {}
    __device__ __forceinline__ void done(const Unit&) const {}
};
struct GateOrder {
    StaticOrder inner;
    __host__ __device__ void init(int M, int G_, int c_) { inner.init(M, 1024, G_, c_); }
    __host__ __device__ bool next(int i, Unit& u) const { Unit v; if (!inner.next(i >> 1, v)) return false; u.pm = v.pm; u.pn = 2 * v.pn + (i & 1); return true; }
    __device__ __forceinline__ void a_ready(const Unit&) const {}
    __device__ __forceinline__ void done(const Unit&) const {}
};


typedef float f32x2_t __attribute__((ext_vector_type(2))); typedef __bf16 bf16x2_t __attribute__((ext_vector_type(2)));
__device__ __forceinline__ unsigned cvt_pk_bf16(float lo, float hi) { f32x2_t v = {lo, hi}; bf16x2_t b = __builtin_convertvector(v, bf16x2_t); return __builtin_bit_cast(unsigned, b); }
__device__ __forceinline__ float sigm(float x) { return __builtin_amdgcn_rcpf(1.f + __builtin_amdgcn_exp2f(-1.4426950408889634f * x)); }
__device__ __forceinline__ u32x4 pack8(const f32x4 a, const f32x4 b) { u32x4 w; w.x = cvt_pk_bf16(a[0], a[1]); w.y = cvt_pk_bf16(a[2], a[3]); w.z = cvt_pk_bf16(b[0], b[1]); w.w = cvt_pk_bf16(b[2], b[3]); return w; }
__device__ __forceinline__ void unpack8(const u32x4 w, f32x4& a, f32x4& b) {
    a[0] = __uint_as_float(w.x << 16); a[1] = __uint_as_float(w.x & 0xffff0000u); a[2] = __uint_as_float(w.y << 16); a[3] = __uint_as_float(w.y & 0xffff0000u);
    b[0] = __uint_as_float(w.z << 16); b[1] = __uint_as_float(w.z & 0xffff0000u); b[2] = __uint_as_float(w.w << 16); b[3] = __uint_as_float(w.w & 0xffff0000u); }
typedef _Float16 f16x2_t __attribute__((ext_vector_type(2)));
__device__ __forceinline__ unsigned cvt_pk_f16(float lo, float hi) { f32x2_t v = {lo, hi}; f16x2_t h = __builtin_convertvector(v, f16x2_t); return __builtin_bit_cast(unsigned, h); }
__device__ __forceinline__ u32x4 pack8h(const f32x4 a, const f32x4 b) { u32x4 w; w.x = cvt_pk_f16(a[0], a[1]); w.y = cvt_pk_f16(a[2], a[3]); w.z = cvt_pk_f16(b[0], b[1]); w.w = cvt_pk_f16(b[2], b[3]); return w; }
__device__ __forceinline__ void unpack8h(const u32x4 w, f32x4& a, f32x4& b) {
    const unsigned x0 = w.x, x1 = w.y, x2 = w.z, x3 = w.w;
    const f32x2_t p0 = __builtin_convertvector(__builtin_bit_cast(f16x2_t, x0), f32x2_t), p1 = __builtin_convertvector(__builtin_bit_cast(f16x2_t, x1), f32x2_t);
    const f32x2_t p2 = __builtin_convertvector(__builtin_bit_cast(f16x2_t, x2), f32x2_t), p3 = __builtin_convertvector(__builtin_bit_cast(f16x2_t, x3), f32x2_t);
    a[0] = p0[0]; a[1] = p0[1]; a[2] = p1[0]; a[3] = p1[1]; b[0] = p2[0]; b[1] = p2[1]; b[2] = p3[0]; b[3] = p3[1]; }
#define PG8_FENCE asm volatile("" ::: "memory")

constexpr int P1_NQ = 20, P1_F0 = 12, P1_NF = 8;
__host__ __device__ constexpr int p1_qtile(int j) { return j < 12 ? j : 20 + (j - 12); }
__host__ __device__ constexpr int p1_qslot(int tile) { return tile < 12 ? tile : (tile >= 20 && tile < 28 ? 12 + (tile - 20) : -1); }
template <bool Q> struct Epi1 {
    static constexpr bool PERM = true, AFTER_DRAIN = false, HAS_MID = false;
    bf16_t *UGQ, *V, *K, *VB, *GB; float qscale; const float* XS; const float* CS;
    __device__ __forceinline__ static f32x4 val(const f32x4 a, float rs, const f32x4 cs) {
        if constexpr (Q) { const i32x4 q = __builtin_bit_cast(i32x4, a); return (f32x4){(float)q[0], (float)q[1], (float)q[2], (float)q[3]} * (cs * rs); } else return a; }
    __device__ __forceinline__ void operator()(const f32x4 (&acc)[2][2][4][2], const Unit& u, int wr, int wc, int fr, int fq) const {
        asm volatile("" : "+v"(fr), "+v"(fq));
        const int row0 = u.pm * BM + wr * 64 + fr, cw = wc * 32 + 8 * fq;
        const int pn = Q ? p1_qtile(u.pn) : u.pn + P1_F0;
        float rsc[2][4]; f32x4 cs[2][2];
#pragma unroll
        for (int ai = 0; ai < 2; ++ai)
#pragma unroll
            for (int m = 0; m < 4; ++m) rsc[ai][m] = Q ? XS[row0 + ai * HALF + m * 16] * (1.f / (127.f * 127.f)) : 1.f;
#pragma unroll
        for (int bj = 0; bj < 2; ++bj)
#pragma unroll
            for (int n = 0; n < 2; ++n) cs[bj][n] = Q ? *(const f32x4*)(CS + u.pn * BM + bj * HALF + cw + 4 * n) : (f32x4){1.f, 1.f, 1.f, 1.f};
        if (pn < 8) {
            bf16_t* base = UGQ + pn * 128 + cw;
#pragma unroll
            for (int ai = 0; ai < 2; ++ai)
#pragma unroll
                for (int m = 0; m < 4; ++m) {
                    f32x4 u0 = val(acc[ai][0][m][0], rsc[ai][m], cs[0][0]), u1 = val(acc[ai][0][m][1], rsc[ai][m], cs[0][1]);
                    const f32x4 g0 = val(acc[ai][1][m][0], rsc[ai][m], cs[1][0]), g1 = val(acc[ai][1][m][1], rsc[ai][m], cs[1][1]);
#pragma unroll
                    for (int e = 0; e < 4; ++e) { u0[e] *= g0[e] * sigm(g0[e]); u1[e] *= g1[e] * sigm(g1[e]); }
                    __builtin_nontemporal_store(pack8(u0, u1), (u32x4*)(base + (size_t)(row0 + ai * HALF + m * 16) * 2048));
                }
        } else {
            const int seg = (pn - 8) >> 2, ct = (pn - 8) & 3;
            bf16_t* base; int ldc = 1024; float sc = 1.f;
            if (seg == 0) base = V; else if (seg == 1) { base = UGQ + 1024; ldc = 2048; sc = qscale; } else if (seg == 2) base = K; else if (seg == 3) base = VB; else base = GB;
            base += ct * 256 + cw;
#pragma unroll
            for (int ai = 0; ai < 2; ++ai)
#pragma unroll
                for (int m = 0; m < 4; ++m) { bf16_t* rowp = base + (size_t)(row0 + ai * HALF + m * 16) * ldc;
#pragma unroll
                    for (int bj = 0; bj < 2; ++bj) __builtin_nontemporal_store(pack8(val(acc[ai][bj][m][0], rsc[ai][m], cs[bj][0]) * sc, val(acc[ai][bj][m][1], rsc[ai][m], cs[bj][1]) * sc), (u32x4*)(rowp + bj * HALF)); }
        }
    }
};
template <int SIG> struct EpiStore {
    static constexpr bool PERM = true, AFTER_DRAIN = false, HAS_MID = false;
    bf16_t *D0, *D1;
    __device__ __forceinline__ void operator()(const f32x4 (&acc)[2][2][4][2], const Unit& u, int wr, int wc, int fr, int fq) const {
        asm volatile("" : "+v"(fr), "+v"(fq));
        const int row0 = u.pm * BM + wr * 64 + fr, cw = wc * 32 + 8 * fq;
        bf16_t* base = (u.pn < 4 ? D0 : D1) + (u.pn & 3) * 256 + cw;
#pragma unroll
        for (int ai = 0; ai < 2; ++ai)
#pragma unroll
            for (int m = 0; m < 4; ++m) { bf16_t* rowp = base + (size_t)(row0 + ai * HALF + m * 16) * 1024;
#pragma unroll
                for (int bj = 0; bj < 2; ++bj) { f32x4 v0 = acc[ai][bj][m][0], v1 = acc[ai][bj][m][1];
                    if (SIG) {
#pragma unroll
                        for (int e = 0; e < 4; ++e) { v0[e] = sigm(v0[e]); v1[e] = sigm(v1[e]); } }
                    __builtin_nontemporal_store(pack8(v0, v1), (u32x4*)(rowp + bj * HALF)); } }
    }
};
struct EpiGate {
    static constexpr bool PERM = true, AFTER_DRAIN = false, HAS_MID = false;
    bf16_t *RHO, *SMB;
    __device__ __forceinline__ void operator()(const f32x4 (&acc)[2][2][4][2], const Unit& u, int wr, int wc, int fr, int fq) const {
        asm volatile("" : "+v"(fr), "+v"(fq));
        const int row0 = u.pm * BM + wr * 64 + fr, c0 = u.pn * 128 + wc * 32 + 8 * fq;
#pragma unroll
        for (int ai = 0; ai < 2; ++ai)
#pragma unroll
            for (int m = 0; m < 4; ++m) { const size_t off = (size_t)(row0 + ai * HALF + m * 16) * 1024 + c0;
                f32x4 r0, r1, s0, s1;
#pragma unroll
                for (int e = 0; e < 4; ++e) {
                    const float ea0 = __builtin_amdgcn_exp2f(fminf(-1.4426950408889634f * acc[ai][0][m][0][e], 80.f)), eb0 = __builtin_amdgcn_exp2f(fminf(-1.4426950408889634f * acc[ai][1][m][0][e], 80.f));
                    const float ea1 = __builtin_amdgcn_exp2f(fminf(-1.4426950408889634f * acc[ai][0][m][1][e], 80.f)), eb1 = __builtin_amdgcn_exp2f(fminf(-1.4426950408889634f * acc[ai][1][m][1][e], 80.f));
                    r0[e] = (1.f + eb0) * __builtin_amdgcn_rcpf(1.f + ea0); r1[e] = (1.f + eb1) * __builtin_amdgcn_rcpf(1.f + ea1);
                    s0[e] = __builtin_amdgcn_rcpf(1.f + eb0); s1[e] = __builtin_amdgcn_rcpf(1.f + eb1); }
                *(u32x4*)(RHO + off) = pack8(r0, r1); *(u32x4*)(SMB + off) = pack8(s0, s1); }
    }
};
struct EpiGateQ {
    static constexpr bool PERM = true, AFTER_DRAIN = false, HAS_MID = false;
    bf16_t *RHO, *SMB; const float* XS; const float* CS;
    __device__ __forceinline__ void operator()(const f32x4 (&acc)[2][2][4][2], const Unit& u, int wr, int wc, int fr, int fq) const {
        asm volatile("" : "+v"(fr), "+v"(fq));
        const int row0 = u.pm * BM + wr * 64 + fr, c0 = u.pn * 128 + wc * 32 + 8 * fq;
        float rsc[2][4]; f32x4 cs[2][2];
#pragma unroll
        for (int ai = 0; ai < 2; ++ai)
#pragma unroll
            for (int m = 0; m < 4; ++m) rsc[ai][m] = XS[row0 + ai * HALF + m * 16] * (1.f / (127.f * 127.f));
#pragma unroll
        for (int bj = 0; bj < 2; ++bj) { const int ci = u.pn * BM + bj * HALF + wc * 32 + 8 * fq; cs[bj][0] = *(const f32x4*)(CS + ci); cs[bj][1] = *(const f32x4*)(CS + ci + 4); }
#pragma unroll
        for (int ai = 0; ai < 2; ++ai)
#pragma unroll
            for (int m = 0; m < 4; ++m) { const size_t off = (size_t)(row0 + ai * HALF + m * 16) * 1024 + c0;
                f32x4 r0, r1, s0, s1;
#pragma unroll
                for (int e = 0; e < 4; ++e) {
                    const i32x4 qa0 = __builtin_bit_cast(i32x4, acc[ai][0][m][0]), qa1 = __builtin_bit_cast(i32x4, acc[ai][0][m][1]), qb0 = __builtin_bit_cast(i32x4, acc[ai][1][m][0]), qb1 = __builtin_bit_cast(i32x4, acc[ai][1][m][1]);
                    const float ma0 = (float)qa0[e] * (rsc[ai][m] * cs[0][0][e]), ma1 = (float)qa1[e] * (rsc[ai][m] * cs[0][1][e]);
                    const float mb0 = (float)qb0[e] * (rsc[ai][m] * cs[1][0][e]), mb1 = (float)qb1[e] * (rsc[ai][m] * cs[1][1][e]);
                    const float ea0 = __builtin_amdgcn_exp2f(fminf(-1.4426950408889634f * ma0, 80.f)), eb0 = __builtin_amdgcn_exp2f(fminf(-1.4426950408889634f * mb0, 80.f));
                    const float ea1 = __builtin_amdgcn_exp2f(fminf(-1.4426950408889634f * ma1, 80.f)), eb1 = __builtin_amdgcn_exp2f(fminf(-1.4426950408889634f * mb1, 80.f));
                    r0[e] = (1.f + eb0) * __builtin_amdgcn_rcpf(1.f + ea0); r1[e] = (1.f + eb1) * __builtin_amdgcn_rcpf(1.f + ea1);
                    s0[e] = __builtin_amdgcn_rcpf(1.f + eb0); s1[e] = __builtin_amdgcn_rcpf(1.f + eb1); }
                *(u32x4*)(RHO + off) = pack8(r0, r1); *(u32x4*)(SMB + off) = pack8(s0, s1); }
    }
};
struct Epi2 {
    static constexpr bool PERM = true, AFTER_DRAIN = false, HAS_MID = true;
    const bf16_t *SMA, *SMB; bf16_t* OUT;
    __device__ __forceinline__ void mid(f32x4 (&acc)[2][2][4][2], const Unit& u, int wr, int wc, int fr, int fq) const {
        asm volatile("" : "+v"(fr), "+v"(fq));
        const int row0 = u.pm * BM + wr * 64 + fr, c0 = u.pn * BM + wc * 32 + 8 * fq;
#pragma unroll
        for (int ai = 0; ai < 2; ++ai) {
            u32x4 wa[4][2];
#pragma unroll
            for (int m = 0; m < 4; ++m) { const size_t off = (size_t)(row0 + ai * HALF + m * 16) * 1024 + c0;
#pragma unroll
                for (int bj = 0; bj < 2; ++bj) wa[m][bj] = *(const u32x4*)(SMA + off + bj * HALF); }
            PG8_FENCE;
#pragma unroll
            for (int m = 0; m < 4; ++m)
#pragma unroll
                for (int bj = 0; bj < 2; ++bj) { f32x4 a0, a1; unpack8(wa[m][bj], a0, a1); acc[ai][bj][m][0] *= a0; acc[ai][bj][m][1] *= a1; }
            PG8_FENCE; }
    }
    __device__ __forceinline__ void operator()(const f32x4 (&acc)[2][2][4][2], const Unit& u, int wr, int wc, int fr, int fq) const {
        asm volatile("" : "+v"(fr), "+v"(fq));
        const int row0 = u.pm * BM + wr * 64 + fr, c0 = u.pn * BM + wc * 32 + 8 * fq;
        u32x4 wb[2][4][2];
#pragma unroll
        for (int ai = 0; ai < 2; ++ai)
#pragma unroll
            for (int m = 0; m < 4; ++m) { const size_t off = (size_t)(row0 + ai * HALF + m * 16) * 1024 + c0;
#pragma unroll
                for (int bj = 0; bj < 2; ++bj) wb[ai][m][bj] = *(const u32x4*)(SMB + off + bj * HALF); }
        PG8_FENCE;
#pragma unroll
        for (int ai = 0; ai < 2; ++ai)
#pragma unroll
            for (int m = 0; m < 4; ++m) { const size_t off = (size_t)(row0 + ai * HALF + m * 16) * 1024 + c0;
#pragma unroll
                for (int bj = 0; bj < 2; ++bj) { f32x4 b0, b1; unpack8(wb[ai][m][bj], b0, b1);
                    *(u32x4*)(OUT + off + bj * HALF) = pack8(acc[ai][bj][m][0] * b0, acc[ai][bj][m][1] * b1); } }
    }
};
struct Epi3 {
    static constexpr bool PERM = true, AFTER_DRAIN = false, HAS_MID = false;
    const bf16_t* XH; bf16_t* XO; float alpha;
    __device__ __forceinline__ void operator()(const f32x4 (&acc)[2][2][4][2], const Unit& u, int wr, int wc, int fr, int fq) const {
        asm volatile("" : "+v"(fr), "+v"(fq));
        const int row0 = u.pm * BM + wr * 64 + fr, c0 = u.pn * BM + wc * 32 + 8 * fq;
#pragma unroll
        for (int ai = 0; ai < 2; ++ai) {
            u32x4 wx[4][2];
#pragma unroll
            for (int m = 0; m < 4; ++m) { const size_t off = (size_t)(row0 + ai * HALF + m * 16) * 1024 + c0;
#pragma unroll
                for (int bj = 0; bj < 2; ++bj) wx[m][bj] = *(const u32x4*)(XH + off + bj * HALF); }
            PG8_FENCE;
#pragma unroll
            for (int m = 0; m < 4; ++m) { const size_t off = (size_t)(row0 + ai * HALF + m * 16) * 1024 + c0;
#pragma unroll
                for (int bj = 0; bj < 2; ++bj) { f32x4 r0, r1; unpack8h(wx[m][bj], r0, r1);
                    const f32x4 h0 = r0 * alpha + acc[ai][bj][m][0], h1 = r1 * alpha + acc[ai][bj][m][1];
                    *(u32x4*)(XO + off + bj * HALF) = pack8h(h0, h1); } }
            PG8_FENCE; }
    }
};
struct Epi4 {
    static constexpr bool PERM = true, AFTER_DRAIN = false, HAS_MID = false;
    const bf16_t* H0; bf16_t* XO; const bf16_t* E;
    __device__ __forceinline__ void operator()(const f32x4 (&acc)[2][2][4][2], const Unit& u, int wr, int wc, int fr, int fq) const {
        asm volatile("" : "+v"(fr), "+v"(fq));
        const int row0 = u.pm * BM + wr * 64 + fr, c0 = u.pn * BM + wc * 32 + 8 * fq;
#pragma unroll
        for (int ai = 0; ai < 2; ++ai) {
            u32x4 wx[4][2], we[4][2];
#pragma unroll
            for (int m = 0; m < 4; ++m) { const size_t off = (size_t)(row0 + ai * HALF + m * 16) * 1024 + c0;
#pragma unroll
                for (int bj = 0; bj < 2; ++bj) { wx[m][bj] = *(const u32x4*)(H0 + off + bj * HALF); we[m][bj] = *(const u32x4*)(E + off + bj * HALF); } }
            PG8_FENCE;
#pragma unroll
            for (int m = 0; m < 4; ++m) { const size_t off = (size_t)(row0 + ai * HALF + m * 16) * 1024 + c0;
#pragma unroll
                for (int bj = 0; bj < 2; ++bj) { f32x4 h0, h1, e0, e1; unpack8h(wx[m][bj], h0, h1); unpack8(we[m][bj], e0, e1);
#pragma unroll
                    for (int e = 0; e < 4; ++e) { h0[e] += e0[e] * sigm(acc[ai][bj][m][0][e]); h1[e] += e1[e] * sigm(acc[ai][bj][m][1][e]); }
                    *(u32x4*)(XO + off + bj * HALF) = pack8h(h0, h1); } }
            PG8_FENCE; }
    }
};
template <class Epi, class Sched, bool ALIGN_EPI = false, bool SP2 = false, int MODE = 0>
__device__ __forceinline__ void gemm_phase(PG8_LAS unsigned char* lds, const Gemm g, const Sched& S, const Epi& E) {
    int tid_ = threadIdx.x; asm volatile("" : "+v"(tid_));
    const int tid = tid_, wid = __builtin_amdgcn_readfirstlane(tid >> 6), lane = tid & 63, wr = wid >> 2, wc = wid & 3, fr = lane & 15, fq = lane >> 4;
    const int K = g.K, nt = K / BK;
    unsigned voffA[2], voffB[2];
#pragma unroll
    for (int i = 0; i < 2; ++i) { int R, C; stage_rc(tid * 16 + i * 8192, R, C); const int Rb = Epi::PERM ? ((R & ~31) + perm32(R & 31)) : R;
        voffA[i] = (unsigned)(R * g.lda + C) * 2u; voffB[i] = (unsigned)(Rb * K + C) * 2u; }
    const size_t kstep = (size_t)(BK * 2);
    const size_t hstepA = (size_t)HALF * g.lda * 2, hstepB = (size_t)HALF * K * 2;
    const size_t tstepA = 2 * hstepA, tstepB = 2 * hstepB;
    const unsigned ldsw = (unsigned)wid * 1024u;
    const int aoff = lds_byte(wr * 64 + fr, fq * 8), boff = lds_byte(wc * 32 + fr, fq * 8);
#define PG8_SA(b, h) (((b) * 2 + (h)) * HTB)
#define PG8_SB(b, h) ((4 + (b) * 2 + (h)) * HTB)
#define PG8_STAGE(bufoff, gbase, voff) do { _Pragma("unroll") for (int _i = 0; _i < 2; ++_i) \
        __builtin_amdgcn_global_load_lds((const unsigned*)((const char*)(gbase) + (voff)[_i]), (PG8_LAS unsigned*)(lds + (bufoff) + ldsw + _i * 8192), 16, 0, 0); } while (0)
#define PG8_LDA(dst, b, h) do { _Pragma("unroll") for (int m = 0; m < 4; ++m) _Pragma("unroll") for (int k = 0; k < 2; ++k) dst[m][k] = *(const PG8_LAS bf16x8*)(lds + PG8_SA(b, h) + aoff + m * 2048 + k * 1024); } while (0)
#define PG8_LDB(dst, b, h) do { _Pragma("unroll") for (int n = 0; n < 2; ++n) _Pragma("unroll") for (int k = 0; k < 2; ++k) dst[n][k] = *(const PG8_LAS bf16x8*)(lds + PG8_SB(b, h) + boff + n * 2048 + k * 1024); } while (0)
#define PG8_MMA(ai, bj, At, Bt) do { __builtin_amdgcn_s_setprio(1); _Pragma("unroll") for (int m = 0; m < 4; ++m) _Pragma("unroll") for (int n = 0; n < 2; ++n) _Pragma("unroll") for (int k = 0; k < 2; ++k) \
        { if constexpr (MODE == 2) acc[ai][bj][m][n] = __builtin_bit_cast(f32x4, __builtin_amdgcn_mfma_i32_16x16x64_i8(__builtin_bit_cast(i32x4, Bt[n][k]), __builtin_bit_cast(i32x4, At[m][k]), __builtin_bit_cast(i32x4, acc[ai][bj][m][n]), 0, 0, 0)); \
          else if constexpr (MODE == 1) acc[ai][bj][m][n] = __builtin_amdgcn_mfma_f32_16x16x32_f16(__builtin_bit_cast(f16x8, Bt[n][k]), __builtin_bit_cast(f16x8, At[m][k]), acc[ai][bj][m][n], 0, 0, 0); \
          else acc[ai][bj][m][n] = __builtin_amdgcn_mfma_f32_16x16x32_bf16(Bt[n][k], At[m][k], acc[ai][bj][m][n], 0, 0, 0); } __builtin_amdgcn_s_setprio(0); } while (0)
#define PG8_WAIT_V(n) asm volatile("s_waitcnt vmcnt(" #n ")" ::: "memory")
#define PG8_WAIT_L(n) asm volatile("s_waitcnt lgkmcnt(" #n ")" ::: "memory")
#define PG8_BAR __builtin_amdgcn_s_barrier()
#define PG8_SCHED __builtin_amdgcn_sched_barrier(0)
    Unit cur, nxt; int ui = 0;
    if (!S.next(0, cur)) return;
    f32x4 acc[2][2][4][2];
#pragma unroll
    for (int a = 0; a < 2; ++a)
#pragma unroll
        for (int b = 0; b < 2; ++b)
#pragma unroll
            for (int m = 0; m < 4; ++m)
#pragma unroll
                for (int n = 0; n < 2; ++n) acc[a][b][m][n] = (f32x4){0.f, 0.f, 0.f, 0.f};
    bf16x8 At[4][2], B0[2][2], B1[2][2];
    const char* cA = (const char*)g.A + (size_t)cur.pm * tstepA; const char* cB = (const char*)g.Bt + (size_t)cur.pn * tstepB;
    S.a_ready(cur);
    if constexpr (SP2) {
        PG8_STAGE(PG8_SB(0, 0), cB, voffB); PG8_STAGE(PG8_SB(0, 1), cB + hstepB, voffB); PG8_STAGE(PG8_SA(0, 0), cA, voffA); PG8_STAGE(PG8_SA(0, 1), cA + hstepA, voffA);
        if (wr == 1) PG8_BAR;
        PG8_WAIT_V(2); PG8_BAR;
        PG8_STAGE(PG8_SB(1, 0), cB + kstep, voffB); PG8_STAGE(PG8_SA(1, 0), cA + kstep, voffA); PG8_STAGE(PG8_SB(1, 1), cB + hstepB + kstep, voffB);
        PG8_WAIT_V(6); PG8_BAR;
    } else {
        PG8_STAGE(PG8_SB(0, 0), cB, voffB); PG8_STAGE(PG8_SA(0, 0), cA, voffA); PG8_STAGE(PG8_SB(0, 1), cB + hstepB, voffB); PG8_STAGE(PG8_SA(0, 1), cA + hstepA, voffA);
        if (wr == 1) PG8_BAR;
        PG8_WAIT_V(4); PG8_BAR;
        PG8_STAGE(PG8_SB(1, 0), cB + kstep, voffB); PG8_STAGE(PG8_SA(1, 0), cA + kstep, voffA); PG8_STAGE(PG8_SB(1, 1), cB + hstepB + kstep, voffB);
        PG8_WAIT_V(6); PG8_BAR;
    }
    for (;;) {
        const bool has_next = S.next(ui + 1, nxt);
        const char* nA = has_next ? (const char*)g.A + (size_t)nxt.pm * tstepA : cA; const char* nB = has_next ? (const char*)g.Bt + (size_t)nxt.pn * tstepB : cB;
        for (int t = 0; t < nt; t += 2) { if constexpr (Epi::HAS_MID) { if (t == (nt >> 1)) E.mid(acc, cur, wr, wc, fr, fq); }
            const bool last = (t == nt - 2);
            const char* a1 = cA + (size_t)(t + 1) * kstep;
            const char* a2 = last ? nA : cA + (size_t)(t + 2) * kstep; const char* b2 = last ? nB : cB + (size_t)(t + 2) * kstep;
            const char* a3 = a2 + kstep; const char* b3 = b2 + kstep;
            if (last && has_next) S.a_ready(nxt);
            if constexpr (SP2) {
            PG8_LDB(B0, 0, 0); PG8_LDB(B1, 0, 1); PG8_SCHED; PG8_LDA(At, 0, 0); PG8_STAGE(PG8_SA(1, 1), a1 + hstepA, voffA);
            PG8_WAIT_V(8); PG8_WAIT_L(0); PG8_BAR; PG8_MMA(0, 0, At, B0); PG8_MMA(0, 1, At, B1); PG8_BAR; PG8_SCHED;
            PG8_LDA(At, 0, 1); PG8_STAGE(PG8_SB(0, 0), b2, voffB); PG8_STAGE(PG8_SB(0, 1), b2 + hstepB, voffB); PG8_STAGE(PG8_SA(0, 0), a2, voffA);
            PG8_WAIT_V(8); PG8_WAIT_L(0); PG8_BAR; PG8_MMA(1, 0, At, B0); PG8_MMA(1, 1, At, B1); PG8_BAR; PG8_SCHED;
            PG8_LDB(B0, 1, 0); PG8_LDB(B1, 1, 1); PG8_SCHED; PG8_LDA(At, 1, 0); PG8_STAGE(PG8_SA(0, 1), a2 + hstepA, voffA);
            PG8_WAIT_V(8); PG8_WAIT_L(0); PG8_BAR; PG8_MMA(0, 0, At, B0); PG8_MMA(0, 1, At, B1); PG8_BAR; PG8_SCHED;
            PG8_LDA(At, 1, 1); PG8_STAGE(PG8_SB(1, 0), b3, voffB); PG8_STAGE(PG8_SB(1, 1), b3 + hstepB, voffB); PG8_STAGE(PG8_SA(1, 0), a3, voffA);
            PG8_WAIT_V(8); PG8_WAIT_L(0); PG8_BAR; PG8_MMA(1, 0, At, B0); PG8_MMA(1, 1, At, B1); PG8_BAR; PG8_SCHED;
            } else {
            PG8_LDB(B0, 0, 0); PG8_SCHED; PG8_LDA(At, 0, 0); PG8_STAGE(PG8_SA(1, 1), a1 + hstepA, voffA);
            PG8_WAIT_L(8); PG8_BAR; PG8_WAIT_L(0); PG8_MMA(0, 0, At, B0); PG8_BAR; PG8_SCHED;
            PG8_LDB(B1, 0, 1); PG8_STAGE(PG8_SB(0, 0), b2, voffB);
            PG8_BAR; PG8_WAIT_L(0); PG8_MMA(0, 1, At, B1); PG8_BAR;
            PG8_LDA(At, 0, 1); PG8_STAGE(PG8_SA(0, 0), a2, voffA);
            PG8_BAR; PG8_WAIT_L(0); PG8_MMA(1, 0, At, B0); PG8_BAR; PG8_SCHED;
            PG8_STAGE(PG8_SB(0, 1), b2 + hstepB, voffB);
            PG8_WAIT_V(6); PG8_BAR; PG8_MMA(1, 1, At, B1); PG8_BAR;
            PG8_LDB(B0, 1, 0); PG8_SCHED; PG8_LDA(At, 1, 0); PG8_STAGE(PG8_SA(0, 1), a2 + hstepA, voffA);
            PG8_WAIT_L(8); PG8_BAR; PG8_WAIT_L(0); PG8_MMA(0, 0, At, B0); PG8_BAR; PG8_SCHED;
            PG8_LDB(B1, 1, 1); PG8_STAGE(PG8_SB(1, 0), b3, voffB);
            PG8_BAR; PG8_WAIT_L(0); PG8_MMA(0, 1, At, B1); PG8_BAR;
            PG8_LDA(At, 1, 1); PG8_STAGE(PG8_SA(1, 0), a3, voffA);
            PG8_BAR; PG8_WAIT_L(0); PG8_MMA(1, 0, At, B0); PG8_BAR; PG8_SCHED;
            PG8_STAGE(PG8_SB(1, 1), b3 + hstepB, voffB);
            PG8_WAIT_V(6); PG8_BAR; PG8_MMA(1, 1, At, B1); PG8_BAR;
            }
        }
        if constexpr (ALIGN_EPI) { if (wr == 0) PG8_BAR; }
        if constexpr (!Epi::AFTER_DRAIN) { E(acc, cur, wr, wc, fr, fq); S.done(cur); }
        if (!has_next) break;
#pragma unroll
        for (int a = 0; a < 2; ++a)
#pragma unroll
            for (int b = 0; b < 2; ++b)
#pragma unroll
                for (int m = 0; m < 4; ++m)
#pragma unroll
                    for (int n = 0; n < 2; ++n) acc[a][b][m][n] = (f32x4){0.f, 0.f, 0.f, 0.f};
        cur = nxt; cA = nA; cB = nB; ++ui;
        if constexpr (ALIGN_EPI) { if (wr == 1) PG8_BAR; }
    }
    PG8_WAIT_V(0);
    if constexpr (!ALIGN_EPI) { if (wr == 0) PG8_BAR; }
    PG8_BAR;
    if constexpr (Epi::AFTER_DRAIN) { E.fused(acc, cur, wr, wc, fr, fq, lds, wid, lane); S.done(cur); }
#undef PG8_SA
#undef PG8_SB
#undef PG8_STAGE
#undef PG8_LDA
#undef PG8_LDB
#undef PG8_MMA
#undef PG8_WAIT_V
#undef PG8_WAIT_L
#undef PG8_BAR
#undef PG8_SCHED
}
}
#define LAS __attribute__((address_space(3)))
typedef unsigned short bf16;
typedef unsigned u32x4 __attribute__((ext_vector_type(4)));
typedef unsigned u32x2 __attribute__((ext_vector_type(2)));
typedef float f32x4 __attribute__((ext_vector_type(4)));
typedef float f32x16 __attribute__((ext_vector_type(16)));
typedef short bf16x8 __attribute__((ext_vector_type(8)));
constexpr int DM = 1024, NBATCH = 8, SEQ = 4096, T = NBATCH * SEQ, DEPTH = 4, PLE = 256, NIN = 9216, NHEAD = 16, HD = 64;
constexpr float LN_EPS = 1e-5f;
constexpr float ALPHA = 1.681792830507429f;
constexpr float QSCALE = 0.125f * 1.4426950408889634f;
constexpr size_t MiB = 1u << 20;
constexpr size_t WS_WIN = 0, WS_W2 = 18 * MiB, WS_WO = 22 * MiB, WS_WG = 24 * MiB, WS_WE = 26 * MiB, WS_WS = 27 * MiB, WS_PB = 28 * MiB, WS_XH1 = 44 * MiB,
                 WS_UGQ = 108 * MiB, WS_V = 236 * MiB, WS_K = 300 * MiB, WS_VB = 364 * MiB, WS_GB = 428 * MiB, WS_CTL = 492 * MiB, WS_XH = 493 * MiB, WS_XS = 557 * MiB  , WS_CMAX = WS_XS + 256 * 1024  , WS_CMAX1 = WS_CMAX + 32 * 1024  , WS_END = 558 * MiB;
constexpr size_t OUT_XQ = 64 * MiB;
constexpr int LDS_BYTES = 147456, RING_BYTES = 131072;

__device__ __forceinline__ float wave_sum(float v) {
#pragma unroll
    for (int o = 1; o < 64; o <<= 1) v += __shfl_xor(v, o);
    return v;
}
__device__ __forceinline__ unsigned pk2(float lo, float hi) { return pg8::cvt_pk_bf16(lo, hi); }
__device__ __forceinline__ float bf_lo(unsigned w) { return __uint_as_float(w << 16); }
__device__ __forceinline__ float bf_hi(unsigned w) { return __uint_as_float(w & 0xffff0000u); }

template <bool F16 = false> __device__ __forceinline__ void tr_item(const float* W, int N, bf16* WT, int ldk, int koff, int k0, int n0, int drow0, LAS float* scr, int lane) {
#pragma unroll 8
    for (int i = 0; i < 32; ++i) { const int kk = 2 * i + (lane >> 5); scr[kk * 33 + (lane & 31)] = W[(size_t)(k0 + kk) * N + n0 + (lane & 31)]; }
    asm volatile("s_waitcnt lgkmcnt(0)" ::: "memory");
    const int c = lane & 7;
#pragma unroll
    for (int j = 0; j < 4; ++j) { const int n = (lane >> 3) + 8 * j; const LAS float* s = scr + (8 * c) * 33 + n;
        u32x4 o;
        if constexpr (F16) { o.x = pg8::cvt_pk_f16(s[0 * 33], s[1 * 33]); o.y = pg8::cvt_pk_f16(s[2 * 33], s[3 * 33]); o.z = pg8::cvt_pk_f16(s[4 * 33], s[5 * 33]); o.w = pg8::cvt_pk_f16(s[6 * 33], s[7 * 33]); }
        else { o.x = pk2(s[0 * 33], s[1 * 33]); o.y = pk2(s[2 * 33], s[3 * 33]); o.z = pk2(s[4 * 33], s[5 * 33]); o.w = pk2(s[6 * 33], s[7 * 33]); }
        *(u32x4*)(WT + (size_t)(drow0 + n) * ldk + koff + k0 + 8 * c) = o; }
    asm volatile("s_waitcnt lgkmcnt(0)" ::: "memory");
}
__device__ __forceinline__ float wave_max(float v) {
#pragma unroll
    for (int o = 1; o < 64; o <<= 1) v = fmaxf(v, __shfl_xor(v, o));
    return v;
}
__device__ __forceinline__ unsigned q4(float a, float b, float c, float d, float inv) {
    const int ia = (int)__builtin_rintf(a * inv), ib = (int)__builtin_rintf(b * inv), ic = (int)__builtin_rintf(c * inv), id = (int)__builtin_rintf(d * inv);
    return (unsigned)(ia & 0xff) | ((unsigned)(ib & 0xff) << 8) | ((unsigned)(ic & 0xff) << 16) | ((unsigned)(id & 0xff) << 24);
}
__device__ __forceinline__ int win_dest_row(int c);
__device__ __forceinline__ void tr_item_q(const float* W, const float* cmax, unsigned char* WQ, int k0, int n0, int qrow0, LAS float* scr, int lane) {
#pragma unroll 8
    for (int i = 0; i < 32; ++i) { const int kk = 2 * i + (lane >> 5); scr[kk * 33 + (lane & 31)] = W[(size_t)(k0 + kk) * NIN + n0 + (lane & 31)]; }
    asm volatile("s_waitcnt lgkmcnt(0)" ::: "memory");
    const int c16 = lane & 3;
#pragma unroll
    for (int j = 0; j < 2; ++j) { const int n = (lane >> 2) + 16 * j; const LAS float* sp = scr + (16 * c16) * 33 + n;
        const float cm = cmax[qrow0 + n], inv = cm > 0.f ? 127.f / cm : 0.f;
        u32x4 o; o.x = q4(sp[0 * 33], sp[1 * 33], sp[2 * 33], sp[3 * 33], inv); o.y = q4(sp[4 * 33], sp[5 * 33], sp[6 * 33], sp[7 * 33], inv);
        o.z = q4(sp[8 * 33], sp[9 * 33], sp[10 * 33], sp[11 * 33], inv); o.w = q4(sp[12 * 33], sp[13 * 33], sp[14 * 33], sp[15 * 33], inv);
        *(u32x4*)(WQ + (size_t)(qrow0 + n) * 1024 + k0 + 16 * c16) = o; }
    asm volatile("s_waitcnt lgkmcnt(0)" ::: "memory");
}
__device__ __forceinline__ int win_dest_row(int c) {
    if (c < 1024) return 256 * (c >> 7) + (c & 127);
    if (c < 2048) return 2048 + (c - 1024);
    if (c < 3072) { const int cc = c - 2048; return 256 * (cc >> 7) + 128 + (cc & 127); }
    if (c < 7168) return c;
    if (c < 8192) { const int cc = c - 7168; return 7168 + 256 * (cc >> 7) + (cc & 127); }
    { const int cc = c - 8192; return 7168 + 256 * (cc >> 7) + 128 + (cc & 127); }
}
struct Args { const float* in[14]; float* out; unsigned char* ws; };
__device__ __forceinline__ void win_item(const Args& a, int l, unsigned char* wb, int kb, int nb, int what, LAS float* scr, int lane) {
    const float* w_in = a.in[2] + (size_t)l * DM * NIN; const int drow0 = win_dest_row(32 * nb);
    if (drow0 >= 7168) { if (what >= 1) tr_item_q(w_in, (const float*)(a.ws + WS_CMAX) + l * 2048, wb + WS_WIN + (size_t)7168 * 2048, 64 * kb, 32 * nb, drow0 - 7168, scr, lane); return; }
    const int slot = pg8::p1_qslot(drow0 >> 8);
    if (slot >= 0) { if (what >= 1) tr_item_q(w_in, (const float*)(a.ws + WS_CMAX1) + l * (pg8::P1_NQ * 256), wb + WS_WIN, 64 * kb, 32 * nb, slot * 256 + (drow0 & 255), scr, lane); return; }
    if (what != 1) tr_item<true>(w_in, NIN, (bf16*)(wb + WS_WIN), 1024, 0, 64 * kb, 32 * nb, drow0, scr, lane);
}

__device__ __forceinline__ void convert_layer(const Args& a, int l, LAS unsigned char* lds, int gw, int NGW, int lane, int wave, bool gates = true) {
    LAS float* scr = (LAS float*)(lds + wave * 8704);
    unsigned char* ws = (l & 1) ? (unsigned char*)a.out : a.ws;
    const float* w_in = a.in[2] + (size_t)l * DM * NIN;
    const float* w_pa = a.in[7] + (size_t)l * DM * DM; const float* w_pb = a.in[8] + (size_t)l * DM * DM; const float* w_out = a.in[9] + (size_t)l * DM * DM;
    const float* w_pe = a.in[10] + (size_t)l * PLE * DM; const float* w_pg = a.in[11] + (size_t)l * DM * DM;
    constexpr int I_IN = 16 * (NIN / 32), I_SQ = 16 * 32, I_PE = 4 * 32, NITEMS = I_IN + 4 * I_SQ + I_PE;
    for (int it = gw; it < NITEMS; it += NGW) {
        int r = it;
        if (r < I_IN) { win_item(a, l, ws, r / (NIN / 32), r % (NIN / 32), gates ? 2 : 0, scr, lane); continue; } r -= I_IN;
        if (r < I_SQ) { tr_item(w_pa, DM, (bf16*)(ws + WS_W2), 2048, 0, 64 * (r >> 5), 32 * (r & 31), 32 * (r & 31), scr, lane); continue; } r -= I_SQ;
        if (r < I_SQ) { tr_item(w_pb, DM, (bf16*)(ws + WS_W2), 2048, 1024, 64 * (r >> 5), 32 * (r & 31), 32 * (r & 31), scr, lane); continue; } r -= I_SQ;
        if (r < I_SQ) { tr_item(w_out, DM, (bf16*)(ws + WS_WO), 1024, 0, 64 * (r >> 5), 32 * (r & 31), 32 * (r & 31), scr, lane); continue; } r -= I_SQ;
        if (r < I_SQ) { tr_item<true>(w_pg, DM, (bf16*)(ws + WS_WG), 1024, 0, 64 * (r >> 5), 32 * (r & 31), 32 * (r & 31), scr, lane); continue; } r -= I_SQ;
        tr_item(w_pe, DM, (bf16*)(ws + WS_WE), 256, 0, 64 * (r >> 5), 32 * (r & 31), 32 * (r & 31), scr, lane);
    }
    const int gt = gw * 64 + lane, NGT = NGW * 64;
    { const float* w_s = a.in[5] + (size_t)l * 8 * 128 * 128; bf16* WsB = (bf16*)(ws + WS_WS);
      for (int p = gt; p < 8 * 128 * 16; p += NGT) { const int s0 = (p & 15) * 8, t = (p >> 4) & 127;
          const f32x4 x0 = *(const f32x4*)(w_s + (size_t)p * 8), x1 = *(const f32x4*)(w_s + (size_t)p * 8 + 4);
          float v[8] = {x0[0], x0[1], x0[2], x0[3], x1[0], x1[1], x1[2], x1[3]};
#pragma unroll
          for (int j = 0; j < 8; ++j) v[j] = (s0 + j <= t) ? v[j] : 0.f;
          u32x4 o; o.x = pk2(v[0], v[1]); o.y = pk2(v[2], v[3]); o.z = pk2(v[4], v[5]); o.w = pk2(v[6], v[7]);
          *(u32x4*)(WsB + (size_t)p * 8) = o; } }
    { const float* p = a.in[1] + (size_t)l * T * PLE; bf16* PB = (bf16*)(ws + WS_PB);
      for (int q = gt; q < T * PLE / 8; q += NGT) { const f32x4 x0 = *(const f32x4*)(p + (size_t)q * 8), x1 = *(const f32x4*)(p + (size_t)q * 8 + 4);
          u32x4 o; o.x = pk2(x0[0], x0[1]); o.y = pk2(x0[2], x0[3]); o.z = pk2(x1[0], x1[1]); o.w = pk2(x1[2], x1[3]);
          *(u32x4*)(PB + (size_t)q * 8) = o; } }
}

constexpr int AT_K = 0, AT_V = 16384, AT_STG = 16384 + 2 * 9216, AT_STG_W = 8704;
__device__ __forceinline__ void attn_unit(int b, int h, int qb, bf16* UGQ, const bf16* Kb, const bf16* Vb, const bf16* GBb, LAS unsigned char* lds, int dry = 0) {
    int tid_ = threadIdx.x; asm volatile("" : "+v"(tid_));
    const int tid = tid_, lane = tid & 63, wid = __builtin_amdgcn_readfirstlane(tid >> 6), r32 = lane & 31, hi = lane >> 5;
    const size_t rowbase = (size_t)b * SEQ;
    const int q0 = qb * 256, qw = q0 + wid * 32;
    bf16x8 qr[4];
    { const bf16* qp = UGQ + (rowbase + qw + r32) * 2048 + 1024 + h * HD + hi * 8;
#pragma unroll
      for (int d0 = 0; d0 < 4; ++d0) qr[d0] = *(const bf16x8*)(qp + d0 * 16); }
    f32x16 o0, o1;
#pragma unroll
    for (int r = 0; r < 16; ++r) { o0[r] = 0.f; o1[r] = 0.f; }
    float C = 1.f; int alive = 1;
    volatile LAS unsigned* aflag = (volatile LAS unsigned*)(lds + RING_BYTES);
    const int NT = 4 * (qb + 1);
    const int lkey = lane, lch = wid;
    const int kk = lkey & 31, slot = (lkey & 32) | (8 * ((kk >> 2) & 3) + 4 * (kk >> 4) + (kk & 3));
    const bf16* kg = Kb + (rowbase + lkey) * 1024 + h * HD + lch * 8;
    const bf16* vg = Vb + (rowbase + lkey) * 1024 + h * HD + lch * 8;
    u32x4 kreg, vreg;
    kreg = *(const u32x4*)(kg + (size_t)(NT - 1) * 64 * 1024); vreg = *(const u32x4*)(vg + (size_t)(NT - 1) * 64 * 1024);
#define AT_WRITE(buf) do { *(LAS u32x4*)(lds + AT_K + (buf) * 8192 + lch * 1024 + slot * 16) = kreg; \
        LAS unsigned short* vt_ = (LAS unsigned short*)(lds + AT_V + (buf) * 9216) + (lch * 8) * 72 + lkey; \
        vt_[0 * 72] = (unsigned short)(vreg.x & 0xffffu); vt_[1 * 72] = (unsigned short)(vreg.x >> 16); vt_[2 * 72] = (unsigned short)(vreg.y & 0xffffu); vt_[3 * 72] = (unsigned short)(vreg.y >> 16); \
        vt_[4 * 72] = (unsigned short)(vreg.z & 0xffffu); vt_[5 * 72] = (unsigned short)(vreg.z >> 16); vt_[6 * 72] = (unsigned short)(vreg.w & 0xffffu); vt_[7 * 72] = (unsigned short)(vreg.w >> 16); } while (0)
    AT_WRITE(0);
    __syncthreads();
    const int qrel = qw + r32;
    for (int it = 0; it < NT; ++it) {
        const int kt = NT - 1 - it, cur = it & 1;
        if (it + 1 < NT) { kreg = *(const u32x4*)(kg + (size_t)(kt - 1) * 64 * 1024); vreg = *(const u32x4*)(vg + (size_t)(kt - 1) * 64 * 1024); }
        const int k0 = kt * 64;
        if (k0 < qw + 32 && alive) {
            const LAS unsigned char* kb = lds + AT_K + cur * 8192 + hi * 1024 + r32 * 16;
            f32x16 p0, p1;
#pragma unroll
            for (int r = 0; r < 16; ++r) { p0[r] = 0.f; p1[r] = 0.f; }
#pragma unroll
            for (int d0 = 0; d0 < 4; ++d0) {
                const bf16x8 a0 = *(const LAS bf16x8*)(kb + d0 * 2048), a1 = *(const LAS bf16x8*)(kb + d0 * 2048 + 512);
                p0 = __builtin_amdgcn_mfma_f32_32x32x16_bf16(a0, qr[d0], p0, 0, 0, 0);
                p1 = __builtin_amdgcn_mfma_f32_32x32x16_bf16(a1, qr[d0], p1, 0, 0, 0);
            }
#pragma unroll
            for (int r = 0; r < 16; ++r) { p0[r] = __builtin_amdgcn_rcpf(1.f + __builtin_amdgcn_exp2f(p0[r])); p1[r] = __builtin_amdgcn_rcpf(1.f + __builtin_amdgcn_exp2f(p1[r])); }
            if (k0 + 63 >= qw) {
                const int kb0 = k0 + 16 * hi;
#pragma unroll
                for (int r = 0; r < 16; ++r) { if (kb0 + r >= qrel) p0[r] = 1.f; if (kb0 + 32 + r >= qrel) p1[r] = 1.f; }
            }
#pragma unroll
            for (int r = 14; r >= 0; --r) { p0[r] *= p0[r + 1]; p1[r] *= p1[r + 1]; }
            const float L0 = p0[0], L1 = p1[0];
            const float pL0 = __shfl_xor(L0, 32), pL1 = __shfl_xor(L1, 32);
            const float tot1 = L1 * pL1;
            const float pre1 = hi ? C : C * pL1;
            const float pre0 = C * tot1 * (hi ? 1.f : pL0);
            C = C * tot1 * (L0 * pL0);
#pragma unroll
            for (int r = 0; r < 15; ++r) { p0[r] = pre0 * (p0[r + 1] - p0[r]); p1[r] = pre1 * (p1[r + 1] - p1[r]); }
            p0[15] = pre0 * (1.f - p0[15]); p1[15] = pre1 * (1.f - p1[15]);
            u32x4 w00, w01, w10, w11;
            w00.x = pk2(p0[0], p0[1]); w00.y = pk2(p0[2], p0[3]); w00.z = pk2(p0[4], p0[5]); w00.w = pk2(p0[6], p0[7]);
            w01.x = pk2(p0[8], p0[9]); w01.y = pk2(p0[10], p0[11]); w01.z = pk2(p0[12], p0[13]); w01.w = pk2(p0[14], p0[15]);
            w10.x = pk2(p1[0], p1[1]); w10.y = pk2(p1[2], p1[3]); w10.z = pk2(p1[4], p1[5]); w10.w = pk2(p1[6], p1[7]);
            w11.x = pk2(p1[8], p1[9]); w11.y = pk2(p1[10], p1[11]); w11.z = pk2(p1[12], p1[13]); w11.w = pk2(p1[14], p1[15]);
            const LAS unsigned char* vb = lds + AT_V + cur * 9216 + r32 * 144 + hi * 32;
#define AT_PV(W, off) do { const bf16x8 pf_ = __builtin_bit_cast(bf16x8, W); \
                const bf16x8 v0_ = *(const LAS bf16x8*)(vb + (off)), v1_ = *(const LAS bf16x8*)(vb + 4608 + (off)); \
                o0 = __builtin_amdgcn_mfma_f32_32x32x16_bf16(v0_, pf_, o0, 0, 0, 0); o1 = __builtin_amdgcn_mfma_f32_32x32x16_bf16(v1_, pf_, o1, 0, 0, 0); } while (0)
            AT_PV(w00, 0); AT_PV(w01, 16); AT_PV(w10, 64); AT_PV(w11, 80);
#undef AT_PV
            alive = __any(C != 0.f);
        }
        if (it + 1 < NT) AT_WRITE(cur ^ 1);
        if (lane == 0) aflag[(it & 1) * 8 + wid] = (unsigned)alive;
        __syncthreads();
        const unsigned fl = (lane < 8) ? aflag[(it & 1) * 8 + lane] : 0u;
        if (!__any(fl != 0u)) break;
    }
#undef AT_WRITE
    LAS float* stg = (LAS float*)(lds + AT_STG + wid * AT_STG_W);
#pragma unroll
    for (int g4 = 0; g4 < 4; ++g4) {
        *(LAS f32x4*)(stg + r32 * 68 + 8 * g4 + 4 * hi) = (f32x4){o0[4 * g4], o0[4 * g4 + 1], o0[4 * g4 + 2], o0[4 * g4 + 3]};
        *(LAS f32x4*)(stg + r32 * 68 + 32 + 8 * g4 + 4 * hi) = (f32x4){o1[4 * g4], o1[4 * g4 + 1], o1[4 * g4 + 2], o1[4 * g4 + 3]};
    }
    asm volatile("s_waitcnt lgkmcnt(0)" ::: "memory");
#pragma unroll
    for (int i = 0; i < 4; ++i) {
        const int row = i * 8 + (lane >> 3), ch = lane & 7;
        f32x4 a0 = *(const LAS f32x4*)(stg + row * 68 + ch * 8), a1 = *(const LAS f32x4*)(stg + row * 68 + ch * 8 + 4);
        const size_t tok = rowbase + qw + row;
        const u32x4 gw_ = *(const u32x4*)(GBb + tok * 1024 + h * HD + ch * 8);
        f32x4 g0, g1; pg8::unpack8(gw_, g0, g1);
#pragma unroll
        for (int e = 0; e < 4; ++e) { a0[e] *= g0[e] * pg8::sigm(g0[e]); a1[e] *= g1[e] * pg8::sigm(g1[e]); }
        if (!dry) *(u32x4*)(UGQ + tok * 2048 + 1024 + h * HD + ch * 8) = pg8::pack8(a0, a1);
    }
    asm volatile("s_waitcnt lgkmcnt(0)" ::: "memory");
}

constexpr int BA_STAT = 0, BA_GB = 1024, BA_VNT = 1024 + 8192, BA_OT = BA_VNT + 128 * 272;
__device__ __forceinline__ void brancha_unit(int chunk, bf16* UGQ, const bf16* Vb, const bf16* WsB, const float* vn_g, const float* vn_b, const float* b_s, LAS unsigned char* lds, int dry = 0) {
    int tid_ = threadIdx.x; asm volatile("" : "+v"(tid_));
    const int tid = tid_, lane = tid & 63, wid = __builtin_amdgcn_readfirstlane(tid >> 6), r32 = lane & 31, hi = lane >> 5;
    const size_t t0 = (size_t)chunk * 128;
    LAS float* stat = (LAS float*)(lds + BA_STAT);
    LAS float* gbl = (LAS float*)(lds + BA_GB);
    u32x4 vpc[4];
#pragma unroll
    for (int i = 0; i < 4; ++i) { const int p = tid + 512 * i, s = p >> 4, dc = p & 15; vpc[i] = *(const u32x4*)(Vb + (t0 + s) * 1024 + dc * 8); }
    gbl[tid] = vn_g[tid]; gbl[tid + 512] = vn_g[tid + 512]; gbl[1024 + tid] = vn_b[tid]; gbl[1536 + tid] = vn_b[tid + 512];
#pragma unroll
    for (int hb = 0; hb < 2; ++hb) {
        u32x4 x0[8], x1[8];
#pragma unroll
        for (int i = 0; i < 8; ++i) { const bf16* vr = Vb + (t0 + wid * 16 + hb * 8 + i) * 1024; x0[i] = *(const u32x4*)(vr + lane * 8); x1[i] = *(const u32x4*)(vr + 512 + lane * 8); }
#pragma unroll
        for (int i = 0; i < 8; ++i) {
            f32x4 a, bq, c, d; pg8::unpack8(x0[i], a, bq); pg8::unpack8(x1[i], c, d);
            float s = (a[0] + a[1]) + (a[2] + a[3]) + (bq[0] + bq[1]) + (bq[2] + bq[3]) + (c[0] + c[1]) + (c[2] + c[3]) + (d[0] + d[1]) + (d[2] + d[3]);
            const float mean = wave_sum(s) * (1.f / 1024.f);
            a = a - mean; bq = bq - mean; c = c - mean; d = d - mean;
            float q = (a[0] * a[0] + a[1] * a[1]) + (a[2] * a[2] + a[3] * a[3]) + (bq[0] * bq[0] + bq[1] * bq[1]) + (bq[2] * bq[2] + bq[3] * bq[3])
                    + (c[0] * c[0] + c[1] * c[1]) + (c[2] * c[2] + c[3] * c[3]) + (d[0] * d[0] + d[1] * d[1]) + (d[2] * d[2] + d[3] * d[3]);
            const float rstd = 1.0f / sqrtf(wave_sum(q) * (1.f / 1024.f) + LN_EPS);
            if (lane == 0) { const int row = wid * 16 + hb * 8 + i; stat[row * 2] = mean; stat[row * 2 + 1] = rstd; }
        }
    }
    __syncthreads();
    const int dblk = wid & 3, tbp = wid >> 2;
    u32x4 ugp[4]; bf16x8 wf[2][8];
#define BA_LOAD_UG(g_) do { _Pragma("unroll") for (int i = 0; i < 4; ++i) { const int p = tid + 512 * i, t = p >> 4, dc = p & 15; ugp[i] = *(const u32x4*)(UGQ + (t0 + t) * 2048 + (g_) * 128 + dc * 8); } } while (0)
#define BA_LOAD_WS(g_) do { _Pragma("unroll") for (int j = 0; j < 2; ++j) { const int tb = 2 * tbp + j; const bf16* wrow = WsB + ((size_t)(g_) * 128 + 32 * tb + r32) * 128 + hi * 8; \
        _Pragma("unroll") for (int ks = 0; ks < 8; ++ks) if (ks < 2 * (tb + 1)) wf[j][ks] = *(const bf16x8*)(wrow + ks * 16); } } while (0)
    BA_LOAD_WS(0); BA_LOAD_UG(0);
    for (int g = 0; g < 8; ++g) {
#pragma unroll
        for (int i = 0; i < 4; ++i) {
            const int p = tid + 512 * i, s = p >> 4, dc = p & 15;
            f32x4 v0, v1; pg8::unpack8(vpc[i], v0, v1);
            const f32x4 ga = *(const LAS f32x4*)(gbl + g * 128 + dc * 8), gb2 = *(const LAS f32x4*)(gbl + g * 128 + dc * 8 + 4);
            const f32x4 ba = *(const LAS f32x4*)(gbl + 1024 + g * 128 + dc * 8), bb2 = *(const LAS f32x4*)(gbl + 1024 + g * 128 + dc * 8 + 4);
            const float mean = stat[s * 2], rstd = stat[s * 2 + 1];
            v0 = (v0 - mean) * rstd * ga + ba; v1 = (v1 - mean) * rstd * gb2 + bb2;
            const u32x4 w = pg8::pack8(v0, v1);
            LAS unsigned short* dst = (LAS unsigned short*)(lds + BA_VNT) + dc * 136 + s;
            dst[0 * 16 * 136] = (unsigned short)(w.x & 0xffffu); dst[1 * 16 * 136] = (unsigned short)(w.x >> 16); dst[2 * 16 * 136] = (unsigned short)(w.y & 0xffffu); dst[3 * 16 * 136] = (unsigned short)(w.y >> 16);
            dst[4 * 16 * 136] = (unsigned short)(w.z & 0xffffu); dst[5 * 16 * 136] = (unsigned short)(w.z >> 16); dst[6 * 16 * 136] = (unsigned short)(w.w & 0xffffu); dst[7 * 16 * 136] = (unsigned short)(w.w >> 16);
        }
        if (g + 1 < 8) {
#pragma unroll
            for (int i = 0; i < 4; ++i) { const int p = tid + 512 * i, s = p >> 4, dc = p & 15; vpc[i] = *(const u32x4*)(Vb + (t0 + s) * 1024 + (g + 1) * 128 + dc * 8); }
        }
        __syncthreads();
        const int d = 32 * dblk + r32;
        const LAS unsigned char* ab = lds + BA_VNT + ((d & 7) * 16 + (d >> 3)) * 272 + hi * 16;
        f32x16 acc[2];
#pragma unroll
        for (int j = 0; j < 2; ++j) {
            const int tb = 2 * tbp + j;
#pragma unroll
            for (int r = 0; r < 16; ++r) acc[j][r] = 0.f;
#pragma unroll
            for (int ks = 0; ks < 8; ++ks) if (ks < 2 * (tb + 1)) {
                const bf16x8 af = *(const LAS bf16x8*)(ab + ks * 32);
                acc[j] = __builtin_amdgcn_mfma_f32_32x32x16_bf16(af, wf[j][ks], acc[j], 0, 0, 0);
            }
        }
        if (g + 1 < 8) BA_LOAD_WS(g + 1);
#pragma unroll
        for (int j = 0; j < 2; ++j) {
            const int tb = 2 * tbp + j, t = 32 * tb + r32;
            const float bias = b_s[g * 128 + t];
            LAS float* ot = (LAS float*)(lds + BA_OT) + t * 132 + 32 * dblk + 4 * hi;
#pragma unroll
            for (int g4 = 0; g4 < 4; ++g4) *(LAS f32x4*)(ot + 8 * g4) = (f32x4){acc[j][4 * g4] + bias, acc[j][4 * g4 + 1] + bias, acc[j][4 * g4 + 2] + bias, acc[j][4 * g4 + 3] + bias};
        }
        __syncthreads();
#pragma unroll
        for (int i = 0; i < 4; ++i) {
            const int p = tid + 512 * i, t = p >> 4, dc = p & 15;
            const LAS float* ot = (const LAS float*)(lds + BA_OT) + t * 132 + dc * 8;
            const f32x4 m0 = *(const LAS f32x4*)ot, m1 = *(const LAS f32x4*)(ot + 4);
            bf16* up = UGQ + (t0 + t) * 2048 + g * 128 + dc * 8;
            f32x4 u0, u1; pg8::unpack8(ugp[i], u0, u1);
            if (!dry) *(u32x4*)up = pg8::pack8(u0 * m0, u1 * m1);
        }
        if (g + 1 < 8) BA_LOAD_UG(g + 1);
    }
#undef BA_LOAD_UG
#undef BA_LOAD_WS
    __syncthreads();
}

__device__ __forceinline__ void ln_rows(bf16* XH, unsigned char* XQ, float* XS, float* OUT, const float* g, const float* bta, bool last, int gw, int NGW, int lane) {
    f32x4 gv[4], bv[4];
#pragma unroll
    for (int j = 0; j < 2; ++j) { gv[2 * j] = *(const f32x4*)(g + 512 * j + lane * 8); gv[2 * j + 1] = *(const f32x4*)(g + 512 * j + lane * 8 + 4);
                                  bv[2 * j] = *(const f32x4*)(bta + 512 * j + lane * 8); bv[2 * j + 1] = *(const f32x4*)(bta + 512 * j + lane * 8 + 4); }
    for (int m = gw; m < T; m += NGW) {
        bf16* xr = XH + (size_t)m * DM + lane * 8;
        f32x4 v[4]; float s = 0.f;
        pg8::unpack8h(*(const u32x4*)xr, v[0], v[1]); pg8::unpack8h(*(const u32x4*)(xr + 512), v[2], v[3]);
#pragma unroll
        for (int j = 0; j < 4; ++j) s += (v[j][0] + v[j][1]) + (v[j][2] + v[j][3]);
        const float mean = wave_sum(s) * (1.f / DM); float s2 = 0.f;
#pragma unroll
        for (int j = 0; j < 4; ++j) { v[j] = v[j] - mean; s2 += (v[j][0] * v[j][0] + v[j][1] * v[j][1]) + (v[j][2] * v[j][2] + v[j][3] * v[j][3]); }
        const float rstd = 1.0f / sqrtf(wave_sum(s2) * (1.f / DM) + LN_EPS);
#pragma unroll
        for (int j = 0; j < 4; ++j) v[j] = v[j] * rstd * gv[j] + bv[j];
        if (last) { float* o = OUT + (size_t)m * DM + lane * 8;
            *(f32x4*)o = v[0]; *(f32x4*)(o + 4) = v[1]; *(f32x4*)(o + 512) = v[2]; *(f32x4*)(o + 516) = v[3]; }
        else { *(u32x4*)xr = pg8::pack8h(v[0], v[1]); *(u32x4*)(xr + 512) = pg8::pack8h(v[2], v[3]);
            float am = 0.f;
#pragma unroll
            for (int j = 0; j < 4; ++j) am = fmaxf(am, fmaxf(fmaxf(fabsf(v[j][0]), fabsf(v[j][1])), fmaxf(fabsf(v[j][2]), fabsf(v[j][3]))));
            am = wave_max(am); const float inv = am > 0.f ? 127.f / am : 0.f;
            unsigned char* xq = XQ + (size_t)m * DM + lane * 8;
            u32x2 w0, w1; w0.x = q4(v[0][0], v[0][1], v[0][2], v[0][3], inv); w0.y = q4(v[1][0], v[1][1], v[1][2], v[1][3], inv);
            w1.x = q4(v[2][0], v[2][1], v[2][2], v[2][3], inv); w1.y = q4(v[3][0], v[3][1], v[3][2], v[3][3], inv);
            *(u32x2*)xq = w0; *(u32x2*)(xq + 512) = w1; if (lane == 0) XS[m] = am; }
    }
}

#define XB_TMO      128
#define XB_XCNT(j)  (256  + 64 * (j))
#define XB_XSUB(j)  (1280 + 64 * (j))
#define XB_XGEN(j)  (2304 + 64 * (j))
#define XB_TOP      3328
#define XB_TOPGEN   3392
#define XCD_BAR_WORDS 3456
#define XB_SPIN_CAP (1u << 18)

__device__ __forceinline__ unsigned xb_ld(unsigned* p)              { return __hip_atomic_load(p, __ATOMIC_RELAXED, __HIP_MEMORY_SCOPE_AGENT); }
__device__ __forceinline__ unsigned xb_add(unsigned* p, unsigned v) { return __hip_atomic_fetch_add(p, v, __ATOMIC_RELAXED, __HIP_MEMORY_SCOPE_AGENT); }
__device__ __forceinline__ unsigned xb_xcc_id() { return (unsigned)__builtin_amdgcn_s_getreg((3 << 11) | 20) & 0xFu; }
#define XB_SPIN(cond, bar) do { unsigned _sp = 0; while (cond) { __builtin_amdgcn_s_sleep(1); \
    if ((++_sp & 255u) == 0u) { if (xb_ld(&(bar)[XB_TMO])) break; if (_sp > XB_SPIN_CAP) { atomicAdd(&(bar)[XB_TMO], 1u); break; } } } } while (0)

struct XcdBarrier {
    unsigned* bar; unsigned x;
    volatile LAS unsigned* st;
};

__device__ __forceinline__ XcdBarrier xcd_barrier_post(unsigned* bar, volatile LAS unsigned* st) {
    XcdBarrier b; b.bar = bar; b.x = xb_xcc_id(); b.st = st;
    if (threadIdx.x == 0) (void)xb_add(&bar[XB_XCNT(b.x)], 1u);
    return b;
}
__device__ __forceinline__ void xcd_barrier_complete(unsigned* bar, unsigned x, unsigned& nloc, unsigned& nx) {
    const unsigned G = gridDim.x * gridDim.y * gridDim.z;
    unsigned sum, cnt, mine, sp = 0u;
    for (;;) {
        sum = 0u; cnt = 0u; mine = 0u;
#pragma unroll
        for (unsigned j = 0; j < 16; ++j) { const unsigned c = xb_ld(&bar[XB_XCNT(j)]); sum += c; cnt += (c > 0u) ? 1u : 0u; mine = (j == x) ? c : mine; }
        if (sum == G) break;
        __builtin_amdgcn_s_sleep(1);
        if ((++sp & 255u) == 0u) { if (xb_ld(&bar[XB_TMO])) break; if (sp > XB_SPIN_CAP) { atomicAdd(&bar[XB_TMO], 1u); break; } }
    }
    nloc = mine > 0u ? mine : 1u; nx = cnt > 0u ? cnt : 1u;
}

__device__ __forceinline__ void xcd_barrier(const XcdBarrier& b) {
    asm volatile("s_waitcnt vmcnt(0)" ::: "memory");
    __syncthreads();
    if (threadIdx.x == 0) {
        unsigned* bar = b.bar;
        __builtin_amdgcn_s_waitcnt(0);
        unsigned nloc = b.st[0], nx = b.st[1];
        if (nloc == 0u) { xcd_barrier_complete(bar, b.x, nloc, nx); b.st[0] = nloc; b.st[1] = nx; }
        const unsigned old = xb_add(&bar[XB_XSUB(b.x)], 1u);
        const unsigned gen = old / nloc;
        if (old + 1u == (gen + 1u) * nloc) {
            __builtin_amdgcn_fence(__ATOMIC_RELEASE, "agent");
            asm volatile("s_waitcnt vmcnt(0)" ::: "memory");
            const unsigned og = xb_add(&bar[XB_TOP], 1u);
            const unsigned tg = og / nx;
            if (og + 1u == (tg + 1u) * nx) xb_add(&bar[XB_TOPGEN], 1u);
            else XB_SPIN(xb_ld(&bar[XB_TOPGEN]) == tg, bar);
            __builtin_amdgcn_fence(__ATOMIC_ACQUIRE, "agent");
            xb_add(&bar[XB_XGEN(b.x)], 1u);
            asm volatile("s_waitcnt vmcnt(0)" ::: "memory");
        } else {
            XB_SPIN(xb_ld(&bar[XB_XGEN(b.x)]) == gen, bar);
            __builtin_amdgcn_fence(__ATOMIC_ACQUIRE, "agent");
            asm volatile("s_waitcnt vmcnt(0)" ::: "memory");
        }
    }
    __syncthreads();
}

__global__ void __launch_bounds__(512, 2) fwd_kernel(Args a) {
    extern __shared__ __attribute__((aligned(16))) unsigned char lds_raw[];
    cg::grid_group grid = cg::this_grid();
    LAS unsigned char* lds = (LAS unsigned char*)lds_raw;
    const int G = gridDim.x, bx = blockIdx.x;
    const int vcu = (G % 8 == 0) ? (bx % 8) * (G / 8) + bx / 8 : bx;
    const int NGW = G * 8;
#define LAUNDER_TID int tid_l = threadIdx.x; asm volatile("" : "+v"(tid_l)); const int lane = tid_l & 63, wave = __builtin_amdgcn_readfirstlane(tid_l >> 6), gw = vcu * 8 + wave;
#define WSW(name, off) size_t name##_o = (off); asm volatile("" : "+s"(name##_o)); bf16* const name = (bf16*)(((l & 1) ? (unsigned char*)a.out : a.ws) + name##_o);
#define WSP(name, off) size_t name##_o = (off); asm volatile("" : "+s"(name##_o)); bf16* const name = (bf16*)(a.ws + name##_o);
    volatile LAS unsigned* MISC = (volatile LAS unsigned*)(lds + RING_BYTES + 256);
    if (threadIdx.x < 16) MISC[threadIdx.x] = 0u;
    unsigned* barw = (unsigned*)(a.ws + WS_CTL);
    if (bx == 0) for (int i = threadIdx.x; i < XCD_BAR_WORDS; i += 512) barw[i] = 0u;
    __syncthreads();
    { LAUNDER_TID
    for (int tk = gw; tk < 4 * 144 * 16; tk += NGW) { const int l4 = tk / (144 * 16), cg = (tk >> 4) % 144, kc = tk & 15, c = 64 * cg + lane;
        const int drow = win_dest_row(c), slot = drow >= 7168 ? -2 : pg8::p1_qslot(__builtin_amdgcn_readfirstlane(drow) >> 8);
        if (slot == -1) continue;
        const float* wp = a.in[2] + (size_t)l4 * DM * NIN + (size_t)(64 * kc) * NIN + c; float mx = 0.f;
#pragma unroll 16
        for (int kk = 0; kk < 64; ++kk) mx = fmaxf(mx, fabsf(wp[(size_t)kk * NIN]));
        unsigned* dst = slot == -2 ? (unsigned*)(a.ws + WS_CMAX) + l4 * 2048 + (drow - 7168) : (unsigned*)(a.ws + WS_CMAX1) + l4 * (pg8::P1_NQ * 256) + slot * 256 + (drow & 255);
        atomicMax(dst, __float_as_uint(mx)); }
    convert_layer(a, 0, lds, gw, NGW, lane, wave, false);
    { const float* x = a.in[0]; WSP(XH, WS_XH) unsigned char* XQ = (unsigned char*)a.out + OUT_XQ; float* XS = (float*)(a.ws + WS_XS);
      for (int m = gw; m < T; m += NGW) { const float* xr = x + (size_t)m * DM + lane * 8;
          const f32x4 v0 = *(const f32x4*)xr, v1 = *(const f32x4*)(xr + 4), v2 = *(const f32x4*)(xr + 512), v3 = *(const f32x4*)(xr + 516);
          bf16* xo = XH + (size_t)m * DM + lane * 8; *(u32x4*)xo = pg8::pack8h(v0, v1); *(u32x4*)(xo + 512) = pg8::pack8h(v2, v3);
          float am = fmaxf(fmaxf(fmaxf(fabsf(v0[0]), fabsf(v0[1])), fmaxf(fabsf(v0[2]), fabsf(v0[3]))), fmaxf(fmaxf(fabsf(v1[0]), fabsf(v1[1])), fmaxf(fabsf(v1[2]), fabsf(v1[3]))));
          am = fmaxf(am, fmaxf(fmaxf(fmaxf(fabsf(v2[0]), fabsf(v2[1])), fmaxf(fabsf(v2[2]), fabsf(v2[3]))), fmaxf(fmaxf(fabsf(v3[0]), fabsf(v3[1])), fmaxf(fabsf(v3[2]), fabsf(v3[3])))));
          am = wave_max(am); const float inv = am > 0.f ? 127.f / am : 0.f;
          unsigned char* xq = XQ + (size_t)m * DM + lane * 8;
          u32x2 w0, w1; w0.x = q4(v0[0], v0[1], v0[2], v0[3], inv); w0.y = q4(v1[0], v1[1], v1[2], v1[3], inv); w1.x = q4(v2[0], v2[1], v2[2], v2[3], inv); w1.y = q4(v3[0], v3[1], v3[2], v3[3], inv);
          *(u32x2*)xq = w0; *(u32x2*)(xq + 512) = w1; if (lane == 0) XS[m] = am; } } }
    grid.sync();
    const XcdBarrier xbar = xcd_barrier_post(barw, MISC + 8);
#define GRID_SYNC() xcd_barrier(xbar)
#pragma unroll 1
    for (int l = 0; l < DEPTH; ++l) {
#ifndef SKIP_P1
        if (l == 0) { LAUNDER_TID
            LAS float* scr = (LAS float*)(lds + wave * 8704);
            for (int it = gw; it < 16 * (NIN / 32); it += NGW) win_item(a, 0, a.ws, it / (NIN / 32), it % (NIN / 32), 1, scr, lane);
            GRID_SYNC(); }
        { WSP(XH, WS_XH) WSW(WinT, WS_WIN) WSP(UGQ, WS_UGQ) WSP(Vb, WS_V) WSP(Kb, WS_K) WSP(VBb, WS_VB) WSP(GBb, WS_GB)
          { pg8::Gemm g{XH, WinT + (size_t)(pg8::P1_F0 * 256) * DM, T, pg8::P1_NF * 256, DM, DM}; pg8::StaticOrder S; S.init(T, pg8::P1_NF * 256, G, bx);
            pg8::Epi1<false> E{UGQ, Vb, Kb, VBb, GBb, QSCALE, nullptr, nullptr};
            pg8::gemm_phase<pg8::Epi1<false>, pg8::StaticOrder, true, true, 1>(lds, g, S, E); }
          { const bf16* XQ = (const bf16*)((const unsigned char*)a.out + OUT_XQ);
            pg8::Gemm g{XQ, WinT, T, pg8::P1_NQ * 256, 512, 512}; pg8::StaticOrder S; S.init(T, pg8::P1_NQ * 256, G, bx);
            pg8::Epi1<true> E{UGQ, Vb, Kb, VBb, GBb, QSCALE, (const float*)(a.ws + WS_XS), (const float*)(a.ws + WS_CMAX1) + l * (pg8::P1_NQ * 256)};
            pg8::gemm_phase<pg8::Epi1<true>, pg8::StaticOrder, true, true, 2>(lds, g, S, E); }
        }
#endif
        GRID_SYNC();
        { WSP(UGQ, WS_UGQ) WSP(Vb, WS_V) WSW(WsB, WS_WS) WSP(Kb, WS_K) WSP(VBb, WS_VB) WSP(GBb, WS_GB)
#pragma unroll 1
        for (int st = 0; st < 2; ++st) {
            if (((st ^ vcu) & 1) == 0) {
#ifndef SKIP_BA
                for (int c = vcu; c < T / 128; c += G)
                    brancha_unit(c, UGQ, Vb, WsB, a.in[3] + l * DM, a.in[4] + l * DM, a.in[6] + l * 8 * 128, lds);
#endif
            } else {
#ifndef SKIP_AT
#pragma unroll 1
                for (int pu2 = 2 * vcu; pu2 < 128 * 16; pu2 += 2 * G) {
#pragma unroll 1
                    for (int j2 = 0; j2 < 2; ++j2) {
                        const int pu = pu2 >> 1, bh = pu >> 3, s = pu & 7;
                        attn_unit(bh >> 4, bh & 15, j2 ? s : 15 - s, UGQ, Kb, VBb, GBb, lds);
                    }
                }
#endif
            }
        }
        if (l + 1 < DEPTH) { __syncthreads(); LAUNDER_TID convert_layer(a, l + 1, lds, gw, NGW, lane, wave); }
        }
        GRID_SYNC();
#ifndef SKIP_P25
        { WSW(WinT, WS_WIN) WSP(SMA, WS_K) WSP(SMB, WS_VB)
          const bf16* XQ = (const bf16*)((const unsigned char*)a.out + OUT_XQ);
          pg8::Gemm g{XQ, WinT + (size_t)7168 * DM, T, 2048, 512, 512}; pg8::GateOrder S; S.init(T, G, bx);
          pg8::EpiGateQ E{SMA, SMB, (const float*)(a.ws + WS_XS), (const float*)(a.ws + WS_CMAX) + l * 2048};
          pg8::gemm_phase<pg8::EpiGateQ, pg8::GateOrder, true, true, 2>(lds, g, S, E); }
        { WSW(PB, WS_PB) WSW(WeT, WS_WE) WSP(EB, WS_GB)
          int kp = PLE; asm volatile("" : "+s"(kp));
          pg8::Gemm g{PB, WeT, T, DM, kp, kp}; pg8::StaticOrder S; S.init(T, DM, G, bx);
          pg8::EpiStore<0> E{EB, EB};
          pg8::gemm_phase<pg8::EpiStore<0>, pg8::StaticOrder, true, true>(lds, g, S, E); }
#endif
#ifndef SKIP_P3
        { WSP(UGQ, WS_UGQ) WSW(W2T, WS_W2) WSP(SMA, WS_K) WSP(SMB, WS_VB) WSP(MERGED, WS_V)
          pg8::Gemm g{UGQ, W2T, T, DM, 2048, 2048}; pg8::StaticOrder S; S.init(T, DM, G, bx);
          pg8::Epi2 E{SMA, SMB, MERGED};
          pg8::gemm_phase<pg8::Epi2, pg8::StaticOrder, true, true>(lds, g, S, E);
#ifdef PROBE_DUP_P3
          pg8::gemm_phase<pg8::Epi2, pg8::StaticOrder, true, true>(lds, g, S, E);
#endif
        }
#endif
        GRID_SYNC();
#ifndef SKIP_P4
        { WSP(MERGED, WS_V) WSW(WoT, WS_WO) WSP(XH1, WS_XH1) WSP(XH, WS_XH)
          pg8::Gemm g{MERGED, WoT, T, DM, DM, DM}; pg8::StaticOrder S; S.init(T, DM, G, bx);
          pg8::Epi3 E{XH, XH1, ALPHA};
          pg8::gemm_phase<pg8::Epi3, pg8::StaticOrder, true, true>(lds, g, S, E); }
#endif
        GRID_SYNC();
#ifndef SKIP_P5
        { WSP(XH1, WS_XH1) WSW(WgT, WS_WG) WSP(EB, WS_GB) WSP(XH, WS_XH)
          pg8::Gemm g{XH1, WgT, T, DM, DM, DM}; pg8::StaticOrder S; S.init(T, DM, G, bx);
          pg8::Epi4 E{XH1, XH, EB};
          pg8::gemm_phase<pg8::Epi4, pg8::StaticOrder, true, true, true>(lds, g, S, E); }
#endif
        GRID_SYNC();
#ifdef PROBE_SYNC
        for (int z = 0; z < 10; ++z) GRID_SYNC();
#endif
        LAUNDER_TID WSP(XH, WS_XH)
        ln_rows(XH, (unsigned char*)a.out + OUT_XQ, (float*)(a.ws + WS_XS), a.out, a.in[12] + l * DM, a.in[13] + l * DM, l + 1 == DEPTH, gw, NGW, lane);
        if (l + 1 < DEPTH) GRID_SYNC();
    }
}

extern "C" void kernel_launch(void* const* d_in, const int* in_sizes, int n_in, void* d_out, int out_size, void* d_ws, size_t ws_size, hipStream_t stream) {
    static int grid = 0;
    if (grid == 0) {
        if (n_in != 14 || out_size != T * DM || ws_size < WS_END) { fprintf(stderr, "kernel_launch: unexpected shapes (n_in %d out %d ws %zu)\n", n_in, out_size, ws_size); grid = -1; return; }
        int dev = 0, cus = 0, per_cu = 0;
        hipGetDevice(&dev); hipDeviceGetAttribute(&cus, hipDeviceAttributeMultiprocessorCount, dev);
        hipFuncSetAttribute((const void*)fwd_kernel, hipFuncAttributeMaxDynamicSharedMemorySize, LDS_BYTES);
        hipOccupancyMaxActiveBlocksPerMultiprocessor(&per_cu, (const void*)fwd_kernel, 512, LDS_BYTES);
        if (per_cu < 1) per_cu = 1;
        grid = cus;
        (void)hipGetLastError();
    }
    if (grid < 0) return;
    Args a{};
    for (int i = 0; i < 14; ++i) a.in[i] = (const float*)d_in[i];
    a.out = (float*)d_out; a.ws = (unsigned char*)d_ws;
    hipMemsetAsync((char*)d_ws + WS_CMAX, 0, 4 * (2048 + pg8::P1_NQ * 256) * sizeof(float), stream);
    void* args[] = {&a};
    hipError_t e = hipLaunchCooperativeKernel((const void*)fwd_kernel, dim3(grid), dim3(512), args, LDS_BYTES, stream);
    if (e != hipSuccess) fprintf(stderr, "cooperative launch failed: %s (grid %d)\n", hipGetErrorString(e), grid);
}
```

```cpp
#include <hip/hip_runtime.h>
#include <hip/hip_cooperative_groups.h>
#include <cstdio>
#include <cstdint>
namespace cg = cooperative_groups;
namespace pg8 {
#define PG8_LAS __attribute__((address_space(3)))
typedef unsigned short bf16_t;
typedef short bf16x8 __attribute__((ext_vector_type(8)));
typedef _Float16 f16x8 __attribute__((ext_vector_type(8)));
typedef int i32x4 __attribute__((ext_vector_type(4)));
typedef float f32x4 __attribute__((ext_vector_type(4)));
typedef unsigned u32x4 __attribute__((ext_vector_type(4)));
constexpr int BM = 256, BK = 64, HALF = 128, HTB = HALF * BK * 2  , STAGE_BYTES = 8 * HTB, NXCD = 8, WGM = 8;

__host__ __device__ __forceinline__ int lds_byte(int r, int c) { const int st = (r >> 4) * 2 + (c >> 5), rr = r & 15, cc = c & 31, ob = rr * 64 + cc * 2; return st * 1024 + (ob ^ (((ob >> 9) & 1) << 5)); }
__host__ __device__ __forceinline__ void stage_rc(int b, int& R, int& C) { const int st = b / 1024, sb = b % 1024, swz = sb ^ (((sb >> 9) & 1) << 5); R = (st >> 1) * 16 + swz / 64; C = (st & 1) * 32 + (swz % 64) / 2; }
__host__ __device__ __forceinline__ int perm32(int rho) { const int n = rho >> 4, i = rho & 15; return 8 * (i >> 2) + 4 * n + (i & 3); }

struct Unit { int pm, pn; };
struct Gemm { const bf16_t* A; const bf16_t* Bt; int M, N, K, lda; };

struct StaticOrder {
    int nM, nN, nwg, G, c;
    __host__ __device__ void init(int M, int N, int G_, int c_) { nM = M / BM; nN = N / BM; nwg = nM * nN; G = G_; c = c_; }
    __host__ __device__ bool next(int i, Unit& u) const {
        const long L = (long)i * G + c; if (L >= nwg) return false;
        int wgid = (int)L; { const int q = nwg / NXCD, r = nwg % NXCD, xcd = wgid % NXCD, off = wgid / NXCD; wgid = (xcd < r ? xcd * (q + 1) : r * (q + 1) + (xcd - r) * q) + off; }
        const int nig = WGM * nN, gid = wgid / nig, fm = gid * WGM, gsz = (nM - fm) < WGM ? (nM - fm) : WGM;
        u.pm = fm + ((wgid % nig) % gsz); u.pn = (wgid % nig) / gsz; return true;
    }
    __device__ __forceinline__ void a_ready(const Unit&) const {}
    __device__ __forceinline__ void done(const Unit&) const {}
};
struct GateOrder {
    StaticOrder inner;
    __host__ __device__ void init(int M, int G_, int c_) { inner.init(M, 1024, G_, c_); }
    __host__ __device__ bool next(int i, Unit& u) const { Unit v; if (!inner.next(i >> 1, v)) return false; u.pm = v.pm; u.pn = 2 * v.pn + (i & 1); return true; }
    __device__ __forceinline__ void a_ready(const Unit&) const {}
    __device__ __forceinline__ void done(const Unit&) const {}
};


typedef float f32x2_t __attribute__((ext_vector_type(2))); typedef __bf16 bf16x2_t __attribute__((ext_vector_type(2)));
__device__ __forceinline__ unsigned cvt_pk_bf16(float lo, float hi) { f32x2_t v = {lo, hi}; bf16x2_t b = __builtin_convertvector(v, bf16x2_t); return __builtin_bit_cast(unsigned, b); }
__device__ __forceinline__ float sigm(float x) { return __builtin_amdgcn_rcpf(1.f + __builtin_amdgcn_exp2f(-1.4426950408889634f * x)); }
__device__ __forceinline__ u32x4 pack8(const f32x4 a, const f32x4 b) { u32x4 w; w.x = cvt_pk_bf16(a[0], a[1]); w.y = cvt_pk_bf16(a[2], a[3]); w.z = cvt_pk_bf16(b[0], b[1]); w.w = cvt_pk_bf16(b[2], b[3]); return w; }
__device__ __forceinline__ void unpack8(const u32x4 w, f32x4& a, f32x4& b) {
    a[0] = __uint_as_float(w.x << 16); a[1] = __uint_as_float(w.x & 0xffff0000u); a[2] = __uint_as_float(w.y << 16); a[3] = __uint_as_float(w.y & 0xffff0000u);
    b[0] = __uint_as_float(w.z << 16); b[1] = __uint_as_float(w.z & 0xffff0000u); b[2] = __uint_as_float(w.w << 16); b[3] = __uint_as_float(w.w & 0xffff0000u); }
typedef _Float16 f16x2_t __attribute__((ext_vector_type(2)));
__device__ __forceinline__ unsigned cvt_pk_f16(float lo, float hi) { f32x2_t v = {lo, hi}; f16x2_t h = __builtin_convertvector(v, f16x2_t); return __builtin_bit_cast(unsigned, h); }
__device__ __forceinline__ u32x4 pack8h(const f32x4 a, const f32x4 b) { u32x4 w; w.x = cvt_pk_f16(a[0], a[1]); w.y = cvt_pk_f16(a[2], a[3]); w.z = cvt_pk_f16(b[0], b[1]); w.w = cvt_pk_f16(b[2], b[3]); return w; }
__device__ __forceinline__ void unpack8h(const u32x4 w, f32x4& a, f32x4& b) {
    const unsigned x0 = w.x, x1 = w.y, x2 = w.z, x3 = w.w;
    const f32x2_t p0 = __builtin_convertvector(__builtin_bit_cast(f16x2_t, x0), f32x2_t), p1 = __builtin_convertvector(__builtin_bit_cast(f16x2_t, x1), f32x2_t);
    const f32x2_t p2 = __builtin_convertvector(__builtin_bit_cast(f16x2_t, x2), f32x2_t), p3 = __builtin_convertvector(__builtin_bit_cast(f16x2_t, x3), f32x2_t);
    a[0] = p0[0]; a[1] = p0[1]; a[2] = p1[0]; a[3] = p1[1]; b[0] = p2[0]; b[1] = p2[1]; b[2] = p3[0]; b[3] = p3[1]; }
#define PG8_FENCE asm volatile("" ::: "memory")

#ifndef P1_ALL_INT8
#define P1_ALL_INT8 1
#endif
#if P1_ALL_INT8
constexpr int P1_NQ = 28, P1_F0 = 28, P1_NF = 0;
__host__ __device__ constexpr int p1_qtile(int j) { return j; }
__host__ __device__ constexpr int p1_qslot(int tile) { return tile < 28 ? tile : -1; }
#else
constexpr int P1_NQ = 20, P1_F0 = 12, P1_NF = 8;
__host__ __device__ constexpr int p1_qtile(int j) { return j < 12 ? j : 20 + (j - 12); }
__host__ __device__ constexpr int p1_qslot(int tile) { return tile < 12 ? tile : (tile >= 20 && tile < 28 ? 12 + (tile - 20) : -1); }
#endif
template <bool Q> struct Epi1 {
    static constexpr bool PERM = true, AFTER_DRAIN = false, HAS_MID = false;
    bf16_t *UGQ, *V, *K, *VB, *GB; float qscale; const float* XS; const float* CS;
    __device__ __forceinline__ static f32x4 val(const f32x4 a, float rs, const f32x4 cs) {
        if constexpr (Q) { const i32x4 q = __builtin_bit_cast(i32x4, a); return (f32x4){(float)q[0], (float)q[1], (float)q[2], (float)q[3]} * (cs * rs); } else return a; }
    __device__ __forceinline__ void operator()(const f32x4 (&acc)[2][2][4][2], const Unit& u, int wr, int wc, int fr, int fq) const {
        asm volatile("" : "+v"(fr), "+v"(fq));
        const int row0 = u.pm * BM + wr * 64 + fr, cw = wc * 32 + 8 * fq;
        const int pn = Q ? p1_qtile(u.pn) : u.pn + P1_F0;
        float rsc[2][4]; f32x4 cs[2][2];
#pragma unroll
        for (int ai = 0; ai < 2; ++ai)
#pragma unroll
            for (int m = 0; m < 4; ++m) rsc[ai][m] = Q ? XS[row0 + ai * HALF + m * 16] * (1.f / (127.f * 127.f)) : 1.f;
#pragma unroll
        for (int bj = 0; bj < 2; ++bj)
#pragma unroll
            for (int n = 0; n < 2; ++n) cs[bj][n] = Q ? *(const f32x4*)(CS + u.pn * BM + bj * HALF + cw + 4 * n) : (f32x4){1.f, 1.f, 1.f, 1.f};
        if (pn < 8) {
            bf16_t* base = UGQ + pn * 128 + cw;
#pragma unroll
            for (int ai = 0; ai < 2; ++ai)
#pragma unroll
                for (int m = 0; m < 4; ++m) {
                    f32x4 u0 = val(acc[ai][0][m][0], rsc[ai][m], cs[0][0]), u1 = val(acc[ai][0][m][1], rsc[ai][m], cs[0][1]);
                    const f32x4 g0 = val(acc[ai][1][m][0], rsc[ai][m], cs[1][0]), g1 = val(acc[ai][1][m][1], rsc[ai][m], cs[1][1]);
#pragma unroll
                    for (int e = 0; e < 4; ++e) { u0[e] *= g0[e] * sigm(g0[e]); u1[e] *= g1[e] * sigm(g1[e]); }
                    __builtin_nontemporal_store(pack8(u0, u1), (u32x4*)(base + (size_t)(row0 + ai * HALF + m * 16) * 2048));
                }
        } else {
            const int seg = (pn - 8) >> 2, ct = (pn - 8) & 3;
            bf16_t* base; int ldc = 1024; float sc = 1.f;
            if (seg == 0) base = V; else if (seg == 1) { base = UGQ + 1024; ldc = 2048; sc = qscale; } else if (seg == 2) base = K; else if (seg == 3) base = VB; else base = GB;
            base += ct * 256 + cw;
#pragma unroll
            for (int ai = 0; ai < 2; ++ai)
#pragma unroll
                for (int m = 0; m < 4; ++m) { bf16_t* rowp = base + (size_t)(row0 + ai * HALF + m * 16) * ldc;
#pragma unroll
                    for (int bj = 0; bj < 2; ++bj) __builtin_nontemporal_store(pack8(val(acc[ai][bj][m][0], rsc[ai][m], cs[bj][0]) * sc, val(acc[ai][bj][m][1], rsc[ai][m], cs[bj][1]) * sc), (u32x4*)(rowp + bj * HALF)); }
        }
    }
};
template <int SIG> struct EpiStore {
    static constexpr bool PERM = true, AFTER_DRAIN = false, HAS_MID = false;
    bf16_t *D0, *D1;
    __device__ __forceinline__ void operator()(const f32x4 (&acc)[2][2][4][2], const Unit& u, int wr, int wc, int fr, int fq) const {
        asm volatile("" : "+v"(fr), "+v"(fq));
        const int row0 = u.pm * BM + wr * 64 + fr, cw = wc * 32 + 8 * fq;
        bf16_t* base = (u.pn < 4 ? D0 : D1) + (u.pn & 3) * 256 + cw;
#pragma unroll
        for (int ai = 0; ai < 2; ++ai)
#pragma unroll
            for (int m = 0; m < 4; ++m) { bf16_t* rowp = base + (size_t)(row0 + ai * HALF + m * 16) * 1024;
#pragma unroll
                for (int bj = 0; bj < 2; ++bj) { f32x4 v0 = acc[ai][bj][m][0], v1 = acc[ai][bj][m][1];
                    if (SIG) {
#pragma unroll
                        for (int e = 0; e < 4; ++e) { v0[e] = sigm(v0[e]); v1[e] = sigm(v1[e]); } }
                    __builtin_nontemporal_store(pack8(v0, v1), (u32x4*)(rowp + bj * HALF)); } }
    }
};
struct EpiGate {
    static constexpr bool PERM = true, AFTER_DRAIN = false, HAS_MID = false;
    bf16_t *RHO, *SMB;
    __device__ __forceinline__ void operator()(const f32x4 (&acc)[2][2][4][2], const Unit& u, int wr, int wc, int fr, int fq) const {
        asm volatile("" : "+v"(fr), "+v"(fq));
        const int row0 = u.pm * BM + wr * 64 + fr, c0 = u.pn * 128 + wc * 32 + 8 * fq;
#pragma unroll
        for (int ai = 0; ai < 2; ++ai)
#pragma unroll
            for (int m = 0; m < 4; ++m) { const size_t off = (size_t)(row0 + ai * HALF + m * 16) * 1024 + c0;
                f32x4 r0, r1, s0, s1;
#pragma unroll
                for (int e = 0; e < 4; ++e) {
                    const float ea0 = __builtin_amdgcn_exp2f(fminf(-1.4426950408889634f * acc[ai][0][m][0][e], 80.f)), eb0 = __builtin_amdgcn_exp2f(fminf(-1.4426950408889634f * acc[ai][1][m][0][e], 80.f));
                    const float ea1 = __builtin_amdgcn_exp2f(fminf(-1.4426950408889634f * acc[ai][0][m][1][e], 80.f)), eb1 = __builtin_amdgcn_exp2f(fminf(-1.4426950408889634f * acc[ai][1][m][1][e], 80.f));
                    r0[e] = (1.f + eb0) * __builtin_amdgcn_rcpf(1.f + ea0); r1[e] = (1.f + eb1) * __builtin_amdgcn_rcpf(1.f + ea1);
                    s0[e] = __builtin_amdgcn_rcpf(1.f + eb0); s1[e] = __builtin_amdgcn_rcpf(1.f + eb1); }
                *(u32x4*)(RHO + off) = pack8(r0, r1); *(u32x4*)(SMB + off) = pack8(s0, s1); }
    }
};
struct EpiGateQ {
    static constexpr bool PERM = true, AFTER_DRAIN = false, HAS_MID = false;
    bf16_t *RHO, *SMB; const float* XS; const float* CS;
    __device__ __forceinline__ void operator()(const f32x4 (&acc)[2][2][4][2], const Unit& u, int wr, int wc, int fr, int fq) const {
        asm volatile("" : "+v"(fr), "+v"(fq));
        const int row0 = u.pm * BM + wr * 64 + fr, c0 = u.pn * 128 + wc * 32 + 8 * fq;
        float rsc[2][4]; f32x4 cs[2][2];
#pragma unroll
        for (int ai = 0; ai < 2; ++ai)
#pragma unroll
            for (int m = 0; m < 4; ++m) rsc[ai][m] = XS[row0 + ai * HALF + m * 16] * (1.f / (127.f * 127.f));
#pragma unroll
        for (int bj = 0; bj < 2; ++bj) { const int ci = u.pn * BM + bj * HALF + wc * 32 + 8 * fq; cs[bj][0] = *(const f32x4*)(CS + ci); cs[bj][1] = *(const f32x4*)(CS + ci + 4); }
#pragma unroll
        for (int ai = 0; ai < 2; ++ai)
#pragma unroll
            for (int m = 0; m < 4; ++m) { const size_t off = (size_t)(row0 + ai * HALF + m * 16) * 1024 + c0;
                f32x4 r0, r1, s0, s1;
#pragma unroll
                for (int e = 0; e < 4; ++e) {
                    const i32x4 qa0 = __builtin_bit_cast(i32x4, acc[ai][0][m][0]), qa1 = __builtin_bit_cast(i32x4, acc[ai][0][m][1]), qb0 = __builtin_bit_cast(i32x4, acc[ai][1][m][0]), qb1 = __builtin_bit_cast(i32x4, acc[ai][1][m][1]);
                    const float ma0 = (float)qa0[e] * (rsc[ai][m] * cs[0][0][e]), ma1 = (float)qa1[e] * (rsc[ai][m] * cs[0][1][e]);
                    const float mb0 = (float)qb0[e] * (rsc[ai][m] * cs[1][0][e]), mb1 = (float)qb1[e] * (rsc[ai][m] * cs[1][1][e]);
                    const float ea0 = __builtin_amdgcn_exp2f(fminf(-1.4426950408889634f * ma0, 80.f)), eb0 = __builtin_amdgcn_exp2f(fminf(-1.4426950408889634f * mb0, 80.f));
                    const float ea1 = __builtin_amdgcn_exp2f(fminf(-1.4426950408889634f * ma1, 80.f)), eb1 = __builtin_amdgcn_exp2f(fminf(-1.4426950408889634f * mb1, 80.f));
                    r0[e] = (1.f + eb0) * __builtin_amdgcn_rcpf(1.f + ea0); r1[e] = (1.f + eb1) * __builtin_amdgcn_rcpf(1.f + ea1);
                    s0[e] = __builtin_amdgcn_rcpf(1.f + eb0); s1[e] = __builtin_amdgcn_rcpf(1.f + eb1); }
                *(u32x4*)(RHO + off) = pack8(r0, r1); *(u32x4*)(SMB + off) = pack8(s0, s1); }
    }
};
struct Epi2 {
    static constexpr bool PERM = true, AFTER_DRAIN = false, HAS_MID = true;
    const bf16_t *SMA, *SMB; bf16_t* OUT;
    __device__ __forceinline__ void mid(f32x4 (&acc)[2][2][4][2], const Unit& u, int wr, int wc, int fr, int fq) const {
        asm volatile("" : "+v"(fr), "+v"(fq));
        const int row0 = u.pm * BM + wr * 64 + fr, c0 = u.pn * BM + wc * 32 + 8 * fq;
#pragma unroll
        for (int ai = 0; ai < 2; ++ai) {
            u32x4 wa[4][2];
#pragma unroll
            for (int m = 0; m < 4; ++m) { const size_t off = (size_t)(row0 + ai * HALF + m * 16) * 1024 + c0;
#pragma unroll
                for (int bj = 0; bj < 2; ++bj) wa[m][bj] = *(const u32x4*)(SMA + off + bj * HALF); }
            PG8_FENCE;
#pragma unroll
            for (int m = 0; m < 4; ++m)
#pragma unroll
                for (int bj = 0; bj < 2; ++bj) { f32x4 a0, a1; unpack8(wa[m][bj], a0, a1); acc[ai][bj][m][0] *= a0; acc[ai][bj][m][1] *= a1; }
            PG8_FENCE; }
    }
    __device__ __forceinline__ void operator()(const f32x4 (&acc)[2][2][4][2], const Unit& u, int wr, int wc, int fr, int fq) const {
        asm volatile("" : "+v"(fr), "+v"(fq));
        const int row0 = u.pm * BM + wr * 64 + fr, c0 = u.pn * BM + wc * 32 + 8 * fq;
        u32x4 wb[2][4][2];
#pragma unroll
        for (int ai = 0; ai < 2; ++ai)
#pragma unroll
            for (int m = 0; m < 4; ++m) { const size_t off = (size_t)(row0 + ai * HALF + m * 16) * 1024 + c0;
#pragma unroll
                for (int bj = 0; bj < 2; ++bj) wb[ai][m][bj] = *(const u32x4*)(SMB + off + bj * HALF); }
        PG8_FENCE;
#pragma unroll
        for (int ai = 0; ai < 2; ++ai)
#pragma unroll
            for (int m = 0; m < 4; ++m) { const size_t off = (size_t)(row0 + ai * HALF + m * 16) * 1024 + c0;
#pragma unroll
                for (int bj = 0; bj < 2; ++bj) { f32x4 b0, b1; unpack8(wb[ai][m][bj], b0, b1);
                    *(u32x4*)(OUT + off + bj * HALF) = pack8(acc[ai][bj][m][0] * b0, acc[ai][bj][m][1] * b1); } }
    }
};
struct Epi3 {
    static constexpr bool PERM = true, AFTER_DRAIN = false, HAS_MID = false;
    const bf16_t* XH; bf16_t* XO; float alpha;
    __device__ __forceinline__ void operator()(const f32x4 (&acc)[2][2][4][2], const Unit& u, int wr, int wc, int fr, int fq) const {
        asm volatile("" : "+v"(fr), "+v"(fq));
        const int row0 = u.pm * BM + wr * 64 + fr, c0 = u.pn * BM + wc * 32 + 8 * fq;
#pragma unroll
        for (int ai = 0; ai < 2; ++ai) {
            u32x4 wx[4][2];
#pragma unroll
            for (int m = 0; m < 4; ++m) { const size_t off = (size_t)(row0 + ai * HALF + m * 16) * 1024 + c0;
#pragma unroll
                for (int bj = 0; bj < 2; ++bj) wx[m][bj] = *(const u32x4*)(XH + off + bj * HALF); }
            PG8_FENCE;
#pragma unroll
            for (int m = 0; m < 4; ++m) { const size_t off = (size_t)(row0 + ai * HALF + m * 16) * 1024 + c0;
#pragma unroll
                for (int bj = 0; bj < 2; ++bj) { f32x4 r0, r1; unpack8h(wx[m][bj], r0, r1);
                    const f32x4 h0 = r0 * alpha + acc[ai][bj][m][0], h1 = r1 * alpha + acc[ai][bj][m][1];
                    *(u32x4*)(XO + off + bj * HALF) = pack8h(h0, h1); } }
            PG8_FENCE; }
    }
};
struct Epi4 {
    static constexpr bool PERM = true, AFTER_DRAIN = false, HAS_MID = false;
    const bf16_t* H0; bf16_t* XO; const bf16_t* E;
    __device__ __forceinline__ void operator()(const f32x4 (&acc)[2][2][4][2], const Unit& u, int wr, int wc, int fr, int fq) const {
        asm volatile("" : "+v"(fr), "+v"(fq));
        const int row0 = u.pm * BM + wr * 64 + fr, c0 = u.pn * BM + wc * 32 + 8 * fq;
#pragma unroll
        for (int ai = 0; ai < 2; ++ai) {
            u32x4 wx[4][2], we[4][2];
#pragma unroll
            for (int m = 0; m < 4; ++m) { const size_t off = (size_t)(row0 + ai * HALF + m * 16) * 1024 + c0;
#pragma unroll
                for (int bj = 0; bj < 2; ++bj) { wx[m][bj] = *(const u32x4*)(H0 + off + bj * HALF); we[m][bj] = *(const u32x4*)(E + off + bj * HALF); } }
            PG8_FENCE;
#pragma unroll
            for (int m = 0; m < 4; ++m) { const size_t off = (size_t)(row0 + ai * HALF + m * 16) * 1024 + c0;
#pragma unroll
                for (int bj = 0; bj < 2; ++bj) { f32x4 h0, h1, e0, e1; unpack8h(wx[m][bj], h0, h1); unpack8(we[m][bj], e0, e1);
#pragma unroll
                    for (int e = 0; e < 4; ++e) { h0[e] += e0[e] * sigm(acc[ai][bj][m][0][e]); h1[e] += e1[e] * sigm(acc[ai][bj][m][1][e]); }
                    *(u32x4*)(XO + off + bj * HALF) = pack8h(h0, h1); } }
            PG8_FENCE; }
    }
};
template <class Epi, class Sched, bool ALIGN_EPI = false, bool SP2 = false, int MODE = 0>
__device__ __forceinline__ void gemm_phase(PG8_LAS unsigned char* lds, const Gemm g, const Sched& S, const Epi& E) {
    int tid_ = threadIdx.x; asm volatile("" : "+v"(tid_));
    const int tid = tid_, wid = __builtin_amdgcn_readfirstlane(tid >> 6), lane = tid & 63, wr = wid >> 2, wc = wid & 3, fr = lane & 15, fq = lane >> 4;
    const int K = g.K, nt = K / BK;
    unsigned voffA[2], voffB[2];
#pragma unroll
    for (int i = 0; i < 2; ++i) { int R, C; stage_rc(tid * 16 + i * 8192, R, C); const int Rb = Epi::PERM ? ((R & ~31) + perm32(R & 31)) : R;
        voffA[i] = (unsigned)(R * g.lda + C) * 2u; voffB[i] = (unsigned)(Rb * K + C) * 2u; }
    const size_t kstep = (size_t)(BK * 2);
    const size_t hstepA = (size_t)HALF * g.lda * 2, hstepB = (size_t)HALF * K * 2;
    const size_t tstepA = 2 * hstepA, tstepB = 2 * hstepB;
    const unsigned ldsw = (unsigned)wid * 1024u;
    const int aoff = lds_byte(wr * 64 + fr, fq * 8), boff = lds_byte(wc * 32 + fr, fq * 8);
#define PG8_SA(b, h) (((b) * 2 + (h)) * HTB)
#define PG8_SB(b, h) ((4 + (b) * 2 + (h)) * HTB)
#define PG8_STAGE(bufoff, gbase, voff) do { _Pragma("unroll") for (int _i = 0; _i < 2; ++_i) \
        __builtin_amdgcn_global_load_lds((const unsigned*)((const char*)(gbase) + (voff)[_i]), (PG8_LAS unsigned*)(lds + (bufoff) + ldsw + _i * 8192), 16, 0, 0); } while (0)
#define PG8_LDA(dst, b, h) do { _Pragma("unroll") for (int m = 0; m < 4; ++m) _Pragma("unroll") for (int k = 0; k < 2; ++k) dst[m][k] = *(const PG8_LAS bf16x8*)(lds + PG8_SA(b, h) + aoff + m * 2048 + k * 1024); } while (0)
#define PG8_LDB(dst, b, h) do { _Pragma("unroll") for (int n = 0; n < 2; ++n) _Pragma("unroll") for (int k = 0; k < 2; ++k) dst[n][k] = *(const PG8_LAS bf16x8*)(lds + PG8_SB(b, h) + boff + n * 2048 + k * 1024); } while (0)
#define PG8_MMA(ai, bj, At, Bt) do { __builtin_amdgcn_s_setprio(1); _Pragma("unroll") for (int m = 0; m < 4; ++m) _Pragma("unroll") for (int n = 0; n < 2; ++n) _Pragma("unroll") for (int k = 0; k < 2; ++k) \
        { if constexpr (MODE == 2) acc[ai][bj][m][n] = __builtin_bit_cast(f32x4, __builtin_amdgcn_mfma_i32_16x16x64_i8(__builtin_bit_cast(i32x4, Bt[n][k]), __builtin_bit_cast(i32x4, At[m][k]), __builtin_bit_cast(i32x4, acc[ai][bj][m][n]), 0, 0, 0)); \
          else if constexpr (MODE == 1) acc[ai][bj][m][n] = __builtin_amdgcn_mfma_f32_16x16x32_f16(__builtin_bit_cast(f16x8, Bt[n][k]), __builtin_bit_cast(f16x8, At[m][k]), acc[ai][bj][m][n], 0, 0, 0); \
          else acc[ai][bj][m][n] = __builtin_amdgcn_mfma_f32_16x16x32_bf16(Bt[n][k], At[m][k], acc[ai][bj][m][n], 0, 0, 0); } __builtin_amdgcn_s_setprio(0); } while (0)
#define PG8_WAIT_V(n) asm volatile("s_waitcnt vmcnt(" #n ")" ::: "memory")
#define PG8_WAIT_L(n) asm volatile("s_waitcnt lgkmcnt(" #n ")" ::: "memory")
#define PG8_BAR __builtin_amdgcn_s_barrier()
#define PG8_SCHED __builtin_amdgcn_sched_barrier(0)
    Unit cur, nxt; int ui = 0;
    if (!S.next(0, cur)) return;
    f32x4 acc[2][2][4][2];
#pragma unroll
    for (int a = 0; a < 2; ++a)
#pragma unroll
        for (int b = 0; b < 2; ++b)
#pragma unroll
            for (int m = 0; m < 4; ++m)
#pragma unroll
                for (int n = 0; n < 2; ++n) acc[a][b][m][n] = (f32x4){0.f, 0.f, 0.f, 0.f};
    bf16x8 At[4][2], B0[2][2], B1[2][2];
    const char* cA = (const char*)g.A + (size_t)cur.pm * tstepA; const char* cB = (const char*)g.Bt + (size_t)cur.pn * tstepB;
    S.a_ready(cur);
    if constexpr (SP2) {
        PG8_STAGE(PG8_SB(0, 0), cB, voffB); PG8_STAGE(PG8_SB(0, 1), cB + hstepB, voffB); PG8_STAGE(PG8_SA(0, 0), cA, voffA); PG8_STAGE(PG8_SA(0, 1), cA + hstepA, voffA);
        if (wr == 1) PG8_BAR;
        PG8_WAIT_V(2); PG8_BAR;
        PG8_STAGE(PG8_SB(1, 0), cB + kstep, voffB); PG8_STAGE(PG8_SA(1, 0), cA + kstep, voffA); PG8_STAGE(PG8_SB(1, 1), cB + hstepB + kstep, voffB);
        PG8_WAIT_V(6); PG8_BAR;
    } else {
        PG8_STAGE(PG8_SB(0, 0), cB, voffB); PG8_STAGE(PG8_SA(0, 0), cA, voffA); PG8_STAGE(PG8_SB(0, 1), cB + hstepB, voffB); PG8_STAGE(PG8_SA(0, 1), cA + hstepA, voffA);
        if (wr == 1) PG8_BAR;
        PG8_WAIT_V(4); PG8_BAR;
        PG8_STAGE(PG8_SB(1, 0), cB + kstep, voffB); PG8_STAGE(PG8_SA(1, 0), cA + kstep, voffA); PG8_STAGE(PG8_SB(1, 1), cB + hstepB + kstep, voffB);
        PG8_WAIT_V(6); PG8_BAR;
    }
    for (;;) {
        const bool has_next = S.next(ui + 1, nxt);
        const char* nA = has_next ? (const char*)g.A + (size_t)nxt.pm * tstepA : cA; const char* nB = has_next ? (const char*)g.Bt + (size_t)nxt.pn * tstepB : cB;
        for (int t = 0; t < nt; t += 2) { if constexpr (Epi::HAS_MID) { if (t == (nt >> 1)) E.mid(acc, cur, wr, wc, fr, fq); }
            const bool last = (t == nt - 2);
            const char* a1 = cA + (size_t)(t + 1) * kstep;
            const char* a2 = last ? nA : cA + (size_t)(t + 2) * kstep; const char* b2 = last ? nB : cB + (size_t)(t + 2) * kstep;
            const char* a3 = a2 + kstep; const char* b3 = b2 + kstep;
            if (last && has_next) S.a_ready(nxt);
            if constexpr (SP2) {
            PG8_LDB(B0, 0, 0); PG8_LDB(B1, 0, 1); PG8_SCHED; PG8_LDA(At, 0, 0); PG8_STAGE(PG8_SA(1, 1), a1 + hstepA, voffA);
            PG8_WAIT_V(8); PG8_WAIT_L(0); PG8_BAR; PG8_MMA(0, 0, At, B0); PG8_MMA(0, 1, At, B1); PG8_BAR; PG8_SCHED;
            PG8_LDA(At, 0, 1); PG8_STAGE(PG8_SB(0, 0), b2, voffB); PG8_STAGE(PG8_SB(0, 1), b2 + hstepB, voffB); PG8_STAGE(PG8_SA(0, 0), a2, voffA);
            PG8_WAIT_V(8); PG8_WAIT_L(0); PG8_BAR; PG8_MMA(1, 0, At, B0); PG8_MMA(1, 1, At, B1); PG8_BAR; PG8_SCHED;
            PG8_LDB(B0, 1, 0); PG8_LDB(B1, 1, 1); PG8_SCHED; PG8_LDA(At, 1, 0); PG8_STAGE(PG8_SA(0, 1), a2 + hstepA, voffA);
            PG8_WAIT_V(8); PG8_WAIT_L(0); PG8_BAR; PG8_MMA(0, 0, At, B0); PG8_MMA(0, 1, At, B1); PG8_BAR; PG8_SCHED;
            PG8_LDA(At, 1, 1); PG8_STAGE(PG8_SB(1, 0), b3, voffB); PG8_STAGE(PG8_SB(1, 1), b3 + hstepB, voffB); PG8_STAGE(PG8_SA(1, 0), a3, voffA);
            PG8_WAIT_V(8); PG8_WAIT_L(0); PG8_BAR; PG8_MMA(1, 0, At, B0); PG8_MMA(1, 1, At, B1); PG8_BAR; PG8_SCHED;
            } else {
            PG8_LDB(B0, 0, 0); PG8_SCHED; PG8_LDA(At, 0, 0); PG8_STAGE(PG8_SA(1, 1), a1 + hstepA, voffA);
            PG8_WAIT_L(8); PG8_BAR; PG8_WAIT_L(0); PG8_MMA(0, 0, At, B0); PG8_BAR; PG8_SCHED;
            PG8_LDB(B1, 0, 1); PG8_STAGE(PG8_SB(0, 0), b2, voffB);
            PG8_BAR; PG8_WAIT_L(0); PG8_MMA(0, 1, At, B1); PG8_BAR;
            PG8_LDA(At, 0, 1); PG8_STAGE(PG8_SA(0, 0), a2, voffA);
            PG8_BAR; PG8_WAIT_L(0); PG8_MMA(1, 0, At, B0); PG8_BAR; PG8_SCHED;
            PG8_STAGE(PG8_SB(0, 1), b2 + hstepB, voffB);
            PG8_WAIT_V(6); PG8_BAR; PG8_MMA(1, 1, At, B1); PG8_BAR;
            PG8_LDB(B0, 1, 0); PG8_SCHED; PG8_LDA(At, 1, 0); PG8_STAGE(PG8_SA(0, 1), a2 + hstepA, voffA);
            PG8_WAIT_L(8); PG8_BAR; PG8_WAIT_L(0); PG8_MMA(0, 0, At, B0); PG8_BAR; PG8_SCHED;
            PG8_LDB(B1, 1, 1); PG8_STAGE(PG8_SB(1, 0), b3, voffB);
            PG8_BAR; PG8_WAIT_L(0); PG8_MMA(0, 1, At, B1); PG8_BAR;
            PG8_LDA(At, 1, 1); PG8_STAGE(PG8_SA(1, 0), a3, voffA);
            PG8_BAR; PG8_WAIT_L(0); PG8_MMA(1, 0, At, B0); PG8_BAR; PG8_SCHED;
            PG8_STAGE(PG8_SB(1, 1), b3 + hstepB, voffB);
            PG8_WAIT_V(6); PG8_BAR; PG8_MMA(1, 1, At, B1); PG8_BAR;
            }
        }
        if constexpr (ALIGN_EPI) { if (wr == 0) PG8_BAR; }
        if constexpr (!Epi::AFTER_DRAIN) { E(acc, cur, wr, wc, fr, fq); S.done(cur); }
        if (!has_next) break;
#pragma unroll
        for (int a = 0; a < 2; ++a)
#pragma unroll
            for (int b = 0; b < 2; ++b)
#pragma unroll
                for (int m = 0; m < 4; ++m)
#pragma unroll
                    for (int n = 0; n < 2; ++n) acc[a][b][m][n] = (f32x4){0.f, 0.f, 0.f, 0.f};
        cur = nxt; cA = nA; cB = nB; ++ui;
        if constexpr (ALIGN_EPI) { if (wr == 1) PG8_BAR; }
    }
    PG8_WAIT_V(0);
    if constexpr (!ALIGN_EPI) { if (wr == 0) PG8_BAR; }
    PG8_BAR;
    if constexpr (Epi::AFTER_DRAIN) { E.fused(acc, cur, wr, wc, fr, fq, lds, wid, lane); S.done(cur); }
#undef PG8_SA
#undef PG8_SB
#undef PG8_STAGE
#undef PG8_LDA
#undef PG8_LDB
#undef PG8_MMA
#undef PG8_WAIT_V
#undef PG8_WAIT_L
#undef PG8_BAR
#undef PG8_SCHED
}
}
#define LAS __attribute__((address_space(3)))
typedef unsigned short bf16;
typedef unsigned u32x4 __attribute__((ext_vector_type(4)));
typedef unsigned u32x2 __attribute__((ext_vector_type(2)));
typedef float f32x4 __attribute__((ext_vector_type(4)));
typedef float f32x16 __attribute__((ext_vector_type(16)));
typedef short bf16x8 __attribute__((ext_vector_type(8)));
constexpr int DM = 1024, NBATCH = 8, SEQ = 4096, T = NBATCH * SEQ, DEPTH = 4, PLE = 256, NIN = 9216, NHEAD = 16, HD = 64;
constexpr float LN_EPS = 1e-5f;
constexpr float ALPHA = 1.681792830507429f;
constexpr float QSCALE = 0.125f * 1.4426950408889634f;
constexpr size_t MiB = 1u << 20;
constexpr size_t WS_WIN = 0, WS_W2 = 18 * MiB, WS_WO = 22 * MiB, WS_WG = 24 * MiB, WS_WE = 26 * MiB, WS_WS = 27 * MiB, WS_PB = 28 * MiB, WS_XH1 = 44 * MiB,
                 WS_UGQ = 108 * MiB, WS_V = 236 * MiB, WS_K = 300 * MiB, WS_VB = 364 * MiB, WS_GB = 428 * MiB, WS_CTL = 492 * MiB, WS_XH = 493 * MiB, WS_XS = 557 * MiB  , WS_CMAX = WS_XS + 256 * 1024  , WS_CMAX1 = WS_CMAX + 32 * 1024  , WS_END = 558 * MiB;
constexpr size_t OUT_XQ = 64 * MiB;
constexpr int LDS_BYTES = 147456, RING_BYTES = 131072;

__device__ __forceinline__ float wave_sum(float v) {
#pragma unroll
    for (int o = 1; o < 64; o <<= 1) v += __shfl_xor(v, o);
    return v;
}
__device__ __forceinline__ unsigned pk2(float lo, float hi) { return pg8::cvt_pk_bf16(lo, hi); }
__device__ __forceinline__ float bf_lo(unsigned w) { return __uint_as_float(w << 16); }
__device__ __forceinline__ float bf_hi(unsigned w) { return __uint_as_float(w & 0xffff0000u); }

template <bool F16 = false> __device__ __forceinline__ void tr_item(const float* W, int N, bf16* WT, int ldk, int koff, int k0, int n0, int drow0, LAS float* scr, int lane) {
#pragma unroll 8
    for (int i = 0; i < 32; ++i) { const int kk = 2 * i + (lane >> 5); scr[kk * 33 + (lane & 31)] = W[(size_t)(k0 + kk) * N + n0 + (lane & 31)]; }
    asm volatile("s_waitcnt lgkmcnt(0)" ::: "memory");
    const int c = lane & 7;
#pragma unroll
    for (int j = 0; j < 4; ++j) { const int n = (lane >> 3) + 8 * j; const LAS float* s = scr + (8 * c) * 33 + n;
        u32x4 o;
        if constexpr (F16) { o.x = pg8::cvt_pk_f16(s[0 * 33], s[1 * 33]); o.y = pg8::cvt_pk_f16(s[2 * 33], s[3 * 33]); o.z = pg8::cvt_pk_f16(s[4 * 33], s[5 * 33]); o.w = pg8::cvt_pk_f16(s[6 * 33], s[7 * 33]); }
        else { o.x = pk2(s[0 * 33], s[1 * 33]); o.y = pk2(s[2 * 33], s[3 * 33]); o.z = pk2(s[4 * 33], s[5 * 33]); o.w = pk2(s[6 * 33], s[7 * 33]); }
        *(u32x4*)(WT + (size_t)(drow0 + n) * ldk + koff + k0 + 8 * c) = o; }
    asm volatile("s_waitcnt lgkmcnt(0)" ::: "memory");
}
__device__ __forceinline__ float wave_max(float v) {
#pragma unroll
    for (int o = 1; o < 64; o <<= 1) v = fmaxf(v, __shfl_xor(v, o));
    return v;
}
__device__ __forceinline__ unsigned q4(float a, float b, float c, float d, float inv) {
    const int ia = (int)__builtin_rintf(a * inv), ib = (int)__builtin_rintf(b * inv), ic = (int)__builtin_rintf(c * inv), id = (int)__builtin_rintf(d * inv);
    return (unsigned)(ia & 0xff) | ((unsigned)(ib & 0xff) << 8) | ((unsigned)(ic & 0xff) << 16) | ((unsigned)(id & 0xff) << 24);
}
__device__ __forceinline__ int win_dest_row(int c);
__device__ __forceinline__ void tr_item_q(const float* W, const float* cmax, unsigned char* WQ, int k0, int n0, int qrow0, LAS float* scr, int lane) {
#pragma unroll 8
    for (int i = 0; i < 32; ++i) { const int kk = 2 * i + (lane >> 5); scr[kk * 33 + (lane & 31)] = W[(size_t)(k0 + kk) * NIN + n0 + (lane & 31)]; }
    asm volatile("s_waitcnt lgkmcnt(0)" ::: "memory");
    const int c16 = lane & 3;
#pragma unroll
    for (int j = 0; j < 2; ++j) { const int n = (lane >> 2) + 16 * j; const LAS float* sp = scr + (16 * c16) * 33 + n;
        const float cm = cmax[qrow0 + n], inv = cm > 0.f ? 127.f / cm : 0.f;
        u32x4 o; o.x = q4(sp[0 * 33], sp[1 * 33], sp[2 * 33], sp[3 * 33], inv); o.y = q4(sp[4 * 33], sp[5 * 33], sp[6 * 33], sp[7 * 33], inv);
        o.z = q4(sp[8 * 33], sp[9 * 33], sp[10 * 33], sp[11 * 33], inv); o.w = q4(sp[12 * 33], sp[13 * 33], sp[14 * 33], sp[15 * 33], inv);
        *(u32x4*)(WQ + (size_t)(qrow0 + n) * 1024 + k0 + 16 * c16) = o; }
    asm volatile("s_waitcnt lgkmcnt(0)" ::: "memory");
}
__device__ __forceinline__ int win_dest_row(int c) {
    if (c < 1024) return 256 * (c >> 7) + (c & 127);
    if (c < 2048) return 2048 + (c - 1024);
    if (c < 3072) { const int cc = c - 2048; return 256 * (cc >> 7) + 128 + (cc & 127); }
    if (c < 7168) return c;
    if (c < 8192) { const int cc = c - 7168; return 7168 + 256 * (cc >> 7) + (cc & 127); }
    { const int cc = c - 8192; return 7168 + 256 * (cc >> 7) + 128 + (cc & 127); }
}
struct Args { const float* in[14]; float* out; unsigned char* ws; };
__device__ __forceinline__ void win_item(const Args& a, int l, unsigned char* wb, int kb, int nb, int what, LAS float* scr, int lane) {
    const float* w_in = a.in[2] + (size_t)l * DM * NIN; const int drow0 = win_dest_row(32 * nb);
    if (drow0 >= 7168) { if (what >= 1) tr_item_q(w_in, (const float*)(a.ws + WS_CMAX) + l * 2048, wb + WS_WIN + (size_t)7168 * 2048, 64 * kb, 32 * nb, drow0 - 7168, scr, lane); return; }
    const int slot = pg8::p1_qslot(drow0 >> 8);
    if (slot >= 0) { if (what >= 1) tr_item_q(w_in, (const float*)(a.ws + WS_CMAX1) + l * (pg8::P1_NQ * 256), wb + WS_WIN, 64 * kb, 32 * nb, slot * 256 + (drow0 & 255), scr, lane); return; }
    if (what != 1) tr_item<true>(w_in, NIN, (bf16*)(wb + WS_WIN), 1024, 0, 64 * kb, 32 * nb, drow0, scr, lane);
}

__device__ __forceinline__ void convert_layer(const Args& a, int l, LAS unsigned char* lds, int gw, int NGW, int lane, int wave, bool gates = true) {
    LAS float* scr = (LAS float*)(lds + wave * 8704);
    unsigned char* ws = (l & 1) ? (unsigned char*)a.out : a.ws;
    const float* w_in = a.in[2] + (size_t)l * DM * NIN;
    const float* w_pa = a.in[7] + (size_t)l * DM * DM; const float* w_pb = a.in[8] + (size_t)l * DM * DM; const float* w_out = a.in[9] + (size_t)l * DM * DM;
    const float* w_pe = a.in[10] + (size_t)l * PLE * DM; const float* w_pg = a.in[11] + (size_t)l * DM * DM;
    constexpr int I_IN = 16 * (NIN / 32), I_SQ = 16 * 32, I_PE = 4 * 32, NITEMS = I_IN + 4 * I_SQ + I_PE;
    for (int it = gw; it < NITEMS; it += NGW) {
        int r = it;
        if (r < I_IN) { win_item(a, l, ws, r / (NIN / 32), r % (NIN / 32), gates ? 2 : 0, scr, lane); continue; } r -= I_IN;
        if (r < I_SQ) { tr_item(w_pa, DM, (bf16*)(ws + WS_W2), 2048, 0, 64 * (r >> 5), 32 * (r & 31), 32 * (r & 31), scr, lane); continue; } r -= I_SQ;
        if (r < I_SQ) { tr_item(w_pb, DM, (bf16*)(ws + WS_W2), 2048, 1024, 64 * (r >> 5), 32 * (r & 31), 32 * (r & 31), scr, lane); continue; } r -= I_SQ;
        if (r < I_SQ) { tr_item(w_out, DM, (bf16*)(ws + WS_WO), 1024, 0, 64 * (r >> 5), 32 * (r & 31), 32 * (r & 31), scr, lane); continue; } r -= I_SQ;
        if (r < I_SQ) { tr_item<true>(w_pg, DM, (bf16*)(ws + WS_WG), 1024, 0, 64 * (r >> 5), 32 * (r & 31), 32 * (r & 31), scr, lane); continue; } r -= I_SQ;
        tr_item(w_pe, DM, (bf16*)(ws + WS_WE), 256, 0, 64 * (r >> 5), 32 * (r & 31), 32 * (r & 31), scr, lane);
    }
    const int gt = gw * 64 + lane, NGT = NGW * 64;
    { const float* w_s = a.in[5] + (size_t)l * 8 * 128 * 128; bf16* WsB = (bf16*)(ws + WS_WS);
      for (int p = gt; p < 8 * 128 * 16; p += NGT) { const int s0 = (p & 15) * 8, t = (p >> 4) & 127;
          const f32x4 x0 = *(const f32x4*)(w_s + (size_t)p * 8), x1 = *(const f32x4*)(w_s + (size_t)p * 8 + 4);
          float v[8] = {x0[0], x0[1], x0[2], x0[3], x1[0], x1[1], x1[2], x1[3]};
#pragma unroll
          for (int j = 0; j < 8; ++j) v[j] = (s0 + j <= t) ? v[j] : 0.f;
          u32x4 o; o.x = pk2(v[0], v[1]); o.y = pk2(v[2], v[3]); o.z = pk2(v[4], v[5]); o.w = pk2(v[6], v[7]);
          *(u32x4*)(WsB + (size_t)p * 8) = o; } }
    { const float* p = a.in[1] + (size_t)l * T * PLE; bf16* PB = (bf16*)(ws + WS_PB);
      for (int q = gt; q < T * PLE / 8; q += NGT) { const f32x4 x0 = *(const f32x4*)(p + (size_t)q * 8), x1 = *(const f32x4*)(p + (size_t)q * 8 + 4);
          u32x4 o; o.x = pk2(x0[0], x0[1]); o.y = pk2(x0[2], x0[3]); o.z = pk2(x1[0], x1[1]); o.w = pk2(x1[2], x1[3]);
          *(u32x4*)(PB + (size_t)q * 8) = o; } }
}

constexpr int AT_K = 0, AT_V = 16384, AT_STG = 16384 + 2 * 9216, AT_STG_W = 8704;
__device__ __forceinline__ void attn_unit(int b, int h, int qb, bf16* UGQ, const bf16* Kb, const bf16* Vb, const bf16* GBb, LAS unsigned char* lds, int dry = 0) {
    int tid_ = threadIdx.x; asm volatile("" : "+v"(tid_));
    const int tid = tid_, lane = tid & 63, wid = __builtin_amdgcn_readfirstlane(tid >> 6), r32 = lane & 31, hi = lane >> 5;
    const size_t rowbase = (size_t)b * SEQ;
    const int q0 = qb * 256, qw = q0 + wid * 32;
    bf16x8 qr[4];
    { const bf16* qp = UGQ + (rowbase + qw + r32) * 2048 + 1024 + h * HD + hi * 8;
#pragma unroll
      for (int d0 = 0; d0 < 4; ++d0) qr[d0] = *(const bf16x8*)(qp + d0 * 16); }
    f32x16 o0, o1;
#pragma unroll
    for (int r = 0; r < 16; ++r) { o0[r] = 0.f; o1[r] = 0.f; }
    float C = 1.f; int alive = 1;
    volatile LAS unsigned* aflag = (volatile LAS unsigned*)(lds + RING_BYTES);
    const int NT = 4 * (qb + 1);
    const int lkey = lane, lch = wid;
    const int kk = lkey & 31, slot = (lkey & 32) | (8 * ((kk >> 2) & 3) + 4 * (kk >> 4) + (kk & 3));
    const bf16* kg = Kb + (rowbase + lkey) * 1024 + h * HD + lch * 8;
    const bf16* vg = Vb + (rowbase + lkey) * 1024 + h * HD + lch * 8;
    u32x4 kreg, vreg;
    kreg = *(const u32x4*)(kg + (size_t)(NT - 1) * 64 * 1024); vreg = *(const u32x4*)(vg + (size_t)(NT - 1) * 64 * 1024);
#define AT_WRITE(buf) do { *(LAS u32x4*)(lds + AT_K + (buf) * 8192 + lch * 1024 + slot * 16) = kreg; \
        LAS unsigned short* vt_ = (LAS unsigned short*)(lds + AT_V + (buf) * 9216) + (lch * 8) * 72 + lkey; \
        vt_[0 * 72] = (unsigned short)(vreg.x & 0xffffu); vt_[1 * 72] = (unsigned short)(vreg.x >> 16); vt_[2 * 72] = (unsigned short)(vreg.y & 0xffffu); vt_[3 * 72] = (unsigned short)(vreg.y >> 16); \
        vt_[4 * 72] = (unsigned short)(vreg.z & 0xffffu); vt_[5 * 72] = (unsigned short)(vreg.z >> 16); vt_[6 * 72] = (unsigned short)(vreg.w & 0xffffu); vt_[7 * 72] = (unsigned short)(vreg.w >> 16); } while (0)
    AT_WRITE(0);
    __syncthreads();
    const int qrel = qw + r32;
    for (int it = 0; it < NT; ++it) {
        const int kt = NT - 1 - it, cur = it & 1;
        if (it + 1 < NT) { kreg = *(const u32x4*)(kg + (size_t)(kt - 1) * 64 * 1024); vreg = *(const u32x4*)(vg + (size_t)(kt - 1) * 64 * 1024); }
        const int k0 = kt * 64;
        if (k0 < qw + 32 && alive) {
            const LAS unsigned char* kb = lds + AT_K + cur * 8192 + hi * 1024 + r32 * 16;
            f32x16 p0, p1;
#pragma unroll
            for (int r = 0; r < 16; ++r) { p0[r] = 0.f; p1[r] = 0.f; }
#pragma unroll
            for (int d0 = 0; d0 < 4; ++d0) {
                const bf16x8 a0 = *(const LAS bf16x8*)(kb + d0 * 2048), a1 = *(const LAS bf16x8*)(kb + d0 * 2048 + 512);
                p0 = __builtin_amdgcn_mfma_f32_32x32x16_bf16(a0, qr[d0], p0, 0, 0, 0);
                p1 = __builtin_amdgcn_mfma_f32_32x32x16_bf16(a1, qr[d0], p1, 0, 0, 0);
            }
#pragma unroll
            for (int r = 0; r < 16; ++r) { p0[r] = __builtin_amdgcn_rcpf(1.f + __builtin_amdgcn_exp2f(p0[r])); p1[r] = __builtin_amdgcn_rcpf(1.f + __builtin_amdgcn_exp2f(p1[r])); }
            if (k0 + 63 >= qw) {
                const int kb0 = k0 + 16 * hi;
#pragma unroll
                for (int r = 0; r < 16; ++r) { if (kb0 + r >= qrel) p0[r] = 1.f; if (kb0 + 32 + r >= qrel) p1[r] = 1.f; }
            }
#pragma unroll
            for (int r = 14; r >= 0; --r) { p0[r] *= p0[r + 1]; p1[r] *= p1[r + 1]; }
            const float L0 = p0[0], L1 = p1[0];
            const float pL0 = __shfl_xor(L0, 32), pL1 = __shfl_xor(L1, 32);
            const float tot1 = L1 * pL1;
            const float pre1 = hi ? C : C * pL1;
            const float pre0 = C * tot1 * (hi ? 1.f : pL0);
            C = C * tot1 * (L0 * pL0);
#pragma unroll
            for (int r = 0; r < 15; ++r) { p0[r] = pre0 * (p0[r + 1] - p0[r]); p1[r] = pre1 * (p1[r + 1] - p1[r]); }
            p0[15] = pre0 * (1.f - p0[15]); p1[15] = pre1 * (1.f - p1[15]);
            u32x4 w00, w01, w10, w11;
            w00.x = pk2(p0[0], p0[1]); w00.y = pk2(p0[2], p0[3]); w00.z = pk2(p0[4], p0[5]); w00.w = pk2(p0[6], p0[7]);
            w01.x = pk2(p0[8], p0[9]); w01.y = pk2(p0[10], p0[11]); w01.z = pk2(p0[12], p0[13]); w01.w = pk2(p0[14], p0[15]);
            w10.x = pk2(p1[0], p1[1]); w10.y = pk2(p1[2], p1[3]); w10.z = pk2(p1[4], p1[5]); w10.w = pk2(p1[6], p1[7]);
            w11.x = pk2(p1[8], p1[9]); w11.y = pk2(p1[10], p1[11]); w11.z = pk2(p1[12], p1[13]); w11.w = pk2(p1[14], p1[15]);
            const LAS unsigned char* vb = lds + AT_V + cur * 9216 + r32 * 144 + hi * 32;
#define AT_PV(W, off) do { const bf16x8 pf_ = __builtin_bit_cast(bf16x8, W); \
                const bf16x8 v0_ = *(const LAS bf16x8*)(vb + (off)), v1_ = *(const LAS bf16x8*)(vb + 4608 + (off)); \
                o0 = __builtin_amdgcn_mfma_f32_32x32x16_bf16(v0_, pf_, o0, 0, 0, 0); o1 = __builtin_amdgcn_mfma_f32_32x32x16_bf16(v1_, pf_, o1, 0, 0, 0); } while (0)
            AT_PV(w00, 0); AT_PV(w01, 16); AT_PV(w10, 64); AT_PV(w11, 80);
#undef AT_PV
            alive = __any(C != 0.f);
        }
        if (it + 1 < NT) AT_WRITE(cur ^ 1);
        if (lane == 0) aflag[(it & 1) * 8 + wid] = (unsigned)alive;
        __syncthreads();
        const unsigned fl = (lane < 8) ? aflag[(it & 1) * 8 + lane] : 0u;
        if (!__any(fl != 0u)) break;
    }
#undef AT_WRITE
    LAS float* stg = (LAS float*)(lds + AT_STG + wid * AT_STG_W);
#pragma unroll
    for (int g4 = 0; g4 < 4; ++g4) {
        *(LAS f32x4*)(stg + r32 * 68 + 8 * g4 + 4 * hi) = (f32x4){o0[4 * g4], o0[4 * g4 + 1], o0[4 * g4 + 2], o0[4 * g4 + 3]};
        *(LAS f32x4*)(stg + r32 * 68 + 32 + 8 * g4 + 4 * hi) = (f32x4){o1[4 * g4], o1[4 * g4 + 1], o1[4 * g4 + 2], o1[4 * g4 + 3]};
    }
    asm volatile("s_waitcnt lgkmcnt(0)" ::: "memory");
#pragma unroll
    for (int i = 0; i < 4; ++i) {
        const int row = i * 8 + (lane >> 3), ch = lane & 7;
        f32x4 a0 = *(const LAS f32x4*)(stg + row * 68 + ch * 8), a1 = *(const LAS f32x4*)(stg + row * 68 + ch * 8 + 4);
        const size_t tok = rowbase + qw + row;
        const u32x4 gw_ = *(const u32x4*)(GBb + tok * 1024 + h * HD + ch * 8);
        f32x4 g0, g1; pg8::unpack8(gw_, g0, g1);
#pragma unroll
        for (int e = 0; e < 4; ++e) { a0[e] *= g0[e] * pg8::sigm(g0[e]); a1[e] *= g1[e] * pg8::sigm(g1[e]); }
        if (!dry) *(u32x4*)(UGQ + tok * 2048 + 1024 + h * HD + ch * 8) = pg8::pack8(a0, a1);
    }
    asm volatile("s_waitcnt lgkmcnt(0)" ::: "memory");
}

constexpr int BA_STAT = 0, BA_GB = 1024, BA_VNT = 1024 + 8192, BA_OT = BA_VNT + 128 * 272;
__device__ __forceinline__ void brancha_unit(int chunk, bf16* UGQ, const bf16* Vb, const bf16* WsB, const float* vn_g, const float* vn_b, const float* b_s, LAS unsigned char* lds, int dry = 0) {
    int tid_ = threadIdx.x; asm volatile("" : "+v"(tid_));
    const int tid = tid_, lane = tid & 63, wid = __builtin_amdgcn_readfirstlane(tid >> 6), r32 = lane & 31, hi = lane >> 5;
    const size_t t0 = (size_t)chunk * 128;
    LAS float* stat = (LAS float*)(lds + BA_STAT);
    LAS float* gbl = (LAS float*)(lds + BA_GB);
    u32x4 vpc[4];
#pragma unroll
    for (int i = 0; i < 4; ++i) { const int p = tid + 512 * i, s = p >> 4, dc = p & 15; vpc[i] = *(const u32x4*)(Vb + (t0 + s) * 1024 + dc * 8); }
    gbl[tid] = vn_g[tid]; gbl[tid + 512] = vn_g[tid + 512]; gbl[1024 + tid] = vn_b[tid]; gbl[1536 + tid] = vn_b[tid + 512];
#pragma unroll
    for (int hb = 0; hb < 2; ++hb) {
        u32x4 x0[8], x1[8];
#pragma unroll
        for (int i = 0; i < 8; ++i) { const bf16* vr = Vb + (t0 + wid * 16 + hb * 8 + i) * 1024; x0[i] = *(const u32x4*)(vr + lane * 8); x1[i] = *(const u32x4*)(vr + 512 + lane * 8); }
#pragma unroll
        for (int i = 0; i < 8; ++i) {
            f32x4 a, bq, c, d; pg8::unpack8(x0[i], a, bq); pg8::unpack8(x1[i], c, d);
            float s = (a[0] + a[1]) + (a[2] + a[3]) + (bq[0] + bq[1]) + (bq[2] + bq[3]) + (c[0] + c[1]) + (c[2] + c[3]) + (d[0] + d[1]) + (d[2] + d[3]);
            const float mean = wave_sum(s) * (1.f / 1024.f);
            a = a - mean; bq = bq - mean; c = c - mean; d = d - mean;
            float q = (a[0] * a[0] + a[1] * a[1]) + (a[2] * a[2] + a[3] * a[3]) + (bq[0] * bq[0] + bq[1] * bq[1]) + (bq[2] * bq[2] + bq[3] * bq[3])
                    + (c[0] * c[0] + c[1] * c[1]) + (c[2] * c[2] + c[3] * c[3]) + (d[0] * d[0] + d[1] * d[1]) + (d[2] * d[2] + d[3] * d[3]);
            const float rstd = 1.0f / sqrtf(wave_sum(q) * (1.f / 1024.f) + LN_EPS);
            if (lane == 0) { const int row = wid * 16 + hb * 8 + i; stat[row * 2] = mean; stat[row * 2 + 1] = rstd; }
        }
    }
    __syncthreads();
    const int dblk = wid & 3, tbp = wid >> 2;
    u32x4 ugp[4]; bf16x8 wf[2][8];
#define BA_LOAD_UG(g_) do { _Pragma("unroll") for (int i = 0; i < 4; ++i) { const int p = tid + 512 * i, t = p >> 4, dc = p & 15; ugp[i] = *(const u32x4*)(UGQ + (t0 + t) * 2048 + (g_) * 128 + dc * 8); } } while (0)
#define BA_LOAD_WS(g_) do { _Pragma("unroll") for (int j = 0; j < 2; ++j) { const int tb = 2 * tbp + j; const bf16* wrow = WsB + ((size_t)(g_) * 128 + 32 * tb + r32) * 128 + hi * 8; \
        _Pragma("unroll") for (int ks = 0; ks < 8; ++ks) if (ks < 2 * (tb + 1)) wf[j][ks] = *(const bf16x8*)(wrow + ks * 16); } } while (0)
    BA_LOAD_WS(0); BA_LOAD_UG(0);
    for (int g = 0; g < 8; ++g) {
#pragma unroll
        for (int i = 0; i < 4; ++i) {
            const int p = tid + 512 * i, s = p >> 4, dc = p & 15;
            f32x4 v0, v1; pg8::unpack8(vpc[i], v0, v1);
            const f32x4 ga = *(const LAS f32x4*)(gbl + g * 128 + dc * 8), gb2 = *(const LAS f32x4*)(gbl + g * 128 + dc * 8 + 4);
            const f32x4 ba = *(const LAS f32x4*)(gbl + 1024 + g * 128 + dc * 8), bb2 = *(const LAS f32x4*)(gbl + 1024 + g * 128 + dc * 8 + 4);
            const float mean = stat[s * 2], rstd = stat[s * 2 + 1];
            v0 = (v0 - mean) * rstd * ga + ba; v1 = (v1 - mean) * rstd * gb2 + bb2;
            const u32x4 w = pg8::pack8(v0, v1);
            LAS unsigned short* dst = (LAS unsigned short*)(lds + BA_VNT) + dc * 136 + s;
            dst[0 * 16 * 136] = (unsigned short)(w.x & 0xffffu); dst[1 * 16 * 136] = (unsigned short)(w.x >> 16); dst[2 * 16 * 136] = (unsigned short)(w.y & 0xffffu); dst[3 * 16 * 136] = (unsigned short)(w.y >> 16);
            dst[4 * 16 * 136] = (unsigned short)(w.z & 0xffffu); dst[5 * 16 * 136] = (unsigned short)(w.z >> 16); dst[6 * 16 * 136] = (unsigned short)(w.w & 0xffffu); dst[7 * 16 * 136] = (unsigned short)(w.w >> 16);
        }
        if (g + 1 < 8) {
#pragma unroll
            for (int i = 0; i < 4; ++i) { const int p = tid + 512 * i, s = p >> 4, dc = p & 15; vpc[i] = *(const u32x4*)(Vb + (t0 + s) * 1024 + (g + 1) * 128 + dc * 8); }
        }
        __syncthreads();
        const int d = 32 * dblk + r32;
        const LAS unsigned char* ab = lds + BA_VNT + ((d & 7) * 16 + (d >> 3)) * 272 + hi * 16;
        f32x16 acc[2];
#pragma unroll
        for (int j = 0; j < 2; ++j) {
            const int tb = 2 * tbp + j;
#pragma unroll
            for (int r = 0; r < 16; ++r) acc[j][r] = 0.f;
#pragma unroll
            for (int ks = 0; ks < 8; ++ks) if (ks < 2 * (tb + 1)) {
                const bf16x8 af = *(const LAS bf16x8*)(ab + ks * 32);
                acc[j] = __builtin_amdgcn_mfma_f32_32x32x16_bf16(af, wf[j][ks], acc[j], 0, 0, 0);
            }
        }
        if (g + 1 < 8) BA_LOAD_WS(g + 1);
#pragma unroll
        for (int j = 0; j < 2; ++j) {
            const int tb = 2 * tbp + j, t = 32 * tb + r32;
            const float bias = b_s[g * 128 + t];
            LAS float* ot = (LAS float*)(lds + BA_OT) + t * 132 + 32 * dblk + 4 * hi;
#pragma unroll
            for (int g4 = 0; g4 < 4; ++g4) *(LAS f32x4*)(ot + 8 * g4) = (f32x4){acc[j][4 * g4] + bias, acc[j][4 * g4 + 1] + bias, acc[j][4 * g4 + 2] + bias, acc[j][4 * g4 + 3] + bias};
        }
        __syncthreads();
#pragma unroll
        for (int i = 0; i < 4; ++i) {
            const int p = tid + 512 * i, t = p >> 4, dc = p & 15;
            const LAS float* ot = (const LAS float*)(lds + BA_OT) + t * 132 + dc * 8;
            const f32x4 m0 = *(const LAS f32x4*)ot, m1 = *(const LAS f32x4*)(ot + 4);
            bf16* up = UGQ + (t0 + t) * 2048 + g * 128 + dc * 8;
            f32x4 u0, u1; pg8::unpack8(ugp[i], u0, u1);
            if (!dry) *(u32x4*)up = pg8::pack8(u0 * m0, u1 * m1);
        }
        if (g + 1 < 8) BA_LOAD_UG(g + 1);
    }
#undef BA_LOAD_UG
#undef BA_LOAD_WS
    __syncthreads();
}

__device__ __forceinline__ void ln_rows(bf16* XH, unsigned char* XQ, float* XS, float* OUT, const float* g, const float* bta, bool last, int gw, int NGW, int lane) {
    f32x4 gv[4], bv[4];
#pragma unroll
    for (int j = 0; j < 2; ++j) { gv[2 * j] = *(const f32x4*)(g + 512 * j + lane * 8); gv[2 * j + 1] = *(const f32x4*)(g + 512 * j + lane * 8 + 4);
                                  bv[2 * j] = *(const f32x4*)(bta + 512 * j + lane * 8); bv[2 * j + 1] = *(const f32x4*)(bta + 512 * j + lane * 8 + 4); }
    for (int m = gw; m < T; m += NGW) {
        bf16* xr = XH + (size_t)m * DM + lane * 8;
        f32x4 v[4]; float s = 0.f;
        pg8::unpack8h(*(const u32x4*)xr, v[0], v[1]); pg8::unpack8h(*(const u32x4*)(xr + 512), v[2], v[3]);
#pragma unroll
        for (int j = 0; j < 4; ++j) s += (v[j][0] + v[j][1]) + (v[j][2] + v[j][3]);
        const float mean = wave_sum(s) * (1.f / DM); float s2 = 0.f;
#pragma unroll
        for (int j = 0; j < 4; ++j) { v[j] = v[j] - mean; s2 += (v[j][0] * v[j][0] + v[j][1] * v[j][1]) + (v[j][2] * v[j][2] + v[j][3] * v[j][3]); }
        const float rstd = 1.0f / sqrtf(wave_sum(s2) * (1.f / DM) + LN_EPS);
#pragma unroll
        for (int j = 0; j < 4; ++j) v[j] = v[j] * rstd * gv[j] + bv[j];
        if (last) { float* o = OUT + (size_t)m * DM + lane * 8;
            *(f32x4*)o = v[0]; *(f32x4*)(o + 4) = v[1]; *(f32x4*)(o + 512) = v[2]; *(f32x4*)(o + 516) = v[3]; }
        else { *(u32x4*)xr = pg8::pack8h(v[0], v[1]); *(u32x4*)(xr + 512) = pg8::pack8h(v[2], v[3]);
            float am = 0.f;
#pragma unroll
            for (int j = 0; j < 4; ++j) am = fmaxf(am, fmaxf(fmaxf(fabsf(v[j][0]), fabsf(v[j][1])), fmaxf(fabsf(v[j][2]), fabsf(v[j][3]))));
            am = wave_max(am); const float inv = am > 0.f ? 127.f / am : 0.f;
            unsigned char* xq = XQ + (size_t)m * DM + lane * 8;
            u32x2 w0, w1; w0.x = q4(v[0][0], v[0][1], v[0][2], v[0][3], inv); w0.y = q4(v[1][0], v[1][1], v[1][2], v[1][3], inv);
            w1.x = q4(v[2][0], v[2][1], v[2][2], v[2][3], inv); w1.y = q4(v[3][0], v[3][1], v[3][2], v[3][3], inv);
            *(u32x2*)xq = w0; *(u32x2*)(xq + 512) = w1; if (lane == 0) XS[m] = am; }
    }
}

#define XB_TMO      128
#define XB_XCNT(j)  (256  + 64 * (j))
#define XB_XSUB(j)  (1280 + 64 * (j))
#define XB_XGEN(j)  (2304 + 64 * (j))
#define XB_TOP      3328
#define XB_TOPGEN   3392
#define XCD_BAR_WORDS 3456
#define XB_SPIN_CAP (1u << 18)

__device__ __forceinline__ unsigned xb_ld(unsigned* p)              { return __hip_atomic_load(p, __ATOMIC_RELAXED, __HIP_MEMORY_SCOPE_AGENT); }
__device__ __forceinline__ unsigned xb_add(unsigned* p, unsigned v) { return __hip_atomic_fetch_add(p, v, __ATOMIC_RELAXED, __HIP_MEMORY_SCOPE_AGENT); }
__device__ __forceinline__ unsigned xb_xcc_id() { return (unsigned)__builtin_amdgcn_s_getreg((3 << 11) | 20) & 0xFu; }
#define XB_SPIN(cond, bar) do { unsigned _sp = 0; while (cond) { __builtin_amdgcn_s_sleep(1); \
    if ((++_sp & 255u) == 0u) { if (xb_ld(&(bar)[XB_TMO])) break; if (_sp > XB_SPIN_CAP) { atomicAdd(&(bar)[XB_TMO], 1u); break; } } } } while (0)

struct XcdBarrier {
    unsigned* bar; unsigned x;
    volatile LAS unsigned* st;
};

__device__ __forceinline__ XcdBarrier xcd_barrier_post(unsigned* bar, volatile LAS unsigned* st) {
    XcdBarrier b; b.bar = bar; b.x = xb_xcc_id(); b.st = st;
    if (threadIdx.x == 0) (void)xb_add(&bar[XB_XCNT(b.x)], 1u);
    return b;
}
__device__ __forceinline__ void xcd_barrier_complete(unsigned* bar, unsigned x, unsigned& nloc, unsigned& nx) {
    const unsigned G = gridDim.x * gridDim.y * gridDim.z;
    unsigned sum, cnt, mine, sp = 0u;
    for (;;) {
        sum = 0u; cnt = 0u; mine = 0u;
#pragma unroll
        for (unsigned j = 0; j < 16; ++j) { const unsigned c = xb_ld(&bar[XB_XCNT(j)]); sum += c; cnt += (c > 0u) ? 1u : 0u; mine = (j == x) ? c : mine; }
        if (sum == G) break;
        __builtin_amdgcn_s_sleep(1);
        if ((++sp & 255u) == 0u) { if (xb_ld(&bar[XB_TMO])) break; if (sp > XB_SPIN_CAP) { atomicAdd(&bar[XB_TMO], 1u); break; } }
    }
    nloc = mine > 0u ? mine : 1u; nx = cnt > 0u ? cnt : 1u;
}

__device__ __forceinline__ void xcd_barrier(const XcdBarrier& b) {
    asm volatile("s_waitcnt vmcnt(0)" ::: "memory");
    __syncthreads();
    if (threadIdx.x == 0) {
        unsigned* bar = b.bar;
        __builtin_amdgcn_s_waitcnt(0);
        unsigned nloc = b.st[0], nx = b.st[1];
        if (nloc == 0u) { xcd_barrier_complete(bar, b.x, nloc, nx); b.st[0] = nloc; b.st[1] = nx; }
        const unsigned old = xb_add(&bar[XB_XSUB(b.x)], 1u);
        const unsigned gen = old / nloc;
        if (old + 1u == (gen + 1u) * nloc) {
            __builtin_amdgcn_fence(__ATOMIC_RELEASE, "agent");
            asm volatile("s_waitcnt vmcnt(0)" ::: "memory");
            const unsigned og = xb_add(&bar[XB_TOP], 1u);
            const unsigned tg = og / nx;
            if (og + 1u == (tg + 1u) * nx) xb_add(&bar[XB_TOPGEN], 1u);
            else XB_SPIN(xb_ld(&bar[XB_TOPGEN]) == tg, bar);
            __builtin_amdgcn_fence(__ATOMIC_ACQUIRE, "agent");
            xb_add(&bar[XB_XGEN(b.x)], 1u);
            asm volatile("s_waitcnt vmcnt(0)" ::: "memory");
        } else {
            XB_SPIN(xb_ld(&bar[XB_XGEN(b.x)]) == gen, bar);
            __builtin_amdgcn_fence(__ATOMIC_ACQUIRE, "agent");
            asm volatile("s_waitcnt vmcnt(0)" ::: "memory");
        }
    }
    __syncthreads();
}

__global__ void __launch_bounds__(512, 2) fwd_kernel(Args a) {
    extern __shared__ __attribute__((aligned(16))) unsigned char lds_raw[];
    cg::grid_group grid = cg::this_grid();
    LAS unsigned char* lds = (LAS unsigned char*)lds_raw;
    const int G = gridDim.x, bx = blockIdx.x;
    const int vcu = (G % 8 == 0) ? (bx % 8) * (G / 8) + bx / 8 : bx;
    const int NGW = G * 8;
#define LAUNDER_TID int tid_l = threadIdx.x; asm volatile("" : "+v"(tid_l)); const int lane = tid_l & 63, wave = __builtin_amdgcn_readfirstlane(tid_l >> 6), gw = vcu * 8 + wave;
#define WSW(name, off) size_t name##_o = (off); asm volatile("" : "+s"(name##_o)); bf16* const name = (bf16*)(((l & 1) ? (unsigned char*)a.out : a.ws) + name##_o);
#define WSP(name, off) size_t name##_o = (off); asm volatile("" : "+s"(name##_o)); bf16* const name = (bf16*)(a.ws + name##_o);
    volatile LAS unsigned* MISC = (volatile LAS unsigned*)(lds + RING_BYTES + 256);
    if (threadIdx.x < 16) MISC[threadIdx.x] = 0u;
    unsigned* barw = (unsigned*)(a.ws + WS_CTL);
    if (bx == 0) for (int i = threadIdx.x; i < XCD_BAR_WORDS; i += 512) barw[i] = 0u;
    __syncthreads();
    { LAUNDER_TID
    for (int tk = gw; tk < 4 * 144 * 16; tk += NGW) { const int l4 = tk / (144 * 16), cg = (tk >> 4) % 144, kc = tk & 15, c = 64 * cg + lane;
        const int drow = win_dest_row(c), slot = drow >= 7168 ? -2 : pg8::p1_qslot(__builtin_amdgcn_readfirstlane(drow) >> 8);
        if (slot == -1) continue;
        const float* wp = a.in[2] + (size_t)l4 * DM * NIN + (size_t)(64 * kc) * NIN + c; float mx = 0.f;
#pragma unroll 16
        for (int kk = 0; kk < 64; ++kk) mx = fmaxf(mx, fabsf(wp[(size_t)kk * NIN]));
        unsigned* dst = slot == -2 ? (unsigned*)(a.ws + WS_CMAX) + l4 * 2048 + (drow - 7168) : (unsigned*)(a.ws + WS_CMAX1) + l4 * (pg8::P1_NQ * 256) + slot * 256 + (drow & 255);
        atomicMax(dst, __float_as_uint(mx)); }
    convert_layer(a, 0, lds, gw, NGW, lane, wave, false);
    { const float* x = a.in[0]; WSP(XH, WS_XH) unsigned char* XQ = (unsigned char*)a.out + OUT_XQ; float* XS = (float*)(a.ws + WS_XS);
      for (int m = gw; m < T; m += NGW) { const float* xr = x + (size_t)m * DM + lane * 8;
          const f32x4 v0 = *(const f32x4*)xr, v1 = *(const f32x4*)(xr + 4), v2 = *(const f32x4*)(xr + 512), v3 = *(const f32x4*)(xr + 516);
          bf16* xo = XH + (size_t)m * DM + lane * 8; *(u32x4*)xo = pg8::pack8h(v0, v1); *(u32x4*)(xo + 512) = pg8::pack8h(v2, v3);
          float am = fmaxf(fmaxf(fmaxf(fabsf(v0[0]), fabsf(v0[1])), fmaxf(fabsf(v0[2]), fabsf(v0[3]))), fmaxf(fmaxf(fabsf(v1[0]), fabsf(v1[1])), fmaxf(fabsf(v1[2]), fabsf(v1[3]))));
          am = fmaxf(am, fmaxf(fmaxf(fmaxf(fabsf(v2[0]), fabsf(v2[1])), fmaxf(fabsf(v2[2]), fabsf(v2[3]))), fmaxf(fmaxf(fabsf(v3[0]), fabsf(v3[1])), fmaxf(fabsf(v3[2]), fabsf(v3[3])))));
          am = wave_max(am); const float inv = am > 0.f ? 127.f / am : 0.f;
          unsigned char* xq = XQ + (size_t)m * DM + lane * 8;
          u32x2 w0, w1; w0.x = q4(v0[0], v0[1], v0[2], v0[3], inv); w0.y = q4(v1[0], v1[1], v1[2], v1[3], inv); w1.x = q4(v2[0], v2[1], v2[2], v2[3], inv); w1.y = q4(v3[0], v3[1], v3[2], v3[3], inv);
          *(u32x2*)xq = w0; *(u32x2*)(xq + 512) = w1; if (lane == 0) XS[m] = am; } } }
    grid.sync();
    const XcdBarrier xbar = xcd_barrier_post(barw, MISC + 8);
#define GRID_SYNC() xcd_barrier(xbar)
#pragma unroll 1
    for (int l = 0; l < DEPTH; ++l) {
#ifndef SKIP_P1
        if (l == 0) { LAUNDER_TID
            LAS float* scr = (LAS float*)(lds + wave * 8704);
            for (int it = gw; it < 16 * (NIN / 32); it += NGW) win_item(a, 0, a.ws, it / (NIN / 32), it % (NIN / 32), 1, scr, lane);
            GRID_SYNC(); }
        { WSP(XH, WS_XH) WSW(WinT, WS_WIN) WSP(UGQ, WS_UGQ) WSP(Vb, WS_V) WSP(Kb, WS_K) WSP(VBb, WS_VB) WSP(GBb, WS_GB)
          if constexpr (pg8::P1_NF > 0)
          { pg8::Gemm g{XH, WinT + (size_t)(pg8::P1_F0 * 256) * DM, T, pg8::P1_NF * 256, DM, DM}; pg8::StaticOrder S; S.init(T, pg8::P1_NF * 256, G, bx);
            pg8::Epi1<false> E{UGQ, Vb, Kb, VBb, GBb, QSCALE, nullptr, nullptr};
            pg8::gemm_phase<pg8::Epi1<false>, pg8::StaticOrder, true, true, 1>(lds, g, S, E); }
          { const bf16* XQ = (const bf16*)((const unsigned char*)a.out + OUT_XQ);
            pg8::Gemm g{XQ, WinT, T, pg8::P1_NQ * 256, 512, 512}; pg8::StaticOrder S; S.init(T, pg8::P1_NQ * 256, G, bx);
            pg8::Epi1<true> E{UGQ, Vb, Kb, VBb, GBb, QSCALE, (const float*)(a.ws + WS_XS), (const float*)(a.ws + WS_CMAX1) + l * (pg8::P1_NQ * 256)};
            pg8::gemm_phase<pg8::Epi1<true>, pg8::StaticOrder, true, true, 2>(lds, g, S, E); }
        }
#endif
        GRID_SYNC();
        { WSP(UGQ, WS_UGQ) WSP(Vb, WS_V) WSW(WsB, WS_WS) WSP(Kb, WS_K) WSP(VBb, WS_VB) WSP(GBb, WS_GB)
#pragma unroll 1
        for (int st = 0; st < 2; ++st) {
            if (((st ^ vcu) & 1) == 0) {
#ifndef SKIP_BA
                for (int c = vcu; c < T / 128; c += G)
                    brancha_unit(c, UGQ, Vb, WsB, a.in[3] + l * DM, a.in[4] + l * DM, a.in[6] + l * 8 * 128, lds);
#endif
            } else {
#ifndef SKIP_AT
#pragma unroll 1
                for (int pu2 = 2 * vcu; pu2 < 128 * 16; pu2 += 2 * G) {
#pragma unroll 1
                    for (int j2 = 0; j2 < 2; ++j2) {
                        const int pu = pu2 >> 1, bh = pu >> 3, s = pu & 7;
                        attn_unit(bh >> 4, bh & 15, j2 ? s : 15 - s, UGQ, Kb, VBb, GBb, lds);
                    }
                }
#endif
            }
        }
        if (l + 1 < DEPTH) { __syncthreads(); LAUNDER_TID convert_layer(a, l + 1, lds, gw, NGW, lane, wave); }
        }
        GRID_SYNC();
#ifndef SKIP_P25
        { WSW(WinT, WS_WIN) WSP(SMA, WS_K) WSP(SMB, WS_VB)
          const bf16* XQ = (const bf16*)((const unsigned char*)a.out + OUT_XQ);
          pg8::Gemm g{XQ, WinT + (size_t)7168 * DM, T, 2048, 512, 512}; pg8::GateOrder S; S.init(T, G, bx);
          pg8::EpiGateQ E{SMA, SMB, (const float*)(a.ws + WS_XS), (const float*)(a.ws + WS_CMAX) + l * 2048};
          pg8::gemm_phase<pg8::EpiGateQ, pg8::GateOrder, true, true, 2>(lds, g, S, E); }
        { WSW(PB, WS_PB) WSW(WeT, WS_WE) WSP(EB, WS_GB)
          int kp = PLE; asm volatile("" : "+s"(kp));
          pg8::Gemm g{PB, WeT, T, DM, kp, kp}; pg8::StaticOrder S; S.init(T, DM, G, bx);
          pg8::EpiStore<0> E{EB, EB};
          pg8::gemm_phase<pg8::EpiStore<0>, pg8::StaticOrder, true, true>(lds, g, S, E); }
#endif
#ifndef SKIP_P3
        { WSP(UGQ, WS_UGQ) WSW(W2T, WS_W2) WSP(SMA, WS_K) WSP(SMB, WS_VB) WSP(MERGED, WS_V)
          pg8::Gemm g{UGQ, W2T, T, DM, 2048, 2048}; pg8::StaticOrder S; S.init(T, DM, G, bx);
          pg8::Epi2 E{SMA, SMB, MERGED};
          pg8::gemm_phase<pg8::Epi2, pg8::StaticOrder, true, true>(lds, g, S, E);
#ifdef PROBE_DUP_P3
          pg8::gemm_phase<pg8::Epi2, pg8::StaticOrder, true, true>(lds, g, S, E);
#endif
        }
#endif
        GRID_SYNC();
#ifndef SKIP_P4
        { WSP(MERGED, WS_V) WSW(WoT, WS_WO) WSP(XH1, WS_XH1) WSP(XH, WS_XH)
          pg8::Gemm g{MERGED, WoT, T, DM, DM, DM}; pg8::StaticOrder S; S.init(T, DM, G, bx);
          pg8::Epi3 E{XH, XH1, ALPHA};
          pg8::gemm_phase<pg8::Epi3, pg8::StaticOrder, true, true>(lds, g, S, E); }
#endif
        GRID_SYNC();
#ifndef SKIP_P5
        { WSP(XH1, WS_XH1) WSW(WgT, WS_WG) WSP(EB, WS_GB) WSP(XH, WS_XH)
          pg8::Gemm g{XH1, WgT, T, DM, DM, DM}; pg8::StaticOrder S; S.init(T, DM, G, bx);
          pg8::Epi4 E{XH1, XH, EB};
          pg8::gemm_phase<pg8::Epi4, pg8::StaticOrder, true, true, true>(lds, g, S, E); }
#endif
        GRID_SYNC();
#ifdef PROBE_SYNC
        for (int z = 0; z < 10; ++z) GRID_SYNC();
#endif
        LAUNDER_TID WSP(XH, WS_XH)
        ln_rows(XH, (unsigned char*)a.out + OUT_XQ, (float*)(a.ws + WS_XS), a.out, a.in[12] + l * DM, a.in[13] + l * DM, l + 1 == DEPTH, gw, NGW, lane);
        if (l + 1 < DEPTH) GRID_SYNC();
    }
}

extern "C" void kernel_launch(void* const* d_in, const int* in_sizes, int n_in, void* d_out, int out_size, void* d_ws, size_t ws_size, hipStream_t stream) {
    static int grid = 0;
    if (grid == 0) {
        if (n_in != 14 || out_size != T * DM || ws_size < WS_END) { fprintf(stderr, "kernel_launch: unexpected shapes (n_in %d out %d ws %zu)\n", n_in, out_size, ws_size); grid = -1; return; }
        int dev = 0, cus = 0, per_cu = 0;
        hipGetDevice(&dev); hipDeviceGetAttribute(&cus, hipDeviceAttributeMultiprocessorCount, dev);
        hipFuncSetAttribute((const void*)fwd_kernel, hipFuncAttributeMaxDynamicSharedMemorySize, LDS_BYTES);
        hipOccupancyMaxActiveBlocksPerMultiprocessor(&per_cu, (const void*)fwd_kernel, 512, LDS_BYTES);
        if (per_cu < 1) per_cu = 1;
        grid = cus;
        (void)hipGetLastError();
    }
    if (grid < 0) return;
    Args a{};
    for (int i = 0; i < 14; ++i) a.in[i] = (const float*)d_in[i];
    a.out = (float*)d_out; a.ws = (unsigned char*)d_ws;
    hipMemsetAsync((char*)d_ws + WS_CMAX, 0, 4 * (2048 + pg8::P1_NQ * 256) * sizeof(float), stream);
    void* args[] = {&a};
    hipError_t e = hipLaunchCooperativeKernel((const void*)fwd_kernel, dim3(grid), dim3(512), args, LDS_BYTES, stream);
    if (e != hipSuccess) fprintf(stderr, "cooperative launch failed: %s (grid %d)\n", hipGetErrorString(e), grid);
}
```

```cpp
#include <hip/hip_runtime.h>
#include <hip/hip_cooperative_groups.h>
#include <cstdio>
#include <cstdint>
namespace cg = cooperative_groups;
namespace pg8 {
#define PG8_LAS __attribute__((address_space(3)))
typedef unsigned short bf16_t;
typedef short bf16x8 __attribute__((ext_vector_type(8)));
typedef _Float16 f16x8 __attribute__((ext_vector_type(8)));
typedef int i32x4 __attribute__((ext_vector_type(4)));
typedef float f32x4 __attribute__((ext_vector_type(4)));
typedef unsigned u32x4 __attribute__((ext_vector_type(4)));
constexpr int BM = 256, BK = 64, HALF = 128, HTB = HALF * BK * 2  , STAGE_BYTES = 8 * HTB, NXCD = 8, WGM = 8;

__host__ __device__ __forceinline__ int lds_byte(int r, int c) { const int st = (r >> 4) * 2 + (c >> 5), rr = r & 15, cc = c & 31, ob = rr * 64 + cc * 2; return st * 1024 + (ob ^ (((ob >> 9) & 1) << 5)); }
__host__ __device__ __forceinline__ void stage_rc(int b, int& R, int& C) { const int st = b / 1024, sb = b % 1024, swz = sb ^ (((sb >> 9) & 1) << 5); R = (st >> 1) * 16 + swz / 64; C = (st & 1) * 32 + (swz % 64) / 2; }
__host__ __device__ __forceinline__ int perm32(int rho) { const int n = rho >> 4, i = rho & 15; return 8 * (i >> 2) + 4 * n + (i & 3); }

struct Unit { int pm, pn; };
struct Gemm { const bf16_t* A; const bf16_t* Bt; int M, N, K, lda; };

struct StaticOrder {
    int nM, nN, nwg, G, c;
    __host__ __device__ void init(int M, int N, int G_, int c_) { nM = M / BM; nN = N / BM; nwg = nM * nN; G = G_; c = c_; }
    __host__ __device__ bool next(int i, Unit& u) const {
        const long L = (long)i * G + c; if (L >= nwg) return false;
        int wgid = (int)L; { const int q = nwg / NXCD, r = nwg % NXCD, xcd = wgid % NXCD, off = wgid / NXCD; wgid = (xcd < r ? xcd * (q + 1) : r * (q + 1) + (xcd - r) * q) + off; }
        const int nig = WGM * nN, gid = wgid / nig, fm = gid * WGM, gsz = (nM - fm) < WGM ? (nM - fm) : WGM;
        u.pm = fm + ((wgid % nig) % gsz); u.pn = (wgid % nig) / gsz; return true;
    }
    __device__ __forceinline__ void a_ready(const Unit&) const {}
    __device__ __forceinline__ void done(const Unit&) const {}
};
struct GateOrder {
    StaticOrder inner;
    __host__ __device__ void init(int M, int G_, int c_) { inner.init(M, 1024, G_, c_); }
    __host__ __device__ bool next(int i, Unit& u) const { Unit v; if (!inner.next(i >> 1, v)) return false; u.pm = v.pm; u.pn = 2 * v.pn + (i & 1); return true; }
    __device__ __forceinline__ void a_ready(const Unit&) const {}
    __device__ __forceinline__ void done(const Unit&) const {}
};


typedef float f32x2_t __attribute__((ext_vector_type(2))); typedef __bf16 bf16x2_t __attribute__((ext_vector_type(2)));
__device__ __forceinline__ unsigned cvt_pk_bf16(float lo, float hi) { f32x2_t v = {lo, hi}; bf16x2_t b = __builtin_convertvector(v, bf16x2_t); return __builtin_bit_cast(unsigned, b); }
__device__ __forceinline__ float sigm(float x) { return __builtin_amdgcn_rcpf(1.f + __builtin_amdgcn_exp2f(-1.4426950408889634f * x)); }
__device__ __forceinline__ u32x4 pack8(const f32x4 a, const f32x4 b) { u32x4 w; w.x = cvt_pk_bf16(a[0], a[1]); w.y = cvt_pk_bf16(a[2], a[3]); w.z = cvt_pk_bf16(b[0], b[1]); w.w = cvt_pk_bf16(b[2], b[3]); return w; }
__device__ __forceinline__ void unpack8(const u32x4 w, f32x4& a, f32x4& b) {
    a[0] = __uint_as_float(w.x << 16); a[1] = __uint_as_float(w.x & 0xffff0000u); a[2] = __uint_as_float(w.y << 16); a[3] = __uint_as_float(w.y & 0xffff0000u);
    b[0] = __uint_as_float(w.z << 16); b[1] = __uint_as_float(w.z & 0xffff0000u); b[2] = __uint_as_float(w.w << 16); b[3] = __uint_as_float(w.w & 0xffff0000u); }
typedef _Float16 f16x2_t __attribute__((ext_vector_type(2)));
__device__ __forceinline__ unsigned cvt_pk_f16(float lo, float hi) { f32x2_t v = {lo, hi}; f16x2_t h = __builtin_convertvector(v, f16x2_t); return __builtin_bit_cast(unsigned, h); }
__device__ __forceinline__ u32x4 pack8h(const f32x4 a, const f32x4 b) { u32x4 w; w.x = cvt_pk_f16(a[0], a[1]); w.y = cvt_pk_f16(a[2], a[3]); w.z = cvt_pk_f16(b[0], b[1]); w.w = cvt_pk_f16(b[2], b[3]); return w; }
__device__ __forceinline__ void unpack8h(const u32x4 w, f32x4& a, f32x4& b) {
    const unsigned x0 = w.x, x1 = w.y, x2 = w.z, x3 = w.w;
    const f32x2_t p0 = __builtin_convertvector(__builtin_bit_cast(f16x2_t, x0), f32x2_t), p1 = __builtin_convertvector(__builtin_bit_cast(f16x2_t, x1), f32x2_t);
    const f32x2_t p2 = __builtin_convertvector(__builtin_bit_cast(f16x2_t, x2), f32x2_t), p3 = __builtin_convertvector(__builtin_bit_cast(f16x2_t, x3), f32x2_t);
    a[0] = p0[0]; a[1] = p0[1]; a[2] = p1[0]; a[3] = p1[1]; b[0] = p2[0]; b[1] = p2[1]; b[2] = p3[0]; b[3] = p3[1]; }
#define PG8_FENCE asm volatile("" ::: "memory")

#ifndef P1_ALL_INT8
#define P1_ALL_INT8 1
#endif
#if P1_ALL_INT8
constexpr int P1_NQ = 28, P1_F0 = 28, P1_NF = 0;
__host__ __device__ constexpr int p1_qtile(int j) { return j; }
__host__ __device__ constexpr int p1_qslot(int tile) { return tile < 28 ? tile : -1; }
#else
constexpr int P1_NQ = 20, P1_F0 = 12, P1_NF = 8;
__host__ __device__ constexpr int p1_qtile(int j) { return j < 12 ? j : 20 + (j - 12); }
__host__ __device__ constexpr int p1_qslot(int tile) { return tile < 12 ? tile : (tile >= 20 && tile < 28 ? 12 + (tile - 20) : -1); }
#endif
template <bool Q> struct Epi1 {
    static constexpr bool PERM = true, AFTER_DRAIN = false, HAS_MID = false;
    bf16_t *UGQ, *V, *K, *VB, *GB; float qscale; const float* XS; const float* CS; float* VST;
    __device__ __forceinline__ static f32x4 val(const f32x4 a, float rs, const f32x4 cs) {
        if constexpr (Q) { const i32x4 q = __builtin_bit_cast(i32x4, a); return (f32x4){(float)q[0], (float)q[1], (float)q[2], (float)q[3]} * (cs * rs); } else return a; }
    __device__ __forceinline__ void operator()(const f32x4 (&acc)[2][2][4][2], const Unit& u, int wr, int wc, int fr, int fq) const {
        asm volatile("" : "+v"(fr), "+v"(fq));
        const int row0 = u.pm * BM + wr * 64 + fr, cw = wc * 32 + 8 * fq;
        const int pn = Q ? p1_qtile(u.pn) : u.pn + P1_F0;
        float rsc[2][4]; f32x4 cs[2][2];
#pragma unroll
        for (int ai = 0; ai < 2; ++ai)
#pragma unroll
            for (int m = 0; m < 4; ++m) rsc[ai][m] = Q ? XS[row0 + ai * HALF + m * 16] * (1.f / (127.f * 127.f)) : 1.f;
#pragma unroll
        for (int bj = 0; bj < 2; ++bj)
#pragma unroll
            for (int n = 0; n < 2; ++n) cs[bj][n] = Q ? *(const f32x4*)(CS + u.pn * BM + bj * HALF + cw + 4 * n) : (f32x4){1.f, 1.f, 1.f, 1.f};
        if (pn < 8) {
            bf16_t* base = UGQ + pn * 128 + cw;
#pragma unroll
            for (int ai = 0; ai < 2; ++ai)
#pragma unroll
                for (int m = 0; m < 4; ++m) {
                    f32x4 u0 = val(acc[ai][0][m][0], rsc[ai][m], cs[0][0]), u1 = val(acc[ai][0][m][1], rsc[ai][m], cs[0][1]);
                    const f32x4 g0 = val(acc[ai][1][m][0], rsc[ai][m], cs[1][0]), g1 = val(acc[ai][1][m][1], rsc[ai][m], cs[1][1]);
#pragma unroll
                    for (int e = 0; e < 4; ++e) { u0[e] *= g0[e] * sigm(g0[e]); u1[e] *= g1[e] * sigm(g1[e]); }
                    __builtin_nontemporal_store(pack8(u0, u1), (u32x4*)(base + (size_t)(row0 + ai * HALF + m * 16) * 2048));
                }
        } else {
            const int seg = (pn - 8) >> 2, ct = (pn - 8) & 3;
            bf16_t* base; int ldc = 1024; float sc = 1.f;
            if (seg == 0) base = V; else if (seg == 1) { base = UGQ + 1024; ldc = 2048; sc = qscale; } else if (seg == 2) base = K; else if (seg == 3) base = VB; else base = GB;
            base += ct * 256 + cw;
#pragma unroll
            for (int ai = 0; ai < 2; ++ai)
#pragma unroll
                for (int m = 0; m < 4; ++m) { bf16_t* rowp = base + (size_t)(row0 + ai * HALF + m * 16) * ldc; float ssum = 0.f, sq = 0.f;
#pragma unroll
                    for (int bj = 0; bj < 2; ++bj) { const u32x4 w = pack8(val(acc[ai][bj][m][0], rsc[ai][m], cs[bj][0]) * sc, val(acc[ai][bj][m][1], rsc[ai][m], cs[bj][1]) * sc);
                        __builtin_nontemporal_store(w, (u32x4*)(rowp + bj * HALF));
                        if (seg == 0) { f32x4 q0, q1; unpack8(w, q0, q1);
                            ssum += (q0[0] + q0[1]) + (q0[2] + q0[3]) + (q1[0] + q1[1]) + (q1[2] + q1[3]);
                            sq += (q0[0] * q0[0] + q0[1] * q0[1]) + (q0[2] * q0[2] + q0[3] * q0[3]) + (q1[0] * q1[0] + q1[1] * q1[1]) + (q1[2] * q1[2] + q1[3] * q1[3]); } }
                    if (seg == 0) { ssum += __shfl_xor(ssum, 16); ssum += __shfl_xor(ssum, 32); sq += __shfl_xor(sq, 16); sq += __shfl_xor(sq, 32);
                        if (fq == 0) { float* sp = VST + 2 * (size_t)(row0 + ai * HALF + m * 16); atomicAdd(sp, ssum); atomicAdd(sp + 1, sq); } } }
        }
    }
};
template <int SIG> struct EpiStore {
    static constexpr bool PERM = true, AFTER_DRAIN = false, HAS_MID = false;
    bf16_t *D0, *D1;
    __device__ __forceinline__ void operator()(const f32x4 (&acc)[2][2][4][2], const Unit& u, int wr, int wc, int fr, int fq) const {
        asm volatile("" : "+v"(fr), "+v"(fq));
        const int row0 = u.pm * BM + wr * 64 + fr, cw = wc * 32 + 8 * fq;
        bf16_t* base = (u.pn < 4 ? D0 : D1) + (u.pn & 3) * 256 + cw;
#pragma unroll
        for (int ai = 0; ai < 2; ++ai)
#pragma unroll
            for (int m = 0; m < 4; ++m) { bf16_t* rowp = base + (size_t)(row0 + ai * HALF + m * 16) * 1024;
#pragma unroll
                for (int bj = 0; bj < 2; ++bj) { f32x4 v0 = acc[ai][bj][m][0], v1 = acc[ai][bj][m][1];
                    if (SIG) {
#pragma unroll
                        for (int e = 0; e < 4; ++e) { v0[e] = sigm(v0[e]); v1[e] = sigm(v1[e]); } }
                    __builtin_nontemporal_store(pack8(v0, v1), (u32x4*)(rowp + bj * HALF)); } }
    }
};
struct EpiGate {
    static constexpr bool PERM = true, AFTER_DRAIN = false, HAS_MID = false;
    bf16_t *RHO, *SMB;
    __device__ __forceinline__ void operator()(const f32x4 (&acc)[2][2][4][2], const Unit& u, int wr, int wc, int fr, int fq) const {
        asm volatile("" : "+v"(fr), "+v"(fq));
        const int row0 = u.pm * BM + wr * 64 + fr, c0 = u.pn * 128 + wc * 32 + 8 * fq;
#pragma unroll
        for (int ai = 0; ai < 2; ++ai)
#pragma unroll
            for (int m = 0; m < 4; ++m) { const size_t off = (size_t)(row0 + ai * HALF + m * 16) * 1024 + c0;
                f32x4 r0, r1, s0, s1;
#pragma unroll
                for (int e = 0; e < 4; ++e) {
                    const float ea0 = __builtin_amdgcn_exp2f(fminf(-1.4426950408889634f * acc[ai][0][m][0][e], 80.f)), eb0 = __builtin_amdgcn_exp2f(fminf(-1.4426950408889634f * acc[ai][1][m][0][e], 80.f));
                    const float ea1 = __builtin_amdgcn_exp2f(fminf(-1.4426950408889634f * acc[ai][0][m][1][e], 80.f)), eb1 = __builtin_amdgcn_exp2f(fminf(-1.4426950408889634f * acc[ai][1][m][1][e], 80.f));
                    r0[e] = (1.f + eb0) * __builtin_amdgcn_rcpf(1.f + ea0); r1[e] = (1.f + eb1) * __builtin_amdgcn_rcpf(1.f + ea1);
                    s0[e] = __builtin_amdgcn_rcpf(1.f + eb0); s1[e] = __builtin_amdgcn_rcpf(1.f + eb1); }
                *(u32x4*)(RHO + off) = pack8(r0, r1); *(u32x4*)(SMB + off) = pack8(s0, s1); }
    }
};
struct EpiGateQ {
    static constexpr bool PERM = true, AFTER_DRAIN = false, HAS_MID = false;
    bf16_t *RHO, *SMB; const float* XS; const float* CS;
    __device__ __forceinline__ void operator()(const f32x4 (&acc)[2][2][4][2], const Unit& u, int wr, int wc, int fr, int fq) const {
        asm volatile("" : "+v"(fr), "+v"(fq));
        const int row0 = u.pm * BM + wr * 64 + fr, c0 = u.pn * 128 + wc * 32 + 8 * fq;
        float rsc[2][4]; f32x4 cs[2][2];
#pragma unroll
        for (int ai = 0; ai < 2; ++ai)
#pragma unroll
            for (int m = 0; m < 4; ++m) rsc[ai][m] = XS[row0 + ai * HALF + m * 16] * (1.f / (127.f * 127.f));
#pragma unroll
        for (int bj = 0; bj < 2; ++bj) { const int ci = u.pn * BM + bj * HALF + wc * 32 + 8 * fq; cs[bj][0] = *(const f32x4*)(CS + ci); cs[bj][1] = *(const f32x4*)(CS + ci + 4); }
#pragma unroll
        for (int ai = 0; ai < 2; ++ai)
#pragma unroll
            for (int m = 0; m < 4; ++m) { const size_t off = (size_t)(row0 + ai * HALF + m * 16) * 1024 + c0;
                f32x4 r0, r1, s0, s1;
#pragma unroll
                for (int e = 0; e < 4; ++e) {
                    const i32x4 qa0 = __builtin_bit_cast(i32x4, acc[ai][0][m][0]), qa1 = __builtin_bit_cast(i32x4, acc[ai][0][m][1]), qb0 = __builtin_bit_cast(i32x4, acc[ai][1][m][0]), qb1 = __builtin_bit_cast(i32x4, acc[ai][1][m][1]);
                    const float ma0 = (float)qa0[e] * (rsc[ai][m] * cs[0][0][e]), ma1 = (float)qa1[e] * (rsc[ai][m] * cs[0][1][e]);
                    const float mb0 = (float)qb0[e] * (rsc[ai][m] * cs[1][0][e]), mb1 = (float)qb1[e] * (rsc[ai][m] * cs[1][1][e]);
                    const float ea0 = __builtin_amdgcn_exp2f(fminf(-1.4426950408889634f * ma0, 80.f)), eb0 = __builtin_amdgcn_exp2f(fminf(-1.4426950408889634f * mb0, 80.f));
                    const float ea1 = __builtin_amdgcn_exp2f(fminf(-1.4426950408889634f * ma1, 80.f)), eb1 = __builtin_amdgcn_exp2f(fminf(-1.4426950408889634f * mb1, 80.f));
                    r0[e] = (1.f + eb0) * __builtin_amdgcn_rcpf(1.f + ea0); r1[e] = (1.f + eb1) * __builtin_amdgcn_rcpf(1.f + ea1);
                    s0[e] = __builtin_amdgcn_rcpf(1.f + eb0); s1[e] = __builtin_amdgcn_rcpf(1.f + eb1); }
                *(u32x4*)(RHO + off) = pack8(r0, r1); *(u32x4*)(SMB + off) = pack8(s0, s1); }
    }
};
struct Epi2 {
    static constexpr bool PERM = true, AFTER_DRAIN = false, HAS_MID = true;
    const bf16_t *SMA, *SMB; bf16_t* OUT;
    __device__ __forceinline__ void mid(f32x4 (&acc)[2][2][4][2], const Unit& u, int wr, int wc, int fr, int fq) const {
        asm volatile("" : "+v"(fr), "+v"(fq));
        const int row0 = u.pm * BM + wr * 64 + fr, c0 = u.pn * BM + wc * 32 + 8 * fq;
#pragma unroll
        for (int ai = 0; ai < 2; ++ai) {
            u32x4 wa[4][2];
#pragma unroll
            for (int m = 0; m < 4; ++m) { const size_t off = (size_t)(row0 + ai * HALF + m * 16) * 1024 + c0;
#pragma unroll
                for (int bj = 0; bj < 2; ++bj) wa[m][bj] = *(const u32x4*)(SMA + off + bj * HALF); }
            PG8_FENCE;
#pragma unroll
            for (int m = 0; m < 4; ++m)
#pragma unroll
                for (int bj = 0; bj < 2; ++bj) { f32x4 a0, a1; unpack8(wa[m][bj], a0, a1); acc[ai][bj][m][0] *= a0; acc[ai][bj][m][1] *= a1; }
            PG8_FENCE; }
    }
    __device__ __forceinline__ void operator()(const f32x4 (&acc)[2][2][4][2], const Unit& u, int wr, int wc, int fr, int fq) const {
        asm volatile("" : "+v"(fr), "+v"(fq));
        const int row0 = u.pm * BM + wr * 64 + fr, c0 = u.pn * BM + wc * 32 + 8 * fq;
        u32x4 wb[2][4][2];
#pragma unroll
        for (int ai = 0; ai < 2; ++ai)
#pragma unroll
            for (int m = 0; m < 4; ++m) { const size_t off = (size_t)(row0 + ai * HALF + m * 16) * 1024 + c0;
#pragma unroll
                for (int bj = 0; bj < 2; ++bj) wb[ai][m][bj] = *(const u32x4*)(SMB + off + bj * HALF); }
        PG8_FENCE;
#pragma unroll
        for (int ai = 0; ai < 2; ++ai)
#pragma unroll
            for (int m = 0; m < 4; ++m) { const size_t off = (size_t)(row0 + ai * HALF + m * 16) * 1024 + c0;
#pragma unroll
                for (int bj = 0; bj < 2; ++bj) { f32x4 b0, b1; unpack8(wb[ai][m][bj], b0, b1);
                    *(u32x4*)(OUT + off + bj * HALF) = pack8(acc[ai][bj][m][0] * b0, acc[ai][bj][m][1] * b1); } }
    }
};
struct Epi3 {
    static constexpr bool PERM = true, AFTER_DRAIN = false, HAS_MID = false;
    const bf16_t* XH; bf16_t* XO; float alpha;
    __device__ __forceinline__ void operator()(const f32x4 (&acc)[2][2][4][2], const Unit& u, int wr, int wc, int fr, int fq) const {
        asm volatile("" : "+v"(fr), "+v"(fq));
        const int row0 = u.pm * BM + wr * 64 + fr, c0 = u.pn * BM + wc * 32 + 8 * fq;
#pragma unroll
        for (int ai = 0; ai < 2; ++ai) {
            u32x4 wx[4][2];
#pragma unroll
            for (int m = 0; m < 4; ++m) { const size_t off = (size_t)(row0 + ai * HALF + m * 16) * 1024 + c0;
#pragma unroll
                for (int bj = 0; bj < 2; ++bj) wx[m][bj] = *(const u32x4*)(XH + off + bj * HALF); }
            PG8_FENCE;
#pragma unroll
            for (int m = 0; m < 4; ++m) { const size_t off = (size_t)(row0 + ai * HALF + m * 16) * 1024 + c0;
#pragma unroll
                for (int bj = 0; bj < 2; ++bj) { f32x4 r0, r1; unpack8h(wx[m][bj], r0, r1);
                    const f32x4 h0 = r0 * alpha + acc[ai][bj][m][0], h1 = r1 * alpha + acc[ai][bj][m][1];
                    *(u32x4*)(XO + off + bj * HALF) = pack8h(h0, h1); } }
            PG8_FENCE; }
    }
};
struct Epi4 {
    static constexpr bool PERM = true, AFTER_DRAIN = false, HAS_MID = false;
    const bf16_t* H0; bf16_t* XO; const bf16_t* E;
    __device__ __forceinline__ void operator()(const f32x4 (&acc)[2][2][4][2], const Unit& u, int wr, int wc, int fr, int fq) const {
        asm volatile("" : "+v"(fr), "+v"(fq));
        const int row0 = u.pm * BM + wr * 64 + fr, c0 = u.pn * BM + wc * 32 + 8 * fq;
#pragma unroll
        for (int ai = 0; ai < 2; ++ai) {
            u32x4 wx[4][2], we[4][2];
#pragma unroll
            for (int m = 0; m < 4; ++m) { const size_t off = (size_t)(row0 + ai * HALF + m * 16) * 1024 + c0;
#pragma unroll
                for (int bj = 0; bj < 2; ++bj) { wx[m][bj] = *(const u32x4*)(H0 + off + bj * HALF); we[m][bj] = *(const u32x4*)(E + off + bj * HALF); } }
            PG8_FENCE;
#pragma unroll
            for (int m = 0; m < 4; ++m) { const size_t off = (size_t)(row0 + ai * HALF + m * 16) * 1024 + c0;
#pragma unroll
                for (int bj = 0; bj < 2; ++bj) { f32x4 h0, h1, e0, e1; unpack8h(wx[m][bj], h0, h1); unpack8(we[m][bj], e0, e1);
#pragma unroll
                    for (int e = 0; e < 4; ++e) { h0[e] += e0[e] * sigm(acc[ai][bj][m][0][e]); h1[e] += e1[e] * sigm(acc[ai][bj][m][1][e]); }
                    *(u32x4*)(XO + off + bj * HALF) = pack8h(h0, h1); } }
            PG8_FENCE; }
    }
};
template <class Epi, class Sched, bool ALIGN_EPI = false, bool SP2 = false, int MODE = 0>
__device__ __forceinline__ void gemm_phase(PG8_LAS unsigned char* lds, const Gemm g, const Sched& S, const Epi& E) {
    int tid_ = threadIdx.x; asm volatile("" : "+v"(tid_));
    const int tid = tid_, wid = __builtin_amdgcn_readfirstlane(tid >> 6), lane = tid & 63, wr = wid >> 2, wc = wid & 3, fr = lane & 15, fq = lane >> 4;
    const int K = g.K, nt = K / BK;
    unsigned voffA[2], voffB[2];
#pragma unroll
    for (int i = 0; i < 2; ++i) { int R, C; stage_rc(tid * 16 + i * 8192, R, C); const int Rb = Epi::PERM ? ((R & ~31) + perm32(R & 31)) : R;
        voffA[i] = (unsigned)(R * g.lda + C) * 2u; voffB[i] = (unsigned)(Rb * K + C) * 2u; }
    const size_t kstep = (size_t)(BK * 2);
    const size_t hstepA = (size_t)HALF * g.lda * 2, hstepB = (size_t)HALF * K * 2;
    const size_t tstepA = 2 * hstepA, tstepB = 2 * hstepB;
    const unsigned ldsw = (unsigned)wid * 1024u;
    const int aoff = lds_byte(wr * 64 + fr, fq * 8), boff = lds_byte(wc * 32 + fr, fq * 8);
#define PG8_SA(b, h) (((b) * 2 + (h)) * HTB)
#define PG8_SB(b, h) ((4 + (b) * 2 + (h)) * HTB)
#define PG8_STAGE(bufoff, gbase, voff) do { _Pragma("unroll") for (int _i = 0; _i < 2; ++_i) \
        __builtin_amdgcn_global_load_lds((const unsigned*)((const char*)(gbase) + (voff)[_i]), (PG8_LAS unsigned*)(lds + (bufoff) + ldsw + _i * 8192), 16, 0, 0); } while (0)
#define PG8_LDA(dst, b, h) do { _Pragma("unroll") for (int m = 0; m < 4; ++m) _Pragma("unroll") for (int k = 0; k < 2; ++k) dst[m][k] = *(const PG8_LAS bf16x8*)(lds + PG8_SA(b, h) + aoff + m * 2048 + k * 1024); } while (0)
#define PG8_LDB(dst, b, h) do { _Pragma("unroll") for (int n = 0; n < 2; ++n) _Pragma("unroll") for (int k = 0; k < 2; ++k) dst[n][k] = *(const PG8_LAS bf16x8*)(lds + PG8_SB(b, h) + boff + n * 2048 + k * 1024); } while (0)
#define PG8_MMA(ai, bj, At, Bt) do { __builtin_amdgcn_s_setprio(1); _Pragma("unroll") for (int m = 0; m < 4; ++m) _Pragma("unroll") for (int n = 0; n < 2; ++n) _Pragma("unroll") for (int k = 0; k < 2; ++k) \
        { if constexpr (MODE == 2) acc[ai][bj][m][n] = __builtin_bit_cast(f32x4, __builtin_amdgcn_mfma_i32_16x16x64_i8(__builtin_bit_cast(i32x4, Bt[n][k]), __builtin_bit_cast(i32x4, At[m][k]), __builtin_bit_cast(i32x4, acc[ai][bj][m][n]), 0, 0, 0)); \
          else if constexpr (MODE == 1) acc[ai][bj][m][n] = __builtin_amdgcn_mfma_f32_16x16x32_f16(__builtin_bit_cast(f16x8, Bt[n][k]), __builtin_bit_cast(f16x8, At[m][k]), acc[ai][bj][m][n], 0, 0, 0); \
          else acc[ai][bj][m][n] = __builtin_amdgcn_mfma_f32_16x16x32_bf16(Bt[n][k], At[m][k], acc[ai][bj][m][n], 0, 0, 0); } __builtin_amdgcn_s_setprio(0); } while (0)
#define PG8_WAIT_V(n) asm volatile("s_waitcnt vmcnt(" #n ")" ::: "memory")
#define PG8_WAIT_L(n) asm volatile("s_waitcnt lgkmcnt(" #n ")" ::: "memory")
#define PG8_BAR __builtin_amdgcn_s_barrier()
#define PG8_SCHED __builtin_amdgcn_sched_barrier(0)
    Unit cur, nxt; int ui = 0;
    if (!S.next(0, cur)) return;
    f32x4 acc[2][2][4][2];
#pragma unroll
    for (int a = 0; a < 2; ++a)
#pragma unroll
        for (int b = 0; b < 2; ++b)
#pragma unroll
            for (int m = 0; m < 4; ++m)
#pragma unroll
                for (int n = 0; n < 2; ++n) acc[a][b][m][n] = (f32x4){0.f, 0.f, 0.f, 0.f};
    bf16x8 At[4][2], B0[2][2], B1[2][2];
    const char* cA = (const char*)g.A + (size_t)cur.pm * tstepA; const char* cB = (const char*)g.Bt + (size_t)cur.pn * tstepB;
    S.a_ready(cur);
    if constexpr (SP2) {
        PG8_STAGE(PG8_SB(0, 0), cB, voffB); PG8_STAGE(PG8_SB(0, 1), cB + hstepB, voffB); PG8_STAGE(PG8_SA(0, 0), cA, voffA); PG8_STAGE(PG8_SA(0, 1), cA + hstepA, voffA);
        if (wr == 1) PG8_BAR;
        PG8_WAIT_V(2); PG8_BAR;
        PG8_STAGE(PG8_SB(1, 0), cB + kstep, voffB); PG8_STAGE(PG8_SA(1, 0), cA + kstep, voffA); PG8_STAGE(PG8_SB(1, 1), cB + hstepB + kstep, voffB);
        PG8_WAIT_V(6); PG8_BAR;
    } else {
        PG8_STAGE(PG8_SB(0, 0), cB, voffB); PG8_STAGE(PG8_SA(0, 0), cA, voffA); PG8_STAGE(PG8_SB(0, 1), cB + hstepB, voffB); PG8_STAGE(PG8_SA(0, 1), cA + hstepA, voffA);
        if (wr == 1) PG8_BAR;
        PG8_WAIT_V(4); PG8_BAR;
        PG8_STAGE(PG8_SB(1, 0), cB + kstep, voffB); PG8_STAGE(PG8_SA(1, 0), cA + kstep, voffA); PG8_STAGE(PG8_SB(1, 1), cB + hstepB + kstep, voffB);
        PG8_WAIT_V(6); PG8_BAR;
    }
    for (;;) {
        const bool has_next = S.next(ui + 1, nxt);
        const char* nA = has_next ? (const char*)g.A + (size_t)nxt.pm * tstepA : cA; const char* nB = has_next ? (const char*)g.Bt + (size_t)nxt.pn * tstepB : cB;
        for (int t = 0; t < nt; t += 2) { if constexpr (Epi::HAS_MID) { if (t == (nt >> 1)) E.mid(acc, cur, wr, wc, fr, fq); }
            const bool last = (t == nt - 2);
            const char* a1 = cA + (size_t)(t + 1) * kstep;
            const char* a2 = last ? nA : cA + (size_t)(t + 2) * kstep; const char* b2 = last ? nB : cB + (size_t)(t + 2) * kstep;
            const char* a3 = a2 + kstep; const char* b3 = b2 + kstep;
            if (last && has_next) S.a_ready(nxt);
            if constexpr (SP2) {
            PG8_LDB(B0, 0, 0); PG8_LDB(B1, 0, 1); PG8_SCHED; PG8_LDA(At, 0, 0); PG8_STAGE(PG8_SA(1, 1), a1 + hstepA, voffA);
            PG8_WAIT_V(8); PG8_WAIT_L(0); PG8_BAR; PG8_MMA(0, 0, At, B0); PG8_MMA(0, 1, At, B1); PG8_BAR; PG8_SCHED;
            PG8_LDA(At, 0, 1); PG8_STAGE(PG8_SB(0, 0), b2, voffB); PG8_STAGE(PG8_SB(0, 1), b2 + hstepB, voffB); PG8_STAGE(PG8_SA(0, 0), a2, voffA);
            PG8_WAIT_V(8); PG8_WAIT_L(0); PG8_BAR; PG8_MMA(1, 0, At, B0); PG8_MMA(1, 1, At, B1); PG8_BAR; PG8_SCHED;
            PG8_LDB(B0, 1, 0); PG8_LDB(B1, 1, 1); PG8_SCHED; PG8_LDA(At, 1, 0); PG8_STAGE(PG8_SA(0, 1), a2 + hstepA, voffA);
            PG8_WAIT_V(8); PG8_WAIT_L(0); PG8_BAR; PG8_MMA(0, 0, At, B0); PG8_MMA(0, 1, At, B1); PG8_BAR; PG8_SCHED;
            PG8_LDA(At, 1, 1); PG8_STAGE(PG8_SB(1, 0), b3, voffB); PG8_STAGE(PG8_SB(1, 1), b3 + hstepB, voffB); PG8_STAGE(PG8_SA(1, 0), a3, voffA);
            PG8_WAIT_V(8); PG8_WAIT_L(0); PG8_BAR; PG8_MMA(1, 0, At, B0); PG8_MMA(1, 1, At, B1); PG8_BAR; PG8_SCHED;
            } else {
            PG8_LDB(B0, 0, 0); PG8_SCHED; PG8_LDA(At, 0, 0); PG8_STAGE(PG8_SA(1, 1), a1 + hstepA, voffA);
            PG8_WAIT_L(8); PG8_BAR; PG8_WAIT_L(0); PG8_MMA(0, 0, At, B0); PG8_BAR; PG8_SCHED;
            PG8_LDB(B1, 0, 1); PG8_STAGE(PG8_SB(0, 0), b2, voffB);
            PG8_BAR; PG8_WAIT_L(0); PG8_MMA(0, 1, At, B1); PG8_BAR;
            PG8_LDA(At, 0, 1); PG8_STAGE(PG8_SA(0, 0), a2, voffA);
            PG8_BAR; PG8_WAIT_L(0); PG8_MMA(1, 0, At, B0); PG8_BAR; PG8_SCHED;
            PG8_STAGE(PG8_SB(0, 1), b2 + hstepB, voffB);
            PG8_WAIT_V(6); PG8_BAR; PG8_MMA(1, 1, At, B1); PG8_BAR;
            PG8_LDB(B0, 1, 0); PG8_SCHED; PG8_LDA(At, 1, 0); PG8_STAGE(PG8_SA(0, 1), a2 + hstepA, voffA);
            PG8_WAIT_L(8); PG8_BAR; PG8_WAIT_L(0); PG8_MMA(0, 0, At, B0); PG8_BAR; PG8_SCHED;
            PG8_LDB(B1, 1, 1); PG8_STAGE(PG8_SB(1, 0), b3, voffB);
            PG8_BAR; PG8_WAIT_L(0); PG8_MMA(0, 1, At, B1); PG8_BAR;
            PG8_LDA(At, 1, 1); PG8_STAGE(PG8_SA(1, 0), a3, voffA);
            PG8_BAR; PG8_WAIT_L(0); PG8_MMA(1, 0, At, B0); PG8_BAR; PG8_SCHED;
            PG8_STAGE(PG8_SB(1, 1), b3 + hstepB, voffB);
            PG8_WAIT_V(6); PG8_BAR; PG8_MMA(1, 1, At, B1); PG8_BAR;
            }
        }
        if constexpr (ALIGN_EPI) { if (wr == 0) PG8_BAR; }
        if constexpr (!Epi::AFTER_DRAIN) { E(acc, cur, wr, wc, fr, fq); S.done(cur); }
        if (!has_next) break;
#pragma unroll
        for (int a = 0; a < 2; ++a)
#pragma unroll
            for (int b = 0; b < 2; ++b)
#pragma unroll
                for (int m = 0; m < 4; ++m)
#pragma unroll
                    for (int n = 0; n < 2; ++n) acc[a][b][m][n] = (f32x4){0.f, 0.f, 0.f, 0.f};
        cur = nxt; cA = nA; cB = nB; ++ui;
        if constexpr (ALIGN_EPI) { if (wr == 1) PG8_BAR; }
    }
    PG8_WAIT_V(0);
    if constexpr (!ALIGN_EPI) { if (wr == 0) PG8_BAR; }
    PG8_BAR;
    if constexpr (Epi::AFTER_DRAIN) { E.fused(acc, cur, wr, wc, fr, fq, lds, wid, lane); S.done(cur); }
#undef PG8_SA
#undef PG8_SB
#undef PG8_STAGE
#undef PG8_LDA
#undef PG8_LDB
#undef PG8_MMA
#undef PG8_WAIT_V
#undef PG8_WAIT_L
#undef PG8_BAR
#undef PG8_SCHED
}
}
#define LAS __attribute__((address_space(3)))
typedef unsigned short bf16;
typedef unsigned u32x4 __attribute__((ext_vector_type(4)));
typedef unsigned u32x2 __attribute__((ext_vector_type(2)));
typedef float f32x4 __attribute__((ext_vector_type(4)));
typedef float f32x16 __attribute__((ext_vector_type(16)));
typedef short bf16x8 __attribute__((ext_vector_type(8)));
constexpr int DM = 1024, NBATCH = 8, SEQ = 4096, T = NBATCH * SEQ, DEPTH = 4, PLE = 256, NIN = 9216, NHEAD = 16, HD = 64;
constexpr float LN_EPS = 1e-5f;
constexpr float ALPHA = 1.681792830507429f;
constexpr float QSCALE = 0.125f * 1.4426950408889634f;
constexpr size_t MiB = 1u << 20;
constexpr size_t WS_WIN = 0, WS_W2 = 18 * MiB, WS_WO = 22 * MiB, WS_WG = 24 * MiB, WS_WE = 26 * MiB, WS_WS = 27 * MiB, WS_PB = 28 * MiB, WS_XH1 = 44 * MiB,
                 WS_UGQ = 108 * MiB, WS_V = 236 * MiB, WS_K = 300 * MiB, WS_VB = 364 * MiB, WS_GB = 428 * MiB, WS_CTL = 492 * MiB, WS_XH = 493 * MiB, WS_XS = 557 * MiB  , WS_CMAX = WS_XS + 256 * 1024  , WS_CMAX1 = WS_CMAX + 32 * 1024  , WS_VST = WS_XS + 512 * 1024  , WS_END = 558 * MiB;
constexpr size_t OUT_XQ = 64 * MiB;
constexpr int LDS_BYTES = 147456, RING_BYTES = 131072;

__device__ __forceinline__ float wave_sum(float v) {
#pragma unroll
    for (int o = 1; o < 64; o <<= 1) v += __shfl_xor(v, o);
    return v;
}
__device__ __forceinline__ unsigned pk2(float lo, float hi) { return pg8::cvt_pk_bf16(lo, hi); }
__device__ __forceinline__ float bf_lo(unsigned w) { return __uint_as_float(w << 16); }
__device__ __forceinline__ float bf_hi(unsigned w) { return __uint_as_float(w & 0xffff0000u); }

template <bool F16 = false> __device__ __forceinline__ void tr_item(const float* W, int N, bf16* WT, int ldk, int koff, int k0, int n0, int drow0, LAS float* scr, int lane) {
#pragma unroll 8
    for (int i = 0; i < 32; ++i) { const int kk = 2 * i + (lane >> 5); scr[kk * 33 + (lane & 31)] = W[(size_t)(k0 + kk) * N + n0 + (lane & 31)]; }
    asm volatile("s_waitcnt lgkmcnt(0)" ::: "memory");
    const int c = lane & 7;
#pragma unroll
    for (int j = 0; j < 4; ++j) { const int n = (lane >> 3) + 8 * j; const LAS float* s = scr + (8 * c) * 33 + n;
        u32x4 o;
        if constexpr (F16) { o.x = pg8::cvt_pk_f16(s[0 * 33], s[1 * 33]); o.y = pg8::cvt_pk_f16(s[2 * 33], s[3 * 33]); o.z = pg8::cvt_pk_f16(s[4 * 33], s[5 * 33]); o.w = pg8::cvt_pk_f16(s[6 * 33], s[7 * 33]); }
        else { o.x = pk2(s[0 * 33], s[1 * 33]); o.y = pk2(s[2 * 33], s[3 * 33]); o.z = pk2(s[4 * 33], s[5 * 33]); o.w = pk2(s[6 * 33], s[7 * 33]); }
        *(u32x4*)(WT + (size_t)(drow0 + n) * ldk + koff + k0 + 8 * c) = o; }
    asm volatile("s_waitcnt lgkmcnt(0)" ::: "memory");
}
__device__ __forceinline__ float wave_max(float v) {
#pragma unroll
    for (int o = 1; o < 64; o <<= 1) v = fmaxf(v, __shfl_xor(v, o));
    return v;
}
__device__ __forceinline__ unsigned q4(float a, float b, float c, float d, float inv) {
    const int ia = (int)__builtin_rintf(a * inv), ib = (int)__builtin_rintf(b * inv), ic = (int)__builtin_rintf(c * inv), id = (int)__builtin_rintf(d * inv);
    return (unsigned)(ia & 0xff) | ((unsigned)(ib & 0xff) << 8) | ((unsigned)(ic & 0xff) << 16) | ((unsigned)(id & 0xff) << 24);
}
__device__ __forceinline__ int win_dest_row(int c);
__device__ __forceinline__ void tr_item_q(const float* W, const float* cmax, unsigned char* WQ, int k0, int n0, int qrow0, LAS float* scr, int lane) {
#pragma unroll 8
    for (int i = 0; i < 32; ++i) { const int kk = 2 * i + (lane >> 5); scr[kk * 33 + (lane & 31)] = W[(size_t)(k0 + kk) * NIN + n0 + (lane & 31)]; }
    asm volatile("s_waitcnt lgkmcnt(0)" ::: "memory");
    const int c16 = lane & 3;
#pragma unroll
    for (int j = 0; j < 2; ++j) { const int n = (lane >> 2) + 16 * j; const LAS float* sp = scr + (16 * c16) * 33 + n;
        const float cm = cmax[qrow0 + n], inv = cm > 0.f ? 127.f / cm : 0.f;
        u32x4 o; o.x = q4(sp[0 * 33], sp[1 * 33], sp[2 * 33], sp[3 * 33], inv); o.y = q4(sp[4 * 33], sp[5 * 33], sp[6 * 33], sp[7 * 33], inv);
        o.z = q4(sp[8 * 33], sp[9 * 33], sp[10 * 33], sp[11 * 33], inv); o.w = q4(sp[12 * 33], sp[13 * 33], sp[14 * 33], sp[15 * 33], inv);
        *(u32x4*)(WQ + (size_t)(qrow0 + n) * 1024 + k0 + 16 * c16) = o; }
    asm volatile("s_waitcnt lgkmcnt(0)" ::: "memory");
}
__device__ __forceinline__ int win_dest_row(int c) {
    if (c < 1024) return 256 * (c >> 7) + (c & 127);
    if (c < 2048) return 2048 + (c - 1024);
    if (c < 3072) { const int cc = c - 2048; return 256 * (cc >> 7) + 128 + (cc & 127); }
    if (c < 7168) return c;
    if (c < 8192) { const int cc = c - 7168; return 7168 + 256 * (cc >> 7) + (cc & 127); }
    { const int cc = c - 8192; return 7168 + 256 * (cc >> 7) + 128 + (cc & 127); }
}
struct Args { const float* in[14]; float* out; unsigned char* ws; };
__device__ __forceinline__ void win_item(const Args& a, int l, unsigned char* wb, int kb, int nb, int what, LAS float* scr, int lane) {
    const float* w_in = a.in[2] + (size_t)l * DM * NIN; const int drow0 = win_dest_row(32 * nb);
    if (drow0 >= 7168) { if (what >= 1) tr_item_q(w_in, (const float*)(a.ws + WS_CMAX) + l * 2048, wb + WS_WIN + (size_t)7168 * 2048, 64 * kb, 32 * nb, drow0 - 7168, scr, lane); return; }
    const int slot = pg8::p1_qslot(drow0 >> 8);
    if (slot >= 0) { if (what >= 1) tr_item_q(w_in, (const float*)(a.ws + WS_CMAX1) + l * (pg8::P1_NQ * 256), wb + WS_WIN, 64 * kb, 32 * nb, slot * 256 + (drow0 & 255), scr, lane); return; }
    if (what != 1) tr_item<true>(w_in, NIN, (bf16*)(wb + WS_WIN), 1024, 0, 64 * kb, 32 * nb, drow0, scr, lane);
}

__device__ __forceinline__ void convert_layer(const Args& a, int l, LAS unsigned char* lds, int gw, int NGW, int lane, int wave, bool gates = true) {
    LAS float* scr = (LAS float*)(lds + wave * 8704);
    unsigned char* ws = (l & 1) ? (unsigned char*)a.out : a.ws;
    const float* w_in = a.in[2] + (size_t)l * DM * NIN;
    const float* w_pa = a.in[7] + (size_t)l * DM * DM; const float* w_pb = a.in[8] + (size_t)l * DM * DM; const float* w_out = a.in[9] + (size_t)l * DM * DM;
    const float* w_pe = a.in[10] + (size_t)l * PLE * DM; const float* w_pg = a.in[11] + (size_t)l * DM * DM;
    constexpr int I_IN = 16 * (NIN / 32), I_SQ = 16 * 32, I_PE = 4 * 32, NITEMS = I_IN + 4 * I_SQ + I_PE;
    for (int it = gw; it < NITEMS; it += NGW) {
        int r = it;
        if (r < I_IN) { win_item(a, l, ws, r / (NIN / 32), r % (NIN / 32), gates ? 2 : 0, scr, lane); continue; } r -= I_IN;
        if (r < I_SQ) { tr_item(w_pa, DM, (bf16*)(ws + WS_W2), 2048, 0, 64 * (r >> 5), 32 * (r & 31), 32 * (r & 31), scr, lane); continue; } r -= I_SQ;
        if (r < I_SQ) { tr_item(w_pb, DM, (bf16*)(ws + WS_W2), 2048, 1024, 64 * (r >> 5), 32 * (r & 31), 32 * (r & 31), scr, lane); continue; } r -= I_SQ;
        if (r < I_SQ) { tr_item(w_out, DM, (bf16*)(ws + WS_WO), 1024, 0, 64 * (r >> 5), 32 * (r & 31), 32 * (r & 31), scr, lane); continue; } r -= I_SQ;
        if (r < I_SQ) { tr_item<true>(w_pg, DM, (bf16*)(ws + WS_WG), 1024, 0, 64 * (r >> 5), 32 * (r & 31), 32 * (r & 31), scr, lane); continue; } r -= I_SQ;
        tr_item(w_pe, DM, (bf16*)(ws + WS_WE), 256, 0, 64 * (r >> 5), 32 * (r & 31), 32 * (r & 31), scr, lane);
    }
    const int gt = gw * 64 + lane, NGT = NGW * 64;
    { const float* w_s = a.in[5] + (size_t)l * 8 * 128 * 128; bf16* WsB = (bf16*)(ws + WS_WS);
      for (int p = gt; p < 8 * 128 * 16; p += NGT) { const int s0 = (p & 15) * 8, t = (p >> 4) & 127;
          const f32x4 x0 = *(const f32x4*)(w_s + (size_t)p * 8), x1 = *(const f32x4*)(w_s + (size_t)p * 8 + 4);
          float v[8] = {x0[0], x0[1], x0[2], x0[3], x1[0], x1[1], x1[2], x1[3]};
#pragma unroll
          for (int j = 0; j < 8; ++j) v[j] = (s0 + j <= t) ? v[j] : 0.f;
          u32x4 o; o.x = pk2(v[0], v[1]); o.y = pk2(v[2], v[3]); o.z = pk2(v[4], v[5]); o.w = pk2(v[6], v[7]);
          *(u32x4*)(WsB + (size_t)p * 8) = o; } }
    { const float* p = a.in[1] + (size_t)l * T * PLE; bf16* PB = (bf16*)(ws + WS_PB);
      for (int q = gt; q < T * PLE / 8; q += NGT) { const f32x4 x0 = *(const f32x4*)(p + (size_t)q * 8), x1 = *(const f32x4*)(p + (size_t)q * 8 + 4);
          u32x4 o; o.x = pk2(x0[0], x0[1]); o.y = pk2(x0[2], x0[3]); o.z = pk2(x1[0], x1[1]); o.w = pk2(x1[2], x1[3]);
          *(u32x4*)(PB + (size_t)q * 8) = o; } }
}

constexpr int AT_K = 0, AT_V = 16384, AT_STG = 16384 + 2 * 9216, AT_STG_W = 8704;
__device__ __forceinline__ void attn_unit(int b, int h, int qb, bf16* UGQ, const bf16* Kb, const bf16* Vb, const bf16* GBb, LAS unsigned char* lds, int dry = 0) {
    int tid_ = threadIdx.x; asm volatile("" : "+v"(tid_));
    const int tid = tid_, lane = tid & 63, wid = __builtin_amdgcn_readfirstlane(tid >> 6), r32 = lane & 31, hi = lane >> 5;
    const size_t rowbase = (size_t)b * SEQ;
    const int q0 = qb * 256, qw = q0 + wid * 32;
    bf16x8 qr[4];
    { const bf16* qp = UGQ + (rowbase + qw + r32) * 2048 + 1024 + h * HD + hi * 8;
#pragma unroll
      for (int d0 = 0; d0 < 4; ++d0) qr[d0] = *(const bf16x8*)(qp + d0 * 16); }
    f32x16 o0, o1;
#pragma unroll
    for (int r = 0; r < 16; ++r) { o0[r] = 0.f; o1[r] = 0.f; }
    float C = 1.f; int alive = 1;
    volatile LAS unsigned* aflag = (volatile LAS unsigned*)(lds + RING_BYTES);
    const int NT = 4 * (qb + 1);
    const int lkey = lane, lch = wid;
    const int kk = lkey & 31, slot = (lkey & 32) | (8 * ((kk >> 2) & 3) + 4 * (kk >> 4) + (kk & 3));
    const bf16* kg = Kb + (rowbase + lkey) * 1024 + h * HD + lch * 8;
    const bf16* vg = Vb + (rowbase + lkey) * 1024 + h * HD + lch * 8;
    u32x4 kreg, vreg;
    kreg = *(const u32x4*)(kg + (size_t)(NT - 1) * 64 * 1024); vreg = *(const u32x4*)(vg + (size_t)(NT - 1) * 64 * 1024);
#define AT_WRITE(buf) do { *(LAS u32x4*)(lds + AT_K + (buf) * 8192 + lch * 1024 + slot * 16) = kreg; \
        LAS unsigned short* vt_ = (LAS unsigned short*)(lds + AT_V + (buf) * 9216) + (lch * 8) * 72 + lkey; \
        vt_[0 * 72] = (unsigned short)(vreg.x & 0xffffu); vt_[1 * 72] = (unsigned short)(vreg.x >> 16); vt_[2 * 72] = (unsigned short)(vreg.y & 0xffffu); vt_[3 * 72] = (unsigned short)(vreg.y >> 16); \
        vt_[4 * 72] = (unsigned short)(vreg.z & 0xffffu); vt_[5 * 72] = (unsigned short)(vreg.z >> 16); vt_[6 * 72] = (unsigned short)(vreg.w & 0xffffu); vt_[7 * 72] = (unsigned short)(vreg.w >> 16); } while (0)
    AT_WRITE(0);
    __syncthreads();
    const int qrel = qw + r32;
    for (int it = 0; it < NT; ++it) {
        const int kt = NT - 1 - it, cur = it & 1;
        if (it + 1 < NT) { kreg = *(const u32x4*)(kg + (size_t)(kt - 1) * 64 * 1024); vreg = *(const u32x4*)(vg + (size_t)(kt - 1) * 64 * 1024); }
        const int k0 = kt * 64;
        if (k0 < qw + 32 && alive) {
            const LAS unsigned char* kb = lds + AT_K + cur * 8192 + hi * 1024 + r32 * 16;
            f32x16 p0, p1;
#pragma unroll
            for (int r = 0; r < 16; ++r) { p0[r] = 0.f; p1[r] = 0.f; }
#pragma unroll
            for (int d0 = 0; d0 < 4; ++d0) {
                const bf16x8 a0 = *(const LAS bf16x8*)(kb + d0 * 2048), a1 = *(const LAS bf16x8*)(kb + d0 * 2048 + 512);
                p0 = __builtin_amdgcn_mfma_f32_32x32x16_bf16(a0, qr[d0], p0, 0, 0, 0);
                p1 = __builtin_amdgcn_mfma_f32_32x32x16_bf16(a1, qr[d0], p1, 0, 0, 0);
            }
#pragma unroll
            for (int r = 0; r < 16; ++r) { p0[r] = __builtin_amdgcn_rcpf(1.f + __builtin_amdgcn_exp2f(p0[r])); p1[r] = __builtin_amdgcn_rcpf(1.f + __builtin_amdgcn_exp2f(p1[r])); }
            if (k0 + 63 >= qw) {
                const int kb0 = k0 + 16 * hi;
#pragma unroll
                for (int r = 0; r < 16; ++r) { if (kb0 + r >= qrel) p0[r] = 1.f; if (kb0 + 32 + r >= qrel) p1[r] = 1.f; }
            }
#pragma unroll
            for (int r = 14; r >= 0; --r) { p0[r] *= p0[r + 1]; p1[r] *= p1[r + 1]; }
            const float L0 = p0[0], L1 = p1[0];
            const float pL0 = __shfl_xor(L0, 32), pL1 = __shfl_xor(L1, 32);
            const float tot1 = L1 * pL1;
            const float pre1 = hi ? C : C * pL1;
            const float pre0 = C * tot1 * (hi ? 1.f : pL0);
            C = C * tot1 * (L0 * pL0);
#pragma unroll
            for (int r = 0; r < 15; ++r) { p0[r] = pre0 * (p0[r + 1] - p0[r]); p1[r] = pre1 * (p1[r + 1] - p1[r]); }
            p0[15] = pre0 * (1.f - p0[15]); p1[15] = pre1 * (1.f - p1[15]);
            u32x4 w00, w01, w10, w11;
            w00.x = pk2(p0[0], p0[1]); w00.y = pk2(p0[2], p0[3]); w00.z = pk2(p0[4], p0[5]); w00.w = pk2(p0[6], p0[7]);
            w01.x = pk2(p0[8], p0[9]); w01.y = pk2(p0[10], p0[11]); w01.z = pk2(p0[12], p0[13]); w01.w = pk2(p0[14], p0[15]);
            w10.x = pk2(p1[0], p1[1]); w10.y = pk2(p1[2], p1[3]); w10.z = pk2(p1[4], p1[5]); w10.w = pk2(p1[6], p1[7]);
            w11.x = pk2(p1[8], p1[9]); w11.y = pk2(p1[10], p1[11]); w11.z = pk2(p1[12], p1[13]); w11.w = pk2(p1[14], p1[15]);
            const LAS unsigned char* vb = lds + AT_V + cur * 9216 + r32 * 144 + hi * 32;
#define AT_PV(W, off) do { const bf16x8 pf_ = __builtin_bit_cast(bf16x8, W); \
                const bf16x8 v0_ = *(const LAS bf16x8*)(vb + (off)), v1_ = *(const LAS bf16x8*)(vb + 4608 + (off)); \
                o0 = __builtin_amdgcn_mfma_f32_32x32x16_bf16(v0_, pf_, o0, 0, 0, 0); o1 = __builtin_amdgcn_mfma_f32_32x32x16_bf16(v1_, pf_, o1, 0, 0, 0); } while (0)
            AT_PV(w00, 0); AT_PV(w01, 16); AT_PV(w10, 64); AT_PV(w11, 80);
#undef AT_PV
            alive = __any(C != 0.f);
        }
        if (it + 1 < NT) AT_WRITE(cur ^ 1);
        if (lane == 0) aflag[(it & 1) * 8 + wid] = (unsigned)alive;
        __syncthreads();
        const unsigned fl = (lane < 8) ? aflag[(it & 1) * 8 + lane] : 0u;
        if (!__any(fl != 0u)) break;
    }
#undef AT_WRITE
    LAS float* stg = (LAS float*)(lds + AT_STG + wid * AT_STG_W);
#pragma unroll
    for (int g4 = 0; g4 < 4; ++g4) {
        *(LAS f32x4*)(stg + r32 * 68 + 8 * g4 + 4 * hi) = (f32x4){o0[4 * g4], o0[4 * g4 + 1], o0[4 * g4 + 2], o0[4 * g4 + 3]};
        *(LAS f32x4*)(stg + r32 * 68 + 32 + 8 * g4 + 4 * hi) = (f32x4){o1[4 * g4], o1[4 * g4 + 1], o1[4 * g4 + 2], o1[4 * g4 + 3]};
    }
    asm volatile("s_waitcnt lgkmcnt(0)" ::: "memory");
#pragma unroll
    for (int i = 0; i < 4; ++i) {
        const int row = i * 8 + (lane >> 3), ch = lane & 7;
        f32x4 a0 = *(const LAS f32x4*)(stg + row * 68 + ch * 8), a1 = *(const LAS f32x4*)(stg + row * 68 + ch * 8 + 4);
        const size_t tok = rowbase + qw + row;
        const u32x4 gw_ = *(const u32x4*)(GBb + tok * 1024 + h * HD + ch * 8);
        f32x4 g0, g1; pg8::unpack8(gw_, g0, g1);
#pragma unroll
        for (int e = 0; e < 4; ++e) { a0[e] *= g0[e] * pg8::sigm(g0[e]); a1[e] *= g1[e] * pg8::sigm(g1[e]); }
        if (!dry) *(u32x4*)(UGQ + tok * 2048 + 1024 + h * HD + ch * 8) = pg8::pack8(a0, a1);
    }
    asm volatile("s_waitcnt lgkmcnt(0)" ::: "memory");
}

constexpr int BA_STAT = 0, BA_GB = 1024, BA_VNT = 1024 + 8192, BA_OT = BA_VNT + 128 * 272;
typedef float f32x2_st __attribute__((ext_vector_type(2)));
__device__ __forceinline__ void brancha_unit(int chunk, bf16* UGQ, const bf16* Vb, const bf16* WsB, const float* VST, const float* vn_g, const float* vn_b, const float* b_s, LAS unsigned char* lds, int dry = 0) {
    int tid_ = threadIdx.x; asm volatile("" : "+v"(tid_));
    const int tid = tid_, lane = tid & 63, wid = __builtin_amdgcn_readfirstlane(tid >> 6), r32 = lane & 31, hi = lane >> 5;
    const size_t t0 = (size_t)chunk * 128;
    LAS float* stat = (LAS float*)(lds + BA_STAT);
    LAS float* gbl = (LAS float*)(lds + BA_GB);
    u32x4 vpc[4];
#pragma unroll
    for (int i = 0; i < 4; ++i) { const int p = tid + 512 * i, s = p >> 4, dc = p & 15; vpc[i] = *(const u32x4*)(Vb + (t0 + s) * 1024 + dc * 8); }
    gbl[tid] = vn_g[tid]; gbl[tid + 512] = vn_g[tid + 512]; gbl[1024 + tid] = vn_b[tid]; gbl[1536 + tid] = vn_b[tid + 512];
    if (tid < 128) { const f32x2_st st = *(const f32x2_st*)(VST + 2 * (t0 + tid));
        const float mean = st[0] * (1.f / 1024.f), var = fmaxf(st[1] * (1.f / 1024.f) - mean * mean, 0.f);
        stat[tid * 2] = mean; stat[tid * 2 + 1] = 1.0f / sqrtf(var + LN_EPS); }
    __syncthreads();
    const int dblk = wid & 3, tbp = wid >> 2;
    u32x4 ugp[4]; bf16x8 wf[2][8];
#define BA_LOAD_UG(g_) do { _Pragma("unroll") for (int i = 0; i < 4; ++i) { const int p = tid + 512 * i, t = p >> 4, dc = p & 15; ugp[i] = *(const u32x4*)(UGQ + (t0 + t) * 2048 + (g_) * 128 + dc * 8); } } while (0)
#define BA_LOAD_WS(g_) do { _Pragma("unroll") for (int j = 0; j < 2; ++j) { const int tb = 2 * tbp + j; const bf16* wrow = WsB + ((size_t)(g_) * 128 + 32 * tb + r32) * 128 + hi * 8; \
        _Pragma("unroll") for (int ks = 0; ks < 8; ++ks) if (ks < 2 * (tb + 1)) wf[j][ks] = *(const bf16x8*)(wrow + ks * 16); } } while (0)
    BA_LOAD_WS(0); BA_LOAD_UG(0);
    for (int g = 0; g < 8; ++g) {
#pragma unroll
        for (int i = 0; i < 4; ++i) {
            const int p = tid + 512 * i, s = p >> 4, dc = p & 15;
            f32x4 v0, v1; pg8::unpack8(vpc[i], v0, v1);
            const f32x4 ga = *(const LAS f32x4*)(gbl + g * 128 + dc * 8), gb2 = *(const LAS f32x4*)(gbl + g * 128 + dc * 8 + 4);
            const f32x4 ba = *(const LAS f32x4*)(gbl + 1024 + g * 128 + dc * 8), bb2 = *(const LAS f32x4*)(gbl + 1024 + g * 128 + dc * 8 + 4);
            const float mean = stat[s * 2], rstd = stat[s * 2 + 1];
            v0 = (v0 - mean) * rstd * ga + ba; v1 = (v1 - mean) * rstd * gb2 + bb2;
            const u32x4 w = pg8::pack8(v0, v1);
            LAS unsigned short* dst = (LAS unsigned short*)(lds + BA_VNT) + dc * 136 + s;
            dst[0 * 16 * 136] = (unsigned short)(w.x & 0xffffu); dst[1 * 16 * 136] = (unsigned short)(w.x >> 16); dst[2 * 16 * 136] = (unsigned short)(w.y & 0xffffu); dst[3 * 16 * 136] = (unsigned short)(w.y >> 16);
            dst[4 * 16 * 136] = (unsigned short)(w.z & 0xffffu); dst[5 * 16 * 136] = (unsigned short)(w.z >> 16); dst[6 * 16 * 136] = (unsigned short)(w.w & 0xffffu); dst[7 * 16 * 136] = (unsigned short)(w.w >> 16);
        }
        if (g + 1 < 8) {
#pragma unroll
            for (int i = 0; i < 4; ++i) { const int p = tid + 512 * i, s = p >> 4, dc = p & 15; vpc[i] = *(const u32x4*)(Vb + (t0 + s) * 1024 + (g + 1) * 128 + dc * 8); }
        }
        __syncthreads();
        const int d = 32 * dblk + r32;
        const LAS unsigned char* ab = lds + BA_VNT + ((d & 7) * 16 + (d >> 3)) * 272 + hi * 16;
        f32x16 acc[2];
#pragma unroll
        for (int j = 0; j < 2; ++j) {
            const int tb = 2 * tbp + j;
#pragma unroll
            for (int r = 0; r < 16; ++r) acc[j][r] = 0.f;
#pragma unroll
            for (int ks = 0; ks < 8; ++ks) if (ks < 2 * (tb + 1)) {
                const bf16x8 af = *(const LAS bf16x8*)(ab + ks * 32);
                acc[j] = __builtin_amdgcn_mfma_f32_32x32x16_bf16(af, wf[j][ks], acc[j], 0, 0, 0);
            }
        }
        if (g + 1 < 8) BA_LOAD_WS(g + 1);
#pragma unroll
        for (int j = 0; j < 2; ++j) {
            const int tb = 2 * tbp + j, t = 32 * tb + r32;
            const float bias = b_s[g * 128 + t];
            LAS float* ot = (LAS float*)(lds + BA_OT) + t * 132 + 32 * dblk + 4 * hi;
#pragma unroll
            for (int g4 = 0; g4 < 4; ++g4) *(LAS f32x4*)(ot + 8 * g4) = (f32x4){acc[j][4 * g4] + bias, acc[j][4 * g4 + 1] + bias, acc[j][4 * g4 + 2] + bias, acc[j][4 * g4 + 3] + bias};
        }
        __syncthreads();
#pragma unroll
        for (int i = 0; i < 4; ++i) {
            const int p = tid + 512 * i, t = p >> 4, dc = p & 15;
            const LAS float* ot = (const LAS float*)(lds + BA_OT) + t * 132 + dc * 8;
            const f32x4 m0 = *(const LAS f32x4*)ot, m1 = *(const LAS f32x4*)(ot + 4);
            bf16* up = UGQ + (t0 + t) * 2048 + g * 128 + dc * 8;
            f32x4 u0, u1; pg8::unpack8(ugp[i], u0, u1);
            if (!dry) *(u32x4*)up = pg8::pack8(u0 * m0, u1 * m1);
        }
        if (g + 1 < 8) BA_LOAD_UG(g + 1);
    }
#undef BA_LOAD_UG
#undef BA_LOAD_WS
    __syncthreads();
}

__device__ __forceinline__ void ln_rows(bf16* XH, unsigned char* XQ, float* XS, float* VST, float* OUT, const float* g, const float* bta, bool last, int gw, int NGW, int lane) {
    f32x4 gv[4], bv[4];
#pragma unroll
    for (int j = 0; j < 2; ++j) { gv[2 * j] = *(const f32x4*)(g + 512 * j + lane * 8); gv[2 * j + 1] = *(const f32x4*)(g + 512 * j + lane * 8 + 4);
                                  bv[2 * j] = *(const f32x4*)(bta + 512 * j + lane * 8); bv[2 * j + 1] = *(const f32x4*)(bta + 512 * j + lane * 8 + 4); }
    for (int m = gw; m < T; m += NGW) {
        bf16* xr = XH + (size_t)m * DM + lane * 8;
        f32x4 v[4]; float s = 0.f;
        pg8::unpack8h(*(const u32x4*)xr, v[0], v[1]); pg8::unpack8h(*(const u32x4*)(xr + 512), v[2], v[3]);
#pragma unroll
        for (int j = 0; j < 4; ++j) s += (v[j][0] + v[j][1]) + (v[j][2] + v[j][3]);
        const float mean = wave_sum(s) * (1.f / DM); float s2 = 0.f;
#pragma unroll
        for (int j = 0; j < 4; ++j) { v[j] = v[j] - mean; s2 += (v[j][0] * v[j][0] + v[j][1] * v[j][1]) + (v[j][2] * v[j][2] + v[j][3] * v[j][3]); }
        const float rstd = 1.0f / sqrtf(wave_sum(s2) * (1.f / DM) + LN_EPS);
#pragma unroll
        for (int j = 0; j < 4; ++j) v[j] = v[j] * rstd * gv[j] + bv[j];
        if (last) { float* o = OUT + (size_t)m * DM + lane * 8;
            *(f32x4*)o = v[0]; *(f32x4*)(o + 4) = v[1]; *(f32x4*)(o + 512) = v[2]; *(f32x4*)(o + 516) = v[3]; }
        else { *(u32x4*)xr = pg8::pack8h(v[0], v[1]); *(u32x4*)(xr + 512) = pg8::pack8h(v[2], v[3]);
            float am = 0.f;
#pragma unroll
            for (int j = 0; j < 4; ++j) am = fmaxf(am, fmaxf(fmaxf(fabsf(v[j][0]), fabsf(v[j][1])), fmaxf(fabsf(v[j][2]), fabsf(v[j][3]))));
            am = wave_max(am); const float inv = am > 0.f ? 127.f / am : 0.f;
            unsigned char* xq = XQ + (size_t)m * DM + lane * 8;
            u32x2 w0, w1; w0.x = q4(v[0][0], v[0][1], v[0][2], v[0][3], inv); w0.y = q4(v[1][0], v[1][1], v[1][2], v[1][3], inv);
            w1.x = q4(v[2][0], v[2][1], v[2][2], v[2][3], inv); w1.y = q4(v[3][0], v[3][1], v[3][2], v[3][3], inv);
            *(u32x2*)xq = w0; *(u32x2*)(xq + 512) = w1; if (lane == 0) { XS[m] = am; VST[2 * (size_t)m] = 0.f; VST[2 * (size_t)m + 1] = 0.f; } }
    }
}

#define XB_TMO      128
#define XB_XCNT(j)  (256  + 64 * (j))
#define XB_XSUB(j)  (1280 + 64 * (j))
#define XB_XGEN(j)  (2304 + 64 * (j))
#define XB_TOP      3328
#define XB_TOPGEN   3392
#define XCD_BAR_WORDS 3456
#define XB_SPIN_CAP (1u << 18)

__device__ __forceinline__ unsigned xb_ld(unsigned* p)              { return __hip_atomic_load(p, __ATOMIC_RELAXED, __HIP_MEMORY_SCOPE_AGENT); }
__device__ __forceinline__ unsigned xb_add(unsigned* p, unsigned v) { return __hip_atomic_fetch_add(p, v, __ATOMIC_RELAXED, __HIP_MEMORY_SCOPE_AGENT); }
__device__ __forceinline__ unsigned xb_xcc_id() { return (unsigned)__builtin_amdgcn_s_getreg((3 << 11) | 20) & 0xFu; }
#define XB_SPIN(cond, bar) do { unsigned _sp = 0; while (cond) { __builtin_amdgcn_s_sleep(1); \
    if ((++_sp & 255u) == 0u) { if (xb_ld(&(bar)[XB_TMO])) break; if (_sp > XB_SPIN_CAP) { atomicAdd(&(bar)[XB_TMO], 1u); break; } } } } while (0)

struct XcdBarrier {
    unsigned* bar; unsigned x;
    volatile LAS unsigned* st;
};

__device__ __forceinline__ XcdBarrier xcd_barrier_post(unsigned* bar, volatile LAS unsigned* st) {
    XcdBarrier b; b.bar = bar; b.x = xb_xcc_id(); b.st = st;
    if (threadIdx.x == 0) (void)xb_add(&bar[XB_XCNT(b.x)], 1u);
    return b;
}
__device__ __forceinline__ void xcd_barrier_complete(unsigned* bar, unsigned x, unsigned& nloc, unsigned& nx) {
    const unsigned G = gridDim.x * gridDim.y * gridDim.z;
    unsigned sum, cnt, mine, sp = 0u;
    for (;;) {
        sum = 0u; cnt = 0u; mine = 0u;
#pragma unroll
        for (unsigned j = 0; j < 16; ++j) { const unsigned c = xb_ld(&bar[XB_XCNT(j)]); sum += c; cnt += (c > 0u) ? 1u : 0u; mine = (j == x) ? c : mine; }
        if (sum == G) break;
        __builtin_amdgcn_s_sleep(1);
        if ((++sp & 255u) == 0u) { if (xb_ld(&bar[XB_TMO])) break; if (sp > XB_SPIN_CAP) { atomicAdd(&bar[XB_TMO], 1u); break; } }
    }
    nloc = mine > 0u ? mine : 1u; nx = cnt > 0u ? cnt : 1u;
}

__device__ __forceinline__ void xcd_barrier(const XcdBarrier& b) {
    asm volatile("s_waitcnt vmcnt(0)" ::: "memory");
    __syncthreads();
    if (threadIdx.x == 0) {
        unsigned* bar = b.bar;
        __builtin_amdgcn_s_waitcnt(0);
        unsigned nloc = b.st[0], nx = b.st[1];
        if (nloc == 0u) { xcd_barrier_complete(bar, b.x, nloc, nx); b.st[0] = nloc; b.st[1] = nx; }
        const unsigned old = xb_add(&bar[XB_XSUB(b.x)], 1u);
        const unsigned gen = old / nloc;
        if (old + 1u == (gen + 1u) * nloc) {
            __builtin_amdgcn_fence(__ATOMIC_RELEASE, "agent");
            asm volatile("s_waitcnt vmcnt(0)" ::: "memory");
            const unsigned og = xb_add(&bar[XB_TOP], 1u);
            const unsigned tg = og / nx;
            if (og + 1u == (tg + 1u) * nx) xb_add(&bar[XB_TOPGEN], 1u);
            else XB_SPIN(xb_ld(&bar[XB_TOPGEN]) == tg, bar);
            __builtin_amdgcn_fence(__ATOMIC_ACQUIRE, "agent");
            xb_add(&bar[XB_XGEN(b.x)], 1u);
            asm volatile("s_waitcnt vmcnt(0)" ::: "memory");
        } else {
            XB_SPIN(xb_ld(&bar[XB_XGEN(b.x)]) == gen, bar);
            __builtin_amdgcn_fence(__ATOMIC_ACQUIRE, "agent");
            asm volatile("s_waitcnt vmcnt(0)" ::: "memory");
        }
    }
    __syncthreads();
}

__global__ void __launch_bounds__(512, 2) fwd_kernel(Args a) {
    extern __shared__ __attribute__((aligned(16))) unsigned char lds_raw[];
    cg::grid_group grid = cg::this_grid();
    LAS unsigned char* lds = (LAS unsigned char*)lds_raw;
    const int G = gridDim.x, bx = blockIdx.x;
    const int vcu = (G % 8 == 0) ? (bx % 8) * (G / 8) + bx / 8 : bx;
    const int NGW = G * 8;
#define LAUNDER_TID int tid_l = threadIdx.x; asm volatile("" : "+v"(tid_l)); const int lane = tid_l & 63, wave = __builtin_amdgcn_readfirstlane(tid_l >> 6), gw = vcu * 8 + wave;
#define WSW(name, off) size_t name##_o = (off); asm volatile("" : "+s"(name##_o)); bf16* const name = (bf16*)(((l & 1) ? (unsigned char*)a.out : a.ws) + name##_o);
#define WSP(name, off) size_t name##_o = (off); asm volatile("" : "+s"(name##_o)); bf16* const name = (bf16*)(a.ws + name##_o);
    volatile LAS unsigned* MISC = (volatile LAS unsigned*)(lds + RING_BYTES + 256);
    if (threadIdx.x < 16) MISC[threadIdx.x] = 0u;
    unsigned* barw = (unsigned*)(a.ws + WS_CTL);
    if (bx == 0) for (int i = threadIdx.x; i < XCD_BAR_WORDS; i += 512) barw[i] = 0u;
    __syncthreads();
    { LAUNDER_TID
    for (int tk = gw; tk < 4 * 144 * 16; tk += NGW) { const int l4 = tk / (144 * 16), cg = (tk >> 4) % 144, kc = tk & 15, c = 64 * cg + lane;
        const int drow = win_dest_row(c), slot = drow >= 7168 ? -2 : pg8::p1_qslot(__builtin_amdgcn_readfirstlane(drow) >> 8);
        if (slot == -1) continue;
        const float* wp = a.in[2] + (size_t)l4 * DM * NIN + (size_t)(64 * kc) * NIN + c; float mx = 0.f;
#pragma unroll 16
        for (int kk = 0; kk < 64; ++kk) mx = fmaxf(mx, fabsf(wp[(size_t)kk * NIN]));
        unsigned* dst = slot == -2 ? (unsigned*)(a.ws + WS_CMAX) + l4 * 2048 + (drow - 7168) : (unsigned*)(a.ws + WS_CMAX1) + l4 * (pg8::P1_NQ * 256) + slot * 256 + (drow & 255);
        atomicMax(dst, __float_as_uint(mx)); }
    convert_layer(a, 0, lds, gw, NGW, lane, wave, false);
    { const float* x = a.in[0]; WSP(XH, WS_XH) unsigned char* XQ = (unsigned char*)a.out + OUT_XQ; float* XS = (float*)(a.ws + WS_XS);
      for (int m = gw; m < T; m += NGW) { const float* xr = x + (size_t)m * DM + lane * 8;
          const f32x4 v0 = *(const f32x4*)xr, v1 = *(const f32x4*)(xr + 4), v2 = *(const f32x4*)(xr + 512), v3 = *(const f32x4*)(xr + 516);
          bf16* xo = XH + (size_t)m * DM + lane * 8; *(u32x4*)xo = pg8::pack8h(v0, v1); *(u32x4*)(xo + 512) = pg8::pack8h(v2, v3);
          float am = fmaxf(fmaxf(fmaxf(fabsf(v0[0]), fabsf(v0[1])), fmaxf(fabsf(v0[2]), fabsf(v0[3]))), fmaxf(fmaxf(fabsf(v1[0]), fabsf(v1[1])), fmaxf(fabsf(v1[2]), fabsf(v1[3]))));
          am = fmaxf(am, fmaxf(fmaxf(fmaxf(fabsf(v2[0]), fabsf(v2[1])), fmaxf(fabsf(v2[2]), fabsf(v2[3]))), fmaxf(fmaxf(fabsf(v3[0]), fabsf(v3[1])), fmaxf(fabsf(v3[2]), fabsf(v3[3])))));
          am = wave_max(am); const float inv = am > 0.f ? 127.f / am : 0.f;
          unsigned char* xq = XQ + (size_t)m * DM + lane * 8;
          u32x2 w0, w1; w0.x = q4(v0[0], v0[1], v0[2], v0[3], inv); w0.y = q4(v1[0], v1[1], v1[2], v1[3], inv); w1.x = q4(v2[0], v2[1], v2[2], v2[3], inv); w1.y = q4(v3[0], v3[1], v3[2], v3[3], inv);
          *(u32x2*)xq = w0; *(u32x2*)(xq + 512) = w1; if (lane == 0) { XS[m] = am; float* vs = (float*)(a.ws + WS_VST) + 2 * (size_t)m; vs[0] = 0.f; vs[1] = 0.f; } } } }
    grid.sync();
    const XcdBarrier xbar = xcd_barrier_post(barw, MISC + 8);
#define GRID_SYNC() xcd_barrier(xbar)
#pragma unroll 1
    for (int l = 0; l < DEPTH; ++l) {
#ifndef SKIP_P1
        if (l == 0) { LAUNDER_TID
            LAS float* scr = (LAS float*)(lds + wave * 8704);
            for (int it = gw; it < 16 * (NIN / 32); it += NGW) win_item(a, 0, a.ws, it / (NIN / 32), it % (NIN / 32), 1, scr, lane);
            GRID_SYNC(); }
        { WSP(XH, WS_XH) WSW(WinT, WS_WIN) WSP(UGQ, WS_UGQ) WSP(Vb, WS_V) WSP(Kb, WS_K) WSP(VBb, WS_VB) WSP(GBb, WS_GB)
          if constexpr (pg8::P1_NF > 0)
          { pg8::Gemm g{XH, WinT + (size_t)(pg8::P1_F0 * 256) * DM, T, pg8::P1_NF * 256, DM, DM}; pg8::StaticOrder S; S.init(T, pg8::P1_NF * 256, G, bx);
            pg8::Epi1<false> E{UGQ, Vb, Kb, VBb, GBb, QSCALE, nullptr, nullptr, nullptr};
            pg8::gemm_phase<pg8::Epi1<false>, pg8::StaticOrder, true, true, 1>(lds, g, S, E); }
          { const bf16* XQ = (const bf16*)((const unsigned char*)a.out + OUT_XQ);
            pg8::Gemm g{XQ, WinT, T, pg8::P1_NQ * 256, 512, 512}; pg8::StaticOrder S; S.init(T, pg8::P1_NQ * 256, G, bx);
            pg8::Epi1<true> E{UGQ, Vb, Kb, VBb, GBb, QSCALE, (const float*)(a.ws + WS_XS), (const float*)(a.ws + WS_CMAX1) + l * (pg8::P1_NQ * 256), (float*)(a.ws + WS_VST)};
            pg8::gemm_phase<pg8::Epi1<true>, pg8::StaticOrder, true, true, 2>(lds, g, S, E); }
        }
#endif
        GRID_SYNC();
        { WSP(UGQ, WS_UGQ) WSP(Vb, WS_V) WSW(WsB, WS_WS) WSP(Kb, WS_K) WSP(VBb, WS_VB) WSP(GBb, WS_GB)
#pragma unroll 1
        for (int st = 0; st < 2; ++st) {
            if (((st ^ vcu) & 1) == 0) {
#ifndef SKIP_BA
                for (int c = vcu; c < T / 128; c += G)
                    brancha_unit(c, UGQ, Vb, WsB, (const float*)(a.ws + WS_VST), a.in[3] + l * DM, a.in[4] + l * DM, a.in[6] + l * 8 * 128, lds);
#endif
            } else {
#ifndef SKIP_AT
#pragma unroll 1
                for (int pu2 = 2 * vcu; pu2 < 128 * 16; pu2 += 2 * G) {
#pragma unroll 1
                    for (int j2 = 0; j2 < 2; ++j2) {
                        const int pu = pu2 >> 1, bh = pu >> 3, s = pu & 7;
                        attn_unit(bh >> 4, bh & 15, j2 ? s : 15 - s, UGQ, Kb, VBb, GBb, lds);
                    }
                }
#endif
            }
        }
        if (l + 1 < DEPTH) { __syncthreads(); LAUNDER_TID convert_layer(a, l + 1, lds, gw, NGW, lane, wave); }
        }
        GRID_SYNC();
#ifndef SKIP_P25
        { WSW(WinT, WS_WIN) WSP(SMA, WS_K) WSP(SMB, WS_VB)
          const bf16* XQ = (const bf16*)((const unsigned char*)a.out + OUT_XQ);
          pg8::Gemm g{XQ, WinT + (size_t)7168 * DM, T, 2048, 512, 512}; pg8::GateOrder S; S.init(T, G, bx);
          pg8::EpiGateQ E{SMA, SMB, (const float*)(a.ws + WS_XS), (const float*)(a.ws + WS_CMAX) + l * 2048};
          pg8::gemm_phase<pg8::EpiGateQ, pg8::GateOrder, true, true, 2>(lds, g, S, E); }
        { WSW(PB, WS_PB) WSW(WeT, WS_WE) WSP(EB, WS_GB)
          int kp = PLE; asm volatile("" : "+s"(kp));
          pg8::Gemm g{PB, WeT, T, DM, kp, kp}; pg8::StaticOrder S; S.init(T, DM, G, bx);
          pg8::EpiStore<0> E{EB, EB};
          pg8::gemm_phase<pg8::EpiStore<0>, pg8::StaticOrder, true, true>(lds, g, S, E); }
#endif
#ifndef SKIP_P3
        { WSP(UGQ, WS_UGQ) WSW(W2T, WS_W2) WSP(SMA, WS_K) WSP(SMB, WS_VB) WSP(MERGED, WS_V)
          pg8::Gemm g{UGQ, W2T, T, DM, 2048, 2048}; pg8::StaticOrder S; S.init(T, DM, G, bx);
          pg8::Epi2 E{SMA, SMB, MERGED};
          pg8::gemm_phase<pg8::Epi2, pg8::StaticOrder, true, true>(lds, g, S, E);
#ifdef PROBE_DUP_P3
          pg8::gemm_phase<pg8::Epi2, pg8::StaticOrder, true, true>(lds, g, S, E);
#endif
        }
#endif
        GRID_SYNC();
#ifndef SKIP_P4
        { WSP(MERGED, WS_V) WSW(WoT, WS_WO) WSP(XH1, WS_XH1) WSP(XH, WS_XH)
          pg8::Gemm g{MERGED, WoT, T, DM, DM, DM}; pg8::StaticOrder S; S.init(T, DM, G, bx);
          pg8::Epi3 E{XH, XH1, ALPHA};
          pg8::gemm_phase<pg8::Epi3, pg8::StaticOrder, true, true>(lds, g, S, E); }
#endif
        GRID_SYNC();
#ifndef SKIP_P5
        { WSP(XH1, WS_XH1) WSW(WgT, WS_WG) WSP(EB, WS_GB) WSP(XH, WS_XH)
          pg8::Gemm g{XH1, WgT, T, DM, DM, DM}; pg8::StaticOrder S; S.init(T, DM, G, bx);
          pg8::Epi4 E{XH1, XH, EB};
          pg8::gemm_phase<pg8::Epi4, pg8::StaticOrder, true, true, true>(lds, g, S, E); }
#endif
        GRID_SYNC();
#ifdef PROBE_SYNC
        for (int z = 0; z < 10; ++z) GRID_SYNC();
#endif
        LAUNDER_TID WSP(XH, WS_XH)
        ln_rows(XH, (unsigned char*)a.out + OUT_XQ, (float*)(a.ws + WS_XS), (float*)(a.ws + WS_VST), a.out, a.in[12] + l * DM, a.in[13] + l * DM, l + 1 == DEPTH, gw, NGW, lane);
        if (l + 1 < DEPTH) GRID_SYNC();
    }
}

extern "C" void kernel_launch(void* const* d_in, const int* in_sizes, int n_in, void* d_out, int out_size, void* d_ws, size_t ws_size, hipStream_t stream) {
    static int grid = 0;
    if (grid == 0) {
        if (n_in != 14 || out_size != T * DM || ws_size < WS_END) { fprintf(stderr, "kernel_launch: unexpected shapes (n_in %d out %d ws %zu)\n", n_in, out_size, ws_size); grid = -1; return; }
        int dev = 0, cus = 0, per_cu = 0;
        hipGetDevice(&dev); hipDeviceGetAttribute(&cus, hipDeviceAttributeMultiprocessorCount, dev);
        hipFuncSetAttribute((const void*)fwd_kernel, hipFuncAttributeMaxDynamicSharedMemorySize, LDS_BYTES);
        hipOccupancyMaxActiveBlocksPerMultiprocessor(&per_cu, (const void*)fwd_kernel, 512, LDS_BYTES);
        if (per_cu < 1) per_cu = 1;
        grid = cus;
        (void)hipGetLastError();
    }
    if (grid < 0) return;
    Args a{};
    for (int i = 0; i < 14; ++i) a.in[i] = (const float*)d_in[i];
    a.out = (float*)d_out; a.ws = (unsigned char*)d_ws;
    hipMemsetAsync((char*)d_ws + WS_CMAX, 0, 4 * (2048 + pg8::P1_NQ * 256) * sizeof(float), stream);
    void* args[] = {&a};
    hipError_t e = hipLaunchCooperativeKernel((const void*)fwd_kernel, dim3(grid), dim3(512), args, LDS_BYTES, stream);
    if (e != hipSuccess) fprintf(stderr, "cooperative launch failed: %s (grid %d)\n", hipGetErrorString(e), grid);
}
```

```cpp
#include <hip/hip_runtime.h>
#include <hip/hip_cooperative_groups.h>
#include <cstdio>
#include <cstdint>
namespace cg = cooperative_groups;
namespace pg8 {
#define PG8_LAS __attribute__((address_space(3)))
typedef unsigned short bf16_t;
typedef short bf16x8 __attribute__((ext_vector_type(8)));
typedef _Float16 f16x8 __attribute__((ext_vector_type(8)));
typedef int i32x4 __attribute__((ext_vector_type(4)));
typedef float f32x4 __attribute__((ext_vector_type(4)));
typedef unsigned u32x4 __attribute__((ext_vector_type(4)));
constexpr int BM = 256, BK = 64, HALF = 128, HTB = HALF * BK * 2  , STAGE_BYTES = 8 * HTB, NXCD = 8, WGM = 8;

__host__ __device__ __forceinline__ int lds_byte(int r, int c) { const int st = (r >> 4) * 2 + (c >> 5), rr = r & 15, cc = c & 31, ob = rr * 64 + cc * 2; return st * 1024 + (ob ^ (((ob >> 9) & 1) << 5)); }
__host__ __device__ __forceinline__ void stage_rc(int b, int& R, int& C) { const int st = b / 1024, sb = b % 1024, swz = sb ^ (((sb >> 9) & 1) << 5); R = (st >> 1) * 16 + swz / 64; C = (st & 1) * 32 + (swz % 64) / 2; }
__host__ __device__ __forceinline__ int perm32(int rho) { const int n = rho >> 4, i = rho & 15; return 8 * (i >> 2) + 4 * n + (i & 3); }

struct Unit { int pm, pn; };
struct Gemm { const bf16_t* A; const bf16_t* Bt; int M, N, K, lda; };

struct StaticOrder {
    int nM, nN, nwg, G, c;
    __host__ __device__ void init(int M, int N, int G_, int c_) { nM = M / BM; nN = N / BM; nwg = nM * nN; G = G_; c = c_; }
    __host__ __device__ bool next(int i, Unit& u) const {
        const long L = (long)i * G + c; if (L >= nwg) return false;
        int wgid = (int)L; { const int q = nwg / NXCD, r = nwg % NXCD, xcd = wgid % NXCD, off = wgid / NXCD; wgid = (xcd < r ? xcd * (q + 1) : r * (q + 1) + (xcd - r) * q) + off; }
        const int nig = WGM * nN, gid = wgid / nig, fm = gid * WGM, gsz = (nM - fm) < WGM ? (nM - fm) : WGM;
        u.pm = fm + ((wgid % nig) % gsz); u.pn = (wgid % nig) / gsz; return true;
    }
    __device__ __forceinline__ void a_ready(const Unit&) const {}
    __device__ __forceinline__ void done(const Unit&) const {}
};
struct GateOrder {
    StaticOrder inner;
    __host__ __device__ void init(int M, int G_, int c_) { inner.init(M, 1024, G_, c_); }
    __host__ __device__ bool next(int i, Unit& u) const { Unit v; if (!inner.next(i >> 1, v)) return false; u.pm = v.pm; u.pn = 2 * v.pn + (i & 1); return true; }
    __device__ __forceinline__ void a_ready(const Unit&) const {}
    __device__ __forceinline__ void done(const Unit&) const {}
};


typedef float f32x2_t __attribute__((ext_vector_type(2))); typedef __bf16 bf16x2_t __attribute__((ext_vector_type(2)));
__device__ __forceinline__ unsigned cvt_pk_bf16(float lo, float hi) { f32x2_t v = {lo, hi}; bf16x2_t b = __builtin_convertvector(v, bf16x2_t); return __builtin_bit_cast(unsigned, b); }
__device__ __forceinline__ float sigm(float x) { return __builtin_amdgcn_rcpf(1.f + __builtin_amdgcn_exp2f(-1.4426950408889634f * x)); }
__device__ __forceinline__ u32x4 pack8(const f32x4 a, const f32x4 b) { u32x4 w; w.x = cvt_pk_bf16(a[0], a[1]); w.y = cvt_pk_bf16(a[2], a[3]); w.z = cvt_pk_bf16(b[0], b[1]); w.w = cvt_pk_bf16(b[2], b[3]); return w; }
__device__ __forceinline__ void unpack8(const u32x4 w, f32x4& a, f32x4& b) {
    a[0] = __uint_as_float(w.x << 16); a[1] = __uint_as_float(w.x & 0xffff0000u); a[2] = __uint_as_float(w.y << 16); a[3] = __uint_as_float(w.y & 0xffff0000u);
    b[0] = __uint_as_float(w.z << 16); b[1] = __uint_as_float(w.z & 0xffff0000u); b[2] = __uint_as_float(w.w << 16); b[3] = __uint_as_float(w.w & 0xffff0000u); }
typedef _Float16 f16x2_t __attribute__((ext_vector_type(2)));
__device__ __forceinline__ unsigned cvt_pk_f16(float lo, float hi) { f32x2_t v = {lo, hi}; f16x2_t h = __builtin_convertvector(v, f16x2_t); return __builtin_bit_cast(unsigned, h); }
__device__ __forceinline__ u32x4 pack8h(const f32x4 a, const f32x4 b) { u32x4 w; w.x = cvt_pk_f16(a[0], a[1]); w.y = cvt_pk_f16(a[2], a[3]); w.z = cvt_pk_f16(b[0], b[1]); w.w = cvt_pk_f16(b[2], b[3]); return w; }
__device__ __forceinline__ void unpack8h(const u32x4 w, f32x4& a, f32x4& b) {
    const unsigned x0 = w.x, x1 = w.y, x2 = w.z, x3 = w.w;
    const f32x2_t p0 = __builtin_convertvector(__builtin_bit_cast(f16x2_t, x0), f32x2_t), p1 = __builtin_convertvector(__builtin_bit_cast(f16x2_t, x1), f32x2_t);
    const f32x2_t p2 = __builtin_convertvector(__builtin_bit_cast(f16x2_t, x2), f32x2_t), p3 = __builtin_convertvector(__builtin_bit_cast(f16x2_t, x3), f32x2_t);
    a[0] = p0[0]; a[1] = p0[1]; a[2] = p1[0]; a[3] = p1[1]; b[0] = p2[0]; b[1] = p2[1]; b[2] = p3[0]; b[3] = p3[1]; }
#define PG8_FENCE asm volatile("" ::: "memory")

#ifndef P1_ALL_INT8
#define P1_ALL_INT8 1
#endif
#if P1_ALL_INT8
constexpr int P1_NQ = 28, P1_F0 = 28, P1_NF = 0;
__host__ __device__ constexpr int p1_qtile(int j) { return j; }
__host__ __device__ constexpr int p1_qslot(int tile) { return tile < 28 ? tile : -1; }
#else
constexpr int P1_NQ = 20, P1_F0 = 12, P1_NF = 8;
__host__ __device__ constexpr int p1_qtile(int j) { return j < 12 ? j : 20 + (j - 12); }
__host__ __device__ constexpr int p1_qslot(int tile) { return tile < 12 ? tile : (tile >= 20 && tile < 28 ? 12 + (tile - 20) : -1); }
#endif
template <bool Q> struct Epi1 {
    static constexpr bool PERM = true, AFTER_DRAIN = false, HAS_MID = false;
    bf16_t *UGQ, *V, *K, *VB, *GB; float qscale; const float* XS; const float* CS; float* VST;
    __device__ __forceinline__ static f32x4 val(const f32x4 a, float rs, const f32x4 cs) {
        if constexpr (Q) { const i32x4 q = __builtin_bit_cast(i32x4, a); return (f32x4){(float)q[0], (float)q[1], (float)q[2], (float)q[3]} * (cs * rs); } else return a; }
    __device__ __forceinline__ void operator()(const f32x4 (&acc)[2][2][4][2], const Unit& u, int wr, int wc, int fr, int fq) const {
        asm volatile("" : "+v"(fr), "+v"(fq));
        const int row0 = u.pm * BM + wr * 64 + fr, cw = wc * 32 + 8 * fq;
        const int pn = Q ? p1_qtile(u.pn) : u.pn + P1_F0;
        float rsc[2][4]; f32x4 cs[2][2];
#pragma unroll
        for (int ai = 0; ai < 2; ++ai)
#pragma unroll
            for (int m = 0; m < 4; ++m) rsc[ai][m] = Q ? XS[row0 + ai * HALF + m * 16] * (1.f / (127.f * 127.f)) : 1.f;
#pragma unroll
        for (int bj = 0; bj < 2; ++bj)
#pragma unroll
            for (int n = 0; n < 2; ++n) cs[bj][n] = Q ? *(const f32x4*)(CS + u.pn * BM + bj * HALF + cw + 4 * n) : (f32x4){1.f, 1.f, 1.f, 1.f};
        if (pn < 8) {
            bf16_t* base = UGQ + pn * 128 + cw;
#pragma unroll
            for (int ai = 0; ai < 2; ++ai)
#pragma unroll
                for (int m = 0; m < 4; ++m) {
                    f32x4 u0 = val(acc[ai][0][m][0], rsc[ai][m], cs[0][0]), u1 = val(acc[ai][0][m][1], rsc[ai][m], cs[0][1]);
                    const f32x4 g0 = val(acc[ai][1][m][0], rsc[ai][m], cs[1][0]), g1 = val(acc[ai][1][m][1], rsc[ai][m], cs[1][1]);
#pragma unroll
                    for (int e = 0; e < 4; ++e) { u0[e] *= g0[e] * sigm(g0[e]); u1[e] *= g1[e] * sigm(g1[e]); }
                    __builtin_nontemporal_store(pack8(u0, u1), (u32x4*)(base + (size_t)(row0 + ai * HALF + m * 16) * 2048));
                }
        } else {
            const int seg = (pn - 8) >> 2, ct = (pn - 8) & 3;
            bf16_t* base; int ldc = 1024; float sc = 1.f;
            if (seg == 0) base = V; else if (seg == 1) { base = UGQ + 1024; ldc = 2048; sc = qscale; } else if (seg == 2) base = K; else if (seg == 3) base = VB; else base = GB;
            base += ct * 256 + cw;
#pragma unroll
            for (int ai = 0; ai < 2; ++ai)
#pragma unroll
                for (int m = 0; m < 4; ++m) { bf16_t* rowp = base + (size_t)(row0 + ai * HALF + m * 16) * ldc; float ssum = 0.f, sq = 0.f;
#pragma unroll
                    for (int bj = 0; bj < 2; ++bj) { const u32x4 w = pack8(val(acc[ai][bj][m][0], rsc[ai][m], cs[bj][0]) * sc, val(acc[ai][bj][m][1], rsc[ai][m], cs[bj][1]) * sc);
                        __builtin_nontemporal_store(w, (u32x4*)(rowp + bj * HALF));
                        if (seg == 0) { f32x4 q0, q1; unpack8(w, q0, q1);
                            ssum += (q0[0] + q0[1]) + (q0[2] + q0[3]) + (q1[0] + q1[1]) + (q1[2] + q1[3]);
                            sq += (q0[0] * q0[0] + q0[1] * q0[1]) + (q0[2] * q0[2] + q0[3] * q0[3]) + (q1[0] * q1[0] + q1[1] * q1[1]) + (q1[2] * q1[2] + q1[3] * q1[3]); } }
                    if (seg == 0) { ssum += __shfl_xor(ssum, 16); ssum += __shfl_xor(ssum, 32); sq += __shfl_xor(sq, 16); sq += __shfl_xor(sq, 32);
                        if (fq == 0) { float* sp = VST + 2 * (size_t)(row0 + ai * HALF + m * 16); atomicAdd(sp, ssum); atomicAdd(sp + 1, sq); } } }
        }
    }
};
template <int SIG> struct EpiStore {
    static constexpr bool PERM = true, AFTER_DRAIN = false, HAS_MID = false;
    bf16_t *D0, *D1;
    __device__ __forceinline__ void operator()(const f32x4 (&acc)[2][2][4][2], const Unit& u, int wr, int wc, int fr, int fq) const {
        asm volatile("" : "+v"(fr), "+v"(fq));
        const int row0 = u.pm * BM + wr * 64 + fr, cw = wc * 32 + 8 * fq;
        bf16_t* base = (u.pn < 4 ? D0 : D1) + (u.pn & 3) * 256 + cw;
#pragma unroll
        for (int ai = 0; ai < 2; ++ai)
#pragma unroll
            for (int m = 0; m < 4; ++m) { bf16_t* rowp = base + (size_t)(row0 + ai * HALF + m * 16) * 1024;
#pragma unroll
                for (int bj = 0; bj < 2; ++bj) { f32x4 v0 = acc[ai][bj][m][0], v1 = acc[ai][bj][m][1];
                    if (SIG) {
#pragma unroll
                        for (int e = 0; e < 4; ++e) { v0[e] = sigm(v0[e]); v1[e] = sigm(v1[e]); } }
                    __builtin_nontemporal_store(pack8(v0, v1), (u32x4*)(rowp + bj * HALF)); } }
    }
};
struct EpiGate {
    static constexpr bool PERM = true, AFTER_DRAIN = false, HAS_MID = false;
    bf16_t *RHO, *SMB;
    __device__ __forceinline__ void operator()(const f32x4 (&acc)[2][2][4][2], const Unit& u, int wr, int wc, int fr, int fq) const {
        asm volatile("" : "+v"(fr), "+v"(fq));
        const int row0 = u.pm * BM + wr * 64 + fr, c0 = u.pn * 128 + wc * 32 + 8 * fq;
#pragma unroll
        for (int ai = 0; ai < 2; ++ai)
#pragma unroll
            for (int m = 0; m < 4; ++m) { const size_t off = (size_t)(row0 + ai * HALF + m * 16) * 1024 + c0;
                f32x4 r0, r1, s0, s1;
#pragma unroll
                for (int e = 0; e < 4; ++e) {
                    const float ea0 = __builtin_amdgcn_exp2f(fminf(-1.4426950408889634f * acc[ai][0][m][0][e], 80.f)), eb0 = __builtin_amdgcn_exp2f(fminf(-1.4426950408889634f * acc[ai][1][m][0][e], 80.f));
                    const float ea1 = __builtin_amdgcn_exp2f(fminf(-1.4426950408889634f * acc[ai][0][m][1][e], 80.f)), eb1 = __builtin_amdgcn_exp2f(fminf(-1.4426950408889634f * acc[ai][1][m][1][e], 80.f));
                    r0[e] = (1.f + eb0) * __builtin_amdgcn_rcpf(1.f + ea0); r1[e] = (1.f + eb1) * __builtin_amdgcn_rcpf(1.f + ea1);
                    s0[e] = __builtin_amdgcn_rcpf(1.f + eb0); s1[e] = __builtin_amdgcn_rcpf(1.f + eb1); }
                *(u32x4*)(RHO + off) = pack8(r0, r1); *(u32x4*)(SMB + off) = pack8(s0, s1); }
    }
};
struct EpiGateQ {
    static constexpr bool PERM = true, AFTER_DRAIN = false, HAS_MID = false;
    bf16_t *RHO, *SMB; const float* XS; const float* CS;
    __device__ __forceinline__ void operator()(const f32x4 (&acc)[2][2][4][2], const Unit& u, int wr, int wc, int fr, int fq) const {
        asm volatile("" : "+v"(fr), "+v"(fq));
        const int row0 = u.pm * BM + wr * 64 + fr, c0 = u.pn * 128 + wc * 32 + 8 * fq;
        float rsc[2][4]; f32x4 cs[2][2];
#pragma unroll
        for (int ai = 0; ai < 2; ++ai)
#pragma unroll
            for (int m = 0; m < 4; ++m) rsc[ai][m] = XS[row0 + ai * HALF + m * 16] * (1.f / (127.f * 127.f));
#pragma unroll
        for (int bj = 0; bj < 2; ++bj) { const int ci = u.pn * BM + bj * HALF + wc * 32 + 8 * fq; cs[bj][0] = *(const f32x4*)(CS + ci); cs[bj][1] = *(const f32x4*)(CS + ci + 4); }
#pragma unroll
        for (int ai = 0; ai < 2; ++ai)
#pragma unroll
            for (int m = 0; m < 4; ++m) { const size_t off = (size_t)(row0 + ai * HALF + m * 16) * 1024 + c0;
                f32x4 r0, r1, s0, s1;
#pragma unroll
                for (int e = 0; e < 4; ++e) {
                    const i32x4 qa0 = __builtin_bit_cast(i32x4, acc[ai][0][m][0]), qa1 = __builtin_bit_cast(i32x4, acc[ai][0][m][1]), qb0 = __builtin_bit_cast(i32x4, acc[ai][1][m][0]), qb1 = __builtin_bit_cast(i32x4, acc[ai][1][m][1]);
                    const float ma0 = (float)qa0[e] * (rsc[ai][m] * cs[0][0][e]), ma1 = (float)qa1[e] * (rsc[ai][m] * cs[0][1][e]);
                    const float mb0 = (float)qb0[e] * (rsc[ai][m] * cs[1][0][e]), mb1 = (float)qb1[e] * (rsc[ai][m] * cs[1][1][e]);
                    const float ea0 = __builtin_amdgcn_exp2f(fminf(-1.4426950408889634f * ma0, 80.f)), eb0 = __builtin_amdgcn_exp2f(fminf(-1.4426950408889634f * mb0, 80.f));
                    const float ea1 = __builtin_amdgcn_exp2f(fminf(-1.4426950408889634f * ma1, 80.f)), eb1 = __builtin_amdgcn_exp2f(fminf(-1.4426950408889634f * mb1, 80.f));
                    r0[e] = (1.f + eb0) * __builtin_amdgcn_rcpf(1.f + ea0); r1[e] = (1.f + eb1) * __builtin_amdgcn_rcpf(1.f + ea1);
                    s0[e] = __builtin_amdgcn_rcpf(1.f + eb0); s1[e] = __builtin_amdgcn_rcpf(1.f + eb1); }
                *(u32x4*)(RHO + off) = pack8(r0, r1); *(u32x4*)(SMB + off) = pack8(s0, s1); }
    }
};
struct Epi2 {
    static constexpr bool PERM = true, AFTER_DRAIN = false, HAS_MID = true;
    const bf16_t *SMA, *SMB; bf16_t* OUT;
    __device__ __forceinline__ void mid(f32x4 (&acc)[2][2][4][2], const Unit& u, int wr, int wc, int fr, int fq) const {
        asm volatile("" : "+v"(fr), "+v"(fq));
        const int row0 = u.pm * BM + wr * 64 + fr, c0 = u.pn * BM + wc * 32 + 8 * fq;
#pragma unroll
        for (int ai = 0; ai < 2; ++ai) {
            u32x4 wa[4][2];
#pragma unroll
            for (int m = 0; m < 4; ++m) { const size_t off = (size_t)(row0 + ai * HALF + m * 16) * 1024 + c0;
#pragma unroll
                for (int bj = 0; bj < 2; ++bj) wa[m][bj] = *(const u32x4*)(SMA + off + bj * HALF); }
            PG8_FENCE;
#pragma unroll
            for (int m = 0; m < 4; ++m)
#pragma unroll
                for (int bj = 0; bj < 2; ++bj) { f32x4 a0, a1; unpack8(wa[m][bj], a0, a1); acc[ai][bj][m][0] *= a0; acc[ai][bj][m][1] *= a1; }
            PG8_FENCE; }
    }
    __device__ __forceinline__ void operator()(const f32x4 (&acc)[2][2][4][2], const Unit& u, int wr, int wc, int fr, int fq) const {
        asm volatile("" : "+v"(fr), "+v"(fq));
        const int row0 = u.pm * BM + wr * 64 + fr, c0 = u.pn * BM + wc * 32 + 8 * fq;
        u32x4 wb[2][4][2];
#pragma unroll
        for (int ai = 0; ai < 2; ++ai)
#pragma unroll
            for (int m = 0; m < 4; ++m) { const size_t off = (size_t)(row0 + ai * HALF + m * 16) * 1024 + c0;
#pragma unroll
                for (int bj = 0; bj < 2; ++bj) wb[ai][m][bj] = *(const u32x4*)(SMB + off + bj * HALF); }
        PG8_FENCE;
#pragma unroll
        for (int ai = 0; ai < 2; ++ai)
#pragma unroll
            for (int m = 0; m < 4; ++m) { const size_t off = (size_t)(row0 + ai * HALF + m * 16) * 1024 + c0;
#pragma unroll
                for (int bj = 0; bj < 2; ++bj) { f32x4 b0, b1; unpack8(wb[ai][m][bj], b0, b1);
                    *(u32x4*)(OUT + off + bj * HALF) = pack8(acc[ai][bj][m][0] * b0, acc[ai][bj][m][1] * b1); } }
    }
};
struct Epi3 {
    static constexpr bool PERM = true, AFTER_DRAIN = false, HAS_MID = false;
    const bf16_t* XH; bf16_t* XO; float alpha;
    __device__ __forceinline__ void operator()(const f32x4 (&acc)[2][2][4][2], const Unit& u, int wr, int wc, int fr, int fq) const {
        asm volatile("" : "+v"(fr), "+v"(fq));
        const int row0 = u.pm * BM + wr * 64 + fr, c0 = u.pn * BM + wc * 32 + 8 * fq;
#pragma unroll
        for (int ai = 0; ai < 2; ++ai) {
            u32x4 wx[4][2];
#pragma unroll
            for (int m = 0; m < 4; ++m) { const size_t off = (size_t)(row0 + ai * HALF + m * 16) * 1024 + c0;
#pragma unroll
                for (int bj = 0; bj < 2; ++bj) wx[m][bj] = *(const u32x4*)(XH + off + bj * HALF); }
            PG8_FENCE;
#pragma unroll
            for (int m = 0; m < 4; ++m) { const size_t off = (size_t)(row0 + ai * HALF + m * 16) * 1024 + c0;
#pragma unroll
                for (int bj = 0; bj < 2; ++bj) { f32x4 r0, r1; unpack8h(wx[m][bj], r0, r1);
                    const f32x4 h0 = r0 * alpha + acc[ai][bj][m][0], h1 = r1 * alpha + acc[ai][bj][m][1];
                    *(u32x4*)(XO + off + bj * HALF) = pack8h(h0, h1); } }
            PG8_FENCE; }
    }
};
struct Epi4 {
    static constexpr bool PERM = true, AFTER_DRAIN = false, HAS_MID = false;
    const bf16_t* H0; bf16_t* XO; const bf16_t* E;
    __device__ __forceinline__ void operator()(const f32x4 (&acc)[2][2][4][2], const Unit& u, int wr, int wc, int fr, int fq) const {
        asm volatile("" : "+v"(fr), "+v"(fq));
        const int row0 = u.pm * BM + wr * 64 + fr, c0 = u.pn * BM + wc * 32 + 8 * fq;
#pragma unroll
        for (int ai = 0; ai < 2; ++ai) {
            u32x4 wx[4][2], we[4][2];
#pragma unroll
            for (int m = 0; m < 4; ++m) { const size_t off = (size_t)(row0 + ai * HALF + m * 16) * 1024 + c0;
#pragma unroll
                for (int bj = 0; bj < 2; ++bj) { wx[m][bj] = *(const u32x4*)(H0 + off + bj * HALF); we[m][bj] = *(const u32x4*)(E + off + bj * HALF); } }
            PG8_FENCE;
#pragma unroll
            for (int m = 0; m < 4; ++m) { const size_t off = (size_t)(row0 + ai * HALF + m * 16) * 1024 + c0;
#pragma unroll
                for (int bj = 0; bj < 2; ++bj) { f32x4 h0, h1, e0, e1; unpack8h(wx[m][bj], h0, h1); unpack8(we[m][bj], e0, e1);
#pragma unroll
                    for (int e = 0; e < 4; ++e) { h0[e] += e0[e] * sigm(acc[ai][bj][m][0][e]); h1[e] += e1[e] * sigm(acc[ai][bj][m][1][e]); }
                    *(u32x4*)(XO + off + bj * HALF) = pack8h(h0, h1); } }
            PG8_FENCE; }
    }
};
template <class Epi, class Sched, bool ALIGN_EPI = false, bool SP2 = false, int MODE = 0>
__device__ __forceinline__ void gemm_phase(PG8_LAS unsigned char* lds, const Gemm g, const Sched& S, const Epi& E) {
    int tid_ = threadIdx.x; asm volatile("" : "+v"(tid_));
    const int tid = tid_, wid = __builtin_amdgcn_readfirstlane(tid >> 6), lane = tid & 63, wr = wid >> 2, wc = wid & 3, fr = lane & 15, fq = lane >> 4;
    const int K = g.K, nt = K / BK;
    unsigned voffA[2], voffB[2];
#pragma unroll
    for (int i = 0; i < 2; ++i) { int R, C; stage_rc(tid * 16 + i * 8192, R, C); const int Rb = Epi::PERM ? ((R & ~31) + perm32(R & 31)) : R;
        voffA[i] = (unsigned)(R * g.lda + C) * 2u; voffB[i] = (unsigned)(Rb * K + C) * 2u; }
    const size_t kstep = (size_t)(BK * 2);
    const size_t hstepA = (size_t)HALF * g.lda * 2, hstepB = (size_t)HALF * K * 2;
    const size_t tstepA = 2 * hstepA, tstepB = 2 * hstepB;
    const unsigned ldsw = (unsigned)wid * 1024u;
    const int aoff = lds_byte(wr * 64 + fr, fq * 8), boff = lds_byte(wc * 32 + fr, fq * 8);
#define PG8_SA(b, h) (((b) * 2 + (h)) * HTB)
#define PG8_SB(b, h) ((4 + (b) * 2 + (h)) * HTB)
#define PG8_STAGE(bufoff, gbase, voff) do { _Pragma("unroll") for (int _i = 0; _i < 2; ++_i) \
        __builtin_amdgcn_global_load_lds((const unsigned*)((const char*)(gbase) + (voff)[_i]), (PG8_LAS unsigned*)(lds + (bufoff) + ldsw + _i * 8192), 16, 0, 0); } while (0)
#define PG8_LDA(dst, b, h) do { _Pragma("unroll") for (int m = 0; m < 4; ++m) _Pragma("unroll") for (int k = 0; k < 2; ++k) dst[m][k] = *(const PG8_LAS bf16x8*)(lds + PG8_SA(b, h) + aoff + m * 2048 + k * 1024); } while (0)
#define PG8_LDB(dst, b, h) do { _Pragma("unroll") for (int n = 0; n < 2; ++n) _Pragma("unroll") for (int k = 0; k < 2; ++k) dst[n][k] = *(const PG8_LAS bf16x8*)(lds + PG8_SB(b, h) + boff + n * 2048 + k * 1024); } while (0)
#define PG8_MMA(ai, bj, At, Bt) do { __builtin_amdgcn_s_setprio(1); _Pragma("unroll") for (int m = 0; m < 4; ++m) _Pragma("unroll") for (int n = 0; n < 2; ++n) _Pragma("unroll") for (int k = 0; k < 2; ++k) \
        { if constexpr (MODE == 2) acc[ai][bj][m][n] = __builtin_bit_cast(f32x4, __builtin_amdgcn_mfma_i32_16x16x64_i8(__builtin_bit_cast(i32x4, Bt[n][k]), __builtin_bit_cast(i32x4, At[m][k]), __builtin_bit_cast(i32x4, acc[ai][bj][m][n]), 0, 0, 0)); \
          else if constexpr (MODE == 1) acc[ai][bj][m][n] = __builtin_amdgcn_mfma_f32_16x16x32_f16(__builtin_bit_cast(f16x8, Bt[n][k]), __builtin_bit_cast(f16x8, At[m][k]), acc[ai][bj][m][n], 0, 0, 0); \
          else acc[ai][bj][m][n] = __builtin_amdgcn_mfma_f32_16x16x32_bf16(Bt[n][k], At[m][k], acc[ai][bj][m][n], 0, 0, 0); } __builtin_amdgcn_s_setprio(0); } while (0)
#define PG8_WAIT_V(n) asm volatile("s_waitcnt vmcnt(" #n ")" ::: "memory")
#define PG8_WAIT_L(n) asm volatile("s_waitcnt lgkmcnt(" #n ")" ::: "memory")
#define PG8_BAR __builtin_amdgcn_s_barrier()
#define PG8_SCHED __builtin_amdgcn_sched_barrier(0)
    Unit cur, nxt; int ui = 0;
    if (!S.next(0, cur)) return;
    f32x4 acc[2][2][4][2];
#pragma unroll
    for (int a = 0; a < 2; ++a)
#pragma unroll
        for (int b = 0; b < 2; ++b)
#pragma unroll
            for (int m = 0; m < 4; ++m)
#pragma unroll
                for (int n = 0; n < 2; ++n) acc[a][b][m][n] = (f32x4){0.f, 0.f, 0.f, 0.f};
    bf16x8 At[4][2], B0[2][2], B1[2][2];
    const char* cA = (const char*)g.A + (size_t)cur.pm * tstepA; const char* cB = (const char*)g.Bt + (size_t)cur.pn * tstepB;
    S.a_ready(cur);
    if constexpr (SP2) {
        PG8_STAGE(PG8_SB(0, 0), cB, voffB); PG8_STAGE(PG8_SB(0, 1), cB + hstepB, voffB); PG8_STAGE(PG8_SA(0, 0), cA, voffA); PG8_STAGE(PG8_SA(0, 1), cA + hstepA, voffA);
        if (wr == 1) PG8_BAR;
        PG8_WAIT_V(2); PG8_BAR;
        PG8_STAGE(PG8_SB(1, 0), cB + kstep, voffB); PG8_STAGE(PG8_SA(1, 0), cA + kstep, voffA); PG8_STAGE(PG8_SB(1, 1), cB + hstepB + kstep, voffB);
        PG8_WAIT_V(6); PG8_BAR;
    } else {
        PG8_STAGE(PG8_SB(0, 0), cB, voffB); PG8_STAGE(PG8_SA(0, 0), cA, voffA); PG8_STAGE(PG8_SB(0, 1), cB + hstepB, voffB); PG8_STAGE(PG8_SA(0, 1), cA + hstepA, voffA);
        if (wr == 1) PG8_BAR;
        PG8_WAIT_V(4); PG8_BAR;
        PG8_STAGE(PG8_SB(1, 0), cB + kstep, voffB); PG8_STAGE(PG8_SA(1, 0), cA + kstep, voffA); PG8_STAGE(PG8_SB(1, 1), cB + hstepB + kstep, voffB);
        PG8_WAIT_V(6); PG8_BAR;
    }
    for (;;) {
        const bool has_next = S.next(ui + 1, nxt);
        const char* nA = has_next ? (const char*)g.A + (size_t)nxt.pm * tstepA : cA; const char* nB = has_next ? (const char*)g.Bt + (size_t)nxt.pn * tstepB : cB;
        for (int t = 0; t < nt; t += 2) { if constexpr (Epi::HAS_MID) { if (t == (nt >> 1)) E.mid(acc, cur, wr, wc, fr, fq); }
            const bool last = (t == nt - 2);
            const char* a1 = cA + (size_t)(t + 1) * kstep;
            const char* a2 = last ? nA : cA + (size_t)(t + 2) * kstep; const char* b2 = last ? nB : cB + (size_t)(t + 2) * kstep;
            const char* a3 = a2 + kstep; const char* b3 = b2 + kstep;
            if (last && has_next) S.a_ready(nxt);
            if constexpr (SP2) {
            PG8_LDB(B0, 0, 0); PG8_LDB(B1, 0, 1); PG8_SCHED; PG8_LDA(At, 0, 0); PG8_STAGE(PG8_SA(1, 1), a1 + hstepA, voffA);
            PG8_WAIT_V(8); PG8_WAIT_L(0); PG8_BAR; PG8_MMA(0, 0, At, B0); PG8_MMA(0, 1, At, B1); PG8_BAR; PG8_SCHED;
            PG8_LDA(At, 0, 1); PG8_STAGE(PG8_SB(0, 0), b2, voffB); PG8_STAGE(PG8_SB(0, 1), b2 + hstepB, voffB); PG8_STAGE(PG8_SA(0, 0), a2, voffA);
            PG8_WAIT_V(8); PG8_WAIT_L(0); PG8_BAR; PG8_MMA(1, 0, At, B0); PG8_MMA(1, 1, At, B1); PG8_BAR; PG8_SCHED;
            PG8_LDB(B0, 1, 0); PG8_LDB(B1, 1, 1); PG8_SCHED; PG8_LDA(At, 1, 0); PG8_STAGE(PG8_SA(0, 1), a2 + hstepA, voffA);
            PG8_WAIT_V(8); PG8_WAIT_L(0); PG8_BAR; PG8_MMA(0, 0, At, B0); PG8_MMA(0, 1, At, B1); PG8_BAR; PG8_SCHED;
            PG8_LDA(At, 1, 1); PG8_STAGE(PG8_SB(1, 0), b3, voffB); PG8_STAGE(PG8_SB(1, 1), b3 + hstepB, voffB); PG8_STAGE(PG8_SA(1, 0), a3, voffA);
            PG8_WAIT_V(8); PG8_WAIT_L(0); PG8_BAR; PG8_MMA(1, 0, At, B0); PG8_MMA(1, 1, At, B1); PG8_BAR; PG8_SCHED;
            } else {
            PG8_LDB(B0, 0, 0); PG8_SCHED; PG8_LDA(At, 0, 0); PG8_STAGE(PG8_SA(1, 1), a1 + hstepA, voffA);
            PG8_WAIT_L(8); PG8_BAR; PG8_WAIT_L(0); PG8_MMA(0, 0, At, B0); PG8_BAR; PG8_SCHED;
            PG8_LDB(B1, 0, 1); PG8_STAGE(PG8_SB(0, 0), b2, voffB);
            PG8_BAR; PG8_WAIT_L(0); PG8_MMA(0, 1, At, B1); PG8_BAR;
            PG8_LDA(At, 0, 1); PG8_STAGE(PG8_SA(0, 0), a2, voffA);
            PG8_BAR; PG8_WAIT_L(0); PG8_MMA(1, 0, At, B0); PG8_BAR; PG8_SCHED;
            PG8_STAGE(PG8_SB(0, 1), b2 + hstepB, voffB);
            PG8_WAIT_V(6); PG8_BAR; PG8_MMA(1, 1, At, B1); PG8_BAR;
            PG8_LDB(B0, 1, 0); PG8_SCHED; PG8_LDA(At, 1, 0); PG8_STAGE(PG8_SA(0, 1), a2 + hstepA, voffA);
            PG8_WAIT_L(8); PG8_BAR; PG8_WAIT_L(0); PG8_MMA(0, 0, At, B0); PG8_BAR; PG8_SCHED;
            PG8_LDB(B1, 1, 1); PG8_STAGE(PG8_SB(1, 0), b3, voffB);
            PG8_BAR; PG8_WAIT_L(0); PG8_MMA(0, 1, At, B1); PG8_BAR;
            PG8_LDA(At, 1, 1); PG8_STAGE(PG8_SA(1, 0), a3, voffA);
            PG8_BAR; PG8_WAIT_L(0); PG8_MMA(1, 0, At, B0); PG8_BAR; PG8_SCHED;
            PG8_STAGE(PG8_SB(1, 1), b3 + hstepB, voffB);
            PG8_WAIT_V(6); PG8_BAR; PG8_MMA(1, 1, At, B1); PG8_BAR;
            }
        }
        if constexpr (ALIGN_EPI) { if (wr == 0) PG8_BAR; }
        if constexpr (!Epi::AFTER_DRAIN) { E(acc, cur, wr, wc, fr, fq); S.done(cur); }
        if (!has_next) break;
#pragma unroll
        for (int a = 0; a < 2; ++a)
#pragma unroll
            for (int b = 0; b < 2; ++b)
#pragma unroll
                for (int m = 0; m < 4; ++m)
#pragma unroll
                    for (int n = 0; n < 2; ++n) acc[a][b][m][n] = (f32x4){0.f, 0.f, 0.f, 0.f};
        cur = nxt; cA = nA; cB = nB; ++ui;
        if constexpr (ALIGN_EPI) { if (wr == 1) PG8_BAR; }
    }
    PG8_WAIT_V(0);
    if constexpr (!ALIGN_EPI) { if (wr == 0) PG8_BAR; }
    PG8_BAR;
    if constexpr (Epi::AFTER_DRAIN) { E.fused(acc, cur, wr, wc, fr, fq, lds, wid, lane); S.done(cur); }
#undef PG8_SA
#undef PG8_SB
#undef PG8_STAGE
#undef PG8_LDA
#undef PG8_LDB
#undef PG8_MMA
#undef PG8_WAIT_V
#undef PG8_WAIT_L
#undef PG8_BAR
#undef PG8_SCHED
}
}
#define LAS __attribute__((address_space(3)))
typedef unsigned short bf16;
typedef unsigned u32x4 __attribute__((ext_vector_type(4)));
typedef unsigned u32x2 __attribute__((ext_vector_type(2)));
typedef float f32x4 __attribute__((ext_vector_type(4)));
typedef float f32x16 __attribute__((ext_vector_type(16)));
typedef short bf16x8 __attribute__((ext_vector_type(8)));
constexpr int DM = 1024, NBATCH = 8, SEQ = 4096, T = NBATCH * SEQ, DEPTH = 4, PLE = 256, NIN = 9216, NHEAD = 16, HD = 64;
constexpr float LN_EPS = 1e-5f;
constexpr float ALPHA = 1.681792830507429f;
constexpr float QSCALE = 0.125f * 1.4426950408889634f;
constexpr size_t MiB = 1u << 20;
constexpr size_t WS_WIN = 0, WS_W2 = 18 * MiB, WS_WO = 22 * MiB, WS_WG = 24 * MiB, WS_WE = 26 * MiB, WS_WS = 27 * MiB, WS_PB = 28 * MiB, WS_XH1 = 44 * MiB,
                 WS_UGQ = 108 * MiB, WS_V = 236 * MiB, WS_K = 300 * MiB, WS_VB = 364 * MiB, WS_GB = 428 * MiB, WS_CTL = 492 * MiB, WS_XH = 493 * MiB, WS_XS = 557 * MiB  , WS_CMAX = WS_XS + 256 * 1024  , WS_CMAX1 = WS_CMAX + 32 * 1024  , WS_BARW = WS_CMAX - 16384  , WS_VST = WS_XS + 512 * 1024  , WS_END = 558 * MiB;
constexpr size_t OUT_XQ = 64 * MiB;
constexpr int LDS_BYTES = 147456, RING_BYTES = 131072;

__device__ __forceinline__ float wave_sum(float v) {
#pragma unroll
    for (int o = 1; o < 64; o <<= 1) v += __shfl_xor(v, o);
    return v;
}
__device__ __forceinline__ unsigned pk2(float lo, float hi) { return pg8::cvt_pk_bf16(lo, hi); }
__device__ __forceinline__ float bf_lo(unsigned w) { return __uint_as_float(w << 16); }
__device__ __forceinline__ float bf_hi(unsigned w) { return __uint_as_float(w & 0xffff0000u); }

template <bool F16 = false> __device__ __forceinline__ void tr_item(const float* W, int N, bf16* WT, int ldk, int koff, int k0, int n0, int drow0, LAS float* scr, int lane) {
#pragma unroll 8
    for (int i = 0; i < 32; ++i) { const int kk = 2 * i + (lane >> 5); scr[kk * 33 + (lane & 31)] = W[(size_t)(k0 + kk) * N + n0 + (lane & 31)]; }
    asm volatile("s_waitcnt lgkmcnt(0)" ::: "memory");
    const int c = lane & 7;
#pragma unroll
    for (int j = 0; j < 4; ++j) { const int n = (lane >> 3) + 8 * j; const LAS float* s = scr + (8 * c) * 33 + n;
        u32x4 o;
        if constexpr (F16) { o.x = pg8::cvt_pk_f16(s[0 * 33], s[1 * 33]); o.y = pg8::cvt_pk_f16(s[2 * 33], s[3 * 33]); o.z = pg8::cvt_pk_f16(s[4 * 33], s[5 * 33]); o.w = pg8::cvt_pk_f16(s[6 * 33], s[7 * 33]); }
        else { o.x = pk2(s[0 * 33], s[1 * 33]); o.y = pk2(s[2 * 33], s[3 * 33]); o.z = pk2(s[4 * 33], s[5 * 33]); o.w = pk2(s[6 * 33], s[7 * 33]); }
        *(u32x4*)(WT + (size_t)(drow0 + n) * ldk + koff + k0 + 8 * c) = o; }
    asm volatile("s_waitcnt lgkmcnt(0)" ::: "memory");
}
__device__ __forceinline__ float wave_max(float v) {
#pragma unroll
    for (int o = 1; o < 64; o <<= 1) v = fmaxf(v, __shfl_xor(v, o));
    return v;
}
__device__ __forceinline__ unsigned q4(float a, float b, float c, float d, float inv) {
    const int ia = (int)__builtin_rintf(a * inv), ib = (int)__builtin_rintf(b * inv), ic = (int)__builtin_rintf(c * inv), id = (int)__builtin_rintf(d * inv);
    return (unsigned)(ia & 0xff) | ((unsigned)(ib & 0xff) << 8) | ((unsigned)(ic & 0xff) << 16) | ((unsigned)(id & 0xff) << 24);
}
__device__ __forceinline__ int win_dest_row(int c);
__device__ __forceinline__ void tr_item_q(const float* W, const float* cmax, unsigned char* WQ, int k0, int n0, int qrow0, LAS float* scr, int lane) {
#pragma unroll 8
    for (int i = 0; i < 32; ++i) { const int kk = 2 * i + (lane >> 5); scr[kk * 33 + (lane & 31)] = W[(size_t)(k0 + kk) * NIN + n0 + (lane & 31)]; }
    asm volatile("s_waitcnt lgkmcnt(0)" ::: "memory");
    const int c16 = lane & 3;
#pragma unroll
    for (int j = 0; j < 2; ++j) { const int n = (lane >> 2) + 16 * j; const LAS float* sp = scr + (16 * c16) * 33 + n;
        const float cm = cmax[qrow0 + n], inv = cm > 0.f ? 127.f / cm : 0.f;
        u32x4 o; o.x = q4(sp[0 * 33], sp[1 * 33], sp[2 * 33], sp[3 * 33], inv); o.y = q4(sp[4 * 33], sp[5 * 33], sp[6 * 33], sp[7 * 33], inv);
        o.z = q4(sp[8 * 33], sp[9 * 33], sp[10 * 33], sp[11 * 33], inv); o.w = q4(sp[12 * 33], sp[13 * 33], sp[14 * 33], sp[15 * 33], inv);
        *(u32x4*)(WQ + (size_t)(qrow0 + n) * 1024 + k0 + 16 * c16) = o; }
    asm volatile("s_waitcnt lgkmcnt(0)" ::: "memory");
}
__device__ __forceinline__ int win_dest_row(int c) {
    if (c < 1024) return 256 * (c >> 7) + (c & 127);
    if (c < 2048) return 2048 + (c - 1024);
    if (c < 3072) { const int cc = c - 2048; return 256 * (cc >> 7) + 128 + (cc & 127); }
    if (c < 7168) return c;
    if (c < 8192) { const int cc = c - 7168; return 7168 + 256 * (cc >> 7) + (cc & 127); }
    { const int cc = c - 8192; return 7168 + 256 * (cc >> 7) + 128 + (cc & 127); }
}
struct Args { const float* in[14]; float* out; unsigned char* ws; };
__device__ __forceinline__ void win_item(const Args& a, int l, unsigned char* wb, int kb, int nb, int what, LAS float* scr, int lane) {
    const float* w_in = a.in[2] + (size_t)l * DM * NIN; const int drow0 = win_dest_row(32 * nb);
    if (drow0 >= 7168) { if (what >= 1) tr_item_q(w_in, (const float*)(a.ws + WS_CMAX) + l * 2048, wb + WS_WIN + (size_t)7168 * 2048, 64 * kb, 32 * nb, drow0 - 7168, scr, lane); return; }
    const int slot = pg8::p1_qslot(drow0 >> 8);
    if (slot >= 0) { if (what >= 1) tr_item_q(w_in, (const float*)(a.ws + WS_CMAX1) + l * (pg8::P1_NQ * 256), wb + WS_WIN, 64 * kb, 32 * nb, slot * 256 + (drow0 & 255), scr, lane); return; }
    if (what != 1) tr_item<true>(w_in, NIN, (bf16*)(wb + WS_WIN), 1024, 0, 64 * kb, 32 * nb, drow0, scr, lane);
}

__device__ __forceinline__ void convert_layer(const Args& a, int l, LAS unsigned char* lds, int gw, int NGW, int lane, int wave, bool gates = true) {
    LAS float* scr = (LAS float*)(lds + wave * 8704);
    unsigned char* ws = (l & 1) ? (unsigned char*)a.out : a.ws;
    const float* w_in = a.in[2] + (size_t)l * DM * NIN;
    const float* w_pa = a.in[7] + (size_t)l * DM * DM; const float* w_pb = a.in[8] + (size_t)l * DM * DM; const float* w_out = a.in[9] + (size_t)l * DM * DM;
    const float* w_pe = a.in[10] + (size_t)l * PLE * DM; const float* w_pg = a.in[11] + (size_t)l * DM * DM;
    constexpr int I_IN = 16 * (NIN / 32), I_SQ = 16 * 32, I_PE = 4 * 32, NITEMS = I_IN + 4 * I_SQ + I_PE;
    for (int it = gw; it < NITEMS; it += NGW) {
        int r = it;
        if (r < I_IN) { win_item(a, l, ws, r / (NIN / 32), r % (NIN / 32), gates ? 2 : 0, scr, lane); continue; } r -= I_IN;
        if (r < I_SQ) { tr_item(w_pa, DM, (bf16*)(ws + WS_W2), 2048, 0, 64 * (r >> 5), 32 * (r & 31), 32 * (r & 31), scr, lane); continue; } r -= I_SQ;
        if (r < I_SQ) { tr_item(w_pb, DM, (bf16*)(ws + WS_W2), 2048, 1024, 64 * (r >> 5), 32 * (r & 31), 32 * (r & 31), scr, lane); continue; } r -= I_SQ;
        if (r < I_SQ) { tr_item(w_out, DM, (bf16*)(ws + WS_WO), 1024, 0, 64 * (r >> 5), 32 * (r & 31), 32 * (r & 31), scr, lane); continue; } r -= I_SQ;
        if (r < I_SQ) { tr_item<true>(w_pg, DM, (bf16*)(ws + WS_WG), 1024, 0, 64 * (r >> 5), 32 * (r & 31), 32 * (r & 31), scr, lane); continue; } r -= I_SQ;
        tr_item(w_pe, DM, (bf16*)(ws + WS_WE), 256, 0, 64 * (r >> 5), 32 * (r & 31), 32 * (r & 31), scr, lane);
    }
    const int gt = gw * 64 + lane, NGT = NGW * 64;
    { const float* w_s = a.in[5] + (size_t)l * 8 * 128 * 128; bf16* WsB = (bf16*)(ws + WS_WS);
      for (int p = gt; p < 8 * 128 * 16; p += NGT) { const int s0 = (p & 15) * 8, t = (p >> 4) & 127;
          const f32x4 x0 = *(const f32x4*)(w_s + (size_t)p * 8), x1 = *(const f32x4*)(w_s + (size_t)p * 8 + 4);
          float v[8] = {x0[0], x0[1], x0[2], x0[3], x1[0], x1[1], x1[2], x1[3]};
#pragma unroll
          for (int j = 0; j < 8; ++j) v[j] = (s0 + j <= t) ? v[j] : 0.f;
          u32x4 o; o.x = pk2(v[0], v[1]); o.y = pk2(v[2], v[3]); o.z = pk2(v[4], v[5]); o.w = pk2(v[6], v[7]);
          *(u32x4*)(WsB + (size_t)p * 8) = o; } }
    { const float* p = a.in[1] + (size_t)l * T * PLE; bf16* PB = (bf16*)(ws + WS_PB);
      for (int q = gt; q < T * PLE / 8; q += NGT) { const f32x4 x0 = *(const f32x4*)(p + (size_t)q * 8), x1 = *(const f32x4*)(p + (size_t)q * 8 + 4);
          u32x4 o; o.x = pk2(x0[0], x0[1]); o.y = pk2(x0[2], x0[3]); o.z = pk2(x1[0], x1[1]); o.w = pk2(x1[2], x1[3]);
          *(u32x4*)(PB + (size_t)q * 8) = o; } }
}

constexpr int AT_K = 0, AT_V = 16384, AT_STG = 16384 + 2 * 9216, AT_STG_W = 8704;
__device__ __forceinline__ void attn_unit(int b, int h, int qb, bf16* UGQ, const bf16* Kb, const bf16* Vb, const bf16* GBb, LAS unsigned char* lds, int dry = 0) {
    int tid_ = threadIdx.x; asm volatile("" : "+v"(tid_));
    const int tid = tid_, lane = tid & 63, wid = __builtin_amdgcn_readfirstlane(tid >> 6), r32 = lane & 31, hi = lane >> 5;
    const size_t rowbase = (size_t)b * SEQ;
    const int q0 = qb * 256, qw = q0 + wid * 32;
    bf16x8 qr[4];
    { const bf16* qp = UGQ + (rowbase + qw + r32) * 2048 + 1024 + h * HD + hi * 8;
#pragma unroll
      for (int d0 = 0; d0 < 4; ++d0) qr[d0] = *(const bf16x8*)(qp + d0 * 16); }
    f32x16 o0, o1;
#pragma unroll
    for (int r = 0; r < 16; ++r) { o0[r] = 0.f; o1[r] = 0.f; }
    float C = 1.f; int alive = 1;
    volatile LAS unsigned* aflag = (volatile LAS unsigned*)(lds + RING_BYTES);
    const int NT = 4 * (qb + 1);
    const int lkey = lane, lch = wid;
    const int kk = lkey & 31, slot = (lkey & 32) | (8 * ((kk >> 2) & 3) + 4 * (kk >> 4) + (kk & 3));
    const bf16* kg = Kb + (rowbase + lkey) * 1024 + h * HD + lch * 8;
    const bf16* vg = Vb + (rowbase + lkey) * 1024 + h * HD + lch * 8;
    u32x4 kreg, vreg;
    kreg = *(const u32x4*)(kg + (size_t)(NT - 1) * 64 * 1024); vreg = *(const u32x4*)(vg + (size_t)(NT - 1) * 64 * 1024);
#define AT_WRITE(buf) do { *(LAS u32x4*)(lds + AT_K + (buf) * 8192 + lch * 1024 + slot * 16) = kreg; \
        LAS unsigned short* vt_ = (LAS unsigned short*)(lds + AT_V + (buf) * 9216) + (lch * 8) * 72 + lkey; \
        vt_[0 * 72] = (unsigned short)(vreg.x & 0xffffu); vt_[1 * 72] = (unsigned short)(vreg.x >> 16); vt_[2 * 72] = (unsigned short)(vreg.y & 0xffffu); vt_[3 * 72] = (unsigned short)(vreg.y >> 16); \
        vt_[4 * 72] = (unsigned short)(vreg.z & 0xffffu); vt_[5 * 72] = (unsigned short)(vreg.z >> 16); vt_[6 * 72] = (unsigned short)(vreg.w & 0xffffu); vt_[7 * 72] = (unsigned short)(vreg.w >> 16); } while (0)
    AT_WRITE(0);
    __syncthreads();
    const int qrel = qw + r32;
    for (int it = 0; it < NT; ++it) {
        const int kt = NT - 1 - it, cur = it & 1;
        if (it + 1 < NT) { kreg = *(const u32x4*)(kg + (size_t)(kt - 1) * 64 * 1024); vreg = *(const u32x4*)(vg + (size_t)(kt - 1) * 64 * 1024); }
        const int k0 = kt * 64;
        if (k0 < qw + 32 && alive) {
            const LAS unsigned char* kb = lds + AT_K + cur * 8192 + hi * 1024 + r32 * 16;
            f32x16 p0, p1;
#pragma unroll
            for (int r = 0; r < 16; ++r) { p0[r] = 0.f; p1[r] = 0.f; }
#pragma unroll
            for (int d0 = 0; d0 < 4; ++d0) {
                const bf16x8 a0 = *(const LAS bf16x8*)(kb + d0 * 2048), a1 = *(const LAS bf16x8*)(kb + d0 * 2048 + 512);
                p0 = __builtin_amdgcn_mfma_f32_32x32x16_bf16(a0, qr[d0], p0, 0, 0, 0);
                p1 = __builtin_amdgcn_mfma_f32_32x32x16_bf16(a1, qr[d0], p1, 0, 0, 0);
            }
#pragma unroll
            for (int r = 0; r < 16; ++r) { p0[r] = __builtin_amdgcn_rcpf(1.f + __builtin_amdgcn_exp2f(p0[r])); p1[r] = __builtin_amdgcn_rcpf(1.f + __builtin_amdgcn_exp2f(p1[r])); }
            if (k0 + 63 >= qw) {
                const int kb0 = k0 + 16 * hi;
#pragma unroll
                for (int r = 0; r < 16; ++r) { if (kb0 + r >= qrel) p0[r] = 1.f; if (kb0 + 32 + r >= qrel) p1[r] = 1.f; }
            }
#pragma unroll
            for (int r = 14; r >= 0; --r) { p0[r] *= p0[r + 1]; p1[r] *= p1[r + 1]; }
            const float L0 = p0[0], L1 = p1[0];
            const float pL0 = __shfl_xor(L0, 32), pL1 = __shfl_xor(L1, 32);
            const float tot1 = L1 * pL1;
            const float pre1 = hi ? C : C * pL1;
            const float pre0 = C * tot1 * (hi ? 1.f : pL0);
            C = C * tot1 * (L0 * pL0);
#pragma unroll
            for (int r = 0; r < 15; ++r) { p0[r] = pre0 * (p0[r + 1] - p0[r]); p1[r] = pre1 * (p1[r + 1] - p1[r]); }
            p0[15] = pre0 * (1.f - p0[15]); p1[15] = pre1 * (1.f - p1[15]);
            u32x4 w00, w01, w10, w11;
            w00.x = pk2(p0[0], p0[1]); w00.y = pk2(p0[2], p0[3]); w00.z = pk2(p0[4], p0[5]); w00.w = pk2(p0[6], p0[7]);
            w01.x = pk2(p0[8], p0[9]); w01.y = pk2(p0[10], p0[11]); w01.z = pk2(p0[12], p0[13]); w01.w = pk2(p0[14], p0[15]);
            w10.x = pk2(p1[0], p1[1]); w10.y = pk2(p1[2], p1[3]); w10.z = pk2(p1[4], p1[5]); w10.w = pk2(p1[6], p1[7]);
            w11.x = pk2(p1[8], p1[9]); w11.y = pk2(p1[10], p1[11]); w11.z = pk2(p1[12], p1[13]); w11.w = pk2(p1[14], p1[15]);
            const LAS unsigned char* vb = lds + AT_V + cur * 9216 + r32 * 144 + hi * 32;
#define AT_PV(W, off) do { const bf16x8 pf_ = __builtin_bit_cast(bf16x8, W); \
                const bf16x8 v0_ = *(const LAS bf16x8*)(vb + (off)), v1_ = *(const LAS bf16x8*)(vb + 4608 + (off)); \
                o0 = __builtin_amdgcn_mfma_f32_32x32x16_bf16(v0_, pf_, o0, 0, 0, 0); o1 = __builtin_amdgcn_mfma_f32_32x32x16_bf16(v1_, pf_, o1, 0, 0, 0); } while (0)
            AT_PV(w00, 0); AT_PV(w01, 16); AT_PV(w10, 64); AT_PV(w11, 80);
#undef AT_PV
            alive = __any(C != 0.f);
        }
        if (it + 1 < NT) AT_WRITE(cur ^ 1);
        if (lane == 0) aflag[(it & 1) * 8 + wid] = (unsigned)alive;
        __syncthreads();
        const unsigned fl = (lane < 8) ? aflag[(it & 1) * 8 + lane] : 0u;
        if (!__any(fl != 0u)) break;
    }
#undef AT_WRITE
    LAS float* stg = (LAS float*)(lds + AT_STG + wid * AT_STG_W);
#pragma unroll
    for (int g4 = 0; g4 < 4; ++g4) {
        *(LAS f32x4*)(stg + r32 * 68 + 8 * g4 + 4 * hi) = (f32x4){o0[4 * g4], o0[4 * g4 + 1], o0[4 * g4 + 2], o0[4 * g4 + 3]};
        *(LAS f32x4*)(stg + r32 * 68 + 32 + 8 * g4 + 4 * hi) = (f32x4){o1[4 * g4], o1[4 * g4 + 1], o1[4 * g4 + 2], o1[4 * g4 + 3]};
    }
    asm volatile("s_waitcnt lgkmcnt(0)" ::: "memory");
#pragma unroll
    for (int i = 0; i < 4; ++i) {
        const int row = i * 8 + (lane >> 3), ch = lane & 7;
        f32x4 a0 = *(const LAS f32x4*)(stg + row * 68 + ch * 8), a1 = *(const LAS f32x4*)(stg + row * 68 + ch * 8 + 4);
        const size_t tok = rowbase + qw + row;
        const u32x4 gw_ = *(const u32x4*)(GBb + tok * 1024 + h * HD + ch * 8);
        f32x4 g0, g1; pg8::unpack8(gw_, g0, g1);
#pragma unroll
        for (int e = 0; e < 4; ++e) { a0[e] *= g0[e] * pg8::sigm(g0[e]); a1[e] *= g1[e] * pg8::sigm(g1[e]); }
        if (!dry) *(u32x4*)(UGQ + tok * 2048 + 1024 + h * HD + ch * 8) = pg8::pack8(a0, a1);
    }
    asm volatile("s_waitcnt lgkmcnt(0)" ::: "memory");
}

constexpr int BA_STAT = 0, BA_GB = 1024, BA_VNT = 1024 + 8192, BA_OT = BA_VNT + 128 * 272;
typedef float f32x2_st __attribute__((ext_vector_type(2)));
__device__ __forceinline__ void brancha_unit(int chunk, bf16* UGQ, const bf16* Vb, const bf16* WsB, const float* VST, const float* vn_g, const float* vn_b, const float* b_s, LAS unsigned char* lds, int dry = 0) {
    int tid_ = threadIdx.x; asm volatile("" : "+v"(tid_));
    const int tid = tid_, lane = tid & 63, wid = __builtin_amdgcn_readfirstlane(tid >> 6), r32 = lane & 31, hi = lane >> 5;
    const size_t t0 = (size_t)chunk * 128;
    LAS float* stat = (LAS float*)(lds + BA_STAT);
    LAS float* gbl = (LAS float*)(lds + BA_GB);
    u32x4 vpc[4];
#pragma unroll
    for (int i = 0; i < 4; ++i) { const int p = tid + 512 * i, s = p >> 4, dc = p & 15; vpc[i] = *(const u32x4*)(Vb + (t0 + s) * 1024 + dc * 8); }
    gbl[tid] = vn_g[tid]; gbl[tid + 512] = vn_g[tid + 512]; gbl[1024 + tid] = vn_b[tid]; gbl[1536 + tid] = vn_b[tid + 512];
    if (tid < 128) { const f32x2_st st = *(const f32x2_st*)(VST + 2 * (t0 + tid));
        const float mean = st[0] * (1.f / 1024.f), var = fmaxf(st[1] * (1.f / 1024.f) - mean * mean, 0.f);
        stat[tid * 2] = mean; stat[tid * 2 + 1] = 1.0f / sqrtf(var + LN_EPS); }
    __syncthreads();
    const int dblk = wid & 3, tbp = wid >> 2;
    u32x4 ugp[4]; bf16x8 wf[2][8];
#define BA_LOAD_UG(g_) do { _Pragma("unroll") for (int i = 0; i < 4; ++i) { const int p = tid + 512 * i, t = p >> 4, dc = p & 15; ugp[i] = *(const u32x4*)(UGQ + (t0 + t) * 2048 + (g_) * 128 + dc * 8); } } while (0)
#define BA_LOAD_WS(g_) do { _Pragma("unroll") for (int j = 0; j < 2; ++j) { const int tb = 2 * tbp + j; const bf16* wrow = WsB + ((size_t)(g_) * 128 + 32 * tb + r32) * 128 + hi * 8; \
        _Pragma("unroll") for (int ks = 0; ks < 8; ++ks) if (ks < 2 * (tb + 1)) wf[j][ks] = *(const bf16x8*)(wrow + ks * 16); } } while (0)
    BA_LOAD_WS(0); BA_LOAD_UG(0);
    for (int g = 0; g < 8; ++g) {
#pragma unroll
        for (int i = 0; i < 4; ++i) {
            const int p = tid + 512 * i, s = p >> 4, dc = p & 15;
            f32x4 v0, v1; pg8::unpack8(vpc[i], v0, v1);
            const f32x4 ga = *(const LAS f32x4*)(gbl + g * 128 + dc * 8), gb2 = *(const LAS f32x4*)(gbl + g * 128 + dc * 8 + 4);
            const f32x4 ba = *(const LAS f32x4*)(gbl + 1024 + g * 128 + dc * 8), bb2 = *(const LAS f32x4*)(gbl + 1024 + g * 128 + dc * 8 + 4);
            const float mean = stat[s * 2], rstd = stat[s * 2 + 1];
            v0 = (v0 - mean) * rstd * ga + ba; v1 = (v1 - mean) * rstd * gb2 + bb2;
            const u32x4 w = pg8::pack8(v0, v1);
            LAS unsigned short* dst = (LAS unsigned short*)(lds + BA_VNT) + dc * 136 + s;
            dst[0 * 16 * 136] = (unsigned short)(w.x & 0xffffu); dst[1 * 16 * 136] = (unsigned short)(w.x >> 16); dst[2 * 16 * 136] = (unsigned short)(w.y & 0xffffu); dst[3 * 16 * 136] = (unsigned short)(w.y >> 16);
            dst[4 * 16 * 136] = (unsigned short)(w.z & 0xffffu); dst[5 * 16 * 136] = (unsigned short)(w.z >> 16); dst[6 * 16 * 136] = (unsigned short)(w.w & 0xffffu); dst[7 * 16 * 136] = (unsigned short)(w.w >> 16);
        }
        if (g + 1 < 8) {
#pragma unroll
            for (int i = 0; i < 4; ++i) { const int p = tid + 512 * i, s = p >> 4, dc = p & 15; vpc[i] = *(const u32x4*)(Vb + (t0 + s) * 1024 + (g + 1) * 128 + dc * 8); }
        }
        __syncthreads();
        const int d = 32 * dblk + r32;
        const LAS unsigned char* ab = lds + BA_VNT + ((d & 7) * 16 + (d >> 3)) * 272 + hi * 16;
        f32x16 acc[2];
#pragma unroll
        for (int j = 0; j < 2; ++j) {
            const int tb = 2 * tbp + j;
#pragma unroll
            for (int r = 0; r < 16; ++r) acc[j][r] = 0.f;
#pragma unroll
            for (int ks = 0; ks < 8; ++ks) if (ks < 2 * (tb + 1)) {
                const bf16x8 af = *(const LAS bf16x8*)(ab + ks * 32);
                acc[j] = __builtin_amdgcn_mfma_f32_32x32x16_bf16(af, wf[j][ks], acc[j], 0, 0, 0);
            }
        }
        if (g + 1 < 8) BA_LOAD_WS(g + 1);
#pragma unroll
        for (int j = 0; j < 2; ++j) {
            const int tb = 2 * tbp + j, t = 32 * tb + r32;
            const float bias = b_s[g * 128 + t];
            LAS float* ot = (LAS float*)(lds + BA_OT) + t * 132 + 32 * dblk + 4 * hi;
#pragma unroll
            for (int g4 = 0; g4 < 4; ++g4) *(LAS f32x4*)(ot + 8 * g4) = (f32x4){acc[j][4 * g4] + bias, acc[j][4 * g4 + 1] + bias, acc[j][4 * g4 + 2] + bias, acc[j][4 * g4 + 3] + bias};
        }
        __syncthreads();
#pragma unroll
        for (int i = 0; i < 4; ++i) {
            const int p = tid + 512 * i, t = p >> 4, dc = p & 15;
            const LAS float* ot = (const LAS float*)(lds + BA_OT) + t * 132 + dc * 8;
            const f32x4 m0 = *(const LAS f32x4*)ot, m1 = *(const LAS f32x4*)(ot + 4);
            bf16* up = UGQ + (t0 + t) * 2048 + g * 128 + dc * 8;
            f32x4 u0, u1; pg8::unpack8(ugp[i], u0, u1);
            if (!dry) *(u32x4*)up = pg8::pack8(u0 * m0, u1 * m1);
        }
        if (g + 1 < 8) BA_LOAD_UG(g + 1);
    }
#undef BA_LOAD_UG
#undef BA_LOAD_WS
    __syncthreads();
}

__device__ __forceinline__ void ln_rows(bf16* XH, unsigned char* XQ, float* XS, float* VST, float* OUT, const float* g, const float* bta, bool last, int gw, int NGW, int lane) {
    f32x4 gv[4], bv[4];
#pragma unroll
    for (int j = 0; j < 2; ++j) { gv[2 * j] = *(const f32x4*)(g + 512 * j + lane * 8); gv[2 * j + 1] = *(const f32x4*)(g + 512 * j + lane * 8 + 4);
                                  bv[2 * j] = *(const f32x4*)(bta + 512 * j + lane * 8); bv[2 * j + 1] = *(const f32x4*)(bta + 512 * j + lane * 8 + 4); }
    for (int m = gw; m < T; m += NGW) {
        bf16* xr = XH + (size_t)m * DM + lane * 8;
        f32x4 v[4]; float s = 0.f;
        pg8::unpack8h(*(const u32x4*)xr, v[0], v[1]); pg8::unpack8h(*(const u32x4*)(xr + 512), v[2], v[3]);
#pragma unroll
        for (int j = 0; j < 4; ++j) s += (v[j][0] + v[j][1]) + (v[j][2] + v[j][3]);
        const float mean = wave_sum(s) * (1.f / DM); float s2 = 0.f;
#pragma unroll
        for (int j = 0; j < 4; ++j) { v[j] = v[j] - mean; s2 += (v[j][0] * v[j][0] + v[j][1] * v[j][1]) + (v[j][2] * v[j][2] + v[j][3] * v[j][3]); }
        const float rstd = 1.0f / sqrtf(wave_sum(s2) * (1.f / DM) + LN_EPS);
#pragma unroll
        for (int j = 0; j < 4; ++j) v[j] = v[j] * rstd * gv[j] + bv[j];
        if (last) { float* o = OUT + (size_t)m * DM + lane * 8;
            *(f32x4*)o = v[0]; *(f32x4*)(o + 4) = v[1]; *(f32x4*)(o + 512) = v[2]; *(f32x4*)(o + 516) = v[3]; }
        else { *(u32x4*)xr = pg8::pack8h(v[0], v[1]); *(u32x4*)(xr + 512) = pg8::pack8h(v[2], v[3]);
            float am = 0.f;
#pragma unroll
            for (int j = 0; j < 4; ++j) am = fmaxf(am, fmaxf(fmaxf(fabsf(v[j][0]), fabsf(v[j][1])), fmaxf(fabsf(v[j][2]), fabsf(v[j][3]))));
            am = wave_max(am); const float inv = am > 0.f ? 127.f / am : 0.f;
            unsigned char* xq = XQ + (size_t)m * DM + lane * 8;
            u32x2 w0, w1; w0.x = q4(v[0][0], v[0][1], v[0][2], v[0][3], inv); w0.y = q4(v[1][0], v[1][1], v[1][2], v[1][3], inv);
            w1.x = q4(v[2][0], v[2][1], v[2][2], v[2][3], inv); w1.y = q4(v[3][0], v[3][1], v[3][2], v[3][3], inv);
            *(u32x2*)xq = w0; *(u32x2*)(xq + 512) = w1; if (lane == 0) { XS[m] = am; VST[2 * (size_t)m] = 0.f; VST[2 * (size_t)m + 1] = 0.f; } }
    }
}

#define XB_TMO      128
#define XB_XCNT(j)  (256  + 64 * (j))
#define XB_XSUB(j)  (1280 + 64 * (j))
#define XB_XGEN(j)  (2304 + 64 * (j))
#define XB_TOP      3328
#define XB_TOPGEN   3392
#define XCD_BAR_WORDS 3456
#define XB_SPIN_CAP (1u << 18)

__device__ __forceinline__ unsigned xb_ld(unsigned* p)              { return __hip_atomic_load(p, __ATOMIC_RELAXED, __HIP_MEMORY_SCOPE_AGENT); }
__device__ __forceinline__ unsigned xb_add(unsigned* p, unsigned v) { return __hip_atomic_fetch_add(p, v, __ATOMIC_RELAXED, __HIP_MEMORY_SCOPE_AGENT); }
__device__ __forceinline__ unsigned xb_xcc_id() { return (unsigned)__builtin_amdgcn_s_getreg((3 << 11) | 20) & 0xFu; }
#define XB_SPIN(cond, bar) do { unsigned _sp = 0; while (cond) { __builtin_amdgcn_s_sleep(1); \
    if ((++_sp & 255u) == 0u) { if (xb_ld(&(bar)[XB_TMO])) break; if (_sp > XB_SPIN_CAP) { atomicAdd(&(bar)[XB_TMO], 1u); break; } } } } while (0)

struct XcdBarrier {
    unsigned* bar; unsigned x;
    volatile LAS unsigned* st;
};

__device__ __forceinline__ XcdBarrier xcd_barrier_post(unsigned* bar, volatile LAS unsigned* st) {
    XcdBarrier b; b.bar = bar; b.x = xb_xcc_id(); b.st = st;
    if (threadIdx.x == 0) (void)xb_add(&bar[XB_XCNT(b.x)], 1u);
    return b;
}
__device__ __forceinline__ void xcd_barrier_complete(unsigned* bar, unsigned x, unsigned& nloc, unsigned& nx) {
    const unsigned G = gridDim.x * gridDim.y * gridDim.z;
    unsigned sum, cnt, mine, sp = 0u;
    for (;;) {
        sum = 0u; cnt = 0u; mine = 0u;
#pragma unroll
        for (unsigned j = 0; j < 16; ++j) { const unsigned c = xb_ld(&bar[XB_XCNT(j)]); sum += c; cnt += (c > 0u) ? 1u : 0u; mine = (j == x) ? c : mine; }
        if (sum == G) break;
        __builtin_amdgcn_s_sleep(1);
        if ((++sp & 255u) == 0u) { if (xb_ld(&bar[XB_TMO])) break; if (sp > XB_SPIN_CAP) { atomicAdd(&bar[XB_TMO], 1u); break; } }
    }
    nloc = mine > 0u ? mine : 1u; nx = cnt > 0u ? cnt : 1u;
}

__device__ __forceinline__ void xcd_barrier(const XcdBarrier& b) {
    asm volatile("s_waitcnt vmcnt(0)" ::: "memory");
    __syncthreads();
    if (threadIdx.x == 0) {
        unsigned* bar = b.bar;
        __builtin_amdgcn_s_waitcnt(0);
        unsigned nloc = b.st[0], nx = b.st[1];
        if (nloc == 0u) { xcd_barrier_complete(bar, b.x, nloc, nx); b.st[0] = nloc; b.st[1] = nx; }
        const unsigned old = xb_add(&bar[XB_XSUB(b.x)], 1u);
        const unsigned gen = old / nloc;
        if (old + 1u == (gen + 1u) * nloc) {
            __builtin_amdgcn_fence(__ATOMIC_RELEASE, "agent");
            asm volatile("s_waitcnt vmcnt(0)" ::: "memory");
            const unsigned og = xb_add(&bar[XB_TOP], 1u);
            const unsigned tg = og / nx;
            if (og + 1u == (tg + 1u) * nx) xb_add(&bar[XB_TOPGEN], 1u);
            else XB_SPIN(xb_ld(&bar[XB_TOPGEN]) == tg, bar);
            __builtin_amdgcn_fence(__ATOMIC_ACQUIRE, "agent");
            xb_add(&bar[XB_XGEN(b.x)], 1u);
            asm volatile("s_waitcnt vmcnt(0)" ::: "memory");
        } else {
            XB_SPIN(xb_ld(&bar[XB_XGEN(b.x)]) == gen, bar);
            __builtin_amdgcn_fence(__ATOMIC_ACQUIRE, "agent");
            asm volatile("s_waitcnt vmcnt(0)" ::: "memory");
        }
    }
    __syncthreads();
}

__global__ void __launch_bounds__(512, 2) fwd_kernel(Args a) {
    extern __shared__ __attribute__((aligned(16))) unsigned char lds_raw[];
    cg::grid_group grid = cg::this_grid();
    LAS unsigned char* lds = (LAS unsigned char*)lds_raw;
    const int G = gridDim.x, bx = blockIdx.x;
    const int vcu = (G % 8 == 0) ? (bx % 8) * (G / 8) + bx / 8 : bx;
    const int NGW = G * 8;
#define LAUNDER_TID int tid_l = threadIdx.x; asm volatile("" : "+v"(tid_l)); const int lane = tid_l & 63, wave = __builtin_amdgcn_readfirstlane(tid_l >> 6), gw = vcu * 8 + wave;
#define WSW(name, off) size_t name##_o = (off); asm volatile("" : "+s"(name##_o)); bf16* const name = (bf16*)(((l & 1) ? (unsigned char*)a.out : a.ws) + name##_o);
#define WSP(name, off) size_t name##_o = (off); asm volatile("" : "+s"(name##_o)); bf16* const name = (bf16*)(a.ws + name##_o);
    volatile LAS unsigned* MISC = (volatile LAS unsigned*)(lds + RING_BYTES + 256);
    if (threadIdx.x < 16) MISC[threadIdx.x] = 0u;
    unsigned* barw = (unsigned*)(a.ws + WS_BARW);
    __syncthreads();
    const XcdBarrier xbar = xcd_barrier_post(barw, MISC + 8);
    { LAUNDER_TID
    for (int tk = gw; tk < 4 * 144 * 16; tk += NGW) { const int l4 = tk / (144 * 16), cg = (tk >> 4) % 144, kc = tk & 15, c = 64 * cg + lane;
        const int drow = win_dest_row(c), slot = drow >= 7168 ? -2 : pg8::p1_qslot(__builtin_amdgcn_readfirstlane(drow) >> 8);
        if (slot == -1) continue;
        const float* wp = a.in[2] + (size_t)l4 * DM * NIN + (size_t)(64 * kc) * NIN + c; float mx = 0.f;
#pragma unroll 16
        for (int kk = 0; kk < 64; ++kk) mx = fmaxf(mx, fabsf(wp[(size_t)kk * NIN]));
        unsigned* dst = slot == -2 ? (unsigned*)(a.ws + WS_CMAX) + l4 * 2048 + (drow - 7168) : (unsigned*)(a.ws + WS_CMAX1) + l4 * (pg8::P1_NQ * 256) + slot * 256 + (drow & 255);
        atomicMax(dst, __float_as_uint(mx)); }
    convert_layer(a, 0, lds, gw, NGW, lane, wave, false);
    { const float* x = a.in[0]; WSP(XH, WS_XH) unsigned char* XQ = (unsigned char*)a.out + OUT_XQ; float* XS = (float*)(a.ws + WS_XS);
      for (int m = gw; m < T; m += NGW) { const float* xr = x + (size_t)m * DM + lane * 8;
          const f32x4 v0 = *(const f32x4*)xr, v1 = *(const f32x4*)(xr + 4), v2 = *(const f32x4*)(xr + 512), v3 = *(const f32x4*)(xr + 516);
          bf16* xo = XH + (size_t)m * DM + lane * 8; *(u32x4*)xo = pg8::pack8h(v0, v1); *(u32x4*)(xo + 512) = pg8::pack8h(v2, v3);
          float am = fmaxf(fmaxf(fmaxf(fabsf(v0[0]), fabsf(v0[1])), fmaxf(fabsf(v0[2]), fabsf(v0[3]))), fmaxf(fmaxf(fabsf(v1[0]), fabsf(v1[1])), fmaxf(fabsf(v1[2]), fabsf(v1[3]))));
          am = fmaxf(am, fmaxf(fmaxf(fmaxf(fabsf(v2[0]), fabsf(v2[1])), fmaxf(fabsf(v2[2]), fabsf(v2[3]))), fmaxf(fmaxf(fabsf(v3[0]), fabsf(v3[1])), fmaxf(fabsf(v3[2]), fabsf(v3[3])))));
          am = wave_max(am); const float inv = am > 0.f ? 127.f / am : 0.f;
          unsigned char* xq = XQ + (size_t)m * DM + lane * 8;
          u32x2 w0, w1; w0.x = q4(v0[0], v0[1], v0[2], v0[3], inv); w0.y = q4(v1[0], v1[1], v1[2], v1[3], inv); w1.x = q4(v2[0], v2[1], v2[2], v2[3], inv); w1.y = q4(v3[0], v3[1], v3[2], v3[3], inv);
          *(u32x2*)xq = w0; *(u32x2*)(xq + 512) = w1; if (lane == 0) { XS[m] = am; float* vs = (float*)(a.ws + WS_VST) + 2 * (size_t)m; vs[0] = 0.f; vs[1] = 0.f; } } } }
    if (a.ws == nullptr) grid.sync();
    xcd_barrier(xbar);
#define GRID_SYNC() xcd_barrier(xbar)
#pragma unroll 1
    for (int l = 0; l < DEPTH; ++l) {
#ifndef SKIP_P1
        if (l == 0) { LAUNDER_TID
            LAS float* scr = (LAS float*)(lds + wave * 8704);
            for (int it = gw; it < 16 * (NIN / 32); it += NGW) win_item(a, 0, a.ws, it / (NIN / 32), it % (NIN / 32), 1, scr, lane);
            GRID_SYNC(); }
        { WSP(XH, WS_XH) WSW(WinT, WS_WIN) WSP(UGQ, WS_UGQ) WSP(Vb, WS_V) WSP(Kb, WS_K) WSP(VBb, WS_VB) WSP(GBb, WS_GB)
          if constexpr (pg8::P1_NF > 0)
          { pg8::Gemm g{XH, WinT + (size_t)(pg8::P1_F0 * 256) * DM, T, pg8::P1_NF * 256, DM, DM}; pg8::StaticOrder S; S.init(T, pg8::P1_NF * 256, G, bx);
            pg8::Epi1<false> E{UGQ, Vb, Kb, VBb, GBb, QSCALE, nullptr, nullptr, nullptr};
            pg8::gemm_phase<pg8::Epi1<false>, pg8::StaticOrder, true, true, 1>(lds, g, S, E); }
          { const bf16* XQ = (const bf16*)((const unsigned char*)a.out + OUT_XQ);
            pg8::Gemm g{XQ, WinT, T, pg8::P1_NQ * 256, 512, 512}; pg8::StaticOrder S; S.init(T, pg8::P1_NQ * 256, G, bx);
            pg8::Epi1<true> E{UGQ, Vb, Kb, VBb, GBb, QSCALE, (const float*)(a.ws + WS_XS), (const float*)(a.ws + WS_CMAX1) + l * (pg8::P1_NQ * 256), (float*)(a.ws + WS_VST)};
            pg8::gemm_phase<pg8::Epi1<true>, pg8::StaticOrder, true, true, 2>(lds, g, S, E); }
        }
#endif
        GRID_SYNC();
        { WSP(UGQ, WS_UGQ) WSP(Vb, WS_V) WSW(WsB, WS_WS) WSP(Kb, WS_K) WSP(VBb, WS_VB) WSP(GBb, WS_GB)
#pragma unroll 1
        for (int st = 0; st < 2; ++st) {
            if (((st ^ vcu) & 1) == 0) {
#ifndef SKIP_BA
                for (int c = vcu; c < T / 128; c += G)
                    brancha_unit(c, UGQ, Vb, WsB, (const float*)(a.ws + WS_VST), a.in[3] + l * DM, a.in[4] + l * DM, a.in[6] + l * 8 * 128, lds);
#endif
            } else {
#ifndef SKIP_AT
#pragma unroll 1
                for (int pu2 = 2 * vcu; pu2 < 128 * 16; pu2 += 2 * G) {
#pragma unroll 1
                    for (int j2 = 0; j2 < 2; ++j2) {
                        const int pu = pu2 >> 1, bh = pu >> 3, s = pu & 7;
                        attn_unit(bh >> 4, bh & 15, j2 ? s : 15 - s, UGQ, Kb, VBb, GBb, lds);
                    }
                }
#endif
            }
        }
        if (l + 1 < DEPTH) { __syncthreads(); LAUNDER_TID convert_layer(a, l + 1, lds, gw, NGW, lane, wave); }
        }
        GRID_SYNC();
#ifndef SKIP_P25
        { WSW(WinT, WS_WIN) WSP(SMA, WS_K) WSP(SMB, WS_VB)
          const bf16* XQ = (const bf16*)((const unsigned char*)a.out + OUT_XQ);
          pg8::Gemm g{XQ, WinT + (size_t)7168 * DM, T, 2048, 512, 512}; pg8::GateOrder S; S.init(T, G, bx);
          pg8::EpiGateQ E{SMA, SMB, (const float*)(a.ws + WS_XS), (const float*)(a.ws + WS_CMAX) + l * 2048};
          pg8::gemm_phase<pg8::EpiGateQ, pg8::GateOrder, true, true, 2>(lds, g, S, E); }
        { WSW(PB, WS_PB) WSW(WeT, WS_WE) WSP(EB, WS_GB)
          int kp = PLE; asm volatile("" : "+s"(kp));
          pg8::Gemm g{PB, WeT, T, DM, kp, kp}; pg8::StaticOrder S; S.init(T, DM, G, bx);
          pg8::EpiStore<0> E{EB, EB};
          pg8::gemm_phase<pg8::EpiStore<0>, pg8::StaticOrder, true, true>(lds, g, S, E); }
#endif
#ifndef SKIP_P3
        { WSP(UGQ, WS_UGQ) WSW(W2T, WS_W2) WSP(SMA, WS_K) WSP(SMB, WS_VB) WSP(MERGED, WS_V)
          pg8::Gemm g{UGQ, W2T, T, DM, 2048, 2048}; pg8::StaticOrder S; S.init(T, DM, G, bx);
          pg8::Epi2 E{SMA, SMB, MERGED};
          pg8::gemm_phase<pg8::Epi2, pg8::StaticOrder, true, true>(lds, g, S, E);
#ifdef PROBE_DUP_P3
          pg8::gemm_phase<pg8::Epi2, pg8::StaticOrder, true, true>(lds, g, S, E);
#endif
        }
#endif
        GRID_SYNC();
#ifndef SKIP_P4
        { WSP(MERGED, WS_V) WSW(WoT, WS_WO) WSP(XH1, WS_XH1) WSP(XH, WS_XH)
          pg8::Gemm g{MERGED, WoT, T, DM, DM, DM}; pg8::StaticOrder S; S.init(T, DM, G, bx);
          pg8::Epi3 E{XH, XH1, ALPHA};
          pg8::gemm_phase<pg8::Epi3, pg8::StaticOrder, true, true>(lds, g, S, E); }
#endif
        GRID_SYNC();
#ifndef SKIP_P5
        { WSP(XH1, WS_XH1) WSW(WgT, WS_WG) WSP(EB, WS_GB) WSP(XH, WS_XH)
          pg8::Gemm g{XH1, WgT, T, DM, DM, DM}; pg8::StaticOrder S; S.init(T, DM, G, bx);
          pg8::Epi4 E{XH1, XH, EB};
          pg8::gemm_phase<pg8::Epi4, pg8::StaticOrder, true, true, true>(lds, g, S, E); }
#endif
        GRID_SYNC();
#ifdef PROBE_SYNC
        for (int z = 0; z < 10; ++z) GRID_SYNC();
#endif
        LAUNDER_TID WSP(XH, WS_XH)
        ln_rows(XH, (unsigned char*)a.out + OUT_XQ, (float*)(a.ws + WS_XS), (float*)(a.ws + WS_VST), a.out, a.in[12] + l * DM, a.in[13] + l * DM, l + 1 == DEPTH, gw, NGW, lane);
        if (l + 1 < DEPTH) GRID_SYNC();
    }
}

extern "C" void kernel_launch(void* const* d_in, const int* in_sizes, int n_in, void* d_out, int out_size, void* d_ws, size_t ws_size, hipStream_t stream) {
    static int grid = 0;
    if (grid == 0) {
        if (n_in != 14 || out_size != T * DM || ws_size < WS_END) { fprintf(stderr, "kernel_launch: unexpected shapes (n_in %d out %d ws %zu)\n", n_in, out_size, ws_size); grid = -1; return; }
        int dev = 0, cus = 0, per_cu = 0;
        hipGetDevice(&dev); hipDeviceGetAttribute(&cus, hipDeviceAttributeMultiprocessorCount, dev);
        hipFuncSetAttribute((const void*)fwd_kernel, hipFuncAttributeMaxDynamicSharedMemorySize, LDS_BYTES);
        hipOccupancyMaxActiveBlocksPerMultiprocessor(&per_cu, (const void*)fwd_kernel, 512, LDS_BYTES);
        if (per_cu < 1) per_cu = 1;
        grid = cus;
        (void)hipGetLastError();
    }
    if (grid < 0) return;
    Args a{};
    for (int i = 0; i < 14; ++i) a.in[i] = (const float*)d_in[i];
    a.out = (float*)d_out; a.ws = (unsigned char*)d_ws;
    hipMemsetAsync((char*)d_ws + WS_BARW, 0, 16384 + 4 * (2048 + pg8::P1_NQ * 256) * sizeof(float), stream);
    void* args[] = {&a};
    hipError_t e = hipLaunchCooperativeKernel((const void*)fwd_kernel, dim3(grid), dim3(512), args, LDS_BYTES, stream);
    if (e != hipSuccess) fprintf(stderr, "cooperative launch failed: %s (grid %d)\n", hipGetErrorString(e), grid);
}
```

```cpp
#include <hip/hip_runtime.h>
#include <hip/hip_cooperative_groups.h>
#include <cstdio>
#include <cstdint>
namespace cg = cooperative_groups;
namespace pg8 {
#define PG8_LAS __attribute__((address_space(3)))
typedef unsigned short bf16_t;
typedef short bf16x8 __attribute__((ext_vector_type(8)));
typedef _Float16 f16x8 __attribute__((ext_vector_type(8)));
typedef int i32x4 __attribute__((ext_vector_type(4)));
typedef float f32x4 __attribute__((ext_vector_type(4)));
typedef unsigned u32x4 __attribute__((ext_vector_type(4)));
constexpr int BM = 256, BK = 64, HALF = 128, HTB = HALF * BK * 2  , STAGE_BYTES = 8 * HTB, NXCD = 8, WGM = 8;

__host__ __device__ __forceinline__ int lds_byte(int r, int c) { const int st = (r >> 4) * 2 + (c >> 5), rr = r & 15, cc = c & 31, ob = rr * 64 + cc * 2; return st * 1024 + (ob ^ (((ob >> 9) & 1) << 5)); }
__host__ __device__ __forceinline__ void stage_rc(int b, int& R, int& C) { const int st = b / 1024, sb = b % 1024, swz = sb ^ (((sb >> 9) & 1) << 5); R = (st >> 1) * 16 + swz / 64; C = (st & 1) * 32 + (swz % 64) / 2; }
__host__ __device__ __forceinline__ int perm32(int rho) { const int n = rho >> 4, i = rho & 15; return 8 * (i >> 2) + 4 * n + (i & 3); }

struct Unit { int pm, pn; };
struct Gemm { const bf16_t* A; const bf16_t* Bt; int M, N, K, lda; };

struct StaticOrder {
    int nM, nN, nwg, G, c;
    __host__ __device__ void init(int M, int N, int G_, int c_) { nM = M / BM; nN = N / BM; nwg = nM * nN; G = G_; c = c_; }
    __host__ __device__ bool next(int i, Unit& u) const {
        const long L = (long)i * G + c; if (L >= nwg) return false;
        int wgid = (int)L; { const int q = nwg / NXCD, r = nwg % NXCD, xcd = wgid % NXCD, off = wgid / NXCD; wgid = (xcd < r ? xcd * (q + 1) : r * (q + 1) + (xcd - r) * q) + off; }
        const int nig = WGM * nN, gid = wgid / nig, fm = gid * WGM, gsz = (nM - fm) < WGM ? (nM - fm) : WGM;
        u.pm = fm + ((wgid % nig) % gsz); u.pn = (wgid % nig) / gsz; return true;
    }
    __device__ __forceinline__ void a_ready(const Unit&) const {}
    __device__ __forceinline__ void done(const Unit&) const {}
};
struct GateOrder {
    StaticOrder inner;
    __host__ __device__ void init(int M, int G_, int c_) { inner.init(M, 1024, G_, c_); }
    __host__ __device__ bool next(int i, Unit& u) const { Unit v; if (!inner.next(i >> 1, v)) return false; u.pm = v.pm; u.pn = 2 * v.pn + (i & 1); return true; }
    __device__ __forceinline__ void a_ready(const Unit&) const {}
    __device__ __forceinline__ void done(const Unit&) const {}
};


typedef float f32x2_t __attribute__((ext_vector_type(2))); typedef __bf16 bf16x2_t __attribute__((ext_vector_type(2)));
__device__ __forceinline__ unsigned cvt_pk_bf16(float lo, float hi) { f32x2_t v = {lo, hi}; bf16x2_t b = __builtin_convertvector(v, bf16x2_t); return __builtin_bit_cast(unsigned, b); }
__device__ __forceinline__ float sigm(float x) { return __builtin_amdgcn_rcpf(1.f + __builtin_amdgcn_exp2f(-1.4426950408889634f * x)); }
__device__ __forceinline__ u32x4 pack8(const f32x4 a, const f32x4 b) { u32x4 w; w.x = cvt_pk_bf16(a[0], a[1]); w.y = cvt_pk_bf16(a[2], a[3]); w.z = cvt_pk_bf16(b[0], b[1]); w.w = cvt_pk_bf16(b[2], b[3]); return w; }
__device__ __forceinline__ void unpack8(const u32x4 w, f32x4& a, f32x4& b) {
    a[0] = __uint_as_float(w.x << 16); a[1] = __uint_as_float(w.x & 0xffff0000u); a[2] = __uint_as_float(w.y << 16); a[3] = __uint_as_float(w.y & 0xffff0000u);
    b[0] = __uint_as_float(w.z << 16); b[1] = __uint_as_float(w.z & 0xffff0000u); b[2] = __uint_as_float(w.w << 16); b[3] = __uint_as_float(w.w & 0xffff0000u); }
typedef _Float16 f16x2_t __attribute__((ext_vector_type(2)));
__device__ __forceinline__ unsigned cvt_pk_f16(float lo, float hi) { f32x2_t v = {lo, hi}; f16x2_t h = __builtin_convertvector(v, f16x2_t); return __builtin_bit_cast(unsigned, h); }
__device__ __forceinline__ u32x4 pack8h(const f32x4 a, const f32x4 b) { u32x4 w; w.x = cvt_pk_f16(a[0], a[1]); w.y = cvt_pk_f16(a[2], a[3]); w.z = cvt_pk_f16(b[0], b[1]); w.w = cvt_pk_f16(b[2], b[3]); return w; }
__device__ __forceinline__ void unpack8h(const u32x4 w, f32x4& a, f32x4& b) {
    const unsigned x0 = w.x, x1 = w.y, x2 = w.z, x3 = w.w;
    const f32x2_t p0 = __builtin_convertvector(__builtin_bit_cast(f16x2_t, x0), f32x2_t), p1 = __builtin_convertvector(__builtin_bit_cast(f16x2_t, x1), f32x2_t);
    const f32x2_t p2 = __builtin_convertvector(__builtin_bit_cast(f16x2_t, x2), f32x2_t), p3 = __builtin_convertvector(__builtin_bit_cast(f16x2_t, x3), f32x2_t);
    a[0] = p0[0]; a[1] = p0[1]; a[2] = p1[0]; a[3] = p1[1]; b[0] = p2[0]; b[1] = p2[1]; b[2] = p3[0]; b[3] = p3[1]; }
#define PG8_FENCE asm volatile("" ::: "memory")

#ifndef P1_ALL_INT8
#define P1_ALL_INT8 1
#endif
#if P1_ALL_INT8
constexpr int P1_NQ = 28, P1_F0 = 28, P1_NF = 0;
__host__ __device__ constexpr int p1_qtile(int j) { return j; }
__host__ __device__ constexpr int p1_qslot(int tile) { return tile < 28 ? tile : -1; }
#else
constexpr int P1_NQ = 20, P1_F0 = 12, P1_NF = 8;
__host__ __device__ constexpr int p1_qtile(int j) { return j < 12 ? j : 20 + (j - 12); }
__host__ __device__ constexpr int p1_qslot(int tile) { return tile < 12 ? tile : (tile >= 20 && tile < 28 ? 12 + (tile - 20) : -1); }
#endif
template <bool Q> struct Epi1 {
    static constexpr bool PERM = true, AFTER_DRAIN = false, HAS_MID = false;
    bf16_t *UGQ, *V, *K, *VB, *GB; float qscale; const float* XS; const float* CS; float* VST;
    __device__ __forceinline__ static f32x4 val(const f32x4 a, float rs, const f32x4 cs) {
        if constexpr (Q) { const i32x4 q = __builtin_bit_cast(i32x4, a); return (f32x4){(float)q[0], (float)q[1], (float)q[2], (float)q[3]} * (cs * rs); } else return a; }
    __device__ __forceinline__ void operator()(const f32x4 (&acc)[2][2][4][2], const Unit& u, int wr, int wc, int fr, int fq) const {
        asm volatile("" : "+v"(fr), "+v"(fq));
        const int row0 = u.pm * BM + wr * 64 + fr, cw = wc * 32 + 8 * fq;
        const int pn = Q ? p1_qtile(u.pn) : u.pn + P1_F0;
        float rsc[2][4]; f32x4 cs[2][2];
#pragma unroll
        for (int ai = 0; ai < 2; ++ai)
#pragma unroll
            for (int m = 0; m < 4; ++m) rsc[ai][m] = Q ? XS[row0 + ai * HALF + m * 16] * (1.f / (127.f * 127.f)) : 1.f;
#pragma unroll
        for (int bj = 0; bj < 2; ++bj)
#pragma unroll
            for (int n = 0; n < 2; ++n) cs[bj][n] = Q ? *(const f32x4*)(CS + u.pn * BM + bj * HALF + cw + 4 * n) : (f32x4){1.f, 1.f, 1.f, 1.f};
        if (pn < 8) {
            bf16_t* base = UGQ + pn * 128 + cw;
#pragma unroll
            for (int ai = 0; ai < 2; ++ai)
#pragma unroll
                for (int m = 0; m < 4; ++m) {
                    f32x4 u0 = val(acc[ai][0][m][0], rsc[ai][m], cs[0][0]), u1 = val(acc[ai][0][m][1], rsc[ai][m], cs[0][1]);
                    const f32x4 g0 = val(acc[ai][1][m][0], rsc[ai][m], cs[1][0]), g1 = val(acc[ai][1][m][1], rsc[ai][m], cs[1][1]);
#pragma unroll
                    for (int e = 0; e < 4; ++e) { u0[e] *= g0[e] * sigm(g0[e]); u1[e] *= g1[e] * sigm(g1[e]); }
                    __builtin_nontemporal_store(pack8(u0, u1), (u32x4*)(base + (size_t)(row0 + ai * HALF + m * 16) * 2048));
                }
        } else {
            const int seg = (pn - 8) >> 2, ct = (pn - 8) & 3;
            bf16_t* base; int ldc = 1024; float sc = 1.f;
            if (seg == 0) base = V; else if (seg == 1) { base = UGQ + 1024; ldc = 2048; sc = qscale; } else if (seg == 2) base = K; else if (seg == 3) base = VB; else base = GB;
            base += ct * 256 + cw;
#pragma unroll
            for (int ai = 0; ai < 2; ++ai)
#pragma unroll
                for (int m = 0; m < 4; ++m) { bf16_t* rowp = base + (size_t)(row0 + ai * HALF + m * 16) * ldc; float ssum = 0.f, sq = 0.f;
#pragma unroll
                    for (int bj = 0; bj < 2; ++bj) { const u32x4 w = pack8(val(acc[ai][bj][m][0], rsc[ai][m], cs[bj][0]) * sc, val(acc[ai][bj][m][1], rsc[ai][m], cs[bj][1]) * sc);
                        __builtin_nontemporal_store(w, (u32x4*)(rowp + bj * HALF));
                        if (seg == 0) { f32x4 q0, q1; unpack8(w, q0, q1);
                            ssum += (q0[0] + q0[1]) + (q0[2] + q0[3]) + (q1[0] + q1[1]) + (q1[2] + q1[3]);
                            sq += (q0[0] * q0[0] + q0[1] * q0[1]) + (q0[2] * q0[2] + q0[3] * q0[3]) + (q1[0] * q1[0] + q1[1] * q1[1]) + (q1[2] * q1[2] + q1[3] * q1[3]); } }
                    if (seg == 0) { ssum += __shfl_xor(ssum, 16); ssum += __shfl_xor(ssum, 32); sq += __shfl_xor(sq, 16); sq += __shfl_xor(sq, 32);
                        if (fq == 0) { float* sp = VST + 2 * (size_t)(row0 + ai * HALF + m * 16); atomicAdd(sp, ssum); atomicAdd(sp + 1, sq); } } }
        }
    }
};
template <int SIG> struct EpiStore {
    static constexpr bool PERM = true, AFTER_DRAIN = false, HAS_MID = false;
    bf16_t *D0, *D1;
    __device__ __forceinline__ void operator()(const f32x4 (&acc)[2][2][4][2], const Unit& u, int wr, int wc, int fr, int fq) const {
        asm volatile("" : "+v"(fr), "+v"(fq));
        const int row0 = u.pm * BM + wr * 64 + fr, cw = wc * 32 + 8 * fq;
        bf16_t* base = (u.pn < 4 ? D0 : D1) + (u.pn & 3) * 256 + cw;
#pragma unroll
        for (int ai = 0; ai < 2; ++ai)
#pragma unroll
            for (int m = 0; m < 4; ++m) { bf16_t* rowp = base + (size_t)(row0 + ai * HALF + m * 16) * 1024;
#pragma unroll
                for (int bj = 0; bj < 2; ++bj) { f32x4 v0 = acc[ai][bj][m][0], v1 = acc[ai][bj][m][1];
                    if (SIG) {
#pragma unroll
                        for (int e = 0; e < 4; ++e) { v0[e] = sigm(v0[e]); v1[e] = sigm(v1[e]); } }
                    __builtin_nontemporal_store(pack8(v0, v1), (u32x4*)(rowp + bj * HALF)); } }
    }
};
struct EpiGate {
    static constexpr bool PERM = true, AFTER_DRAIN = false, HAS_MID = false;
    bf16_t *RHO, *SMB;
    __device__ __forceinline__ void operator()(const f32x4 (&acc)[2][2][4][2], const Unit& u, int wr, int wc, int fr, int fq) const {
        asm volatile("" : "+v"(fr), "+v"(fq));
        const int row0 = u.pm * BM + wr * 64 + fr, c0 = u.pn * 128 + wc * 32 + 8 * fq;
#pragma unroll
        for (int ai = 0; ai < 2; ++ai)
#pragma unroll
            for (int m = 0; m < 4; ++m) { const size_t off = (size_t)(row0 + ai * HALF + m * 16) * 1024 + c0;
                f32x4 r0, r1, s0, s1;
#pragma unroll
                for (int e = 0; e < 4; ++e) {
                    const float ea0 = __builtin_amdgcn_exp2f(fminf(-1.4426950408889634f * acc[ai][0][m][0][e], 80.f)), eb0 = __builtin_amdgcn_exp2f(fminf(-1.4426950408889634f * acc[ai][1][m][0][e], 80.f));
                    const float ea1 = __builtin_amdgcn_exp2f(fminf(-1.4426950408889634f * acc[ai][0][m][1][e], 80.f)), eb1 = __builtin_amdgcn_exp2f(fminf(-1.4426950408889634f * acc[ai][1][m][1][e], 80.f));
                    r0[e] = (1.f + eb0) * __builtin_amdgcn_rcpf(1.f + ea0); r1[e] = (1.f + eb1) * __builtin_amdgcn_rcpf(1.f + ea1);
                    s0[e] = __builtin_amdgcn_rcpf(1.f + eb0); s1[e] = __builtin_amdgcn_rcpf(1.f + eb1); }
                *(u32x4*)(RHO + off) = pack8(r0, r1); *(u32x4*)(SMB + off) = pack8(s0, s1); }
    }
};
struct EpiGateQ {
    static constexpr bool PERM = true, AFTER_DRAIN = false, HAS_MID = false;
    bf16_t *RHO, *SMB; const float* XS; const float* CS;
    __device__ __forceinline__ void operator()(const f32x4 (&acc)[2][2][4][2], const Unit& u, int wr, int wc, int fr, int fq) const {
        asm volatile("" : "+v"(fr), "+v"(fq));
        const int row0 = u.pm * BM + wr * 64 + fr, c0 = u.pn * 128 + wc * 32 + 8 * fq;
        float rsc[2][4]; f32x4 cs[2][2];
#pragma unroll
        for (int ai = 0; ai < 2; ++ai)
#pragma unroll
            for (int m = 0; m < 4; ++m) rsc[ai][m] = XS[row0 + ai * HALF + m * 16] * (1.f / (127.f * 127.f));
#pragma unroll
        for (int bj = 0; bj < 2; ++bj) { const int ci = u.pn * BM + bj * HALF + wc * 32 + 8 * fq; cs[bj][0] = *(const f32x4*)(CS + ci); cs[bj][1] = *(const f32x4*)(CS + ci + 4); }
#pragma unroll
        for (int ai = 0; ai < 2; ++ai)
#pragma unroll
            for (int m = 0; m < 4; ++m) { const size_t off = (size_t)(row0 + ai * HALF + m * 16) * 1024 + c0;
                f32x4 r0, r1, s0, s1;
#pragma unroll
                for (int e = 0; e < 4; ++e) {
                    const i32x4 qa0 = __builtin_bit_cast(i32x4, acc[ai][0][m][0]), qa1 = __builtin_bit_cast(i32x4, acc[ai][0][m][1]), qb0 = __builtin_bit_cast(i32x4, acc[ai][1][m][0]), qb1 = __builtin_bit_cast(i32x4, acc[ai][1][m][1]);
                    const float ma0 = (float)qa0[e] * (rsc[ai][m] * cs[0][0][e]), ma1 = (float)qa1[e] * (rsc[ai][m] * cs[0][1][e]);
                    const float mb0 = (float)qb0[e] * (rsc[ai][m] * cs[1][0][e]), mb1 = (float)qb1[e] * (rsc[ai][m] * cs[1][1][e]);
                    const float ea0 = __builtin_amdgcn_exp2f(fminf(-1.4426950408889634f * ma0, 80.f)), eb0 = __builtin_amdgcn_exp2f(fminf(-1.4426950408889634f * mb0, 80.f));
                    const float ea1 = __builtin_amdgcn_exp2f(fminf(-1.4426950408889634f * ma1, 80.f)), eb1 = __builtin_amdgcn_exp2f(fminf(-1.4426950408889634f * mb1, 80.f));
                    r0[e] = (1.f + eb0) * __builtin_amdgcn_rcpf(1.f + ea0); r1[e] = (1.f + eb1) * __builtin_amdgcn_rcpf(1.f + ea1);
                    s0[e] = __builtin_amdgcn_rcpf(1.f + eb0); s1[e] = __builtin_amdgcn_rcpf(1.f + eb1); }
                *(u32x4*)(RHO + off) = pack8(r0, r1); *(u32x4*)(SMB + off) = pack8(s0, s1); }
    }
};
struct Epi2 {
    static constexpr bool PERM = true, AFTER_DRAIN = false, HAS_MID = true;
    const bf16_t *SMA, *SMB; bf16_t* OUT;
    __device__ __forceinline__ void mid(f32x4 (&acc)[2][2][4][2], const Unit& u, int wr, int wc, int fr, int fq) const {
        asm volatile("" : "+v"(fr), "+v"(fq));
        const int row0 = u.pm * BM + wr * 64 + fr, c0 = u.pn * BM + wc * 32 + 8 * fq;
#pragma unroll
        for (int ai = 0; ai < 2; ++ai) {
            u32x4 wa[4][2];
#pragma unroll
            for (int m = 0; m < 4; ++m) { const size_t off = (size_t)(row0 + ai * HALF + m * 16) * 1024 + c0;
#pragma unroll
                for (int bj = 0; bj < 2; ++bj) wa[m][bj] = *(const u32x4*)(SMA + off + bj * HALF); }
            PG8_FENCE;
#pragma unroll
            for (int m = 0; m < 4; ++m)
#pragma unroll
                for (int bj = 0; bj < 2; ++bj) { f32x4 a0, a1; unpack8(wa[m][bj], a0, a1); acc[ai][bj][m][0] *= a0; acc[ai][bj][m][1] *= a1; }
            PG8_FENCE; }
    }
    __device__ __forceinline__ void operator()(const f32x4 (&acc)[2][2][4][2], const Unit& u, int wr, int wc, int fr, int fq) const {
        asm volatile("" : "+v"(fr), "+v"(fq));
        const int row0 = u.pm * BM + wr * 64 + fr, c0 = u.pn * BM + wc * 32 + 8 * fq;
        u32x4 wb[2][4][2];
#pragma unroll
        for (int ai = 0; ai < 2; ++ai)
#pragma unroll
            for (int m = 0; m < 4; ++m) { const size_t off = (size_t)(row0 + ai * HALF + m * 16) * 1024 + c0;
#pragma unroll
                for (int bj = 0; bj < 2; ++bj) wb[ai][m][bj] = *(const u32x4*)(SMB + off + bj * HALF); }
        PG8_FENCE;
#pragma unroll
        for (int ai = 0; ai < 2; ++ai)
#pragma unroll
            for (int m = 0; m < 4; ++m) { const size_t off = (size_t)(row0 + ai * HALF + m * 16) * 1024 + c0;
#pragma unroll
                for (int bj = 0; bj < 2; ++bj) { f32x4 b0, b1; unpack8(wb[ai][m][bj], b0, b1);
                    *(u32x4*)(OUT + off + bj * HALF) = pack8(acc[ai][bj][m][0] * b0, acc[ai][bj][m][1] * b1); } }
    }
};
struct Epi3 {
    static constexpr bool PERM = true, AFTER_DRAIN = false, HAS_MID = false;
    const bf16_t* XH; bf16_t* XO; float alpha;
    __device__ __forceinline__ void operator()(const f32x4 (&acc)[2][2][4][2], const Unit& u, int wr, int wc, int fr, int fq) const {
        asm volatile("" : "+v"(fr), "+v"(fq));
        const int row0 = u.pm * BM + wr * 64 + fr, c0 = u.pn * BM + wc * 32 + 8 * fq;
#pragma unroll
        for (int ai = 0; ai < 2; ++ai) {
            u32x4 wx[4][2];
#pragma unroll
            for (int m = 0; m < 4; ++m) { const size_t off = (size_t)(row0 + ai * HALF + m * 16) * 1024 + c0;
#pragma unroll
                for (int bj = 0; bj < 2; ++bj) wx[m][bj] = *(const u32x4*)(XH + off + bj * HALF); }
            PG8_FENCE;
#pragma unroll
            for (int m = 0; m < 4; ++m) { const size_t off = (size_t)(row0 + ai * HALF + m * 16) * 1024 + c0;
#pragma unroll
                for (int bj = 0; bj < 2; ++bj) { f32x4 r0, r1; unpack8h(wx[m][bj], r0, r1);
                    const f32x4 h0 = r0 * alpha + acc[ai][bj][m][0], h1 = r1 * alpha + acc[ai][bj][m][1];
                    *(u32x4*)(XO + off + bj * HALF) = pack8h(h0, h1); } }
            PG8_FENCE; }
    }
};
struct Epi4 {
    static constexpr bool PERM = true, AFTER_DRAIN = false, HAS_MID = false;
    const bf16_t* H0; bf16_t* XO; const bf16_t* E;
    __device__ __forceinline__ void operator()(const f32x4 (&acc)[2][2][4][2], const Unit& u, int wr, int wc, int fr, int fq) const {
        asm volatile("" : "+v"(fr), "+v"(fq));
        const int row0 = u.pm * BM + wr * 64 + fr, c0 = u.pn * BM + wc * 32 + 8 * fq;
#pragma unroll
        for (int ai = 0; ai < 2; ++ai) {
            u32x4 wx[4][2], we[4][2];
#pragma unroll
            for (int m = 0; m < 4; ++m) { const size_t off = (size_t)(row0 + ai * HALF + m * 16) * 1024 + c0;
#pragma unroll
                for (int bj = 0; bj < 2; ++bj) { wx[m][bj] = *(const u32x4*)(H0 + off + bj * HALF); we[m][bj] = *(const u32x4*)(E + off + bj * HALF); } }
            PG8_FENCE;
#pragma unroll
            for (int m = 0; m < 4; ++m) { const size_t off = (size_t)(row0 + ai * HALF + m * 16) * 1024 + c0;
#pragma unroll
                for (int bj = 0; bj < 2; ++bj) { f32x4 h0, h1, e0, e1; unpack8h(wx[m][bj], h0, h1); unpack8(we[m][bj], e0, e1);
#pragma unroll
                    for (int e = 0; e < 4; ++e) { h0[e] += e0[e] * sigm(acc[ai][bj][m][0][e]); h1[e] += e1[e] * sigm(acc[ai][bj][m][1][e]); }
                    *(u32x4*)(XO + off + bj * HALF) = pack8h(h0, h1); } }
            PG8_FENCE; }
    }
};
template <class Epi, class Sched, bool ALIGN_EPI = false, bool SP2 = false, int MODE = 0>
__device__ __forceinline__ void gemm_phase(PG8_LAS unsigned char* lds, const Gemm g, const Sched& S, const Epi& E) {
    int tid_ = threadIdx.x; asm volatile("" : "+v"(tid_));
    const int tid = tid_, wid = __builtin_amdgcn_readfirstlane(tid >> 6), lane = tid & 63, wr = wid >> 2, wc = wid & 3, fr = lane & 15, fq = lane >> 4;
    const int K = g.K, nt = K / BK;
    unsigned voffA[2], voffB[2];
#pragma unroll
    for (int i = 0; i < 2; ++i) { int R, C; stage_rc(tid * 16 + i * 8192, R, C); const int Rb = Epi::PERM ? ((R & ~31) + perm32(R & 31)) : R;
        voffA[i] = (unsigned)(R * g.lda + C) * 2u; voffB[i] = (unsigned)(Rb * K + C) * 2u; }
    const size_t kstep = (size_t)(BK * 2);
    const size_t hstepA = (size_t)HALF * g.lda * 2, hstepB = (size_t)HALF * K * 2;
    const size_t tstepA = 2 * hstepA, tstepB = 2 * hstepB;
    const unsigned ldsw = (unsigned)wid * 1024u;
    const int aoff = lds_byte(wr * 64 + fr, fq * 8), boff = lds_byte(wc * 32 + fr, fq * 8);
#define PG8_SA(b, h) (((b) * 2 + (h)) * HTB)
#define PG8_SB(b, h) ((4 + (b) * 2 + (h)) * HTB)
#define PG8_STAGE(bufoff, gbase, voff) do { _Pragma("unroll") for (int _i = 0; _i < 2; ++_i) \
        __builtin_amdgcn_global_load_lds((const unsigned*)((const char*)(gbase) + (voff)[_i]), (PG8_LAS unsigned*)(lds + (bufoff) + ldsw + _i * 8192), 16, 0, 0); } while (0)
#define PG8_LDA(dst, b, h) do { _Pragma("unroll") for (int m = 0; m < 4; ++m) _Pragma("unroll") for (int k = 0; k < 2; ++k) dst[m][k] = *(const PG8_LAS bf16x8*)(lds + PG8_SA(b, h) + aoff + m * 2048 + k * 1024); } while (0)
#define PG8_LDB(dst, b, h) do { _Pragma("unroll") for (int n = 0; n < 2; ++n) _Pragma("unroll") for (int k = 0; k < 2; ++k) dst[n][k] = *(const PG8_LAS bf16x8*)(lds + PG8_SB(b, h) + boff + n * 2048 + k * 1024); } while (0)
#define PG8_MMA(ai, bj, At, Bt) do { __builtin_amdgcn_s_setprio(1); _Pragma("unroll") for (int m = 0; m < 4; ++m) _Pragma("unroll") for (int n = 0; n < 2; ++n) _Pragma("unroll") for (int k = 0; k < 2; ++k) \
        { if constexpr (MODE == 2) acc[ai][bj][m][n] = __builtin_bit_cast(f32x4, __builtin_amdgcn_mfma_i32_16x16x64_i8(__builtin_bit_cast(i32x4, Bt[n][k]), __builtin_bit_cast(i32x4, At[m][k]), __builtin_bit_cast(i32x4, acc[ai][bj][m][n]), 0, 0, 0)); \
          else if constexpr (MODE == 1) acc[ai][bj][m][n] = __builtin_amdgcn_mfma_f32_16x16x32_f16(__builtin_bit_cast(f16x8, Bt[n][k]), __builtin_bit_cast(f16x8, At[m][k]), acc[ai][bj][m][n], 0, 0, 0); \
          else acc[ai][bj][m][n] = __builtin_amdgcn_mfma_f32_16x16x32_bf16(Bt[n][k], At[m][k], acc[ai][bj][m][n], 0, 0, 0); } __builtin_amdgcn_s_setprio(0); } while (0)
#define PG8_WAIT_V(n) asm volatile("s_waitcnt vmcnt(" #n ")" ::: "memory")
#define PG8_WAIT_L(n) asm volatile("s_waitcnt lgkmcnt(" #n ")" ::: "memory")
#define PG8_BAR __builtin_amdgcn_s_barrier()
#define PG8_SCHED __builtin_amdgcn_sched_barrier(0)
    Unit cur, nxt; int ui = 0;
    if (!S.next(0, cur)) return;
    f32x4 acc[2][2][4][2];
#pragma unroll
    for (int a = 0; a < 2; ++a)
#pragma unroll
        for (int b = 0; b < 2; ++b)
#pragma unroll
            for (int m = 0; m < 4; ++m)
#pragma unroll
                for (int n = 0; n < 2; ++n) acc[a][b][m][n] = (f32x4){0.f, 0.f, 0.f, 0.f};
    bf16x8 At[4][2], B0[2][2], B1[2][2];
    const char* cA = (const char*)g.A + (size_t)cur.pm * tstepA; const char* cB = (const char*)g.Bt + (size_t)cur.pn * tstepB;
    S.a_ready(cur);
    if constexpr (SP2) {
        PG8_STAGE(PG8_SB(0, 0), cB, voffB); PG8_STAGE(PG8_SB(0, 1), cB + hstepB, voffB); PG8_STAGE(PG8_SA(0, 0), cA, voffA); PG8_STAGE(PG8_SA(0, 1), cA + hstepA, voffA);
        if (wr == 1) PG8_BAR;
        PG8_WAIT_V(2); PG8_BAR;
        PG8_STAGE(PG8_SB(1, 0), cB + kstep, voffB); PG8_STAGE(PG8_SA(1, 0), cA + kstep, voffA); PG8_STAGE(PG8_SB(1, 1), cB + hstepB + kstep, voffB);
        PG8_WAIT_V(6); PG8_BAR;
    } else {
        PG8_STAGE(PG8_SB(0, 0), cB, voffB); PG8_STAGE(PG8_SA(0, 0), cA, voffA); PG8_STAGE(PG8_SB(0, 1), cB + hstepB, voffB); PG8_STAGE(PG8_SA(0, 1), cA + hstepA, voffA);
        if (wr == 1) PG8_BAR;
        PG8_WAIT_V(4); PG8_BAR;
        PG8_STAGE(PG8_SB(1, 0), cB + kstep, voffB); PG8_STAGE(PG8_SA(1, 0), cA + kstep, voffA); PG8_STAGE(PG8_SB(1, 1), cB + hstepB + kstep, voffB);
        PG8_WAIT_V(6); PG8_BAR;
    }
    for (;;) {
        const bool has_next = S.next(ui + 1, nxt);
        const char* nA = has_next ? (const char*)g.A + (size_t)nxt.pm * tstepA : cA; const char* nB = has_next ? (const char*)g.Bt + (size_t)nxt.pn * tstepB : cB;
        for (int t = 0; t < nt; t += 2) { if constexpr (Epi::HAS_MID) { if (t == (nt >> 1)) E.mid(acc, cur, wr, wc, fr, fq); }
            const bool last = (t == nt - 2);
            const char* a1 = cA + (size_t)(t + 1) * kstep;
            const char* a2 = last ? nA : cA + (size_t)(t + 2) * kstep; const char* b2 = last ? nB : cB + (size_t)(t + 2) * kstep;
            const char* a3 = a2 + kstep; const char* b3 = b2 + kstep;
            if (last && has_next) S.a_ready(nxt);
            if constexpr (SP2) {
            PG8_LDB(B0, 0, 0); PG8_LDB(B1, 0, 1); PG8_SCHED; PG8_LDA(At, 0, 0); PG8_STAGE(PG8_SA(1, 1), a1 + hstepA, voffA);
            PG8_WAIT_V(8); PG8_WAIT_L(0); PG8_BAR; PG8_MMA(0, 0, At, B0); PG8_MMA(0, 1, At, B1); PG8_BAR; PG8_SCHED;
            PG8_LDA(At, 0, 1); PG8_STAGE(PG8_SB(0, 0), b2, voffB); PG8_STAGE(PG8_SB(0, 1), b2 + hstepB, voffB); PG8_STAGE(PG8_SA(0, 0), a2, voffA);
            PG8_WAIT_V(8); PG8_WAIT_L(0); PG8_BAR; PG8_MMA(1, 0, At, B0); PG8_MMA(1, 1, At, B1); PG8_BAR; PG8_SCHED;
            PG8_LDB(B0, 1, 0); PG8_LDB(B1, 1, 1); PG8_SCHED; PG8_LDA(At, 1, 0); PG8_STAGE(PG8_SA(0, 1), a2 + hstepA, voffA);
            PG8_WAIT_V(8); PG8_WAIT_L(0); PG8_BAR; PG8_MMA(0, 0, At, B0); PG8_MMA(0, 1, At, B1); PG8_BAR; PG8_SCHED;
            PG8_LDA(At, 1, 1); PG8_STAGE(PG8_SB(1, 0), b3, voffB); PG8_STAGE(PG8_SB(1, 1), b3 + hstepB, voffB); PG8_STAGE(PG8_SA(1, 0), a3, voffA);
            PG8_WAIT_V(8); PG8_WAIT_L(0); PG8_BAR; PG8_MMA(1, 0, At, B0); PG8_MMA(1, 1, At, B1); PG8_BAR; PG8_SCHED;
            } else {
            PG8_LDB(B0, 0, 0); PG8_SCHED; PG8_LDA(At, 0, 0); PG8_STAGE(PG8_SA(1, 1), a1 + hstepA, voffA);
            PG8_WAIT_L(8); PG8_BAR; PG8_WAIT_L(0); PG8_MMA(0, 0, At, B0); PG8_BAR; PG8_SCHED;
            PG8_LDB(B1, 0, 1); PG8_STAGE(PG8_SB(0, 0), b2, voffB);
            PG8_BAR; PG8_WAIT_L(0); PG8_MMA(0, 1, At, B1); PG8_BAR;
            PG8_LDA(At, 0, 1); PG8_STAGE(PG8_SA(0, 0), a2, voffA);
            PG8_BAR; PG8_WAIT_L(0); PG8_MMA(1, 0, At, B0); PG8_BAR; PG8_SCHED;
            PG8_STAGE(PG8_SB(0, 1), b2 + hstepB, voffB);
            PG8_WAIT_V(6); PG8_BAR; PG8_MMA(1, 1, At, B1); PG8_BAR;
            PG8_LDB(B0, 1, 0); PG8_SCHED; PG8_LDA(At, 1, 0); PG8_STAGE(PG8_SA(0, 1), a2 + hstepA, voffA);
            PG8_WAIT_L(8); PG8_BAR; PG8_WAIT_L(0); PG8_MMA(0, 0, At, B0); PG8_BAR; PG8_SCHED;
            PG8_LDB(B1, 1, 1); PG8_STAGE(PG8_SB(1, 0), b3, voffB);
            PG8_BAR; PG8_WAIT_L(0); PG8_MMA(0, 1, At, B1); PG8_BAR;
            PG8_LDA(At, 1, 1); PG8_STAGE(PG8_SA(1, 0), a3, voffA);
            PG8_BAR; PG8_WAIT_L(0); PG8_MMA(1, 0, At, B0); PG8_BAR; PG8_SCHED;
            PG8_STAGE(PG8_SB(1, 1), b3 + hstepB, voffB);
            PG8_WAIT_V(6); PG8_BAR; PG8_MMA(1, 1, At, B1); PG8_BAR;
            }
        }
        if constexpr (ALIGN_EPI) { if (wr == 0) PG8_BAR; }
        if constexpr (!Epi::AFTER_DRAIN) { E(acc, cur, wr, wc, fr, fq); S.done(cur); }
        if (!has_next) break;
#pragma unroll
        for (int a = 0; a < 2; ++a)
#pragma unroll
            for (int b = 0; b < 2; ++b)
#pragma unroll
                for (int m = 0; m < 4; ++m)
#pragma unroll
                    for (int n = 0; n < 2; ++n) acc[a][b][m][n] = (f32x4){0.f, 0.f, 0.f, 0.f};
        cur = nxt; cA = nA; cB = nB; ++ui;
        if constexpr (ALIGN_EPI) { if (wr == 1) PG8_BAR; }
    }
    PG8_WAIT_V(0);
    if constexpr (!ALIGN_EPI) { if (wr == 0) PG8_BAR; }
    PG8_BAR;
    if constexpr (Epi::AFTER_DRAIN) { E.fused(acc, cur, wr, wc, fr, fq, lds, wid, lane); S.done(cur); }
#undef PG8_SA
#undef PG8_SB
#undef PG8_STAGE
#undef PG8_LDA
#undef PG8_LDB
#undef PG8_MMA
#undef PG8_WAIT_V
#undef PG8_WAIT_L
#undef PG8_BAR
#undef PG8_SCHED
}
}
#define LAS __attribute__((address_space(3)))
typedef unsigned short bf16;
typedef unsigned u32x4 __attribute__((ext_vector_type(4)));
typedef unsigned u32x2 __attribute__((ext_vector_type(2)));
typedef float f32x4 __attribute__((ext_vector_type(4)));
typedef float f32x16 __attribute__((ext_vector_type(16)));
typedef short bf16x8 __attribute__((ext_vector_type(8)));
constexpr int DM = 1024, NBATCH = 8, SEQ = 4096, T = NBATCH * SEQ, DEPTH = 4, PLE = 256, NIN = 9216, NHEAD = 16, HD = 64;
constexpr float LN_EPS = 1e-5f;
constexpr float ALPHA = 1.681792830507429f;
constexpr float QSCALE = 0.125f * 1.4426950408889634f;
constexpr size_t MiB = 1u << 20;
constexpr size_t WS_WIN = 0, WS_W2 = 18 * MiB, WS_WO = 22 * MiB, WS_WG = 24 * MiB, WS_WE = 26 * MiB, WS_WS = 27 * MiB, WS_PB = 28 * MiB, WS_XH1 = 44 * MiB,
                 WS_UGQ = 108 * MiB, WS_V = 236 * MiB, WS_K = 300 * MiB, WS_VB = 364 * MiB, WS_GB = 428 * MiB, WS_CTL = 492 * MiB, WS_XH = 493 * MiB, WS_XS = 557 * MiB  , WS_CMAX = WS_XS + 256 * 1024  , WS_CMAX1 = WS_CMAX + 32 * 1024  , WS_BARW = WS_CMAX - 16384  , WS_VST = WS_XS + 512 * 1024  , WS_END = 558 * MiB;
constexpr size_t OUT_XQ = 64 * MiB;
constexpr int LDS_BYTES = 147456, RING_BYTES = 131072;

__device__ __forceinline__ float wave_sum(float v) {
#pragma unroll
    for (int o = 1; o < 64; o <<= 1) v += __shfl_xor(v, o);
    return v;
}
__device__ __forceinline__ unsigned pk2(float lo, float hi) { return pg8::cvt_pk_bf16(lo, hi); }
__device__ __forceinline__ float bf_lo(unsigned w) { return __uint_as_float(w << 16); }
__device__ __forceinline__ float bf_hi(unsigned w) { return __uint_as_float(w & 0xffff0000u); }

template <bool F16 = false> __device__ __forceinline__ void tr_item(const float* W, int N, bf16* WT, int ldk, int koff, int k0, int n0, int drow0, LAS float* scr, int lane) {
#pragma unroll 8
    for (int i = 0; i < 32; ++i) { const int kk = 2 * i + (lane >> 5); scr[kk * 33 + (lane & 31)] = W[(size_t)(k0 + kk) * N + n0 + (lane & 31)]; }
    asm volatile("s_waitcnt lgkmcnt(0)" ::: "memory");
    const int c = lane & 7;
#pragma unroll
    for (int j = 0; j < 4; ++j) { const int n = (lane >> 3) + 8 * j; const LAS float* s = scr + (8 * c) * 33 + n;
        u32x4 o;
        if constexpr (F16) { o.x = pg8::cvt_pk_f16(s[0 * 33], s[1 * 33]); o.y = pg8::cvt_pk_f16(s[2 * 33], s[3 * 33]); o.z = pg8::cvt_pk_f16(s[4 * 33], s[5 * 33]); o.w = pg8::cvt_pk_f16(s[6 * 33], s[7 * 33]); }
        else { o.x = pk2(s[0 * 33], s[1 * 33]); o.y = pk2(s[2 * 33], s[3 * 33]); o.z = pk2(s[4 * 33], s[5 * 33]); o.w = pk2(s[6 * 33], s[7 * 33]); }
        *(u32x4*)(WT + (size_t)(drow0 + n) * ldk + koff + k0 + 8 * c) = o; }
    asm volatile("s_waitcnt lgkmcnt(0)" ::: "memory");
}
__device__ __forceinline__ float wave_max(float v) {
#pragma unroll
    for (int o = 1; o < 64; o <<= 1) v = fmaxf(v, __shfl_xor(v, o));
    return v;
}
__device__ __forceinline__ unsigned q4(float a, float b, float c, float d, float inv) {
    const int ia = (int)__builtin_rintf(a * inv), ib = (int)__builtin_rintf(b * inv), ic = (int)__builtin_rintf(c * inv), id = (int)__builtin_rintf(d * inv);
    return (unsigned)(ia & 0xff) | ((unsigned)(ib & 0xff) << 8) | ((unsigned)(ic & 0xff) << 16) | ((unsigned)(id & 0xff) << 24);
}
__device__ __forceinline__ int win_dest_row(int c);
__device__ __forceinline__ void tr_item_q(const float* W, const float* cmax, unsigned char* WQ, int k0, int n0, int qrow0, LAS float* scr, int lane) {
#pragma unroll 8
    for (int i = 0; i < 32; ++i) { const int kk = 2 * i + (lane >> 5); scr[kk * 33 + (lane & 31)] = W[(size_t)(k0 + kk) * NIN + n0 + (lane & 31)]; }
    asm volatile("s_waitcnt lgkmcnt(0)" ::: "memory");
    const int c16 = lane & 3;
#pragma unroll
    for (int j = 0; j < 2; ++j) { const int n = (lane >> 2) + 16 * j; const LAS float* sp = scr + (16 * c16) * 33 + n;
        const float cm = cmax[qrow0 + n], inv = cm > 0.f ? 127.f / cm : 0.f;
        u32x4 o; o.x = q4(sp[0 * 33], sp[1 * 33], sp[2 * 33], sp[3 * 33], inv); o.y = q4(sp[4 * 33], sp[5 * 33], sp[6 * 33], sp[7 * 33], inv);
        o.z = q4(sp[8 * 33], sp[9 * 33], sp[10 * 33], sp[11 * 33], inv); o.w = q4(sp[12 * 33], sp[13 * 33], sp[14 * 33], sp[15 * 33], inv);
        *(u32x4*)(WQ + (size_t)(qrow0 + n) * 1024 + k0 + 16 * c16) = o; }
    asm volatile("s_waitcnt lgkmcnt(0)" ::: "memory");
}
__device__ __forceinline__ int win_dest_row(int c) {
    if (c < 1024) return 256 * (c >> 7) + (c & 127);
    if (c < 2048) return 2048 + (c - 1024);
    if (c < 3072) { const int cc = c - 2048; return 256 * (cc >> 7) + 128 + (cc & 127); }
    if (c < 7168) return c;
    if (c < 8192) { const int cc = c - 7168; return 7168 + 256 * (cc >> 7) + (cc & 127); }
    { const int cc = c - 8192; return 7168 + 256 * (cc >> 7) + 128 + (cc & 127); }
}
struct Args { const float* in[14]; float* out; unsigned char* ws; };
__device__ __forceinline__ void win_item(const Args& a, int l, unsigned char* wb, int kb, int nb, int what, LAS float* scr, int lane) {
    const float* w_in = a.in[2] + (size_t)l * DM * NIN; const int drow0 = win_dest_row(32 * nb);
    if (drow0 >= 7168) { if (what >= 1) tr_item_q(w_in, (const float*)(a.ws + WS_CMAX) + l * 2048, wb + WS_WIN + (size_t)7168 * 2048, 64 * kb, 32 * nb, drow0 - 7168, scr, lane); return; }
    const int slot = pg8::p1_qslot(drow0 >> 8);
    if (slot >= 0) { if (what >= 1) tr_item_q(w_in, (const float*)(a.ws + WS_CMAX1) + l * (pg8::P1_NQ * 256), wb + WS_WIN, 64 * kb, 32 * nb, slot * 256 + (drow0 & 255), scr, lane); return; }
    if (what != 1) tr_item<true>(w_in, NIN, (bf16*)(wb + WS_WIN), 1024, 0, 64 * kb, 32 * nb, drow0, scr, lane);
}

__device__ __forceinline__ void convert_layer(const Args& a, int l, LAS unsigned char* lds, int gw, int NGW, int lane, int wave, bool gates = true) {
    LAS float* scr = (LAS float*)(lds + wave * 8704);
    unsigned char* ws = (l & 1) ? (unsigned char*)a.out : a.ws;
    const float* w_in = a.in[2] + (size_t)l * DM * NIN;
    const float* w_pa = a.in[7] + (size_t)l * DM * DM; const float* w_pb = a.in[8] + (size_t)l * DM * DM; const float* w_out = a.in[9] + (size_t)l * DM * DM;
    const float* w_pe = a.in[10] + (size_t)l * PLE * DM; const float* w_pg = a.in[11] + (size_t)l * DM * DM;
    constexpr int I_IN = 16 * (NIN / 32), I_SQ = 16 * 32, I_PE = 4 * 32, NITEMS = I_IN + 4 * I_SQ + I_PE;
    for (int it = gw; it < NITEMS; it += NGW) {
        int r = it;
        if (r < I_IN) { win_item(a, l, ws, r / (NIN / 32), r % (NIN / 32), gates ? 2 : 0, scr, lane); continue; } r -= I_IN;
        if (r < I_SQ) { tr_item(w_pa, DM, (bf16*)(ws + WS_W2), 2048, 0, 64 * (r >> 5), 32 * (r & 31), 32 * (r & 31), scr, lane); continue; } r -= I_SQ;
        if (r < I_SQ) { tr_item(w_pb, DM, (bf16*)(ws + WS_W2), 2048, 1024, 64 * (r >> 5), 32 * (r & 31), 32 * (r & 31), scr, lane); continue; } r -= I_SQ;
        if (r < I_SQ) { tr_item(w_out, DM, (bf16*)(ws + WS_WO), 1024, 0, 64 * (r >> 5), 32 * (r & 31), 32 * (r & 31), scr, lane); continue; } r -= I_SQ;
        if (r < I_SQ) { tr_item<true>(w_pg, DM, (bf16*)(ws + WS_WG), 1024, 0, 64 * (r >> 5), 32 * (r & 31), 32 * (r & 31), scr, lane); continue; } r -= I_SQ;
        tr_item(w_pe, DM, (bf16*)(ws + WS_WE), 256, 0, 64 * (r >> 5), 32 * (r & 31), 32 * (r & 31), scr, lane);
    }
    const int gt = gw * 64 + lane, NGT = NGW * 64;
    { const float* w_s = a.in[5] + (size_t)l * 8 * 128 * 128; bf16* WsB = (bf16*)(ws + WS_WS);
      for (int p = gt; p < 8 * 128 * 16; p += NGT) { const int s0 = (p & 15) * 8, t = (p >> 4) & 127;
          const f32x4 x0 = *(const f32x4*)(w_s + (size_t)p * 8), x1 = *(const f32x4*)(w_s + (size_t)p * 8 + 4);
          float v[8] = {x0[0], x0[1], x0[2], x0[3], x1[0], x1[1], x1[2], x1[3]};
#pragma unroll
          for (int j = 0; j < 8; ++j) v[j] = (s0 + j <= t) ? v[j] : 0.f;
          u32x4 o; o.x = pk2(v[0], v[1]); o.y = pk2(v[2], v[3]); o.z = pk2(v[4], v[5]); o.w = pk2(v[6], v[7]);
          *(u32x4*)(WsB + (size_t)p * 8) = o; } }
    { const float* p = a.in[1] + (size_t)l * T * PLE; bf16* PB = (bf16*)(ws + WS_PB);
      for (int q = gt; q < T * PLE / 8; q += NGT) { const f32x4 x0 = *(const f32x4*)(p + (size_t)q * 8), x1 = *(const f32x4*)(p + (size_t)q * 8 + 4);
          u32x4 o; o.x = pk2(x0[0], x0[1]); o.y = pk2(x0[2], x0[3]); o.z = pk2(x1[0], x1[1]); o.w = pk2(x1[2], x1[3]);
          *(u32x4*)(PB + (size_t)q * 8) = o; } }
}

constexpr int AT_K = 0, AT_V = 16384, AT_STG = 16384 + 2 * 9216, AT_STG_W = 8704;
__device__ __forceinline__ void attn_unit(int b, int h, int qb, bf16* UGQ, const bf16* Kb, const bf16* Vb, const bf16* GBb, LAS unsigned char* lds, int dry = 0) {
    int tid_ = threadIdx.x; asm volatile("" : "+v"(tid_));
    const int tid = tid_, lane = tid & 63, wid = __builtin_amdgcn_readfirstlane(tid >> 6), r32 = lane & 31, hi = lane >> 5;
    const size_t rowbase = (size_t)b * SEQ;
    const int q0 = qb * 256, qw = q0 + wid * 32;
    bf16x8 qr[4];
    { const bf16* qp = UGQ + (rowbase + qw + r32) * 2048 + 1024 + h * HD + hi * 8;
#pragma unroll
      for (int d0 = 0; d0 < 4; ++d0) qr[d0] = *(const bf16x8*)(qp + d0 * 16); }
    f32x16 o0, o1;
#pragma unroll
    for (int r = 0; r < 16; ++r) { o0[r] = 0.f; o1[r] = 0.f; }
    float C = 1.f; int alive = 1;
    volatile LAS unsigned* aflag = (volatile LAS unsigned*)(lds + RING_BYTES);
    const int NT = 4 * (qb + 1);
    const int lkey = lane, lch = wid;
    const int kk = lkey & 31, slot = (lkey & 32) | (8 * ((kk >> 2) & 3) + 4 * (kk >> 4) + (kk & 3));
    const bf16* kg = Kb + (rowbase + lkey) * 1024 + h * HD + lch * 8;
    const bf16* vg = Vb + (rowbase + lkey) * 1024 + h * HD + lch * 8;
    u32x4 kreg, vreg;
    kreg = *(const u32x4*)(kg + (size_t)(NT - 1) * 64 * 1024); vreg = *(const u32x4*)(vg + (size_t)(NT - 1) * 64 * 1024);
#define AT_WRITE(buf) do { *(LAS u32x4*)(lds + AT_K + (buf) * 8192 + lch * 1024 + slot * 16) = kreg; \
        LAS unsigned short* vt_ = (LAS unsigned short*)(lds + AT_V + (buf) * 9216) + (lch * 8) * 72 + lkey; \
        vt_[0 * 72] = (unsigned short)(vreg.x & 0xffffu); vt_[1 * 72] = (unsigned short)(vreg.x >> 16); vt_[2 * 72] = (unsigned short)(vreg.y & 0xffffu); vt_[3 * 72] = (unsigned short)(vreg.y >> 16); \
        vt_[4 * 72] = (unsigned short)(vreg.z & 0xffffu); vt_[5 * 72] = (unsigned short)(vreg.z >> 16); vt_[6 * 72] = (unsigned short)(vreg.w & 0xffffu); vt_[7 * 72] = (unsigned short)(vreg.w >> 16); } while (0)
    AT_WRITE(0);
    __syncthreads();
    const int qrel = qw + r32;
    for (int it = 0; it < NT; ++it) {
        const int kt = NT - 1 - it, cur = it & 1;
        if (it + 1 < NT) { kreg = *(const u32x4*)(kg + (size_t)(kt - 1) * 64 * 1024); vreg = *(const u32x4*)(vg + (size_t)(kt - 1) * 64 * 1024); }
        const int k0 = kt * 64;
        if (k0 < qw + 32 && alive) {
            const LAS unsigned char* kb = lds + AT_K + cur * 8192 + hi * 1024 + r32 * 16;
            f32x16 p0, p1;
#pragma unroll
            for (int r = 0; r < 16; ++r) { p0[r] = 0.f; p1[r] = 0.f; }
#pragma unroll
            for (int d0 = 0; d0 < 4; ++d0) {
                const bf16x8 a0 = *(const LAS bf16x8*)(kb + d0 * 2048), a1 = *(const LAS bf16x8*)(kb + d0 * 2048 + 512);
                p0 = __builtin_amdgcn_mfma_f32_32x32x16_bf16(a0, qr[d0], p0, 0, 0, 0);
                p1 = __builtin_amdgcn_mfma_f32_32x32x16_bf16(a1, qr[d0], p1, 0, 0, 0);
            }
#pragma unroll
            for (int r = 0; r < 16; ++r) { p0[r] = __builtin_amdgcn_rcpf(1.f + __builtin_amdgcn_exp2f(p0[r])); p1[r] = __builtin_amdgcn_rcpf(1.f + __builtin_amdgcn_exp2f(p1[r])); }
            if (k0 + 63 >= qw) {
                const int kb0 = k0 + 16 * hi;
#pragma unroll
                for (int r = 0; r < 16; ++r) { if (kb0 + r >= qrel) p0[r] = 1.f; if (kb0 + 32 + r >= qrel) p1[r] = 1.f; }
            }
#pragma unroll
            for (int r = 14; r >= 0; --r) { p0[r] *= p0[r + 1]; p1[r] *= p1[r + 1]; }
            const float L0 = p0[0], L1 = p1[0];
            const float pL0 = __shfl_xor(L0, 32), pL1 = __shfl_xor(L1, 32);
            const float tot1 = L1 * pL1;
            const float pre1 = hi ? C : C * pL1;
            const float pre0 = C * tot1 * (hi ? 1.f : pL0);
            C = C * tot1 * (L0 * pL0);
#pragma unroll
            for (int r = 0; r < 15; ++r) { p0[r] = pre0 * (p0[r + 1] - p0[r]); p1[r] = pre1 * (p1[r + 1] - p1[r]); }
            p0[15] = pre0 * (1.f - p0[15]); p1[15] = pre1 * (1.f - p1[15]);
            u32x4 w00, w01, w10, w11;
            w00.x = pk2(p0[0], p0[1]); w00.y = pk2(p0[2], p0[3]); w00.z = pk2(p0[4], p0[5]); w00.w = pk2(p0[6], p0[7]);
            w01.x = pk2(p0[8], p0[9]); w01.y = pk2(p0[10], p0[11]); w01.z = pk2(p0[12], p0[13]); w01.w = pk2(p0[14], p0[15]);
            w10.x = pk2(p1[0], p1[1]); w10.y = pk2(p1[2], p1[3]); w10.z = pk2(p1[4], p1[5]); w10.w = pk2(p1[6], p1[7]);
            w11.x = pk2(p1[8], p1[9]); w11.y = pk2(p1[10], p1[11]); w11.z = pk2(p1[12], p1[13]); w11.w = pk2(p1[14], p1[15]);
            const LAS unsigned char* vb = lds + AT_V + cur * 9216 + r32 * 144 + hi * 32;
#define AT_PV(W, off) do { const bf16x8 pf_ = __builtin_bit_cast(bf16x8, W); \
                const bf16x8 v0_ = *(const LAS bf16x8*)(vb + (off)), v1_ = *(const LAS bf16x8*)(vb + 4608 + (off)); \
                o0 = __builtin_amdgcn_mfma_f32_32x32x16_bf16(v0_, pf_, o0, 0, 0, 0); o1 = __builtin_amdgcn_mfma_f32_32x32x16_bf16(v1_, pf_, o1, 0, 0, 0); } while (0)
            AT_PV(w00, 0); AT_PV(w01, 16); AT_PV(w10, 64); AT_PV(w11, 80);
#undef AT_PV
            alive = __any(C != 0.f);
        }
        if (it + 1 < NT) AT_WRITE(cur ^ 1);
        if (lane == 0) aflag[(it & 1) * 8 + wid] = (unsigned)alive;
        __syncthreads();
        const unsigned fl = (lane < 8) ? aflag[(it & 1) * 8 + lane] : 0u;
        if (!__any(fl != 0u)) break;
    }
#undef AT_WRITE
    LAS float* stg = (LAS float*)(lds + AT_STG + wid * AT_STG_W);
#pragma unroll
    for (int g4 = 0; g4 < 4; ++g4) {
        *(LAS f32x4*)(stg + r32 * 68 + 8 * g4 + 4 * hi) = (f32x4){o0[4 * g4], o0[4 * g4 + 1], o0[4 * g4 + 2], o0[4 * g4 + 3]};
        *(LAS f32x4*)(stg + r32 * 68 + 32 + 8 * g4 + 4 * hi) = (f32x4){o1[4 * g4], o1[4 * g4 + 1], o1[4 * g4 + 2], o1[4 * g4 + 3]};
    }
    asm volatile("s_waitcnt lgkmcnt(0)" ::: "memory");
#pragma unroll
    for (int i = 0; i < 4; ++i) {
        const int row = i * 8 + (lane >> 3), ch = lane & 7;
        f32x4 a0 = *(const LAS f32x4*)(stg + row * 68 + ch * 8), a1 = *(const LAS f32x4*)(stg + row * 68 + ch * 8 + 4);
        const size_t tok = rowbase + qw + row;
        const u32x4 gw_ = *(const u32x4*)(GBb + tok * 1024 + h * HD + ch * 8);
        f32x4 g0, g1; pg8::unpack8(gw_, g0, g1);
#pragma unroll
        for (int e = 0; e < 4; ++e) { a0[e] *= g0[e] * pg8::sigm(g0[e]); a1[e] *= g1[e] * pg8::sigm(g1[e]); }
        if (!dry) *(u32x4*)(UGQ + tok * 2048 + 1024 + h * HD + ch * 8) = pg8::pack8(a0, a1);
    }
    asm volatile("s_waitcnt lgkmcnt(0)" ::: "memory");
}

constexpr int BA_STAT = 0, BA_GB = 1024, BA_VNT = 1024 + 8192, BA_OT = BA_VNT + 128 * 272;
typedef float f32x2_st __attribute__((ext_vector_type(2)));
__device__ __forceinline__ void brancha_unit(int chunk, bf16* UGQ, const bf16* Vb, const bf16* WsB, const float* VST, const float* vn_g, const float* vn_b, const float* b_s, LAS unsigned char* lds, int dry = 0) {
    int tid_ = threadIdx.x; asm volatile("" : "+v"(tid_));
    const int tid = tid_, lane = tid & 63, wid = __builtin_amdgcn_readfirstlane(tid >> 6), r32 = lane & 31, hi = lane >> 5;
    const size_t t0 = (size_t)chunk * 128;
    LAS float* stat = (LAS float*)(lds + BA_STAT);
    LAS float* gbl = (LAS float*)(lds + BA_GB);
    u32x4 vpc[4];
#pragma unroll
    for (int i = 0; i < 4; ++i) { const int p = tid + 512 * i, s = p >> 4, dc = p & 15; vpc[i] = *(const u32x4*)(Vb + (t0 + s) * 1024 + dc * 8); }
    gbl[tid] = vn_g[tid]; gbl[tid + 512] = vn_g[tid + 512]; gbl[1024 + tid] = vn_b[tid]; gbl[1536 + tid] = vn_b[tid + 512];
    if (tid < 128) { const f32x2_st st = *(const f32x2_st*)(VST + 2 * (t0 + tid));
        const float mean = st[0] * (1.f / 1024.f), var = fmaxf(st[1] * (1.f / 1024.f) - mean * mean, 0.f);
        stat[tid * 2] = mean; stat[tid * 2 + 1] = 1.0f / sqrtf(var + LN_EPS); }
    __syncthreads();
    const int dblk = wid & 3, tbp = wid >> 2;
    u32x4 ugp[4]; bf16x8 wf[2][8];
#define BA_LOAD_UG(g_) do { _Pragma("unroll") for (int i = 0; i < 4; ++i) { const int p = tid + 512 * i, t = p >> 4, dc = p & 15; ugp[i] = *(const u32x4*)(UGQ + (t0 + t) * 2048 + (g_) * 128 + dc * 8); } } while (0)
#define BA_LOAD_WS(g_) do { _Pragma("unroll") for (int j = 0; j < 2; ++j) { const int tb = 2 * tbp + j; const bf16* wrow = WsB + ((size_t)(g_) * 128 + 32 * tb + r32) * 128 + hi * 8; \
        _Pragma("unroll") for (int ks = 0; ks < 8; ++ks) if (ks < 2 * (tb + 1)) wf[j][ks] = *(const bf16x8*)(wrow + ks * 16); } } while (0)
    BA_LOAD_WS(0); BA_LOAD_UG(0);
    for (int g = 0; g < 8; ++g) {
        const f32x4 ga = *(const LAS f32x4*)(gbl + g * 128 + (tid & 15) * 8), gb2 = *(const LAS f32x4*)(gbl + g * 128 + (tid & 15) * 8 + 4);
        const f32x4 ba = *(const LAS f32x4*)(gbl + 1024 + g * 128 + (tid & 15) * 8), bb2 = *(const LAS f32x4*)(gbl + 1024 + g * 128 + (tid & 15) * 8 + 4);
#pragma unroll
        for (int i = 0; i < 4; ++i) {
            const int p = tid + 512 * i, s = p >> 4, dc = p & 15;
            f32x4 v0, v1; pg8::unpack8(vpc[i], v0, v1);
            const float mean = stat[s * 2], rstd = stat[s * 2 + 1];
            v0 = (v0 - mean) * rstd * ga + ba; v1 = (v1 - mean) * rstd * gb2 + bb2;
            const u32x4 w = pg8::pack8(v0, v1);
            LAS unsigned short* dst = (LAS unsigned short*)(lds + BA_VNT) + dc * 136 + s;
            dst[0 * 16 * 136] = (unsigned short)(w.x & 0xffffu); dst[1 * 16 * 136] = (unsigned short)(w.x >> 16); dst[2 * 16 * 136] = (unsigned short)(w.y & 0xffffu); dst[3 * 16 * 136] = (unsigned short)(w.y >> 16);
            dst[4 * 16 * 136] = (unsigned short)(w.z & 0xffffu); dst[5 * 16 * 136] = (unsigned short)(w.z >> 16); dst[6 * 16 * 136] = (unsigned short)(w.w & 0xffffu); dst[7 * 16 * 136] = (unsigned short)(w.w >> 16);
        }
        if (g + 1 < 8) {
#pragma unroll
            for (int i = 0; i < 4; ++i) { const int p = tid + 512 * i, s = p >> 4, dc = p & 15; vpc[i] = *(const u32x4*)(Vb + (t0 + s) * 1024 + (g + 1) * 128 + dc * 8); }
        }
        __syncthreads();
        const int d = 32 * dblk + r32;
        const LAS unsigned char* ab = lds + BA_VNT + ((d & 7) * 16 + (d >> 3)) * 272 + hi * 16;
        f32x16 acc[2];
#pragma unroll
        for (int j = 0; j < 2; ++j) {
            const int tb = 2 * tbp + j;
#pragma unroll
            for (int r = 0; r < 16; ++r) acc[j][r] = 0.f;
#pragma unroll
            for (int ks = 0; ks < 8; ++ks) if (ks < 2 * (tb + 1)) {
                const bf16x8 af = *(const LAS bf16x8*)(ab + ks * 32);
                acc[j] = __builtin_amdgcn_mfma_f32_32x32x16_bf16(af, wf[j][ks], acc[j], 0, 0, 0);
            }
        }
        if (g + 1 < 8) BA_LOAD_WS(g + 1);
#pragma unroll
        for (int j = 0; j < 2; ++j) {
            const int tb = 2 * tbp + j, t = 32 * tb + r32;
            const float bias = b_s[g * 128 + t];
            LAS float* ot = (LAS float*)(lds + BA_OT) + t * 132 + 32 * dblk + 4 * hi;
#pragma unroll
            for (int g4 = 0; g4 < 4; ++g4) *(LAS f32x4*)(ot + 8 * g4) = (f32x4){acc[j][4 * g4] + bias, acc[j][4 * g4 + 1] + bias, acc[j][4 * g4 + 2] + bias, acc[j][4 * g4 + 3] + bias};
        }
        __syncthreads();
#pragma unroll
        for (int i = 0; i < 4; ++i) {
            const int p = tid + 512 * i, t = p >> 4, dc = p & 15;
            const LAS float* ot = (const LAS float*)(lds + BA_OT) + t * 132 + dc * 8;
            const f32x4 m0 = *(const LAS f32x4*)ot, m1 = *(const LAS f32x4*)(ot + 4);
            bf16* up = UGQ + (t0 + t) * 2048 + g * 128 + dc * 8;
            f32x4 u0, u1; pg8::unpack8(ugp[i], u0, u1);
            if (!dry) *(u32x4*)up = pg8::pack8(u0 * m0, u1 * m1);
        }
        if (g + 1 < 8) BA_LOAD_UG(g + 1);
    }
#undef BA_LOAD_UG
#undef BA_LOAD_WS
    __syncthreads();
}

__device__ __forceinline__ void ln_rows(bf16* XH, unsigned char* XQ, float* XS, float* VST, float* OUT, const float* g, const float* bta, bool last, int gw, int NGW, int lane) {
    f32x4 gv[4], bv[4];
#pragma unroll
    for (int j = 0; j < 2; ++j) { gv[2 * j] = *(const f32x4*)(g + 512 * j + lane * 8); gv[2 * j + 1] = *(const f32x4*)(g + 512 * j + lane * 8 + 4);
                                  bv[2 * j] = *(const f32x4*)(bta + 512 * j + lane * 8); bv[2 * j + 1] = *(const f32x4*)(bta + 512 * j + lane * 8 + 4); }
    for (int m = gw; m < T; m += NGW) {
        bf16* xr = XH + (size_t)m * DM + lane * 8;
        f32x4 v[4]; float s = 0.f;
        pg8::unpack8h(*(const u32x4*)xr, v[0], v[1]); pg8::unpack8h(*(const u32x4*)(xr + 512), v[2], v[3]);
#pragma unroll
        for (int j = 0; j < 4; ++j) s += (v[j][0] + v[j][1]) + (v[j][2] + v[j][3]);
        const float mean = wave_sum(s) * (1.f / DM); float s2 = 0.f;
#pragma unroll
        for (int j = 0; j < 4; ++j) { v[j] = v[j] - mean; s2 += (v[j][0] * v[j][0] + v[j][1] * v[j][1]) + (v[j][2] * v[j][2] + v[j][3] * v[j][3]); }
        const float rstd = 1.0f / sqrtf(wave_sum(s2) * (1.f / DM) + LN_EPS);
#pragma unroll
        for (int j = 0; j < 4; ++j) v[j] = v[j] * rstd * gv[j] + bv[j];
        if (last) { float* o = OUT + (size_t)m * DM + lane * 8;
            *(f32x4*)o = v[0]; *(f32x4*)(o + 4) = v[1]; *(f32x4*)(o + 512) = v[2]; *(f32x4*)(o + 516) = v[3]; }
        else { *(u32x4*)xr = pg8::pack8h(v[0], v[1]); *(u32x4*)(xr + 512) = pg8::pack8h(v[2], v[3]);
            float am = 0.f;
#pragma unroll
            for (int j = 0; j < 4; ++j) am = fmaxf(am, fmaxf(fmaxf(fabsf(v[j][0]), fabsf(v[j][1])), fmaxf(fabsf(v[j][2]), fabsf(v[j][3]))));
            am = wave_max(am); const float inv = am > 0.f ? 127.f / am : 0.f;
            unsigned char* xq = XQ + (size_t)m * DM + lane * 8;
            u32x2 w0, w1; w0.x = q4(v[0][0], v[0][1], v[0][2], v[0][3], inv); w0.y = q4(v[1][0], v[1][1], v[1][2], v[1][3], inv);
            w1.x = q4(v[2][0], v[2][1], v[2][2], v[2][3], inv); w1.y = q4(v[3][0], v[3][1], v[3][2], v[3][3], inv);
            *(u32x2*)xq = w0; *(u32x2*)(xq + 512) = w1; if (lane == 0) { XS[m] = am; VST[2 * (size_t)m] = 0.f; VST[2 * (size_t)m + 1] = 0.f; } }
    }
}

#define XB_TMO      128
#define XB_XCNT(j)  (256  + 64 * (j))
#define XB_XSUB(j)  (1280 + 64 * (j))
#define XB_XGEN(j)  (2304 + 64 * (j))
#define XB_TOP      3328
#define XB_TOPGEN   3392
#define XCD_BAR_WORDS 3456
#define XB_SPIN_CAP (1u << 18)

__device__ __forceinline__ unsigned xb_ld(unsigned* p)              { return __hip_atomic_load(p, __ATOMIC_RELAXED, __HIP_MEMORY_SCOPE_AGENT); }
__device__ __forceinline__ unsigned xb_add(unsigned* p, unsigned v) { return __hip_atomic_fetch_add(p, v, __ATOMIC_RELAXED, __HIP_MEMORY_SCOPE_AGENT); }
__device__ __forceinline__ unsigned xb_xcc_id() { return (unsigned)__builtin_amdgcn_s_getreg((3 << 11) | 20) & 0xFu; }
#define XB_SPIN(cond, bar) do { unsigned _sp = 0; while (cond) { __builtin_amdgcn_s_sleep(1); \
    if ((++_sp & 255u) == 0u) { if (xb_ld(&(bar)[XB_TMO])) break; if (_sp > XB_SPIN_CAP) { atomicAdd(&(bar)[XB_TMO], 1u); break; } } } } while (0)

struct XcdBarrier {
    unsigned* bar; unsigned x;
    volatile LAS unsigned* st;
};

__device__ __forceinline__ XcdBarrier xcd_barrier_post(unsigned* bar, volatile LAS unsigned* st) {
    XcdBarrier b; b.bar = bar; b.x = xb_xcc_id(); b.st = st;
    if (threadIdx.x == 0) (void)xb_add(&bar[XB_XCNT(b.x)], 1u);
    return b;
}
__device__ __forceinline__ void xcd_barrier_complete(unsigned* bar, unsigned x, unsigned& nloc, unsigned& nx) {
    const unsigned G = gridDim.x * gridDim.y * gridDim.z;
    unsigned sum, cnt, mine, sp = 0u;
    for (;;) {
        sum = 0u; cnt = 0u; mine = 0u;
#pragma unroll
        for (unsigned j = 0; j < 16; ++j) { const unsigned c = xb_ld(&bar[XB_XCNT(j)]); sum += c; cnt += (c > 0u) ? 1u : 0u; mine = (j == x) ? c : mine; }
        if (sum == G) break;
        __builtin_amdgcn_s_sleep(1);
        if ((++sp & 255u) == 0u) { if (xb_ld(&bar[XB_TMO])) break; if (sp > XB_SPIN_CAP) { atomicAdd(&bar[XB_TMO], 1u); break; } }
    }
    nloc = mine > 0u ? mine : 1u; nx = cnt > 0u ? cnt : 1u;
}

__device__ __forceinline__ void xcd_barrier(const XcdBarrier& b) {
    asm volatile("s_waitcnt vmcnt(0)" ::: "memory");
    __syncthreads();
    if (threadIdx.x == 0) {
        unsigned* bar = b.bar;
        __builtin_amdgcn_s_waitcnt(0);
        unsigned nloc = b.st[0], nx = b.st[1];
        if (nloc == 0u) { xcd_barrier_complete(bar, b.x, nloc, nx); b.st[0] = nloc; b.st[1] = nx; }
        const unsigned old = xb_add(&bar[XB_XSUB(b.x)], 1u);
        const unsigned gen = old / nloc;
        if (old + 1u == (gen + 1u) * nloc) {
            __builtin_amdgcn_fence(__ATOMIC_RELEASE, "agent");
            asm volatile("s_waitcnt vmcnt(0)" ::: "memory");
            const unsigned og = xb_add(&bar[XB_TOP], 1u);
            const unsigned tg = og / nx;
            if (og + 1u == (tg + 1u) * nx) xb_add(&bar[XB_TOPGEN], 1u);
            else XB_SPIN(xb_ld(&bar[XB_TOPGEN]) == tg, bar);
            __builtin_amdgcn_fence(__ATOMIC_ACQUIRE, "agent");
            xb_add(&bar[XB_XGEN(b.x)], 1u);
            asm volatile("s_waitcnt vmcnt(0)" ::: "memory");
        } else {
            XB_SPIN(xb_ld(&bar[XB_XGEN(b.x)]) == gen, bar);
            __builtin_amdgcn_fence(__ATOMIC_ACQUIRE, "agent");
            asm volatile("s_waitcnt vmcnt(0)" ::: "memory");
        }
    }
    __syncthreads();
}

__global__ void __launch_bounds__(512, 2) fwd_kernel(Args a) {
    extern __shared__ __attribute__((aligned(16))) unsigned char lds_raw[];
    cg::grid_group grid = cg::this_grid();
    LAS unsigned char* lds = (LAS unsigned char*)lds_raw;
    const int G = gridDim.x, bx = blockIdx.x;
    const int vcu = (G % 8 == 0) ? (bx % 8) * (G / 8) + bx / 8 : bx;
    const int NGW = G * 8;
#define LAUNDER_TID int tid_l = threadIdx.x; asm volatile("" : "+v"(tid_l)); const int lane = tid_l & 63, wave = __builtin_amdgcn_readfirstlane(tid_l >> 6), gw = vcu * 8 + wave;
#define WSW(name, off) size_t name##_o = (off); asm volatile("" : "+s"(name##_o)); bf16* const name = (bf16*)(((l & 1) ? (unsigned char*)a.out : a.ws) + name##_o);
#define WSP(name, off) size_t name##_o = (off); asm volatile("" : "+s"(name##_o)); bf16* const name = (bf16*)(a.ws + name##_o);
    volatile LAS unsigned* MISC = (volatile LAS unsigned*)(lds + RING_BYTES + 256);
    if (threadIdx.x < 16) MISC[threadIdx.x] = 0u;
    unsigned* barw = (unsigned*)(a.ws + WS_BARW);
    __syncthreads();
    const XcdBarrier xbar = xcd_barrier_post(barw, MISC + 8);
    { LAUNDER_TID
    for (int tk = gw; tk < 4 * 144 * 16; tk += NGW) { const int l4 = tk / (144 * 16), cg = (tk >> 4) % 144, kc = tk & 15, c = 64 * cg + lane;
        const int drow = win_dest_row(c), slot = drow >= 7168 ? -2 : pg8::p1_qslot(__builtin_amdgcn_readfirstlane(drow) >> 8);
        if (slot == -1) continue;
        const float* wp = a.in[2] + (size_t)l4 * DM * NIN + (size_t)(64 * kc) * NIN + c; float mx = 0.f;
#pragma unroll 16
        for (int kk = 0; kk < 64; ++kk) mx = fmaxf(mx, fabsf(wp[(size_t)kk * NIN]));
        unsigned* dst = slot == -2 ? (unsigned*)(a.ws + WS_CMAX) + l4 * 2048 + (drow - 7168) : (unsigned*)(a.ws + WS_CMAX1) + l4 * (pg8::P1_NQ * 256) + slot * 256 + (drow & 255);
        atomicMax(dst, __float_as_uint(mx)); }
    convert_layer(a, 0, lds, gw, NGW, lane, wave, false);
    { const float* x = a.in[0]; WSP(XH, WS_XH) unsigned char* XQ = (unsigned char*)a.out + OUT_XQ; float* XS = (float*)(a.ws + WS_XS);
      for (int m = gw; m < T; m += NGW) { const float* xr = x + (size_t)m * DM + lane * 8;
          const f32x4 v0 = *(const f32x4*)xr, v1 = *(const f32x4*)(xr + 4), v2 = *(const f32x4*)(xr + 512), v3 = *(const f32x4*)(xr + 516);
          bf16* xo = XH + (size_t)m * DM + lane * 8; *(u32x4*)xo = pg8::pack8h(v0, v1); *(u32x4*)(xo + 512) = pg8::pack8h(v2, v3);
          float am = fmaxf(fmaxf(fmaxf(fabsf(v0[0]), fabsf(v0[1])), fmaxf(fabsf(v0[2]), fabsf(v0[3]))), fmaxf(fmaxf(fabsf(v1[0]), fabsf(v1[1])), fmaxf(fabsf(v1[2]), fabsf(v1[3]))));
          am = fmaxf(am, fmaxf(fmaxf(fmaxf(fabsf(v2[0]), fabsf(v2[1])), fmaxf(fabsf(v2[2]), fabsf(v2[3]))), fmaxf(fmaxf(fabsf(v3[0]), fabsf(v3[1])), fmaxf(fabsf(v3[2]), fabsf(v3[3])))));
          am = wave_max(am); const float inv = am > 0.f ? 127.f / am : 0.f;
          unsigned char* xq = XQ + (size_t)m * DM + lane * 8;
          u32x2 w0, w1; w0.x = q4(v0[0], v0[1], v0[2], v0[3], inv); w0.y = q4(v1[0], v1[1], v1[2], v1[3], inv); w1.x = q4(v2[0], v2[1], v2[2], v2[3], inv); w1.y = q4(v3[0], v3[1], v3[2], v3[3], inv);
          *(u32x2*)xq = w0; *(u32x2*)(xq + 512) = w1; if (lane == 0) { XS[m] = am; float* vs = (float*)(a.ws + WS_VST) + 2 * (size_t)m; vs[0] = 0.f; vs[1] = 0.f; } } } }
    if (a.ws == nullptr) grid.sync();
    xcd_barrier(xbar);
#define GRID_SYNC() xcd_barrier(xbar)
#pragma unroll 1
    for (int l = 0; l < DEPTH; ++l) {
#ifndef SKIP_P1
        if (l == 0) { LAUNDER_TID
            LAS float* scr = (LAS float*)(lds + wave * 8704);
            for (int it = gw; it < 16 * (NIN / 32); it += NGW) win_item(a, 0, a.ws, it / (NIN / 32), it % (NIN / 32), 1, scr, lane);
            GRID_SYNC(); }
        { WSP(XH, WS_XH) WSW(WinT, WS_WIN) WSP(UGQ, WS_UGQ) WSP(Vb, WS_V) WSP(Kb, WS_K) WSP(VBb, WS_VB) WSP(GBb, WS_GB)
          if constexpr (pg8::P1_NF > 0)
          { pg8::Gemm g{XH, WinT + (size_t)(pg8::P1_F0 * 256) * DM, T, pg8::P1_NF * 256, DM, DM}; pg8::StaticOrder S; S.init(T, pg8::P1_NF * 256, G, bx);
            pg8::Epi1<false> E{UGQ, Vb, Kb, VBb, GBb, QSCALE, nullptr, nullptr, nullptr};
            pg8::gemm_phase<pg8::Epi1<false>, pg8::StaticOrder, true, true, 1>(lds, g, S, E); }
          { const bf16* XQ = (const bf16*)((const unsigned char*)a.out + OUT_XQ);
            pg8::Gemm g{XQ, WinT, T, pg8::P1_NQ * 256, 512, 512}; pg8::StaticOrder S; S.init(T, pg8::P1_NQ * 256, G, bx);
            pg8::Epi1<true> E{UGQ, Vb, Kb, VBb, GBb, QSCALE, (const float*)(a.ws + WS_XS), (const float*)(a.ws + WS_CMAX1) + l * (pg8::P1_NQ * 256), (float*)(a.ws + WS_VST)};
            pg8::gemm_phase<pg8::Epi1<true>, pg8::StaticOrder, true, true, 2>(lds, g, S, E); }
        }
#endif
        GRID_SYNC();
        { WSP(UGQ, WS_UGQ) WSP(Vb, WS_V) WSW(WsB, WS_WS) WSP(Kb, WS_K) WSP(VBb, WS_VB) WSP(GBb, WS_GB)
#pragma unroll 1
        for (int st = 0; st < 2; ++st) {
            if (((st ^ vcu) & 1) == 0) {
#ifndef SKIP_BA
                for (int c = vcu; c < T / 128; c += G)
                    brancha_unit(c, UGQ, Vb, WsB, (const float*)(a.ws + WS_VST), a.in[3] + l * DM, a.in[4] + l * DM, a.in[6] + l * 8 * 128, lds);
#endif
            } else {
#ifndef SKIP_AT
#pragma unroll 1
                for (int pu2 = 2 * vcu; pu2 < 128 * 16; pu2 += 2 * G) {
#pragma unroll 1
                    for (int j2 = 0; j2 < 2; ++j2) {
                        const int pu = pu2 >> 1, bh = pu >> 3, s = pu & 7;
                        attn_unit(bh >> 4, bh & 15, j2 ? s : 15 - s, UGQ, Kb, VBb, GBb, lds);
                    }
                }
#endif
            }
        }
        if (l + 1 < DEPTH) { __syncthreads(); LAUNDER_TID convert_layer(a, l + 1, lds, gw, NGW, lane, wave); }
        }
        GRID_SYNC();
#ifndef SKIP_P25
        { WSW(WinT, WS_WIN) WSP(SMA, WS_K) WSP(SMB, WS_VB)
          const bf16* XQ = (const bf16*)((const unsigned char*)a.out + OUT_XQ);
          pg8::Gemm g{XQ, WinT + (size_t)7168 * DM, T, 2048, 512, 512}; pg8::GateOrder S; S.init(T, G, bx);
          pg8::EpiGateQ E{SMA, SMB, (const float*)(a.ws + WS_XS), (const float*)(a.ws + WS_CMAX) + l * 2048};
          pg8::gemm_phase<pg8::EpiGateQ, pg8::GateOrder, true, true, 2>(lds, g, S, E); }
        { WSW(PB, WS_PB) WSW(WeT, WS_WE) WSP(EB, WS_GB)
          int kp = PLE; asm volatile("" : "+s"(kp));
          pg8::Gemm g{PB, WeT, T, DM, kp, kp}; pg8::StaticOrder S; S.init(T, DM, G, bx);
          pg8::EpiStore<0> E{EB, EB};
          pg8::gemm_phase<pg8::EpiStore<0>, pg8::StaticOrder, true, true>(lds, g, S, E); }
#endif
#ifndef SKIP_P3
        { WSP(UGQ, WS_UGQ) WSW(W2T, WS_W2) WSP(SMA, WS_K) WSP(SMB, WS_VB) WSP(MERGED, WS_V)
          pg8::Gemm g{UGQ, W2T, T, DM, 2048, 2048}; pg8::StaticOrder S; S.init(T, DM, G, bx);
          pg8::Epi2 E{SMA, SMB, MERGED};
          pg8::gemm_phase<pg8::Epi2, pg8::StaticOrder, true, true>(lds, g, S, E);
#ifdef PROBE_DUP_P3
          pg8::gemm_phase<pg8::Epi2, pg8::StaticOrder, true, true>(lds, g, S, E);
#endif
        }
#endif
        GRID_SYNC();
#ifndef SKIP_P4
        { WSP(MERGED, WS_V) WSW(WoT, WS_WO) WSP(XH1, WS_XH1) WSP(XH, WS_XH)
          pg8::Gemm g{MERGED, WoT, T, DM, DM, DM}; pg8::StaticOrder S; S.init(T, DM, G, bx);
          pg8::Epi3 E{XH, XH1, ALPHA};
          pg8::gemm_phase<pg8::Epi3, pg8::StaticOrder, true, true>(lds, g, S, E); }
#endif
        GRID_SYNC();
#ifndef SKIP_P5
        { WSP(XH1, WS_XH1) WSW(WgT, WS_WG) WSP(EB, WS_GB) WSP(XH, WS_XH)
          pg8::Gemm g{XH1, WgT, T, DM, DM, DM}; pg8::StaticOrder S; S.init(T, DM, G, bx);
          pg8::Epi4 E{XH1, XH, EB};
          pg8::gemm_phase<pg8::Epi4, pg8::StaticOrder, true, true, true>(lds, g, S, E); }
#endif
        GRID_SYNC();
#ifdef PROBE_SYNC
        for (int z = 0; z < 10; ++z) GRID_SYNC();
#endif
        LAUNDER_TID WSP(XH, WS_XH)
        ln_rows(XH, (unsigned char*)a.out + OUT_XQ, (float*)(a.ws + WS_XS), (float*)(a.ws + WS_VST), a.out, a.in[12] + l * DM, a.in[13] + l * DM, l + 1 == DEPTH, gw, NGW, lane);
        if (l + 1 < DEPTH) GRID_SYNC();
    }
}

extern "C" void kernel_launch(void* const* d_in, const int* in_sizes, int n_in, void* d_out, int out_size, void* d_ws, size_t ws_size, hipStream_t stream) {
    static int grid = 0;
    if (grid == 0) {
        if (n_in != 14 || out_size != T * DM || ws_size < WS_END) { fprintf(stderr, "kernel_launch: unexpected shapes (n_in %d out %d ws %zu)\n", n_in, out_size, ws_size); grid = -1; return; }
        int dev = 0, cus = 0, per_cu = 0;
        hipGetDevice(&dev); hipDeviceGetAttribute(&cus, hipDeviceAttributeMultiprocessorCount, dev);
        hipFuncSetAttribute((const void*)fwd_kernel, hipFuncAttributeMaxDynamicSharedMemorySize, LDS_BYTES);
        hipOccupancyMaxActiveBlocksPerMultiprocessor(&per_cu, (const void*)fwd_kernel, 512, LDS_BYTES);
        if (per_cu < 1) per_cu = 1;
        grid = cus;
        (void)hipGetLastError();
    }
    if (grid < 0) return;
    Args a{};
    for (int i = 0; i < 14; ++i) a.in[i] = (const float*)d_in[i];
    a.out = (float*)d_out; a.ws = (unsigned char*)d_ws;
    hipMemsetAsync((char*)d_ws + WS_BARW, 0, 16384 + 4 * (2048 + pg8::P1_NQ * 256) * sizeof(float), stream);
    void* args[] = {&a};
    hipError_t e = hipLaunchCooperativeKernel((const void*)fwd_kernel, dim3(grid), dim3(512), args, LDS_BYTES, stream);
    if (e != hipSuccess) fprintf(stderr, "cooperative launch failed: %s (grid %d)\n", hipGetErrorString(e), grid);
}
```

```cpp
#include <hip/hip_runtime.h>
#include <hip/hip_cooperative_groups.h>
#include <cstdio>
#include <cstdint>
namespace cg = cooperative_groups;
namespace pg8 {
#define PG8_LAS __attribute__((address_space(3)))
typedef unsigned short bf16_t;
typedef short bf16x8 __attribute__((ext_vector_type(8)));
typedef _Float16 f16x8 __attribute__((ext_vector_type(8)));
typedef int i32x4 __attribute__((ext_vector_type(4)));
typedef float f32x4 __attribute__((ext_vector_type(4)));
typedef unsigned u32x4 __attribute__((ext_vector_type(4)));
constexpr int BM = 256, BK = 64, HALF = 128, HTB = HALF * BK * 2  , STAGE_BYTES = 8 * HTB, NXCD = 8, WGM = 8;

__host__ __device__ __forceinline__ int lds_byte(int r, int c) { const int st = (r >> 4) * 2 + (c >> 5), rr = r & 15, cc = c & 31, ob = rr * 64 + cc * 2; return st * 1024 + (ob ^ (((ob >> 9) & 1) << 5)); }
__host__ __device__ __forceinline__ void stage_rc(int b, int& R, int& C) { const int st = b / 1024, sb = b % 1024, swz = sb ^ (((sb >> 9) & 1) << 5); R = (st >> 1) * 16 + swz / 64; C = (st & 1) * 32 + (swz % 64) / 2; }
__host__ __device__ __forceinline__ int perm32(int rho) { const int n = rho >> 4, i = rho & 15; return 8 * (i >> 2) + 4 * n + (i & 3); }

struct Unit { int pm, pn; };
struct Gemm { const bf16_t* A; const bf16_t* Bt; int M, N, K, lda; };

struct StaticOrder {
    int nM, nN, nwg, G, c;
    __host__ __device__ void init(int M, int N, int G_, int c_) { nM = M / BM; nN = N / BM; nwg = nM * nN; G = G_; c = c_; }
    __host__ __device__ bool next(int i, Unit& u) const {
        const long L = (long)i * G + c; if (L >= nwg) return false;
        int wgid = (int)L; { const int q = nwg / NXCD, r = nwg % NXCD, xcd = wgid % NXCD, off = wgid / NXCD; wgid = (xcd < r ? xcd * (q + 1) : r * (q + 1) + (xcd - r) * q) + off; }
        const int nig = WGM * nN, gid = wgid / nig, fm = gid * WGM, gsz = (nM - fm) < WGM ? (nM - fm) : WGM;
        u.pm = fm + ((wgid % nig) % gsz); u.pn = (wgid % nig) / gsz; return true;
    }
    __device__ __forceinline__ void a_ready(const Unit&) const {}
    __device__ __forceinline__ void done(const Unit&) const {}
};
struct GateOrder {
    StaticOrder inner;
    __host__ __device__ void init(int M, int G_, int c_) { inner.init(M, 1024, G_, c_); }
    __host__ __device__ bool next(int i, Unit& u) const { Unit v; if (!inner.next(i >> 1, v)) return false; u.pm = v.pm; u.pn = 2 * v.pn + (i & 1); return true; }
    __device__ __forceinline__ void a_ready(const Unit&) const {}
    __device__ __forceinline__ void done(const Unit&) const {}
};


typedef float f32x2_t __attribute__((ext_vector_type(2))); typedef __bf16 bf16x2_t __attribute__((ext_vector_type(2)));
__device__ __forceinline__ unsigned cvt_pk_bf16(float lo, float hi) { f32x2_t v = {lo, hi}; bf16x2_t b = __builtin_convertvector(v, bf16x2_t); return __builtin_bit_cast(unsigned, b); }
__device__ __forceinline__ float sigm(float x) { return __builtin_amdgcn_rcpf(1.f + __builtin_amdgcn_exp2f(-1.4426950408889634f * x)); }
__device__ __forceinline__ u32x4 pack8(const f32x4 a, const f32x4 b) { u32x4 w; w.x = cvt_pk_bf16(a[0], a[1]); w.y = cvt_pk_bf16(a[2], a[3]); w.z = cvt_pk_bf16(b[0], b[1]); w.w = cvt_pk_bf16(b[2], b[3]); return w; }
__device__ __forceinline__ void unpack8(const u32x4 w, f32x4& a, f32x4& b) {
    a[0] = __uint_as_float(w.x << 16); a[1] = __uint_as_float(w.x & 0xffff0000u); a[2] = __uint_as_float(w.y << 16); a[3] = __uint_as_float(w.y & 0xffff0000u);
    b[0] = __uint_as_float(w.z << 16); b[1] = __uint_as_float(w.z & 0xffff0000u); b[2] = __uint_as_float(w.w << 16); b[3] = __uint_as_float(w.w & 0xffff0000u); }
typedef _Float16 f16x2_t __attribute__((ext_vector_type(2)));
__device__ __forceinline__ unsigned cvt_pk_f16(float lo, float hi) { f32x2_t v = {lo, hi}; f16x2_t h = __builtin_convertvector(v, f16x2_t); return __builtin_bit_cast(unsigned, h); }
__device__ __forceinline__ u32x4 pack8h(const f32x4 a, const f32x4 b) { u32x4 w; w.x = cvt_pk_f16(a[0], a[1]); w.y = cvt_pk_f16(a[2], a[3]); w.z = cvt_pk_f16(b[0], b[1]); w.w = cvt_pk_f16(b[2], b[3]); return w; }
__device__ __forceinline__ void unpack8h(const u32x4 w, f32x4& a, f32x4& b) {
    const unsigned x0 = w.x, x1 = w.y, x2 = w.z, x3 = w.w;
    const f32x2_t p0 = __builtin_convertvector(__builtin_bit_cast(f16x2_t, x0), f32x2_t), p1 = __builtin_convertvector(__builtin_bit_cast(f16x2_t, x1), f32x2_t);
    const f32x2_t p2 = __builtin_convertvector(__builtin_bit_cast(f16x2_t, x2), f32x2_t), p3 = __builtin_convertvector(__builtin_bit_cast(f16x2_t, x3), f32x2_t);
    a[0] = p0[0]; a[1] = p0[1]; a[2] = p1[0]; a[3] = p1[1]; b[0] = p2[0]; b[1] = p2[1]; b[2] = p3[0]; b[3] = p3[1]; }
#define PG8_FENCE asm volatile("" ::: "memory")

#ifndef P1_ALL_INT8
#define P1_ALL_INT8 1
#endif
#if P1_ALL_INT8
constexpr int P1_NQ = 28, P1_F0 = 28, P1_NF = 0;
__host__ __device__ constexpr int p1_qtile(int j) { return j; }
__host__ __device__ constexpr int p1_qslot(int tile) { return tile < 28 ? tile : -1; }
#else
constexpr int P1_NQ = 20, P1_F0 = 12, P1_NF = 8;
__host__ __device__ constexpr int p1_qtile(int j) { return j < 12 ? j : 20 + (j - 12); }
__host__ __device__ constexpr int p1_qslot(int tile) { return tile < 12 ? tile : (tile >= 20 && tile < 28 ? 12 + (tile - 20) : -1); }
#endif
template <bool Q> struct Epi1 {
    static constexpr bool PERM = true, AFTER_DRAIN = false, HAS_MID = false;
    bf16_t *UGQ, *V, *K, *VB, *GB; float qscale; const float* XS; const float* CS; float* VST;
    __device__ __forceinline__ static f32x4 val(const f32x4 a, float rs, const f32x4 cs) {
        if constexpr (Q) { const i32x4 q = __builtin_bit_cast(i32x4, a); return (f32x4){(float)q[0], (float)q[1], (float)q[2], (float)q[3]} * (cs * rs); } else return a; }
    __device__ __forceinline__ void operator()(const f32x4 (&acc)[2][2][4][2], const Unit& u, int wr, int wc, int fr, int fq) const {
        asm volatile("" : "+v"(fr), "+v"(fq));
        const int row0 = u.pm * BM + wr * 64 + fr, cw = wc * 32 + 8 * fq;
        const int pn = Q ? p1_qtile(u.pn) : u.pn + P1_F0;
        float rsc[2][4]; f32x4 cs[2][2];
#pragma unroll
        for (int ai = 0; ai < 2; ++ai)
#pragma unroll
            for (int m = 0; m < 4; ++m) rsc[ai][m] = Q ? XS[row0 + ai * HALF + m * 16] * (1.f / (127.f * 127.f)) : 1.f;
#pragma unroll
        for (int bj = 0; bj < 2; ++bj)
#pragma unroll
            for (int n = 0; n < 2; ++n) cs[bj][n] = Q ? *(const f32x4*)(CS + u.pn * BM + bj * HALF + cw + 4 * n) : (f32x4){1.f, 1.f, 1.f, 1.f};
        if (pn < 8) {
            bf16_t* base = UGQ + pn * 128 + cw;
#pragma unroll
            for (int ai = 0; ai < 2; ++ai)
#pragma unroll
                for (int m = 0; m < 4; ++m) {
                    f32x4 u0 = val(acc[ai][0][m][0], rsc[ai][m], cs[0][0]), u1 = val(acc[ai][0][m][1], rsc[ai][m], cs[0][1]);
                    const f32x4 g0 = val(acc[ai][1][m][0], rsc[ai][m], cs[1][0]), g1 = val(acc[ai][1][m][1], rsc[ai][m], cs[1][1]);
#pragma unroll
                    for (int e = 0; e < 4; ++e) { u0[e] *= g0[e] * sigm(g0[e]); u1[e] *= g1[e] * sigm(g1[e]); }
                    __builtin_nontemporal_store(pack8(u0, u1), (u32x4*)(base + (size_t)(row0 + ai * HALF + m * 16) * 2048));
                }
        } else {
            const int seg = (pn - 8) >> 2, ct = (pn - 8) & 3;
            bf16_t* base; int ldc = 1024; float sc = 1.f;
            if (seg == 0) base = V; else if (seg == 1) { base = UGQ + 1024; ldc = 2048; sc = qscale; } else if (seg == 2) base = K; else if (seg == 3) base = VB; else base = GB;
            base += ct * 256 + cw;
#pragma unroll
            for (int ai = 0; ai < 2; ++ai)
#pragma unroll
                for (int m = 0; m < 4; ++m) { bf16_t* rowp = base + (size_t)(row0 + ai * HALF + m * 16) * ldc; float ssum = 0.f, sq = 0.f;
#pragma unroll
                    for (int bj = 0; bj < 2; ++bj) { const u32x4 w = pack8(val(acc[ai][bj][m][0], rsc[ai][m], cs[bj][0]) * sc, val(acc[ai][bj][m][1], rsc[ai][m], cs[bj][1]) * sc);
                        __builtin_nontemporal_store(w, (u32x4*)(rowp + bj * HALF));
                        if (seg == 0) { f32x4 q0, q1; unpack8(w, q0, q1);
                            ssum += (q0[0] + q0[1]) + (q0[2] + q0[3]) + (q1[0] + q1[1]) + (q1[2] + q1[3]);
                            sq += (q0[0] * q0[0] + q0[1] * q0[1]) + (q0[2] * q0[2] + q0[3] * q0[3]) + (q1[0] * q1[0] + q1[1] * q1[1]) + (q1[2] * q1[2] + q1[3] * q1[3]); } }
                    if (seg == 0) { ssum += __shfl_xor(ssum, 16); ssum += __shfl_xor(ssum, 32); sq += __shfl_xor(sq, 16); sq += __shfl_xor(sq, 32);
                        if (fq == 0) { float* sp = VST + 2 * (size_t)(row0 + ai * HALF + m * 16); atomicAdd(sp, ssum); atomicAdd(sp + 1, sq); } } }
        }
    }
};
template <int SIG> struct EpiStore {
    static constexpr bool PERM = true, AFTER_DRAIN = false, HAS_MID = false;
    bf16_t *D0, *D1;
    __device__ __forceinline__ void operator()(const f32x4 (&acc)[2][2][4][2], const Unit& u, int wr, int wc, int fr, int fq) const {
        asm volatile("" : "+v"(fr), "+v"(fq));
        const int row0 = u.pm * BM + wr * 64 + fr, cw = wc * 32 + 8 * fq;
        bf16_t* base = (u.pn < 4 ? D0 : D1) + (u.pn & 3) * 256 + cw;
#pragma unroll
        for (int ai = 0; ai < 2; ++ai)
#pragma unroll
            for (int m = 0; m < 4; ++m) { bf16_t* rowp = base + (size_t)(row0 + ai * HALF + m * 16) * 1024;
#pragma unroll
                for (int bj = 0; bj < 2; ++bj) { f32x4 v0 = acc[ai][bj][m][0], v1 = acc[ai][bj][m][1];
                    if (SIG) {
#pragma unroll
                        for (int e = 0; e < 4; ++e) { v0[e] = sigm(v0[e]); v1[e] = sigm(v1[e]); } }
                    __builtin_nontemporal_store(pack8(v0, v1), (u32x4*)(rowp + bj * HALF)); } }
    }
};
struct EpiGate {
    static constexpr bool PERM = true, AFTER_DRAIN = false, HAS_MID = false;
    bf16_t *RHO, *SMB;
    __device__ __forceinline__ void operator()(const f32x4 (&acc)[2][2][4][2], const Unit& u, int wr, int wc, int fr, int fq) const {
        asm volatile("" : "+v"(fr), "+v"(fq));
        const int row0 = u.pm * BM + wr * 64 + fr, c0 = u.pn * 128 + wc * 32 + 8 * fq;
#pragma unroll
        for (int ai = 0; ai < 2; ++ai)
#pragma unroll
            for (int m = 0; m < 4; ++m) { const size_t off = (size_t)(row0 + ai * HALF + m * 16) * 1024 + c0;
                f32x4 r0, r1, s0, s1;
#pragma unroll
                for (int e = 0; e < 4; ++e) {
                    const float ea0 = __builtin_amdgcn_exp2f(fminf(-1.4426950408889634f * acc[ai][0][m][0][e], 80.f)), eb0 = __builtin_amdgcn_exp2f(fminf(-1.4426950408889634f * acc[ai][1][m][0][e], 80.f));
                    const float ea1 = __builtin_amdgcn_exp2f(fminf(-1.4426950408889634f * acc[ai][0][m][1][e], 80.f)), eb1 = __builtin_amdgcn_exp2f(fminf(-1.4426950408889634f * acc[ai][1][m][1][e], 80.f));
                    r0[e] = (1.f + eb0) * __builtin_amdgcn_rcpf(1.f + ea0); r1[e] = (1.f + eb1) * __builtin_amdgcn_rcpf(1.f + ea1);
                    s0[e] = __builtin_amdgcn_rcpf(1.f + eb0); s1[e] = __builtin_amdgcn_rcpf(1.f + eb1); }
                *(u32x4*)(RHO + off) = pack8(r0, r1); *(u32x4*)(SMB + off) = pack8(s0, s1); }
    }
};
struct EpiGateQ {
    static constexpr bool PERM = true, AFTER_DRAIN = false, HAS_MID = false;
    bf16_t *RHO, *SMB; const float* XS; const float* CS;
    __device__ __forceinline__ void operator()(const f32x4 (&acc)[2][2][4][2], const Unit& u, int wr, int wc, int fr, int fq) const {
        asm volatile("" : "+v"(fr), "+v"(fq));
        const int row0 = u.pm * BM + wr * 64 + fr, c0 = u.pn * 128 + wc * 32 + 8 * fq;
        float rsc[2][4]; f32x4 cs[2][2];
#pragma unroll
        for (int ai = 0; ai < 2; ++ai)
#pragma unroll
            for (int m = 0; m < 4; ++m) rsc[ai][m] = XS[row0 + ai * HALF + m * 16] * (1.f / (127.f * 127.f));
#pragma unroll
        for (int bj = 0; bj < 2; ++bj) { const int ci = u.pn * BM + bj * HALF + wc * 32 + 8 * fq; cs[bj][0] = *(const f32x4*)(CS + ci); cs[bj][1] = *(const f32x4*)(CS + ci + 4); }
#pragma unroll
        for (int ai = 0; ai < 2; ++ai)
#pragma unroll
            for (int m = 0; m < 4; ++m) { const size_t off = (size_t)(row0 + ai * HALF + m * 16) * 1024 + c0;
                f32x4 r0, r1, s0, s1;
#pragma unroll
                for (int e = 0; e < 4; ++e) {
                    const i32x4 qa0 = __builtin_bit_cast(i32x4, acc[ai][0][m][0]), qa1 = __builtin_bit_cast(i32x4, acc[ai][0][m][1]), qb0 = __builtin_bit_cast(i32x4, acc[ai][1][m][0]), qb1 = __builtin_bit_cast(i32x4, acc[ai][1][m][1]);
                    const float ma0 = (float)qa0[e] * (rsc[ai][m] * cs[0][0][e]), ma1 = (float)qa1[e] * (rsc[ai][m] * cs[0][1][e]);
                    const float mb0 = (float)qb0[e] * (rsc[ai][m] * cs[1][0][e]), mb1 = (float)qb1[e] * (rsc[ai][m] * cs[1][1][e]);
                    const float ea0 = __builtin_amdgcn_exp2f(fminf(-1.4426950408889634f * ma0, 80.f)), eb0 = __builtin_amdgcn_exp2f(fminf(-1.4426950408889634f * mb0, 80.f));
                    const float ea1 = __builtin_amdgcn_exp2f(fminf(-1.4426950408889634f * ma1, 80.f)), eb1 = __builtin_amdgcn_exp2f(fminf(-1.4426950408889634f * mb1, 80.f));
                    r0[e] = (1.f + eb0) * __builtin_amdgcn_rcpf(1.f + ea0); r1[e] = (1.f + eb1) * __builtin_amdgcn_rcpf(1.f + ea1);
                    s0[e] = __builtin_amdgcn_rcpf(1.f + eb0); s1[e] = __builtin_amdgcn_rcpf(1.f + eb1); }
                *(u32x4*)(RHO + off) = pack8(r0, r1); *(u32x4*)(SMB + off) = pack8(s0, s1); }
    }
};
struct Epi2 {
    static constexpr bool PERM = true, AFTER_DRAIN = false, HAS_MID = true;
    const bf16_t *SMA, *SMB; bf16_t* OUT;
    __device__ __forceinline__ void mid(f32x4 (&acc)[2][2][4][2], const Unit& u, int wr, int wc, int fr, int fq) const {
        asm volatile("" : "+v"(fr), "+v"(fq));
        const int row0 = u.pm * BM + wr * 64 + fr, c0 = u.pn * BM + wc * 32 + 8 * fq;
#pragma unroll
        for (int ai = 0; ai < 2; ++ai) {
            u32x4 wa[4][2];
#pragma unroll
            for (int m = 0; m < 4; ++m) { const size_t off = (size_t)(row0 + ai * HALF + m * 16) * 1024 + c0;
#pragma unroll
                for (int bj = 0; bj < 2; ++bj) wa[m][bj] = *(const u32x4*)(SMA + off + bj * HALF); }
            PG8_FENCE;
#pragma unroll
            for (int m = 0; m < 4; ++m)
#pragma unroll
                for (int bj = 0; bj < 2; ++bj) { f32x4 a0, a1; unpack8(wa[m][bj], a0, a1); acc[ai][bj][m][0] *= a0; acc[ai][bj][m][1] *= a1; }
            PG8_FENCE; }
    }
    __device__ __forceinline__ void operator()(const f32x4 (&acc)[2][2][4][2], const Unit& u, int wr, int wc, int fr, int fq) const {
        asm volatile("" : "+v"(fr), "+v"(fq));
        const int row0 = u.pm * BM + wr * 64 + fr, c0 = u.pn * BM + wc * 32 + 8 * fq;
        u32x4 wb[2][4][2];
#pragma unroll
        for (int ai = 0; ai < 2; ++ai)
#pragma unroll
            for (int m = 0; m < 4; ++m) { const size_t off = (size_t)(row0 + ai * HALF + m * 16) * 1024 + c0;
#pragma unroll
                for (int bj = 0; bj < 2; ++bj) wb[ai][m][bj] = *(const u32x4*)(SMB + off + bj * HALF); }
        PG8_FENCE;
#pragma unroll
        for (int ai = 0; ai < 2; ++ai)
#pragma unroll
            for (int m = 0; m < 4; ++m) { const size_t off = (size_t)(row0 + ai * HALF + m * 16) * 1024 + c0;
#pragma unroll
                for (int bj = 0; bj < 2; ++bj) { f32x4 b0, b1; unpack8(wb[ai][m][bj], b0, b1);
                    *(u32x4*)(OUT + off + bj * HALF) = pack8(acc[ai][bj][m][0] * b0, acc[ai][bj][m][1] * b1); } }
    }
};
struct Epi3 {
    static constexpr bool PERM = true, AFTER_DRAIN = false, HAS_MID = false;
    const bf16_t* XH; bf16_t* XO; float alpha;
    __device__ __forceinline__ void operator()(const f32x4 (&acc)[2][2][4][2], const Unit& u, int wr, int wc, int fr, int fq) const {
        asm volatile("" : "+v"(fr), "+v"(fq));
        const int row0 = u.pm * BM + wr * 64 + fr, c0 = u.pn * BM + wc * 32 + 8 * fq;
#pragma unroll
        for (int ai = 0; ai < 2; ++ai) {
            u32x4 wx[4][2];
#pragma unroll
            for (int m = 0; m < 4; ++m) { const size_t off = (size_t)(row0 + ai * HALF + m * 16) * 1024 + c0;
#pragma unroll
                for (int bj = 0; bj < 2; ++bj) wx[m][bj] = *(const u32x4*)(XH + off + bj * HALF); }
            PG8_FENCE;
#pragma unroll
            for (int m = 0; m < 4; ++m) { const size_t off = (size_t)(row0 + ai * HALF + m * 16) * 1024 + c0;
#pragma unroll
                for (int bj = 0; bj < 2; ++bj) { f32x4 r0, r1; unpack8h(wx[m][bj], r0, r1);
                    const f32x4 h0 = r0 * alpha + acc[ai][bj][m][0], h1 = r1 * alpha + acc[ai][bj][m][1];
                    *(u32x4*)(XO + off + bj * HALF) = pack8h(h0, h1); } }
            PG8_FENCE; }
    }
};
struct Epi4 {
    static constexpr bool PERM = true, AFTER_DRAIN = false, HAS_MID = false;
    const bf16_t* H0; bf16_t* XO; const bf16_t* E;
    __device__ __forceinline__ void operator()(const f32x4 (&acc)[2][2][4][2], const Unit& u, int wr, int wc, int fr, int fq) const {
        asm volatile("" : "+v"(fr), "+v"(fq));
        const int row0 = u.pm * BM + wr * 64 + fr, c0 = u.pn * BM + wc * 32 + 8 * fq;
#pragma unroll
        for (int ai = 0; ai < 2; ++ai) {
            u32x4 wx[4][2], we[4][2];
#pragma unroll
            for (int m = 0; m < 4; ++m) { const size_t off = (size_t)(row0 + ai * HALF + m * 16) * 1024 + c0;
#pragma unroll
                for (int bj = 0; bj < 2; ++bj) { wx[m][bj] = *(const u32x4*)(H0 + off + bj * HALF); we[m][bj] = *(const u32x4*)(E + off + bj * HALF); } }
            PG8_FENCE;
#pragma unroll
            for (int m = 0; m < 4; ++m) { const size_t off = (size_t)(row0 + ai * HALF + m * 16) * 1024 + c0;
#pragma unroll
                for (int bj = 0; bj < 2; ++bj) { f32x4 h0, h1, e0, e1; unpack8h(wx[m][bj], h0, h1); unpack8(we[m][bj], e0, e1);
#pragma unroll
                    for (int e = 0; e < 4; ++e) { h0[e] += e0[e] * sigm(acc[ai][bj][m][0][e]); h1[e] += e1[e] * sigm(acc[ai][bj][m][1][e]); }
                    *(u32x4*)(XO + off + bj * HALF) = pack8h(h0, h1); } }
            PG8_FENCE; }
    }
};
template <class Epi, class Sched, bool ALIGN_EPI = false, bool SP2 = false, int MODE = 0>
__device__ __forceinline__ void gemm_phase(PG8_LAS unsigned char* lds, const Gemm g, const Sched& S, const Epi& E) {
    int tid_ = threadIdx.x; asm volatile("" : "+v"(tid_));
    const int tid = tid_, wid = __builtin_amdgcn_readfirstlane(tid >> 6), lane = tid & 63, wr = wid >> 2, wc = wid & 3, fr = lane & 15, fq = lane >> 4;
    const int K = g.K, nt = K / BK;
    unsigned voffA[2], voffB[2];
#pragma unroll
    for (int i = 0; i < 2; ++i) { int R, C; stage_rc(tid * 16 + i * 8192, R, C); const int Rb = Epi::PERM ? ((R & ~31) + perm32(R & 31)) : R;
        voffA[i] = (unsigned)(R * g.lda + C) * 2u; voffB[i] = (unsigned)(Rb * K + C) * 2u; }
    const size_t kstep = (size_t)(BK * 2);
    const size_t hstepA = (size_t)HALF * g.lda * 2, hstepB = (size_t)HALF * K * 2;
    const size_t tstepA = 2 * hstepA, tstepB = 2 * hstepB;
    const unsigned ldsw = (unsigned)wid * 1024u;
    const int aoff = lds_byte(wr * 64 + fr, fq * 8), boff = lds_byte(wc * 32 + fr, fq * 8);
#define PG8_SA(b, h) (((b) * 2 + (h)) * HTB)
#define PG8_SB(b, h) ((4 + (b) * 2 + (h)) * HTB)
#define PG8_STAGE(bufoff, gbase, voff) do { _Pragma("unroll") for (int _i = 0; _i < 2; ++_i) \
        __builtin_amdgcn_global_load_lds((const unsigned*)((const char*)(gbase) + (voff)[_i]), (PG8_LAS unsigned*)(lds + (bufoff) + ldsw + _i * 8192), 16, 0, 0); } while (0)
#define PG8_LDA(dst, b, h) do { _Pragma("unroll") for (int m = 0; m < 4; ++m) _Pragma("unroll") for (int k = 0; k < 2; ++k) dst[m][k] = *(const PG8_LAS bf16x8*)(lds + PG8_SA(b, h) + aoff + m * 2048 + k * 1024); } while (0)
#define PG8_LDB(dst, b, h) do { _Pragma("unroll") for (int n = 0; n < 2; ++n) _Pragma("unroll") for (int k = 0; k < 2; ++k) dst[n][k] = *(const PG8_LAS bf16x8*)(lds + PG8_SB(b, h) + boff + n * 2048 + k * 1024); } while (0)
#define PG8_MMA(ai, bj, At, Bt) do { __builtin_amdgcn_s_setprio(1); _Pragma("unroll") for (int m = 0; m < 4; ++m) _Pragma("unroll") for (int n = 0; n < 2; ++n) _Pragma("unroll") for (int k = 0; k < 2; ++k) \
        { if constexpr (MODE == 2) acc[ai][bj][m][n] = __builtin_bit_cast(f32x4, __builtin_amdgcn_mfma_i32_16x16x64_i8(__builtin_bit_cast(i32x4, Bt[n][k]), __builtin_bit_cast(i32x4, At[m][k]), __builtin_bit_cast(i32x4, acc[ai][bj][m][n]), 0, 0, 0)); \
          else if constexpr (MODE == 1) acc[ai][bj][m][n] = __builtin_amdgcn_mfma_f32_16x16x32_f16(__builtin_bit_cast(f16x8, Bt[n][k]), __builtin_bit_cast(f16x8, At[m][k]), acc[ai][bj][m][n], 0, 0, 0); \
          else acc[ai][bj][m][n] = __builtin_amdgcn_mfma_f32_16x16x32_bf16(Bt[n][k], At[m][k], acc[ai][bj][m][n], 0, 0, 0); } __builtin_amdgcn_s_setprio(0); } while (0)
#define PG8_WAIT_V(n) asm volatile("s_waitcnt vmcnt(" #n ")" ::: "memory")
#define PG8_WAIT_L(n) asm volatile("s_waitcnt lgkmcnt(" #n ")" ::: "memory")
#define PG8_BAR __builtin_amdgcn_s_barrier()
#define PG8_SCHED __builtin_amdgcn_sched_barrier(0)
    Unit cur, nxt; int ui = 0;
    if (!S.next(0, cur)) return;
    f32x4 acc[2][2][4][2];
#pragma unroll
    for (int a = 0; a < 2; ++a)
#pragma unroll
        for (int b = 0; b < 2; ++b)
#pragma unroll
            for (int m = 0; m < 4; ++m)
#pragma unroll
                for (int n = 0; n < 2; ++n) acc[a][b][m][n] = (f32x4){0.f, 0.f, 0.f, 0.f};
    bf16x8 At[4][2], B0[2][2], B1[2][2];
    const char* cA = (const char*)g.A + (size_t)cur.pm * tstepA; const char* cB = (const char*)g.Bt + (size_t)cur.pn * tstepB;
    S.a_ready(cur);
    if constexpr (SP2) {
        PG8_STAGE(PG8_SB(0, 0), cB, voffB); PG8_STAGE(PG8_SB(0, 1), cB + hstepB, voffB); PG8_STAGE(PG8_SA(0, 0), cA, voffA); PG8_STAGE(PG8_SA(0, 1), cA + hstepA, voffA);
        if (wr == 1) PG8_BAR;
        PG8_WAIT_V(2); PG8_BAR;
        PG8_STAGE(PG8_SB(1, 0), cB + kstep, voffB); PG8_STAGE(PG8_SA(1, 0), cA + kstep, voffA); PG8_STAGE(PG8_SB(1, 1), cB + hstepB + kstep, voffB);
        PG8_WAIT_V(6); PG8_BAR;
    } else {
        PG8_STAGE(PG8_SB(0, 0), cB, voffB); PG8_STAGE(PG8_SA(0, 0), cA, voffA); PG8_STAGE(PG8_SB(0, 1), cB + hstepB, voffB); PG8_STAGE(PG8_SA(0, 1), cA + hstepA, voffA);
        if (wr == 1) PG8_BAR;
        PG8_WAIT_V(4); PG8_BAR;
        PG8_STAGE(PG8_SB(1, 0), cB + kstep, voffB); PG8_STAGE(PG8_SA(1, 0), cA + kstep, voffA); PG8_STAGE(PG8_SB(1, 1), cB + hstepB + kstep, voffB);
        PG8_WAIT_V(6); PG8_BAR;
    }
    for (;;) {
        const bool has_next = S.next(ui + 1, nxt);
        const char* nA = has_next ? (const char*)g.A + (size_t)nxt.pm * tstepA : cA; const char* nB = has_next ? (const char*)g.Bt + (size_t)nxt.pn * tstepB : cB;
        for (int t = 0; t < nt; t += 2) { if constexpr (Epi::HAS_MID) { if (t == (nt >> 1)) E.mid(acc, cur, wr, wc, fr, fq); }
            const bool last = (t == nt - 2);
            const char* a1 = cA + (size_t)(t + 1) * kstep;
            const char* a2 = last ? nA : cA + (size_t)(t + 2) * kstep; const char* b2 = last ? nB : cB + (size_t)(t + 2) * kstep;
            const char* a3 = a2 + kstep; const char* b3 = b2 + kstep;
            if (last && has_next) S.a_ready(nxt);
            if constexpr (SP2) {
            PG8_LDB(B0, 0, 0); PG8_LDB(B1, 0, 1); PG8_SCHED; PG8_LDA(At, 0, 0); PG8_STAGE(PG8_SA(1, 1), a1 + hstepA, voffA);
            PG8_WAIT_V(8); PG8_WAIT_L(0); PG8_BAR; PG8_MMA(0, 0, At, B0); PG8_MMA(0, 1, At, B1); PG8_BAR; PG8_SCHED;
            PG8_LDA(At, 0, 1); PG8_STAGE(PG8_SB(0, 0), b2, voffB); PG8_STAGE(PG8_SB(0, 1), b2 + hstepB, voffB); PG8_STAGE(PG8_SA(0, 0), a2, voffA);
            PG8_WAIT_V(8); PG8_WAIT_L(0); PG8_BAR; PG8_MMA(1, 0, At, B0); PG8_MMA(1, 1, At, B1); PG8_BAR; PG8_SCHED;
            PG8_LDB(B0, 1, 0); PG8_LDB(B1, 1, 1); PG8_SCHED; PG8_LDA(At, 1, 0); PG8_STAGE(PG8_SA(0, 1), a2 + hstepA, voffA);
            PG8_WAIT_V(8); PG8_WAIT_L(0); PG8_BAR; PG8_MMA(0, 0, At, B0); PG8_MMA(0, 1, At, B1); PG8_BAR; PG8_SCHED;
            PG8_LDA(At, 1, 1); PG8_STAGE(PG8_SB(1, 0), b3, voffB); PG8_STAGE(PG8_SB(1, 1), b3 + hstepB, voffB); PG8_STAGE(PG8_SA(1, 0), a3, voffA);
            PG8_WAIT_V(8); PG8_WAIT_L(0); PG8_BAR; PG8_MMA(1, 0, At, B0); PG8_MMA(1, 1, At, B1); PG8_BAR; PG8_SCHED;
            } else {
            PG8_LDB(B0, 0, 0); PG8_SCHED; PG8_LDA(At, 0, 0); PG8_STAGE(PG8_SA(1, 1), a1 + hstepA, voffA);
            PG8_WAIT_L(8); PG8_BAR; PG8_WAIT_L(0); PG8_MMA(0, 0, At, B0); PG8_BAR; PG8_SCHED;
            PG8_LDB(B1, 0, 1); PG8_STAGE(PG8_SB(0, 0), b2, voffB);
            PG8_BAR; PG8_WAIT_L(0); PG8_MMA(0, 1, At, B1); PG8_BAR;
            PG8_LDA(At, 0, 1); PG8_STAGE(PG8_SA(0, 0), a2, voffA);
            PG8_BAR; PG8_WAIT_L(0); PG8_MMA(1, 0, At, B0); PG8_BAR; PG8_SCHED;
            PG8_STAGE(PG8_SB(0, 1), b2 + hstepB, voffB);
            PG8_WAIT_V(6); PG8_BAR; PG8_MMA(1, 1, At, B1); PG8_BAR;
            PG8_LDB(B0, 1, 0); PG8_SCHED; PG8_LDA(At, 1, 0); PG8_STAGE(PG8_SA(0, 1), a2 + hstepA, voffA);
            PG8_WAIT_L(8); PG8_BAR; PG8_WAIT_L(0); PG8_MMA(0, 0, At, B0); PG8_BAR; PG8_SCHED;
            PG8_LDB(B1, 1, 1); PG8_STAGE(PG8_SB(1, 0), b3, voffB);
            PG8_BAR; PG8_WAIT_L(0); PG8_MMA(0, 1, At, B1); PG8_BAR;
            PG8_LDA(At, 1, 1); PG8_STAGE(PG8_SA(1, 0), a3, voffA);
            PG8_BAR; PG8_WAIT_L(0); PG8_MMA(1, 0, At, B0); PG8_BAR; PG8_SCHED;
            PG8_STAGE(PG8_SB(1, 1), b3 + hstepB, voffB);
            PG8_WAIT_V(6); PG8_BAR; PG8_MMA(1, 1, At, B1); PG8_BAR;
            }
        }
        if constexpr (ALIGN_EPI) { if (wr == 0) PG8_BAR; }
        if constexpr (!Epi::AFTER_DRAIN) { E(acc, cur, wr, wc, fr, fq); S.done(cur); }
        if (!has_next) break;
#pragma unroll
        for (int a = 0; a < 2; ++a)
#pragma unroll
            for (int b = 0; b < 2; ++b)
#pragma unroll
                for (int m = 0; m < 4; ++m)
#pragma unroll
                    for (int n = 0; n < 2; ++n) acc[a][b][m][n] = (f32x4){0.f, 0.f, 0.f, 0.f};
        cur = nxt; cA = nA; cB = nB; ++ui;
        if constexpr (ALIGN_EPI) { if (wr == 1) PG8_BAR; }
    }
    PG8_WAIT_V(0);
    if constexpr (!ALIGN_EPI) { if (wr == 0) PG8_BAR; }
    PG8_BAR;
    if constexpr (Epi::AFTER_DRAIN) { E.fused(acc, cur, wr, wc, fr, fq, lds, wid, lane); S.done(cur); }
#undef PG8_SA
#undef PG8_SB
#undef PG8_STAGE
#undef PG8_LDA
#undef PG8_LDB
#undef PG8_MMA
#undef PG8_WAIT_V
#undef PG8_WAIT_L
#undef PG8_BAR
#undef PG8_SCHED
}
}
#define LAS __attribute__((address_space(3)))
typedef unsigned short bf16;
typedef unsigned u32x4 __attribute__((ext_vector_type(4)));
typedef unsigned u32x2 __attribute__((ext_vector_type(2)));
typedef float f32x4 __attribute__((ext_vector_type(4)));
typedef float f32x16 __attribute__((ext_vector_type(16)));
typedef short bf16x8 __attribute__((ext_vector_type(8)));
constexpr int DM = 1024, NBATCH = 8, SEQ = 4096, T = NBATCH * SEQ, DEPTH = 4, PLE = 256, NIN = 9216, NHEAD = 16, HD = 64;
constexpr float LN_EPS = 1e-5f;
constexpr float ALPHA = 1.681792830507429f;
constexpr float QSCALE = 0.125f * 1.4426950408889634f;
constexpr size_t MiB = 1u << 20;
constexpr size_t WS_WIN = 0, WS_W2 = 18 * MiB, WS_WO = 22 * MiB, WS_WG = 24 * MiB, WS_WE = 26 * MiB, WS_WS = 27 * MiB, WS_PB = 28 * MiB, WS_XH1 = 44 * MiB,
                 WS_UGQ = 108 * MiB, WS_V = 236 * MiB, WS_K = 300 * MiB, WS_VB = 364 * MiB, WS_GB = 428 * MiB, WS_CTL = 492 * MiB, WS_XH = 493 * MiB, WS_XS = 557 * MiB  , WS_CMAX = WS_XS + 256 * 1024  , WS_CMAX1 = WS_CMAX + 32 * 1024  , WS_BARW = WS_CMAX - 16384  , WS_VST = WS_XS + 512 * 1024  , WS_END = 558 * MiB;
constexpr size_t OUT_XQ = 64 * MiB;
constexpr int LDS_BYTES = 147456, RING_BYTES = 131072;

__device__ __forceinline__ float wave_sum(float v) {
#pragma unroll
    for (int o = 1; o < 64; o <<= 1) v += __shfl_xor(v, o);
    return v;
}
__device__ __forceinline__ unsigned pk2(float lo, float hi) { return pg8::cvt_pk_bf16(lo, hi); }
__device__ __forceinline__ float bf_lo(unsigned w) { return __uint_as_float(w << 16); }
__device__ __forceinline__ float bf_hi(unsigned w) { return __uint_as_float(w & 0xffff0000u); }

template <bool F16 = false> __device__ __forceinline__ void tr_item(const float* W, int N, bf16* WT, int ldk, int koff, int k0, int n0, int drow0, LAS float* scr, int lane) {
#pragma unroll 8
    for (int i = 0; i < 32; ++i) { const int kk = 2 * i + (lane >> 5); scr[kk * 33 + (lane & 31)] = W[(size_t)(k0 + kk) * N + n0 + (lane & 31)]; }
    asm volatile("s_waitcnt lgkmcnt(0)" ::: "memory");
    const int c = lane & 7;
#pragma unroll
    for (int j = 0; j < 4; ++j) { const int n = (lane >> 3) + 8 * j; const LAS float* s = scr + (8 * c) * 33 + n;
        u32x4 o;
        if constexpr (F16) { o.x = pg8::cvt_pk_f16(s[0 * 33], s[1 * 33]); o.y = pg8::cvt_pk_f16(s[2 * 33], s[3 * 33]); o.z = pg8::cvt_pk_f16(s[4 * 33], s[5 * 33]); o.w = pg8::cvt_pk_f16(s[6 * 33], s[7 * 33]); }
        else { o.x = pk2(s[0 * 33], s[1 * 33]); o.y = pk2(s[2 * 33], s[3 * 33]); o.z = pk2(s[4 * 33], s[5 * 33]); o.w = pk2(s[6 * 33], s[7 * 33]); }
        *(u32x4*)(WT + (size_t)(drow0 + n) * ldk + koff + k0 + 8 * c) = o; }
    asm volatile("s_waitcnt lgkmcnt(0)" ::: "memory");
}
__device__ __forceinline__ float wave_max(float v) {
#pragma unroll
    for (int o = 1; o < 64; o <<= 1) v = fmaxf(v, __shfl_xor(v, o));
    return v;
}
__device__ __forceinline__ unsigned q4(float a, float b, float c, float d, float inv) {
    const int ia = (int)__builtin_rintf(a * inv), ib = (int)__builtin_rintf(b * inv), ic = (int)__builtin_rintf(c * inv), id = (int)__builtin_rintf(d * inv);
    return (unsigned)(ia & 0xff) | ((unsigned)(ib & 0xff) << 8) | ((unsigned)(ic & 0xff) << 16) | ((unsigned)(id & 0xff) << 24);
}
__device__ __forceinline__ int win_dest_row(int c);
__device__ __forceinline__ void tr_item_q(const float* W, const float* cmax, unsigned char* WQ, int k0, int n0, int qrow0, LAS float* scr, int lane) {
#pragma unroll 8
    for (int i = 0; i < 32; ++i) { const int kk = 2 * i + (lane >> 5); scr[kk * 33 + (lane & 31)] = W[(size_t)(k0 + kk) * NIN + n0 + (lane & 31)]; }
    asm volatile("s_waitcnt lgkmcnt(0)" ::: "memory");
    const int c16 = lane & 3;
#pragma unroll
    for (int j = 0; j < 2; ++j) { const int n = (lane >> 2) + 16 * j; const LAS float* sp = scr + (16 * c16) * 33 + n;
        const float cm = cmax[qrow0 + n], inv = cm > 0.f ? 127.f / cm : 0.f;
        u32x4 o; o.x = q4(sp[0 * 33], sp[1 * 33], sp[2 * 33], sp[3 * 33], inv); o.y = q4(sp[4 * 33], sp[5 * 33], sp[6 * 33], sp[7 * 33], inv);
        o.z = q4(sp[8 * 33], sp[9 * 33], sp[10 * 33], sp[11 * 33], inv); o.w = q4(sp[12 * 33], sp[13 * 33], sp[14 * 33], sp[15 * 33], inv);
        *(u32x4*)(WQ + (size_t)(qrow0 + n) * 1024 + k0 + 16 * c16) = o; }
    asm volatile("s_waitcnt lgkmcnt(0)" ::: "memory");
}
__device__ __forceinline__ int win_dest_row(int c) {
    if (c < 1024) return 256 * (c >> 7) + (c & 127);
    if (c < 2048) return 2048 + (c - 1024);
    if (c < 3072) { const int cc = c - 2048; return 256 * (cc >> 7) + 128 + (cc & 127); }
    if (c < 7168) return c;
    if (c < 8192) { const int cc = c - 7168; return 7168 + 256 * (cc >> 7) + (cc & 127); }
    { const int cc = c - 8192; return 7168 + 256 * (cc >> 7) + 128 + (cc & 127); }
}
struct Args { const float* in[14]; float* out; unsigned char* ws; };
__device__ __forceinline__ void win_item(const Args& a, int l, unsigned char* wb, int kb, int nb, int what, LAS float* scr, int lane) {
    const float* w_in = a.in[2] + (size_t)l * DM * NIN; const int drow0 = win_dest_row(32 * nb);
    if (drow0 >= 7168) { if (what >= 1) tr_item_q(w_in, (const float*)(a.ws + WS_CMAX) + l * 2048, wb + WS_WIN + (size_t)7168 * 2048, 64 * kb, 32 * nb, drow0 - 7168, scr, lane); return; }
    const int slot = pg8::p1_qslot(drow0 >> 8);
    if (slot >= 0) { if (what >= 1) tr_item_q(w_in, (const float*)(a.ws + WS_CMAX1) + l * (pg8::P1_NQ * 256), wb + WS_WIN, 64 * kb, 32 * nb, slot * 256 + (drow0 & 255), scr, lane); return; }
    if (what != 1) tr_item<true>(w_in, NIN, (bf16*)(wb + WS_WIN), 1024, 0, 64 * kb, 32 * nb, drow0, scr, lane);
}

__device__ __forceinline__ void convert_layer(const Args& a, int l, LAS unsigned char* lds, int gw, int NGW, int lane, int wave, bool gates = true) {
    LAS float* scr = (LAS float*)(lds + wave * 8704);
    unsigned char* ws = (l & 1) ? (unsigned char*)a.out : a.ws;
    const float* w_in = a.in[2] + (size_t)l * DM * NIN;
    const float* w_pa = a.in[7] + (size_t)l * DM * DM; const float* w_pb = a.in[8] + (size_t)l * DM * DM; const float* w_out = a.in[9] + (size_t)l * DM * DM;
    const float* w_pe = a.in[10] + (size_t)l * PLE * DM; const float* w_pg = a.in[11] + (size_t)l * DM * DM;
    constexpr int I_IN = 16 * (NIN / 32), I_SQ = 16 * 32, I_PE = 4 * 32, NITEMS = I_IN + 4 * I_SQ + I_PE;
    for (int it = gw; it < NITEMS; it += NGW) {
        int r = it;
        if (r < I_IN) { win_item(a, l, ws, r / (NIN / 32), r % (NIN / 32), gates ? 2 : 0, scr, lane); continue; } r -= I_IN;
        if (r < I_SQ) { tr_item(w_pa, DM, (bf16*)(ws + WS_W2), 2048, 0, 64 * (r >> 5), 32 * (r & 31), 32 * (r & 31), scr, lane); continue; } r -= I_SQ;
        if (r < I_SQ) { tr_item(w_pb, DM, (bf16*)(ws + WS_W2), 2048, 1024, 64 * (r >> 5), 32 * (r & 31), 32 * (r & 31), scr, lane); continue; } r -= I_SQ;
        if (r < I_SQ) { tr_item(w_out, DM, (bf16*)(ws + WS_WO), 1024, 0, 64 * (r >> 5), 32 * (r & 31), 32 * (r & 31), scr, lane); continue; } r -= I_SQ;
        if (r < I_SQ) { tr_item<true>(w_pg, DM, (bf16*)(ws + WS_WG), 1024, 0, 64 * (r >> 5), 32 * (r & 31), 32 * (r & 31), scr, lane); continue; } r -= I_SQ;
        tr_item(w_pe, DM, (bf16*)(ws + WS_WE), 256, 0, 64 * (r >> 5), 32 * (r & 31), 32 * (r & 31), scr, lane);
    }
    const int gt = gw * 64 + lane, NGT = NGW * 64;
    { const float* w_s = a.in[5] + (size_t)l * 8 * 128 * 128; bf16* WsB = (bf16*)(ws + WS_WS);
      for (int p = gt; p < 8 * 128 * 16; p += NGT) { const int s0 = (p & 15) * 8, t = (p >> 4) & 127;
          const f32x4 x0 = *(const f32x4*)(w_s + (size_t)p * 8), x1 = *(const f32x4*)(w_s + (size_t)p * 8 + 4);
          float v[8] = {x0[0], x0[1], x0[2], x0[3], x1[0], x1[1], x1[2], x1[3]};
#pragma unroll
          for (int j = 0; j < 8; ++j) v[j] = (s0 + j <= t) ? v[j] : 0.f;
          u32x4 o; o.x = pk2(v[0], v[1]); o.y = pk2(v[2], v[3]); o.z = pk2(v[4], v[5]); o.w = pk2(v[6], v[7]);
          *(u32x4*)(WsB + (size_t)p * 8) = o; } }
    { const float* p = a.in[1] + (size_t)l * T * PLE; bf16* PB = (bf16*)(ws + WS_PB);
      for (int q = gt; q < T * PLE / 8; q += NGT) { const f32x4 x0 = *(const f32x4*)(p + (size_t)q * 8), x1 = *(const f32x4*)(p + (size_t)q * 8 + 4);
          u32x4 o; o.x = pk2(x0[0], x0[1]); o.y = pk2(x0[2], x0[3]); o.z = pk2(x1[0], x1[1]); o.w = pk2(x1[2], x1[3]);
          *(u32x4*)(PB + (size_t)q * 8) = o; } }
}

constexpr int AT_K = 0, AT_V = 16384, AT_STG = 16384 + 2 * 9216, AT_STG_W = 8704;
__device__ __forceinline__ void attn_unit(int b, int h, int qb, bf16* UGQ, const bf16* Kb, const bf16* Vb, const bf16* GBb, LAS unsigned char* lds, int dry = 0) {
    int tid_ = threadIdx.x; asm volatile("" : "+v"(tid_));
    const int tid = tid_, lane = tid & 63, wid = __builtin_amdgcn_readfirstlane(tid >> 6), r32 = lane & 31, hi = lane >> 5;
    const size_t rowbase = (size_t)b * SEQ;
    const int q0 = qb * 256, qw = q0 + wid * 32;
    bf16x8 qr[4];
    { const bf16* qp = UGQ + (rowbase + qw + r32) * 2048 + 1024 + h * HD + hi * 8;
#pragma unroll
      for (int d0 = 0; d0 < 4; ++d0) qr[d0] = *(const bf16x8*)(qp + d0 * 16); }
    f32x16 o0, o1;
#pragma unroll
    for (int r = 0; r < 16; ++r) { o0[r] = 0.f; o1[r] = 0.f; }
    float C = 1.f; int alive = 1;
    volatile LAS unsigned* aflag = (volatile LAS unsigned*)(lds + RING_BYTES);
    const int NT = 4 * (qb + 1);
    const int lkey = lane, lch = wid;
    const int kk = lkey & 31, slot = (lkey & 32) | (8 * ((kk >> 2) & 3) + 4 * (kk >> 4) + (kk & 3));
    const bf16* kg = Kb + (rowbase + lkey) * 1024 + h * HD + lch * 8;
    const bf16* vg = Vb + (rowbase + lkey) * 1024 + h * HD + lch * 8;
    u32x4 kreg, vreg;
    kreg = *(const u32x4*)(kg + (size_t)(NT - 1) * 64 * 1024); vreg = *(const u32x4*)(vg + (size_t)(NT - 1) * 64 * 1024);
#define AT_WRITE(buf) do { *(LAS u32x4*)(lds + AT_K + (buf) * 8192 + lch * 1024 + slot * 16) = kreg; \
        LAS unsigned short* vt_ = (LAS unsigned short*)(lds + AT_V + (buf) * 9216) + (lch * 8) * 72 + lkey; \
        vt_[0 * 72] = (unsigned short)(vreg.x & 0xffffu); vt_[1 * 72] = (unsigned short)(vreg.x >> 16); vt_[2 * 72] = (unsigned short)(vreg.y & 0xffffu); vt_[3 * 72] = (unsigned short)(vreg.y >> 16); \
        vt_[4 * 72] = (unsigned short)(vreg.z & 0xffffu); vt_[5 * 72] = (unsigned short)(vreg.z >> 16); vt_[6 * 72] = (unsigned short)(vreg.w & 0xffffu); vt_[7 * 72] = (unsigned short)(vreg.w >> 16); } while (0)
    AT_WRITE(0);
    __syncthreads();
    const int qrel = qw + r32;
    for (int it = 0; it < NT; ++it) {
        const int kt = NT - 1 - it, cur = it & 1;
        if (it + 1 < NT) { kreg = *(const u32x4*)(kg + (size_t)(kt - 1) * 64 * 1024); vreg = *(const u32x4*)(vg + (size_t)(kt - 1) * 64 * 1024); }
        const int k0 = kt * 64;
        if (k0 < qw + 32 && alive) {
            const LAS unsigned char* kb = lds + AT_K + cur * 8192 + hi * 1024 + r32 * 16;
            f32x16 p0, p1;
#pragma unroll
            for (int r = 0; r < 16; ++r) { p0[r] = 0.f; p1[r] = 0.f; }
#pragma unroll
            for (int d0 = 0; d0 < 4; ++d0) {
                const bf16x8 a0 = *(const LAS bf16x8*)(kb + d0 * 2048), a1 = *(const LAS bf16x8*)(kb + d0 * 2048 + 512);
                p0 = __builtin_amdgcn_mfma_f32_32x32x16_bf16(a0, qr[d0], p0, 0, 0, 0);
                p1 = __builtin_amdgcn_mfma_f32_32x32x16_bf16(a1, qr[d0], p1, 0, 0, 0);
            }
#pragma unroll
            for (int r = 0; r < 16; ++r) { p0[r] = __builtin_amdgcn_rcpf(1.f + __builtin_amdgcn_exp2f(p0[r])); p1[r] = __builtin_amdgcn_rcpf(1.f + __builtin_amdgcn_exp2f(p1[r])); }
            if (k0 + 63 >= qw) {
                const int kb0 = k0 + 16 * hi;
#pragma unroll
                for (int r = 0; r < 16; ++r) { if (kb0 + r >= qrel) p0[r] = 1.f; if (kb0 + 32 + r >= qrel) p1[r] = 1.f; }
            }
#pragma unroll
            for (int r = 14; r >= 0; --r) { p0[r] *= p0[r + 1]; p1[r] *= p1[r + 1]; }
            const float L0 = p0[0], L1 = p1[0];
            const float pL0 = __shfl_xor(L0, 32), pL1 = __shfl_xor(L1, 32);
            const float tot1 = L1 * pL1;
            const float pre1 = hi ? C : C * pL1;
            const float pre0 = C * tot1 * (hi ? 1.f : pL0);
            C = C * tot1 * (L0 * pL0);
#pragma unroll
            for (int r = 0; r < 15; ++r) { p0[r] = pre0 * (p0[r + 1] - p0[r]); p1[r] = pre1 * (p1[r + 1] - p1[r]); }
            p0[15] = pre0 * (1.f - p0[15]); p1[15] = pre1 * (1.f - p1[15]);
            u32x4 w00, w01, w10, w11;
            w00.x = pk2(p0[0], p0[1]); w00.y = pk2(p0[2], p0[3]); w00.z = pk2(p0[4], p0[5]); w00.w = pk2(p0[6], p0[7]);
            w01.x = pk2(p0[8], p0[9]); w01.y = pk2(p0[10], p0[11]); w01.z = pk2(p0[12], p0[13]); w01.w = pk2(p0[14], p0[15]);
            w10.x = pk2(p1[0], p1[1]); w10.y = pk2(p1[2], p1[3]); w10.z = pk2(p1[4], p1[5]); w10.w = pk2(p1[6], p1[7]);
            w11.x = pk2(p1[8], p1[9]); w11.y = pk2(p1[10], p1[11]); w11.z = pk2(p1[12], p1[13]); w11.w = pk2(p1[14], p1[15]);
            const LAS unsigned char* vb = lds + AT_V + cur * 9216 + r32 * 144 + hi * 32;
#define AT_PV(W, off) do { const bf16x8 pf_ = __builtin_bit_cast(bf16x8, W); \
                const bf16x8 v0_ = *(const LAS bf16x8*)(vb + (off)), v1_ = *(const LAS bf16x8*)(vb + 4608 + (off)); \
                o0 = __builtin_amdgcn_mfma_f32_32x32x16_bf16(v0_, pf_, o0, 0, 0, 0); o1 = __builtin_amdgcn_mfma_f32_32x32x16_bf16(v1_, pf_, o1, 0, 0, 0); } while (0)
            AT_PV(w00, 0); AT_PV(w01, 16); AT_PV(w10, 64); AT_PV(w11, 80);
#undef AT_PV
            alive = __any(C != 0.f);
        }
        if (it + 1 < NT) AT_WRITE(cur ^ 1);
        if (lane == 0) aflag[(it & 1) * 8 + wid] = (unsigned)alive;
        __syncthreads();
        const unsigned fl = (lane < 8) ? aflag[(it & 1) * 8 + lane] : 0u;
        if (!__any(fl != 0u)) break;
    }
#undef AT_WRITE
    LAS float* stg = (LAS float*)(lds + AT_STG + wid * AT_STG_W);
#pragma unroll
    for (int g4 = 0; g4 < 4; ++g4) {
        *(LAS f32x4*)(stg + r32 * 68 + 8 * g4 + 4 * hi) = (f32x4){o0[4 * g4], o0[4 * g4 + 1], o0[4 * g4 + 2], o0[4 * g4 + 3]};
        *(LAS f32x4*)(stg + r32 * 68 + 32 + 8 * g4 + 4 * hi) = (f32x4){o1[4 * g4], o1[4 * g4 + 1], o1[4 * g4 + 2], o1[4 * g4 + 3]};
    }
    asm volatile("s_waitcnt lgkmcnt(0)" ::: "memory");
#pragma unroll
    for (int i = 0; i < 4; ++i) {
        const int row = i * 8 + (lane >> 3), ch = lane & 7;
        f32x4 a0 = *(const LAS f32x4*)(stg + row * 68 + ch * 8), a1 = *(const LAS f32x4*)(stg + row * 68 + ch * 8 + 4);
        const size_t tok = rowbase + qw + row;
        const u32x4 gw_ = *(const u32x4*)(GBb + tok * 1024 + h * HD + ch * 8);
        f32x4 g0, g1; pg8::unpack8(gw_, g0, g1);
#pragma unroll
        for (int e = 0; e < 4; ++e) { a0[e] *= g0[e] * pg8::sigm(g0[e]); a1[e] *= g1[e] * pg8::sigm(g1[e]); }
        if (!dry) *(u32x4*)(UGQ + tok * 2048 + 1024 + h * HD + ch * 8) = pg8::pack8(a0, a1);
    }
    asm volatile("s_waitcnt lgkmcnt(0)" ::: "memory");
}

constexpr int BA_STAT = 0, BA_GB = 1024, BA_VNT = 1024 + 8192, BA_OT = BA_VNT + 128 * 272;
typedef float f32x2_st __attribute__((ext_vector_type(2)));
__device__ __forceinline__ void brancha_unit(int chunk, bf16* UGQ, const bf16* Vb, const bf16* WsB, const float* VST, const float* vn_g, const float* vn_b, const float* b_s, LAS unsigned char* lds, int dry = 0) {
    int tid_ = threadIdx.x; asm volatile("" : "+v"(tid_));
    const int tid = tid_, lane = tid & 63, wid = __builtin_amdgcn_readfirstlane(tid >> 6), r32 = lane & 31, hi = lane >> 5;
    const size_t t0 = (size_t)chunk * 128;
    LAS float* stat = (LAS float*)(lds + BA_STAT);
    LAS float* gbl = (LAS float*)(lds + BA_GB);
    u32x4 vpc[4];
#pragma unroll
    for (int i = 0; i < 4; ++i) { const int p = tid + 512 * i, s = p >> 4, dc = p & 15; vpc[i] = *(const u32x4*)(Vb + (t0 + s) * 1024 + dc * 8); }
    gbl[tid] = vn_g[tid]; gbl[tid + 512] = vn_g[tid + 512]; gbl[1024 + tid] = vn_b[tid]; gbl[1536 + tid] = vn_b[tid + 512];
    if (tid < 128) { const f32x2_st st = *(const f32x2_st*)(VST + 2 * (t0 + tid));
        const float mean = st[0] * (1.f / 1024.f), var = fmaxf(st[1] * (1.f / 1024.f) - mean * mean, 0.f);
        stat[tid * 2] = mean; stat[tid * 2 + 1] = 1.0f / sqrtf(var + LN_EPS); }
    __syncthreads();
    const int dblk = wid & 3, tbp = wid >> 2;
    u32x4 ugp[4]; bf16x8 wf[2][8];
#define BA_LOAD_UG(g_) do { _Pragma("unroll") for (int i = 0; i < 4; ++i) { const int p = tid + 512 * i, t = p >> 4, dc = p & 15; ugp[i] = *(const u32x4*)(UGQ + (t0 + t) * 2048 + (g_) * 128 + dc * 8); } } while (0)
#define BA_LOAD_WS(g_) do { _Pragma("unroll") for (int j = 0; j < 2; ++j) { const int tb = 2 * tbp + j; const bf16* wrow = WsB + ((size_t)(g_) * 128 + 32 * tb + r32) * 128 + hi * 8; \
        _Pragma("unroll") for (int ks = 0; ks < 8; ++ks) if (ks < 2 * (tb + 1)) wf[j][ks] = *(const bf16x8*)(wrow + ks * 16); } } while (0)
    BA_LOAD_WS(0); BA_LOAD_UG(0);
    for (int g = 0; g < 8; ++g) {
        const f32x4 ga = *(const LAS f32x4*)(gbl + g * 128 + (tid & 15) * 8), gb2 = *(const LAS f32x4*)(gbl + g * 128 + (tid & 15) * 8 + 4);
        const f32x4 ba = *(const LAS f32x4*)(gbl + 1024 + g * 128 + (tid & 15) * 8), bb2 = *(const LAS f32x4*)(gbl + 1024 + g * 128 + (tid & 15) * 8 + 4);
#pragma unroll
        for (int i = 0; i < 4; ++i) {
            const int p = tid + 512 * i, s = p >> 4, dc = p & 15;
            f32x4 v0, v1; pg8::unpack8(vpc[i], v0, v1);
            const float mean = stat[s * 2], rstd = stat[s * 2 + 1];
            v0 = (v0 - mean) * rstd * ga + ba; v1 = (v1 - mean) * rstd * gb2 + bb2;
            const u32x4 w = pg8::pack8(v0, v1);
            LAS unsigned short* dst = (LAS unsigned short*)(lds + BA_VNT) + dc * 136 + s;
            dst[0 * 16 * 136] = (unsigned short)(w.x & 0xffffu); dst[1 * 16 * 136] = (unsigned short)(w.x >> 16); dst[2 * 16 * 136] = (unsigned short)(w.y & 0xffffu); dst[3 * 16 * 136] = (unsigned short)(w.y >> 16);
            dst[4 * 16 * 136] = (unsigned short)(w.z & 0xffffu); dst[5 * 16 * 136] = (unsigned short)(w.z >> 16); dst[6 * 16 * 136] = (unsigned short)(w.w & 0xffffu); dst[7 * 16 * 136] = (unsigned short)(w.w >> 16);
        }
        if (g + 1 < 8) {
#pragma unroll
            for (int i = 0; i < 4; ++i) { const int p = tid + 512 * i, s = p >> 4, dc = p & 15; vpc[i] = *(const u32x4*)(Vb + (t0 + s) * 1024 + (g + 1) * 128 + dc * 8); }
        }
        __syncthreads();
        const int d = 32 * dblk + r32;
        const LAS unsigned char* ab = lds + BA_VNT + ((d & 7) * 16 + (d >> 3)) * 272 + hi * 16;
        f32x16 acc[2];
#pragma unroll
        for (int j = 0; j < 2; ++j) {
            const int tb = 2 * tbp + j;
#pragma unroll
            for (int r = 0; r < 16; ++r) acc[j][r] = 0.f;
#pragma unroll
            for (int ks = 0; ks < 8; ++ks) if (ks < 2 * (tb + 1)) {
                const bf16x8 af = *(const LAS bf16x8*)(ab + ks * 32);
                acc[j] = __builtin_amdgcn_mfma_f32_32x32x16_bf16(af, wf[j][ks], acc[j], 0, 0, 0);
            }
        }
        if (g + 1 < 8) BA_LOAD_WS(g + 1);
#pragma unroll
        for (int j = 0; j < 2; ++j) {
            const int tb = 2 * tbp + j, t = 32 * tb + r32;
            const float bias = b_s[g * 128 + t];
            LAS float* ot = (LAS float*)(lds + BA_OT) + t * 132 + 32 * dblk + 4 * hi;
#pragma unroll
            for (int g4 = 0; g4 < 4; ++g4) *(LAS f32x4*)(ot + 8 * g4) = (f32x4){acc[j][4 * g4] + bias, acc[j][4 * g4 + 1] + bias, acc[j][4 * g4 + 2] + bias, acc[j][4 * g4 + 3] + bias};
        }
        __syncthreads();
#pragma unroll
        for (int i = 0; i < 4; ++i) {
            const int p = tid + 512 * i, t = p >> 4, dc = p & 15;
            const LAS float* ot = (const LAS float*)(lds + BA_OT) + t * 132 + dc * 8;
            const f32x4 m0 = *(const LAS f32x4*)ot, m1 = *(const LAS f32x4*)(ot + 4);
            bf16* up = UGQ + (t0 + t) * 2048 + g * 128 + dc * 8;
            f32x4 u0, u1; pg8::unpack8(ugp[i], u0, u1);
            if (!dry) *(u32x4*)up = pg8::pack8(u0 * m0, u1 * m1);
        }
        if (g + 1 < 8) BA_LOAD_UG(g + 1);
    }
#undef BA_LOAD_UG
#undef BA_LOAD_WS
    __syncthreads();
}

__device__ __forceinline__ void ln_rows(bf16* XH, unsigned char* XQ, float* XS, float* VST, float* OUT, const float* g, const float* bta, bool last, int gw, int NGW, int lane) {
    f32x4 gv[4], bv[4];
#pragma unroll
    for (int j = 0; j < 2; ++j) { gv[2 * j] = *(const f32x4*)(g + 512 * j + lane * 8); gv[2 * j + 1] = *(const f32x4*)(g + 512 * j + lane * 8 + 4);
                                  bv[2 * j] = *(const f32x4*)(bta + 512 * j + lane * 8); bv[2 * j + 1] = *(const f32x4*)(bta + 512 * j + lane * 8 + 4); }
    u32x4 nx0 = *(const u32x4*)(XH + (size_t)gw * DM + lane * 8), nx1 = *(const u32x4*)(XH + (size_t)gw * DM + lane * 8 + 512);
    for (int m = gw; m < T; m += NGW) {
        bf16* xr = XH + (size_t)m * DM + lane * 8;
        f32x4 v[4]; float s = 0.f;
        const u32x4 cx0 = nx0, cx1 = nx1;
        if (m + NGW < T) { nx0 = *(const u32x4*)(xr + (size_t)NGW * DM); nx1 = *(const u32x4*)(xr + (size_t)NGW * DM + 512); }
        pg8::unpack8h(cx0, v[0], v[1]); pg8::unpack8h(cx1, v[2], v[3]);
#pragma unroll
        for (int j = 0; j < 4; ++j) s += (v[j][0] + v[j][1]) + (v[j][2] + v[j][3]);
        const float mean = wave_sum(s) * (1.f / DM); float s2 = 0.f;
#pragma unroll
        for (int j = 0; j < 4; ++j) { v[j] = v[j] - mean; s2 += (v[j][0] * v[j][0] + v[j][1] * v[j][1]) + (v[j][2] * v[j][2] + v[j][3] * v[j][3]); }
        const float rstd = 1.0f / sqrtf(wave_sum(s2) * (1.f / DM) + LN_EPS);
#pragma unroll
        for (int j = 0; j < 4; ++j) v[j] = v[j] * rstd * gv[j] + bv[j];
        if (last) { float* o = OUT + (size_t)m * DM + lane * 8;
            *(f32x4*)o = v[0]; *(f32x4*)(o + 4) = v[1]; *(f32x4*)(o + 512) = v[2]; *(f32x4*)(o + 516) = v[3]; }
        else { *(u32x4*)xr = pg8::pack8h(v[0], v[1]); *(u32x4*)(xr + 512) = pg8::pack8h(v[2], v[3]);
            float am = 0.f;
#pragma unroll
            for (int j = 0; j < 4; ++j) am = fmaxf(am, fmaxf(fmaxf(fabsf(v[j][0]), fabsf(v[j][1])), fmaxf(fabsf(v[j][2]), fabsf(v[j][3]))));
            am = wave_max(am); const float inv = am > 0.f ? 127.f / am : 0.f;
            unsigned char* xq = XQ + (size_t)m * DM + lane * 8;
            u32x2 w0, w1; w0.x = q4(v[0][0], v[0][1], v[0][2], v[0][3], inv); w0.y = q4(v[1][0], v[1][1], v[1][2], v[1][3], inv);
            w1.x = q4(v[2][0], v[2][1], v[2][2], v[2][3], inv); w1.y = q4(v[3][0], v[3][1], v[3][2], v[3][3], inv);
            *(u32x2*)xq = w0; *(u32x2*)(xq + 512) = w1; if (lane == 0) { XS[m] = am; VST[2 * (size_t)m] = 0.f; VST[2 * (size_t)m + 1] = 0.f; } }
    }
}

#define XB_TMO      128
#define XB_XCNT(j)  (256  + 64 * (j))
#define XB_XSUB(j)  (1280 + 64 * (j))
#define XB_XGEN(j)  (2304 + 64 * (j))
#define XB_TOP      3328
#define XB_TOPGEN   3392
#define XCD_BAR_WORDS 3456
#define XB_SPIN_CAP (1u << 18)

__device__ __forceinline__ unsigned xb_ld(unsigned* p)              { return __hip_atomic_load(p, __ATOMIC_RELAXED, __HIP_MEMORY_SCOPE_AGENT); }
__device__ __forceinline__ unsigned xb_add(unsigned* p, unsigned v) { return __hip_atomic_fetch_add(p, v, __ATOMIC_RELAXED, __HIP_MEMORY_SCOPE_AGENT); }
__device__ __forceinline__ unsigned xb_xcc_id() { return (unsigned)__builtin_amdgcn_s_getreg((3 << 11) | 20) & 0xFu; }
#define XB_SPIN(cond, bar) do { unsigned _sp = 0; while (cond) { __builtin_amdgcn_s_sleep(1); \
    if ((++_sp & 255u) == 0u) { if (xb_ld(&(bar)[XB_TMO])) break; if (_sp > XB_SPIN_CAP) { atomicAdd(&(bar)[XB_TMO], 1u); break; } } } } while (0)

struct XcdBarrier {
    unsigned* bar; unsigned x;
    volatile LAS unsigned* st;
};

__device__ __forceinline__ XcdBarrier xcd_barrier_post(unsigned* bar, volatile LAS unsigned* st) {
    XcdBarrier b; b.bar = bar; b.x = xb_xcc_id(); b.st = st;
    if (threadIdx.x == 0) (void)xb_add(&bar[XB_XCNT(b.x)], 1u);
    return b;
}
__device__ __forceinline__ void xcd_barrier_complete(unsigned* bar, unsigned x, unsigned& nloc, unsigned& nx) {
    const unsigned G = gridDim.x * gridDim.y * gridDim.z;
    unsigned sum, cnt, mine, sp = 0u;
    for (;;) {
        sum = 0u; cnt = 0u; mine = 0u;
#pragma unroll
        for (unsigned j = 0; j < 16; ++j) { const unsigned c = xb_ld(&bar[XB_XCNT(j)]); sum += c; cnt += (c > 0u) ? 1u : 0u; mine = (j == x) ? c : mine; }
        if (sum == G) break;
        __builtin_amdgcn_s_sleep(1);
        if ((++sp & 255u) == 0u) { if (xb_ld(&bar[XB_TMO])) break; if (sp > XB_SPIN_CAP) { atomicAdd(&bar[XB_TMO], 1u); break; } }
    }
    nloc = mine > 0u ? mine : 1u; nx = cnt > 0u ? cnt : 1u;
}

__device__ __forceinline__ void xcd_barrier(const XcdBarrier& b) {
    asm volatile("s_waitcnt vmcnt(0)" ::: "memory");
    __syncthreads();
    if (threadIdx.x == 0) {
        unsigned* bar = b.bar;
        __builtin_amdgcn_s_waitcnt(0);
        unsigned nloc = b.st[0], nx = b.st[1];
        if (nloc == 0u) { xcd_barrier_complete(bar, b.x, nloc, nx); b.st[0] = nloc; b.st[1] = nx; }
        const unsigned old = xb_add(&bar[XB_XSUB(b.x)], 1u);
        const unsigned gen = old / nloc;
        if (old + 1u == (gen + 1u) * nloc) {
            __builtin_amdgcn_fence(__ATOMIC_RELEASE, "agent");
            asm volatile("s_waitcnt vmcnt(0)" ::: "memory");
            const unsigned og = xb_add(&bar[XB_TOP], 1u);
            const unsigned tg = og / nx;
            if (og + 1u == (tg + 1u) * nx) xb_add(&bar[XB_TOPGEN], 1u);
            else XB_SPIN(xb_ld(&bar[XB_TOPGEN]) == tg, bar);
            __builtin_amdgcn_fence(__ATOMIC_ACQUIRE, "agent");
            xb_add(&bar[XB_XGEN(b.x)], 1u);
            asm volatile("s_waitcnt vmcnt(0)" ::: "memory");
        } else {
            XB_SPIN(xb_ld(&bar[XB_XGEN(b.x)]) == gen, bar);
            __builtin_amdgcn_fence(__ATOMIC_ACQUIRE, "agent");
            asm volatile("s_waitcnt vmcnt(0)" ::: "memory");
        }
    }
    __syncthreads();
}

__global__ void __launch_bounds__(512, 2) fwd_kernel(Args a) {
    extern __shared__ __attribute__((aligned(16))) unsigned char lds_raw[];
    cg::grid_group grid = cg::this_grid();
    LAS unsigned char* lds = (LAS unsigned char*)lds_raw;
    const int G = gridDim.x, bx = blockIdx.x;
    const int vcu = (G % 8 == 0) ? (bx % 8) * (G / 8) + bx / 8 : bx;
    const int NGW = G * 8;
#define LAUNDER_TID int tid_l = threadIdx.x; asm volatile("" : "+v"(tid_l)); const int lane = tid_l & 63, wave = __builtin_amdgcn_readfirstlane(tid_l >> 6), gw = vcu * 8 + wave;
#define WSW(name, off) size_t name##_o = (off); asm volatile("" : "+s"(name##_o)); bf16* const name = (bf16*)(((l & 1) ? (unsigned char*)a.out : a.ws) + name##_o);
#define WSP(name, off) size_t name##_o = (off); asm volatile("" : "+s"(name##_o)); bf16* const name = (bf16*)(a.ws + name##_o);
    volatile LAS unsigned* MISC = (volatile LAS unsigned*)(lds + RING_BYTES + 256);
    if (threadIdx.x < 16) MISC[threadIdx.x] = 0u;
    unsigned* barw = (unsigned*)(a.ws + WS_BARW);
    __syncthreads();
    const XcdBarrier xbar = xcd_barrier_post(barw, MISC + 8);
    { LAUNDER_TID
    for (int tk = gw; tk < 4 * 144 * 16; tk += NGW) { const int l4 = tk / (144 * 16), cg = (tk >> 4) % 144, kc = tk & 15, c = 64 * cg + lane;
        const int drow = win_dest_row(c), slot = drow >= 7168 ? -2 : pg8::p1_qslot(__builtin_amdgcn_readfirstlane(drow) >> 8);
        if (slot == -1) continue;
        const float* wp = a.in[2] + (size_t)l4 * DM * NIN + (size_t)(64 * kc) * NIN + c; float mx = 0.f;
#pragma unroll 16
        for (int kk = 0; kk < 64; ++kk) mx = fmaxf(mx, fabsf(wp[(size_t)kk * NIN]));
        unsigned* dst = slot == -2 ? (unsigned*)(a.ws + WS_CMAX) + l4 * 2048 + (drow - 7168) : (unsigned*)(a.ws + WS_CMAX1) + l4 * (pg8::P1_NQ * 256) + slot * 256 + (drow & 255);
        atomicMax(dst, __float_as_uint(mx)); }
    convert_layer(a, 0, lds, gw, NGW, lane, wave, false);
    { const float* x = a.in[0]; WSP(XH, WS_XH) unsigned char* XQ = (unsigned char*)a.out + OUT_XQ; float* XS = (float*)(a.ws + WS_XS);
      f32x4 n0 = *(const f32x4*)(x + (size_t)gw * DM + lane * 8), n1 = *(const f32x4*)(x + (size_t)gw * DM + lane * 8 + 4), n2 = *(const f32x4*)(x + (size_t)gw * DM + lane * 8 + 512), n3 = *(const f32x4*)(x + (size_t)gw * DM + lane * 8 + 516);
      for (int m = gw; m < T; m += NGW) { const float* xr = x + (size_t)m * DM + lane * 8;
          const f32x4 v0 = n0, v1 = n1, v2 = n2, v3 = n3;
          if (m + NGW < T) { const float* xn = xr + (size_t)NGW * DM; n0 = *(const f32x4*)xn; n1 = *(const f32x4*)(xn + 4); n2 = *(const f32x4*)(xn + 512); n3 = *(const f32x4*)(xn + 516); }
          bf16* xo = XH + (size_t)m * DM + lane * 8; *(u32x4*)xo = pg8::pack8h(v0, v1); *(u32x4*)(xo + 512) = pg8::pack8h(v2, v3);
          float am = fmaxf(fmaxf(fmaxf(fabsf(v0[0]), fabsf(v0[1])), fmaxf(fabsf(v0[2]), fabsf(v0[3]))), fmaxf(fmaxf(fabsf(v1[0]), fabsf(v1[1])), fmaxf(fabsf(v1[2]), fabsf(v1[3]))));
          am = fmaxf(am, fmaxf(fmaxf(fmaxf(fabsf(v2[0]), fabsf(v2[1])), fmaxf(fabsf(v2[2]), fabsf(v2[3]))), fmaxf(fmaxf(fabsf(v3[0]), fabsf(v3[1])), fmaxf(fabsf(v3[2]), fabsf(v3[3])))));
          am = wave_max(am); const float inv = am > 0.f ? 127.f / am : 0.f;
          unsigned char* xq = XQ + (size_t)m * DM + lane * 8;
          u32x2 w0, w1; w0.x = q4(v0[0], v0[1], v0[2], v0[3], inv); w0.y = q4(v1[0], v1[1], v1[2], v1[3], inv); w1.x = q4(v2[0], v2[1], v2[2], v2[3], inv); w1.y = q4(v3[0], v3[1], v3[2], v3[3], inv);
          *(u32x2*)xq = w0; *(u32x2*)(xq + 512) = w1; if (lane == 0) { XS[m] = am; float* vs = (float*)(a.ws + WS_VST) + 2 * (size_t)m; vs[0] = 0.f; vs[1] = 0.f; } } } }
    if (a.ws == nullptr) grid.sync();
    xcd_barrier(xbar);
#define GRID_SYNC() xcd_barrier(xbar)
#pragma unroll 1
    for (int l = 0; l < DEPTH; ++l) {
#ifndef SKIP_P1
        if (l == 0) { LAUNDER_TID
            LAS float* scr = (LAS float*)(lds + wave * 8704);
            for (int it = gw; it < 16 * (NIN / 32); it += NGW) win_item(a, 0, a.ws, it / (NIN / 32), it % (NIN / 32), 1, scr, lane);
            GRID_SYNC(); }
        { WSP(XH, WS_XH) WSW(WinT, WS_WIN) WSP(UGQ, WS_UGQ) WSP(Vb, WS_V) WSP(Kb, WS_K) WSP(VBb, WS_VB) WSP(GBb, WS_GB)
          if constexpr (pg8::P1_NF > 0)
          { pg8::Gemm g{XH, WinT + (size_t)(pg8::P1_F0 * 256) * DM, T, pg8::P1_NF * 256, DM, DM}; pg8::StaticOrder S; S.init(T, pg8::P1_NF * 256, G, bx);
            pg8::Epi1<false> E{UGQ, Vb, Kb, VBb, GBb, QSCALE, nullptr, nullptr, nullptr};
            pg8::gemm_phase<pg8::Epi1<false>, pg8::StaticOrder, true, true, 1>(lds, g, S, E); }
          { const bf16* XQ = (const bf16*)((const unsigned char*)a.out + OUT_XQ);
            pg8::Gemm g{XQ, WinT, T, pg8::P1_NQ * 256, 512, 512}; pg8::StaticOrder S; S.init(T, pg8::P1_NQ * 256, G, bx);
            pg8::Epi1<true> E{UGQ, Vb, Kb, VBb, GBb, QSCALE, (const float*)(a.ws + WS_XS), (const float*)(a.ws + WS_CMAX1) + l * (pg8::P1_NQ * 256), (float*)(a.ws + WS_VST)};
            pg8::gemm_phase<pg8::Epi1<true>, pg8::StaticOrder, true, true, 2>(lds, g, S, E); }
        }
#endif
        GRID_SYNC();
        { WSP(UGQ, WS_UGQ) WSP(Vb, WS_V) WSW(WsB, WS_WS) WSP(Kb, WS_K) WSP(VBb, WS_VB) WSP(GBb, WS_GB)
#pragma unroll 1
        for (int st = 0; st < 2; ++st) {
            if (((st ^ vcu) & 1) == 0) {
#ifndef SKIP_BA
                for (int c = vcu; c < T / 128; c += G)
                    brancha_unit(c, UGQ, Vb, WsB, (const float*)(a.ws + WS_VST), a.in[3] + l * DM, a.in[4] + l * DM, a.in[6] + l * 8 * 128, lds);
#endif
            } else {
#ifndef SKIP_AT
#pragma unroll 1
                for (int pu2 = 2 * vcu; pu2 < 128 * 16; pu2 += 2 * G) {
#pragma unroll 1
                    for (int j2 = 0; j2 < 2; ++j2) {
                        const int pu = pu2 >> 1, bh = pu >> 3, s = pu & 7;
                        attn_unit(bh >> 4, bh & 15, j2 ? s : 15 - s, UGQ, Kb, VBb, GBb, lds);
                    }
                }
#endif
            }
        }
        if (l + 1 < DEPTH) { __syncthreads(); LAUNDER_TID convert_layer(a, l + 1, lds, gw, NGW, lane, wave); }
        }
        GRID_SYNC();
#ifndef SKIP_P25
        { WSW(WinT, WS_WIN) WSP(SMA, WS_K) WSP(SMB, WS_VB)
          const bf16* XQ = (const bf16*)((const unsigned char*)a.out + OUT_XQ);
          pg8::Gemm g{XQ, WinT + (size_t)7168 * DM, T, 2048, 512, 512}; pg8::GateOrder S; S.init(T, G, bx);
          pg8::EpiGateQ E{SMA, SMB, (const float*)(a.ws + WS_XS), (const float*)(a.ws + WS_CMAX) + l * 2048};
          pg8::gemm_phase<pg8::EpiGateQ, pg8::GateOrder, true, true, 2>(lds, g, S, E); }
        { WSW(PB, WS_PB) WSW(WeT, WS_WE) WSP(EB, WS_GB)
          int kp = PLE; asm volatile("" : "+s"(kp));
          pg8::Gemm g{PB, WeT, T, DM, kp, kp}; pg8::StaticOrder S; S.init(T, DM, G, bx);
          pg8::EpiStore<0> E{EB, EB};
          pg8::gemm_phase<pg8::EpiStore<0>, pg8::StaticOrder, true, true>(lds, g, S, E); }
#endif
#ifndef SKIP_P3
        { WSP(UGQ, WS_UGQ) WSW(W2T, WS_W2) WSP(SMA, WS_K) WSP(SMB, WS_VB) WSP(MERGED, WS_V)
          pg8::Gemm g{UGQ, W2T, T, DM, 2048, 2048}; pg8::StaticOrder S; S.init(T, DM, G, bx);
          pg8::Epi2 E{SMA, SMB, MERGED};
          pg8::gemm_phase<pg8::Epi2, pg8::StaticOrder, true, true>(lds, g, S, E);
#ifdef PROBE_DUP_P3
          pg8::gemm_phase<pg8::Epi2, pg8::StaticOrder, true, true>(lds, g, S, E);
#endif
        }
#endif
        GRID_SYNC();
#ifndef SKIP_P4
        { WSP(MERGED, WS_V) WSW(WoT, WS_WO) WSP(XH1, WS_XH1) WSP(XH, WS_XH)
          pg8::Gemm g{MERGED, WoT, T, DM, DM, DM}; pg8::StaticOrder S; S.init(T, DM, G, bx);
          pg8::Epi3 E{XH, XH1, ALPHA};
          pg8::gemm_phase<pg8::Epi3, pg8::StaticOrder, true, true>(lds, g, S, E); }
#endif
        GRID_SYNC();
#ifndef SKIP_P5
        { WSP(XH1, WS_XH1) WSW(WgT, WS_WG) WSP(EB, WS_GB) WSP(XH, WS_XH)
          pg8::Gemm g{XH1, WgT, T, DM, DM, DM}; pg8::StaticOrder S; S.init(T, DM, G, bx);
          pg8::Epi4 E{XH1, XH, EB};
          pg8::gemm_phase<pg8::Epi4, pg8::StaticOrder, true, true, true>(lds, g, S, E); }
#endif
        GRID_SYNC();
#ifdef PROBE_SYNC
        for (int z = 0; z < 10; ++z) GRID_SYNC();
#endif
        LAUNDER_TID WSP(XH, WS_XH)
        ln_rows(XH, (unsigned char*)a.out + OUT_XQ, (float*)(a.ws + WS_XS), (float*)(a.ws + WS_VST), a.out, a.in[12] + l * DM, a.in[13] + l * DM, l + 1 == DEPTH, gw, NGW, lane);
        if (l + 1 < DEPTH) GRID_SYNC();
    }
}

extern "C" void kernel_launch(void* const* d_in, const int* in_sizes, int n_in, void* d_out, int out_size, void* d_ws, size_t ws_size, hipStream_t stream) {
    static int grid = 0;
    if (grid == 0) {
        if (n_in != 14 || out_size != T * DM || ws_size < WS_END) { fprintf(stderr, "kernel_launch: unexpected shapes (n_in %d out %d ws %zu)\n", n_in, out_size, ws_size); grid = -1; return; }
        int dev = 0, cus = 0, per_cu = 0;
        hipGetDevice(&dev); hipDeviceGetAttribute(&cus, hipDeviceAttributeMultiprocessorCount, dev);
        hipFuncSetAttribute((const void*)fwd_kernel, hipFuncAttributeMaxDynamicSharedMemorySize, LDS_BYTES);
        hipOccupancyMaxActiveBlocksPerMultiprocessor(&per_cu, (const void*)fwd_kernel, 512, LDS_BYTES);
        if (per_cu < 1) per_cu = 1;
        grid = cus;
        (void)hipGetLastError();
    }
    if (grid < 0) return;
    Args a{};
    for (int i = 0; i < 14; ++i) a.in[i] = (const float*)d_in[i];
    a.out = (float*)d_out; a.ws = (unsigned char*)d_ws;
    hipMemsetAsync((char*)d_ws + WS_BARW, 0, 16384 + 4 * (2048 + pg8::P1_NQ * 256) * sizeof(float), stream);
    void* args[] = {&a};
    hipError_t e = hipLaunchCooperativeKernel((const void*)fwd_kernel, dim3(grid), dim3(512), args, LDS_BYTES, stream);
    if (e != hipSuccess) fprintf(stderr, "cooperative launch failed: %s (grid %d)\n", hipGetErrorString(e), grid);
}
```
